# Optimizing an MI355X kernel written in HIP

```python
import jax
import jax.numpy as jnp
from jax import lax
import numpy as np


D_MODEL = 1024
BATCH = 8
SEQ = 8192
DEPTH = 4

MEM_LEN = 256
EPS = 1e-6
N_EVEN = (DEPTH + 1) // 2
N_ODD = DEPTH // 2

MLSTM_HEADS = 4
MLSTM_DQK = 64
MLSTM_DV = 128
MLSTM_CHUNK = 64
GATE_SOFTCAP = 15.0

SB_HEADS = 4
SB_DH = 128
SB_BLOCK = 128

GDN_HEADS = 8
GDN_DK = 128
GDN_DV = 128
GDN_CONV = 4
GDN_CHUNK = 64

XA_HEADS = 4
XA_DH = D_MODEL // XA_HEADS
D_FF = 4 * D_MODEL

ML_QK = MLSTM_HEADS * MLSTM_DQK
ML_V = MLSTM_HEADS * MLSTM_DV
SB_W = SB_HEADS * SB_DH
AB_SIZES = (ML_QK, ML_QK, ML_V, ML_V, MLSTM_HEADS, MLSTM_HEADS, SB_W, SB_W, SB_W)
AB_IN = sum(AB_SIZES)
AB_OUT = ML_V + SB_W

GDN_QK = GDN_HEADS * GDN_DK
GDN_VW = GDN_HEADS * GDN_DV
GDN_CONV_CH = 2 * GDN_QK + GDN_VW
C_SIZES = (GDN_CONV_CH, GDN_VW, GDN_HEADS, GDN_HEADS)
C_IN = sum(C_SIZES)

kernel_name = 'hybrid_mlstm_stickbreak_gdn_memxattn'


def _split(y, sizes):
    return jnp.split(y, np.cumsum(sizes)[:-1].tolist(), axis=-1)


def rmsnorm(x, g):
    xf = x.astype(jnp.float32)
    y = xf * lax.rsqrt(jnp.mean(xf * xf, axis=-1, keepdims=True) + EPS)
    return (y * g.astype(jnp.float32)).astype(x.dtype)


def l2norm(x):
    xf = x.astype(jnp.float32)
    return xf * lax.rsqrt(jnp.sum(xf * xf, axis=-1, keepdims=True) + EPS)


def _to_chunks(a, L):
    B, T = a.shape[0], a.shape[1]
    a = a.reshape((B, T // L, L) + a.shape[2:])
    return jnp.moveaxis(a, (1, 3), (0, 2))


def _from_chunks(a):
    a = jnp.moveaxis(a, (0, 2), (1, 3))
    nc, L = a.shape[1], a.shape[2]
    return a.reshape((a.shape[0], nc * L) + a.shape[3:])


def mlstm(q, k, v, i_pre, f_pre):
    f32 = jnp.float32
    B, T, H, dk = q.shape
    dv = v.shape[-1]
    L = MLSTM_CHUNK
    log_i = GATE_SOFTCAP * jnp.tanh(i_pre.astype(f32) / GATE_SOFTCAP)
    log_f = jax.nn.log_sigmoid(f_pre.astype(f32))
    xs = (_to_chunks(q.astype(f32), L),
          _to_chunks(k.astype(f32) * (dk ** -0.5), L),
          _to_chunks(v.astype(f32), L),
          _to_chunks(log_i, L),
          _to_chunks(log_f, L))
    causal = jnp.tril(jnp.ones((L, L), dtype=bool))

    def step(carry, inp):
        C, n, m = carry
        qc, kc, vc, li, lf = inp
        b = jnp.cumsum(lf, axis=-1)
        d = jnp.where(causal, b[..., :, None] - b[..., None, :] + li[..., None, :], -jnp.inf)
        inter = b + m[..., None]
        m_t = jnp.maximum(inter, jnp.max(d, axis=-1))
        w_inter = jnp.exp(inter - m_t)
        s = jnp.einsum('bhtd,bhsd->bhts', qc, kc) * jnp.exp(d - m_t[..., None])
        num = jnp.einsum('bhts,bhsv->bhtv', s, vc) + w_inter[..., None] * jnp.einsum('bhvd,bhtd->bhtv', C, qc)
        den = jnp.sum(s, axis=-1) + w_inter * jnp.einsum('bhd,bhtd->bht', n, qc)
        h = num / jnp.maximum(jnp.abs(den), jnp.exp(-m_t))[..., None]
        m_new = m_t[..., -1]
        w_old = jnp.exp(b[..., -1] + m - m_new)
        w_s = jnp.exp(b[..., -1:] - b + li - m_new[..., None])
        C = w_old[..., None, None] * C + jnp.einsum('bhsv,bhsd->bhvd', vc * w_s[..., None], kc)
        n = w_old[..., None] * n + jnp.einsum('bhs,bhsd->bhd', w_s, kc)
        return (C, n, m_new), h

    init = (jnp.zeros((B, H, dv, dk), f32), jnp.zeros((B, H, dk), f32), jnp.zeros((B, H), f32))
    _, h = lax.scan(step, init, xs)
    return _from_chunks(h)


def stick_breaking(q, k, v):
    f32 = jnp.float32
    B, T, H, dh = q.shape
    scale = dh ** -0.5
    qf, kf, vf = q.astype(f32), k.astype(f32), v.astype(f32)
    outs = []
    for t0 in range(0, T, SB_BLOCK):
        t1 = t0 + SB_BLOCK
        z = jnp.einsum('bqhd,bkhd->bhqk', qf[:, t0:t1], kf[:, :t1]) * scale
        qpos = t0 + jnp.arange(SB_BLOCK)
        kpos = jnp.arange(t1)
        strict = kpos[None, :] < qpos[:, None]
        log_beta = jnp.where(strict, jax.nn.log_sigmoid(z), -jnp.inf)
        log_1m = jnp.where(strict, jax.nn.log_sigmoid(-z), 0.0)
        acc = lax.cumsum(log_1m, axis=3, reverse=True) - log_1m
        w = jnp.exp(log_beta + acc)
        outs.append(jnp.einsum('bhqk,bkhd->bqhd', w, vf[:, :t1]))
    return jnp.concatenate(outs, axis=1)


def short_conv(x, w):
    K = w.shape[0]
    T = x.shape[1]
    xp = jnp.pad(x, ((0, 0), (K - 1, 0), (0, 0)))
    return sum(xp[:, j:j + T] * w[j] for j in range(K))


def gated_deltanet(q, k, v, beta, log_alpha):
    f32 = jnp.float32
    B, T, H, dk = q.shape
    dv = v.shape[-1]
    L = GDN_CHUNK
    qc = _to_chunks(q.astype(f32) * (dk ** -0.5), L)
    kc = _to_chunks(k.astype(f32), L)
    vc = _to_chunks(v.astype(f32), L)
    bc = _to_chunks(beta.astype(f32), L)
    g = jnp.cumsum(_to_chunks(log_alpha.astype(f32), L), axis=-1)
    incl = jnp.tril(jnp.ones((L, L), dtype=bool))
    strict = jnp.tril(jnp.ones((L, L), dtype=bool), k=-1)
    decay = jnp.where(incl, jnp.exp(jnp.where(incl, g[..., :, None] - g[..., None, :], 0.0)), 0.0)
    kk = jnp.einsum('nbhtd,nbhsd->nbhts', kc, kc)
    lower = jnp.where(strict, bc[..., :, None] * kk * decay, 0.0)
    eye = jnp.eye(L, dtype=f32)
    rhs = jnp.concatenate([vc * bc[..., None], kc * (bc * jnp.exp(g))[..., None]], axis=-1)
    sol = lax.linalg.triangular_solve(lower + eye, rhs, left_side=True, lower=True, unit_diagonal=True)
    u_c, w_c = sol[..., :dv], sol[..., dv:]
    attn = jnp.einsum('nbhtd,nbhsd->nbhts', qc, kc) * decay
    q_dec = qc * jnp.exp(g)[..., None]
    g_last = g[..., -1]
    k_dec = kc * jnp.exp(g_last[..., None] - g)[..., None]

    def step(S, inp):
        u, wk, att, qd, kd, gl = inp
        v_new = u - jnp.einsum('bhtk,bhkv->bhtv', wk, S)
        o = jnp.einsum('bhtk,bhkv->bhtv', qd, S) + jnp.einsum('bhts,bhsv->bhtv', att, v_new)
        S = S * jnp.exp(gl)[..., None, None] + jnp.einsum('bhsk,bhsv->bhkv', kd, v_new)
        return S, o

    S0 = jnp.zeros((B, H, dk, dv), f32)
    _, o = lax.scan(step, S0, (u_c, w_c, attn, q_dec, k_dec, g_last))
    return _from_chunks(o)


def ab_mixer(h, w_in, b_i, b_f, head_gain, w_out):
    B, T, _ = h.shape
    mq, mk, mv, mo, mi, mf, sq, sk, sv = _split(h @ w_in, AB_SIZES)
    hm = mlstm(mq.reshape(B, T, MLSTM_HEADS, MLSTM_DQK),
               mk.reshape(B, T, MLSTM_HEADS, MLSTM_DQK),
               mv.reshape(B, T, MLSTM_HEADS, MLSTM_DV),
               mi + b_i, mf + b_f)
    hm = rmsnorm(hm, head_gain) * jax.nn.sigmoid(mo.reshape(B, T, MLSTM_HEADS, MLSTM_DV).astype(jnp.float32))
    hs = stick_breaking(sq.reshape(B, T, SB_HEADS, SB_DH),
                        sk.reshape(B, T, SB_HEADS, SB_DH),
                        sv.reshape(B, T, SB_HEADS, SB_DH))
    out = jnp.concatenate([hm.reshape(B, T, ML_V), hs.reshape(B, T, SB_W)], axis=-1).astype(h.dtype)
    return out @ w_out


def c_mixer(h, w_in, conv_w, a_log, dt_bias, head_gain, w_out):
    B, T, _ = h.shape
    qkv, gate, b, a = _split(h @ w_in, C_SIZES)
    qkv = jax.nn.silu(short_conv(qkv, conv_w))
    q, k, v = _split(qkv, (GDN_QK, GDN_QK, GDN_VW))
    q = l2norm(q.reshape(B, T, GDN_HEADS, GDN_DK))
    k = l2norm(k.reshape(B, T, GDN_HEADS, GDN_DK))
    v = v.reshape(B, T, GDN_HEADS, GDN_DV)
    beta = jax.nn.sigmoid(b.astype(jnp.float32))
    log_alpha = -jnp.exp(a_log.astype(jnp.float32)) * jax.nn.softplus(a.astype(jnp.float32) + dt_bias.astype(jnp.float32))
    o = gated_deltanet(q, k, v, beta, log_alpha)
    o = rmsnorm(o, head_gain) * jax.nn.silu(gate.reshape(B, T, GDN_HEADS, GDN_DV).astype(jnp.float32))
    return o.reshape(B, T, GDN_VW).astype(h.dtype) @ w_out


def mem_cross_attn(h, memn, wq, wk, wv, wo):
    B, T, _ = h.shape
    M = memn.shape[1]
    q = (h @ wq).reshape(B, T, XA_HEADS, XA_DH)
    k = (memn @ wk).reshape(B, M, XA_HEADS, XA_DH)
    v = (memn @ wv).reshape(B, M, XA_HEADS, XA_DH)
    s = jnp.einsum('bthd,bmhd->bhtm', q, k).astype(jnp.float32) * (XA_DH ** -0.5)
    p = jax.nn.softmax(s, axis=-1).astype(v.dtype)
    o = jnp.einsum('bhtm,bmhd->bthd', p, v).reshape(B, T, XA_HEADS * XA_DH)
    return o @ wo


def sq_relu_mlp(h, w1, w2):
    return jnp.square(jax.nn.relu(h @ w1)) @ w2


def setup_inputs(seed: int = 0) -> dict:
    key = jax.random.key(seed)
    ks = jax.random.split(key, 32)
    f32 = jnp.float32

    def w(k, shape, fan_in):
        return jax.random.normal(k, shape, f32) * (fan_in ** -0.5)

    def gain(k, shape):
        return 1.0 + 0.02 * jax.random.normal(k, shape, f32)

    x = jax.random.normal(ks[0], (BATCH, SEQ, D_MODEL), f32)
    mem = jax.random.normal(ks[1], (BATCH, MEM_LEN, D_MODEL), f32)
    mix_norm = gain(ks[2], (DEPTH, D_MODEL))
    ab_w_in = w(ks[3], (N_EVEN, D_MODEL, AB_IN), D_MODEL)
    ab_b_i = 0.1 * jax.random.normal(ks[4], (N_EVEN, MLSTM_HEADS), f32)
    ab_b_f = jnp.linspace(3.0, 6.0, MLSTM_HEADS, dtype=f32)[None, :] + 0.1 * jax.random.normal(ks[5], (N_EVEN, MLSTM_HEADS), f32)
    ab_head_gain = gain(ks[6], (N_EVEN, MLSTM_HEADS, MLSTM_DV))
    ab_w_out = w(ks[7], (N_EVEN, AB_OUT, D_MODEL), AB_OUT)
    c_w_in = w(ks[8], (N_ODD, D_MODEL, C_IN), D_MODEL)
    c_conv_w = w(ks[9], (N_ODD, GDN_CONV, GDN_CONV_CH), GDN_CONV)
    c_a_log = jnp.log(jax.random.uniform(ks[10], (N_ODD, GDN_HEADS), f32, 1.0, 16.0))
    dt = jnp.exp(jax.random.uniform(ks[11], (N_ODD, GDN_HEADS), f32, float(np.log(1e-3)), float(np.log(1e-1))))
    c_dt_bias = dt + jnp.log(-jnp.expm1(-dt))
    c_head_gain = gain(ks[12], (N_ODD, GDN_DV))
    c_w_out = w(ks[13], (N_ODD, GDN_VW, D_MODEL), GDN_VW)
    xa_norm = gain(ks[14], (DEPTH, D_MODEL))
    mem_norm = gain(ks[15], (D_MODEL,))
    xa_wq = w(ks[16], (DEPTH, D_MODEL, D_MODEL), D_MODEL)
    xa_wk = w(ks[17], (DEPTH, D_MODEL, D_MODEL), D_MODEL)
    xa_wv = w(ks[18], (DEPTH, D_MODEL, D_MODEL), D_MODEL)
    xa_wo = w(ks[19], (DEPTH, D_MODEL, D_MODEL), D_MODEL)
    mlp_norm = gain(ks[20], (DEPTH, D_MODEL))
    mlp_w1 = w(ks[21], (DEPTH, D_MODEL, D_FF), D_MODEL)
    mlp_w2 = w(ks[22], (DEPTH, D_FF, D_MODEL), D_FF)
    final_norm = gain(ks[23], (D_MODEL,))
    return {'x': x, 'mem': mem, 'mix_norm': mix_norm,
            'ab_w_in': ab_w_in, 'ab_b_i': ab_b_i, 'ab_b_f': ab_b_f,
            'ab_head_gain': ab_head_gain, 'ab_w_out': ab_w_out,
            'c_w_in': c_w_in, 'c_conv_w': c_conv_w, 'c_a_log': c_a_log,
            'c_dt_bias': c_dt_bias, 'c_head_gain': c_head_gain, 'c_w_out': c_w_out,
            'xa_norm': xa_norm, 'mem_norm': mem_norm, 'xa_wq': xa_wq, 'xa_wk': xa_wk,
            'xa_wv': xa_wv, 'xa_wo': xa_wo, 'mlp_norm': mlp_norm, 'mlp_w1': mlp_w1,
            'mlp_w2': mlp_w2, 'final_norm': final_norm}


def reference(x, mem, mix_norm, ab_w_in, ab_b_i, ab_b_f, ab_head_gain, ab_w_out,
              c_w_in, c_conv_w, c_a_log, c_dt_bias, c_head_gain, c_w_out,
              xa_norm, mem_norm, xa_wq, xa_wk, xa_wv, xa_wo,
              mlp_norm, mlp_w1, mlp_w2, final_norm):
    memn = rmsnorm(mem, mem_norm)
    for l in range(DEPTH):
        j = l // 2
        h = rmsnorm(x, mix_norm[l])
        if l % 2 == 0:
            x = x + ab_mixer(h, ab_w_in[j], ab_b_i[j], ab_b_f[j], ab_head_gain[j], ab_w_out[j])
        else:
            x = x + c_mixer(h, c_w_in[j], c_conv_w[j], c_a_log[j], c_dt_bias[j], c_head_gain[j], c_w_out[j])
        x = x + mem_cross_attn(rmsnorm(x, xa_norm[l]), memn, xa_wq[l], xa_wk[l], xa_wv[l], xa_wo[l])
        x = x + sq_relu_mlp(rmsnorm(x, mlp_norm[l]), mlp_w1[l], mlp_w2[l])
    return rmsnorm(x, final_norm)
```

```cpp
#include <hip/hip_runtime.h>
#include <cstdio>
#include <cstdint>
namespace pg8 {
#define PG8_LAS __attribute__((address_space(3)))
typedef unsigned short bf16_t;
typedef short bf16x8 __attribute__((ext_vector_type(8)));
typedef float f32x4 __attribute__((ext_vector_type(4)));
typedef unsigned u32x4 __attribute__((ext_vector_type(4)));
constexpr int BM = 256, BK = 64, HALF = 128, HTB = HALF * BK * 2  , STAGE_BYTES = 8 * HTB, NXCD = 8, WGM = 8;

__host__ __device__ __forceinline__ int lds_byte(int r, int c) { const int st = (r >> 4) * 2 + (c >> 5), rr = r & 15, cc = c & 31, ob = rr * 64 + cc * 2; return st * 1024 + (ob ^ (((ob >> 9) & 1) << 5)); }
__host__ __device__ __forceinline__ void stage_rc(int b, int& R, int& C) { const int st = b / 1024, sb = b % 1024, swz = sb ^ (((sb >> 9) & 1) << 5); R = (st >> 1) * 16 + swz / 64; C = (st & 1) * 32 + (swz % 64) / 2; }
__host__ __device__ __forceinline__ int perm32(int rho) { const int n = rho >> 4, i = rho & 15; return 8 * (i >> 2) + 4 * n + (i & 3); }

struct Unit { int pm, pn; };
struct Gemm { const bf16_t* A; const bf16_t* Bt; int M, N, K; };

struct StaticOrder {
    int nM, nN, nwg, G, c;
    __host__ __device__ void init(int M, int N, int G_, int c_) { nM = M / BM; nN = N / BM; nwg = nM * nN; G = G_; c = c_; }
    __host__ __device__ bool next(int i, Unit& u) const {
        const long L = (long)i * G + c; if (L >= nwg) return false;
        int wgid = (int)L; { const int q = nwg / NXCD, r = nwg % NXCD, xcd = wgid % NXCD, off = wgid / NXCD; wgid = (xcd < r ? xcd * (q + 1) : r * (q + 1) + (xcd - r) * q) + off; }
        const int nig = WGM * nN, gid = wgid / nig, fm = gid * WGM, gsz = (nM - fm) < WGM ? (nM - fm) : WGM;
        u.pm = fm + ((wgid % nig) % gsz); u.pn = (wgid % nig) / gsz; return true;
    }
    __device__ __forceinline__ void a_ready(const Unit&) const {}
    __device__ __forceinline__ void done(const Unit&) const {}
};

__device__ __forceinline__ unsigned cvt_pk_bf16(float lo, float hi) { unsigned r; asm volatile("v_cvt_pk_bf16_f32 %0, %1, %2" : "=v"(r) : "v"(lo), "v"(hi)); return r; }
template <int ACT> struct EpiBf16 {
    static constexpr bool PERM = true, AFTER_DRAIN = false;
    bf16_t* O; int ldc;
    __device__ __forceinline__ void operator()(const f32x4 (&acc)[2][2][4][2], const Unit& u, int wr, int wc, int fr, int fq) const {
        const int row0 = u.pm * BM + wr * 64 + fr; const int col0 = u.pn * BM + wc * 32 + 8 * fq;
#pragma unroll
        for (int ai = 0; ai < 2; ++ai)
#pragma unroll
            for (int m = 0; m < 4; ++m) { bf16_t* rowp = O + (size_t)(row0 + ai * HALF + m * 16) * ldc + col0;
#pragma unroll
                for (int bj = 0; bj < 2; ++bj) { f32x4 v0 = acc[ai][bj][m][0], v1 = acc[ai][bj][m][1];
                    if (ACT == 2) {
#pragma unroll
                        for (int j = 0; j < 4; ++j) { const float a = fmaxf(v0[j], 0.f), b = fmaxf(v1[j], 0.f); v0[j] = a * a; v1[j] = b * b; } }
                    u32x4 w; w.x = cvt_pk_bf16(v0[0], v0[1]); w.y = cvt_pk_bf16(v0[2], v0[3]); w.z = cvt_pk_bf16(v1[0], v1[1]); w.w = cvt_pk_bf16(v1[2], v1[3]);
                    *(u32x4*)(rowp + bj * HALF) = w; } }
    }
};
struct EpiResid {
    static constexpr bool PERM = false, AFTER_DRAIN = false;
    const float* base; float* out; int ldc;
    __device__ __forceinline__ void operator()(const f32x4 (&acc)[2][2][4][2], const Unit& u, int wr, int wc, int fr, int fq) const {
        const int row0 = u.pm * BM + wr * 64 + fr, col0 = u.pn * BM + wc * 32 + 4 * fq;
#pragma unroll
        for (int ai = 0; ai < 2; ++ai)
#pragma unroll
            for (int m = 0; m < 4; ++m) { const size_t off = (size_t)(row0 + ai * HALF + m * 16) * ldc + col0;
#pragma unroll
                for (int bj = 0; bj < 2; ++bj)
#pragma unroll
                    for (int n = 0; n < 2; ++n) { const f32x4 bs = *(const f32x4*)(base + off + bj * HALF + n * 16); *(f32x4*)(out + off + bj * HALF + n * 16) = bs + acc[ai][bj][m][n]; }
                if (m & 1) asm volatile("" ::: "memory"); }
    }
};
template <class Epi, class Sched, bool ALIGN_EPI = false, bool SP2 = false>
__device__ __forceinline__ void gemm_phase(PG8_LAS unsigned char* lds, const Gemm g, const Sched& S, const Epi& E, int tid_in) {
    int tid_ = tid_in; asm volatile("" : "+v"(tid_)); const int tid = tid_, wid = __builtin_amdgcn_readfirstlane(tid >> 6), lane = tid & 63, wr = wid >> 2, wc = wid & 3, fr = lane & 15, fq = lane >> 4;
    const int K = g.K, nt = K / BK;
    unsigned voffA[2], voffB[2];
#pragma unroll
    for (int i = 0; i < 2; ++i) { int R, C; stage_rc(tid * 16 + i * 8192, R, C); const int Rb = Epi::PERM ? ((R & ~31) + perm32(R & 31)) : R;
        voffA[i] = (unsigned)(R * K + C) * 2u; voffB[i] = (unsigned)(Rb * K + C) * 2u; }
    const size_t kstep = (size_t)(BK * 2);
    const size_t hstep = (size_t)HALF * K * 2;
    const size_t tstep = 2 * hstep;
    const unsigned ldsw = (unsigned)wid * 1024u;
    const int aoff = lds_byte(wr * 64 + fr, fq * 8), boff = lds_byte(wc * 32 + fr, fq * 8);
#define PG8_SA(b, h) (((b) * 2 + (h)) * HTB)
#define PG8_SB(b, h) ((4 + (b) * 2 + (h)) * HTB)
#define PG8_STAGE(bufoff, gbase, voff) do { _Pragma("unroll") for (int _i = 0; _i < 2; ++_i) \
        __builtin_amdgcn_global_load_lds((const unsigned*)((const char*)(gbase) + (voff)[_i]), (PG8_LAS unsigned*)(lds + (bufoff) + ldsw + _i * 8192), 16, 0, 0); } while (0)
#define PG8_LDA(dst, b, h) do { _Pragma("unroll") for (int m = 0; m < 4; ++m) _Pragma("unroll") for (int k = 0; k < 2; ++k) dst[m][k] = *(const PG8_LAS bf16x8*)(lds + PG8_SA(b, h) + aoff + m * 2048 + k * 1024); } while (0)
#define PG8_LDB(dst, b, h) do { _Pragma("unroll") for (int n = 0; n < 2; ++n) _Pragma("unroll") for (int k = 0; k < 2; ++k) dst[n][k] = *(const PG8_LAS bf16x8*)(lds + PG8_SB(b, h) + boff + n * 2048 + k * 1024); } while (0)
#define PG8_MMA(ai, bj, At, Bt) do { __builtin_amdgcn_s_setprio(1); _Pragma("unroll") for (int m = 0; m < 4; ++m) _Pragma("unroll") for (int n = 0; n < 2; ++n) _Pragma("unroll") for (int k = 0; k < 2; ++k) \
        acc[ai][bj][m][n] = __builtin_amdgcn_mfma_f32_16x16x32_bf16(Bt[n][k], At[m][k], acc[ai][bj][m][n], 0, 0, 0); __builtin_amdgcn_s_setprio(0); } while (0)
#define PG8_WAIT_V(n) asm volatile("s_waitcnt vmcnt(" #n ")" ::: "memory")
#define PG8_WAIT_L(n) asm volatile("s_waitcnt lgkmcnt(" #n ")" ::: "memory")
#define PG8_BAR __builtin_amdgcn_s_barrier()
#define PG8_SCHED __builtin_amdgcn_sched_barrier(0)
    Unit cur, nxt; int ui = 0;
    if (!S.next(0, cur)) return;
    f32x4 acc[2][2][4][2];
#pragma unroll
    for (int a = 0; a < 2; ++a)
#pragma unroll
        for (int b = 0; b < 2; ++b)
#pragma unroll
            for (int m = 0; m < 4; ++m)
#pragma unroll
                for (int n = 0; n < 2; ++n) acc[a][b][m][n] = (f32x4){0.f, 0.f, 0.f, 0.f};
    bf16x8 At[4][2], B0[2][2], B1[2][2];
    const char* cA = (const char*)g.A + (size_t)cur.pm * tstep; const char* cB = (const char*)g.Bt + (size_t)cur.pn * tstep;
    S.a_ready(cur);
    if constexpr (SP2) {
        PG8_STAGE(PG8_SB(0, 0), cB, voffB); PG8_STAGE(PG8_SB(0, 1), cB + hstep, voffB); PG8_STAGE(PG8_SA(0, 0), cA, voffA); PG8_STAGE(PG8_SA(0, 1), cA + hstep, voffA);
        if (wr == 1) PG8_BAR;
        PG8_WAIT_V(2); PG8_BAR;
        PG8_STAGE(PG8_SB(1, 0), cB + kstep, voffB); PG8_STAGE(PG8_SA(1, 0), cA + kstep, voffA); PG8_STAGE(PG8_SB(1, 1), cB + hstep + kstep, voffB);
        PG8_WAIT_V(6); PG8_BAR;
    } else {
        PG8_STAGE(PG8_SB(0, 0), cB, voffB); PG8_STAGE(PG8_SA(0, 0), cA, voffA); PG8_STAGE(PG8_SB(0, 1), cB + hstep, voffB); PG8_STAGE(PG8_SA(0, 1), cA + hstep, voffA);
        if (wr == 1) PG8_BAR;
        PG8_WAIT_V(4); PG8_BAR;
        PG8_STAGE(PG8_SB(1, 0), cB + kstep, voffB); PG8_STAGE(PG8_SA(1, 0), cA + kstep, voffA); PG8_STAGE(PG8_SB(1, 1), cB + hstep + kstep, voffB);
        PG8_WAIT_V(6); PG8_BAR;
    }
    for (;;) {
        const bool has_next = S.next(ui + 1, nxt);
        const char* nA = has_next ? (const char*)g.A + (size_t)nxt.pm * tstep : cA; const char* nB = has_next ? (const char*)g.Bt + (size_t)nxt.pn * tstep : cB;
        for (int t = 0; t < nt; t += 2) {
            const bool last = (t == nt - 2);
            const char* a1 = cA + (size_t)(t + 1) * kstep;
            const char* a2 = last ? nA : cA + (size_t)(t + 2) * kstep; const char* b2 = last ? nB : cB + (size_t)(t + 2) * kstep;
            const char* a3 = a2 + kstep; const char* b3 = b2 + kstep;
            if (last && has_next) S.a_ready(nxt);
            if constexpr (SP2) {
            PG8_LDB(B0, 0, 0); PG8_LDB(B1, 0, 1); PG8_SCHED; PG8_LDA(At, 0, 0); PG8_STAGE(PG8_SA(1, 1), a1 + hstep, voffA);
            PG8_WAIT_V(8); PG8_WAIT_L(0); PG8_BAR; PG8_MMA(0, 0, At, B0); PG8_MMA(0, 1, At, B1); PG8_BAR; PG8_SCHED;
            PG8_LDA(At, 0, 1); PG8_STAGE(PG8_SB(0, 0), b2, voffB); PG8_STAGE(PG8_SB(0, 1), b2 + hstep, voffB); PG8_STAGE(PG8_SA(0, 0), a2, voffA);
            PG8_WAIT_V(8); PG8_WAIT_L(0); PG8_BAR; PG8_MMA(1, 0, At, B0); PG8_MMA(1, 1, At, B1); PG8_BAR; PG8_SCHED;
            PG8_LDB(B0, 1, 0); PG8_LDB(B1, 1, 1); PG8_SCHED; PG8_LDA(At, 1, 0); PG8_STAGE(PG8_SA(0, 1), a2 + hstep, voffA);
            PG8_WAIT_V(8); PG8_WAIT_L(0); PG8_BAR; PG8_MMA(0, 0, At, B0); PG8_MMA(0, 1, At, B1); PG8_BAR; PG8_SCHED;
            PG8_LDA(At, 1, 1); PG8_STAGE(PG8_SB(1, 0), b3, voffB); PG8_STAGE(PG8_SB(1, 1), b3 + hstep, voffB); PG8_STAGE(PG8_SA(1, 0), a3, voffA);
            PG8_WAIT_V(8); PG8_WAIT_L(0); PG8_BAR; PG8_MMA(1, 0, At, B0); PG8_MMA(1, 1, At, B1); PG8_BAR; PG8_SCHED;
            } else {
            PG8_LDB(B0, 0, 0); PG8_SCHED; PG8_LDA(At, 0, 0); PG8_STAGE(PG8_SA(1, 1), a1 + hstep, voffA);
            PG8_WAIT_L(8); PG8_BAR; PG8_WAIT_L(0); PG8_MMA(0, 0, At, B0); PG8_BAR; PG8_SCHED;
            PG8_LDB(B1, 0, 1); PG8_STAGE(PG8_SB(0, 0), b2, voffB);
            PG8_BAR; PG8_WAIT_L(0); PG8_MMA(0, 1, At, B1); PG8_BAR;
            PG8_LDA(At, 0, 1); PG8_STAGE(PG8_SA(0, 0), a2, voffA);
            PG8_BAR; PG8_WAIT_L(0); PG8_MMA(1, 0, At, B0); PG8_BAR; PG8_SCHED;
            PG8_STAGE(PG8_SB(0, 1), b2 + hstep, voffB);
            PG8_WAIT_V(6); PG8_BAR; PG8_MMA(1, 1, At, B1); PG8_BAR;
            PG8_LDB(B0, 1, 0); PG8_SCHED; PG8_LDA(At, 1, 0); PG8_STAGE(PG8_SA(0, 1), a2 + hstep, voffA);
            PG8_WAIT_L(8); PG8_BAR; PG8_WAIT_L(0); PG8_MMA(0, 0, At, B0); PG8_BAR; PG8_SCHED;
            PG8_LDB(B1, 1, 1); PG8_STAGE(PG8_SB(1, 0), b3, voffB);
            PG8_BAR; PG8_WAIT_L(0); PG8_MMA(0, 1, At, B1); PG8_BAR;
            PG8_LDA(At, 1, 1); PG8_STAGE(PG8_SA(1, 0), a3, voffA);
            PG8_BAR; PG8_WAIT_L(0); PG8_MMA(1, 0, At, B0); PG8_BAR; PG8_SCHED;
            PG8_STAGE(PG8_SB(1, 1), b3 + hstep, voffB);
            PG8_WAIT_V(6); PG8_BAR; PG8_MMA(1, 1, At, B1); PG8_BAR;
            }
        }
        if constexpr (ALIGN_EPI) { if (wr == 0) PG8_BAR; }
        if constexpr (!Epi::AFTER_DRAIN) { E(acc, cur, wr, wc, fr, fq); S.done(cur); }
        if (!has_next) break;
#pragma unroll
        for (int a = 0; a < 2; ++a)
#pragma unroll
            for (int b = 0; b < 2; ++b)
#pragma unroll
                for (int m = 0; m < 4; ++m)
#pragma unroll
                    for (int n = 0; n < 2; ++n) acc[a][b][m][n] = (f32x4){0.f, 0.f, 0.f, 0.f};
        cur = nxt; cA = nA; cB = nB; ++ui;
        if constexpr (ALIGN_EPI) { if (wr == 1) PG8_BAR; }
    }
    PG8_WAIT_V(0);
    if constexpr (!ALIGN_EPI) { if (wr == 0) PG8_BAR; }
    PG8_BAR;
    if constexpr (Epi::AFTER_DRAIN) { E.fused(acc, cur, wr, wc, fr, fq, lds, wid, lane); S.done(cur); }
#undef PG8_SA
#undef PG8_SB
#undef PG8_STAGE
#undef PG8_LDA
#undef PG8_LDB
#undef PG8_MMA
#undef PG8_WAIT_V
#undef PG8_WAIT_L
#undef PG8_BAR
#undef PG8_SCHED
}
}
#ifndef PG8_SP2
#define PG8_SP2 true
#endif
#ifndef PG8_ALIGN
#define PG8_ALIGN true
#endif
constexpr int NWAVES = 8, NTHR = 512;
constexpr int BATCH = 8, T = 8192, D = 1024, DEPTH = 4, MEMLEN = 256, FF = 4096;
constexpr int M = BATCH * T;
constexpr int AB_IN = 3080, AB_N = 3072, C_IN = 4112, C_N = 4096;
constexpr float EPS = 1e-6f;
constexpr float SB_THR = 88.0f;

constexpr size_t MiB = 1u << 20;
constexpr size_t WS_CTL = 0, CTL_ZERO_BYTES = 1 * MiB;
constexpr size_t WS_WG = 1 * MiB;
constexpr size_t WS_MEMN = 2 * MiB;
constexpr size_t WS_WKV = 6 * MiB;
constexpr size_t WS_W = 22 * MiB, W_LAYER = 30 * MiB;
constexpr size_t WO_WIN = 0, WO_WOUT = 8 * MiB, WO_WQ = 10 * MiB, WO_WO = 12 * MiB, WO_W1 = 14 * MiB, WO_W2 = 22 * MiB;
constexpr size_t WS_KVX = 142 * MiB;
constexpr size_t WS_GATE = 174 * MiB;
constexpr size_t WS_H = 178 * MiB;
constexpr size_t WS_MIX = 306 * MiB;
constexpr size_t WS_BIG = 434 * MiB;
constexpr size_t WS_END = 946 * MiB;
constexpr int CW_TMO = 0, CW_BAR = 4096;

constexpr int LDS_BYTES = 147456;
constexpr int MISC_OFF = 140 * 1024;

#define GAS __attribute__((address_space(1)))
#define LAS __attribute__((address_space(3)))
#define DI __device__ __forceinline__
typedef unsigned short bf16;
typedef unsigned v4u __attribute__((ext_vector_type(4)));
typedef unsigned v2u __attribute__((ext_vector_type(2)));
typedef float f32x4 __attribute__((ext_vector_type(4)));
typedef short bf16x8 __attribute__((ext_vector_type(8)));
typedef short s16x4 __attribute__((ext_vector_type(4)));
#define LDS_WAIT() asm volatile("s_waitcnt lgkmcnt(0)" ::: "memory")
DI unsigned f2bf(float f) { unsigned u = __builtin_bit_cast(unsigned, f); return (u + 0x7fffu + ((u >> 16) & 1u)) >> 16; }
DI unsigned pk2(float lo, float hi) { return f2bf(lo) | (f2bf(hi) << 16); }
DI float bf2f(unsigned short b) { return __builtin_bit_cast(float, ((unsigned)b) << 16); }
DI float bflo(unsigned u) { return __builtin_bit_cast(float, u << 16); }
DI float bfhi(unsigned u) { return __builtin_bit_cast(float, u & 0xffff0000u); }
DI float wave_sum(float v) {
#pragma unroll
    for (int o = 1; o < 64; o <<= 1) v += __shfl_xor(v, o);
    return v;
}
DI float sigmoidf_(float x) { return 1.0f / (1.0f + __expf(-x)); }
DI f32x4 mfma16(bf16x8 a, bf16x8 b, f32x4 c) { return __builtin_amdgcn_mfma_f32_16x16x32_bf16(a, b, c, 0, 0, 0); }
#define XB_TMO      128
#define XB_XCNT(j)  (256  + 64 * (j))
#define XB_XSUB(j)  (1280 + 64 * (j))
#define XB_XGEN(j)  (2304 + 64 * (j))
#define XB_TOP      3328
#define XB_TOPGEN   3392
#define XCD_BAR_WORDS 3456
#define XB_SPIN_CAP (1u << 18)

__device__ __forceinline__ unsigned xb_ld(unsigned* p)              { return __hip_atomic_load(p, __ATOMIC_RELAXED, __HIP_MEMORY_SCOPE_AGENT); }
__device__ __forceinline__ unsigned xb_add(unsigned* p, unsigned v) { return __hip_atomic_fetch_add(p, v, __ATOMIC_RELAXED, __HIP_MEMORY_SCOPE_AGENT); }
__device__ __forceinline__ unsigned xb_xcc_id() { return (unsigned)__builtin_amdgcn_s_getreg((3 << 11) | 20) & 0xFu; }
#define XB_SPIN(cond, bar) do { unsigned _sp = 0; while (cond) { __builtin_amdgcn_s_sleep(1); \
    if ((++_sp & 255u) == 0u) { if (xb_ld(&(bar)[XB_TMO])) break; if (_sp > XB_SPIN_CAP) { atomicAdd(&(bar)[XB_TMO], 1u); break; } } } } while (0)

struct XcdBarrier {
    unsigned* bar; unsigned x;
    volatile LAS unsigned* st;
};

__device__ __forceinline__ XcdBarrier xcd_barrier_post(unsigned* bar, volatile LAS unsigned* st) {
    XcdBarrier b; b.bar = bar; b.x = xb_xcc_id(); b.st = st;
    if (threadIdx.x == 0) (void)xb_add(&bar[XB_XCNT(b.x)], 1u);
    return b;
}
__device__ __forceinline__ void xcd_barrier_complete(unsigned* bar, unsigned x, unsigned& nloc, unsigned& nx) {
    const unsigned G = gridDim.x * gridDim.y * gridDim.z;
    unsigned sum, cnt, mine, sp = 0u;
    for (;;) {
        sum = 0u; cnt = 0u; mine = 0u;
#pragma unroll
        for (unsigned j = 0; j < 16; ++j) { const unsigned c = xb_ld(&bar[XB_XCNT(j)]); sum += c; cnt += (c > 0u) ? 1u : 0u; mine = (j == x) ? c : mine; }
        if (sum == G) break;
        __builtin_amdgcn_s_sleep(1);
        if ((++sp & 255u) == 0u) { if (xb_ld(&bar[XB_TMO])) break; if (sp > XB_SPIN_CAP) { atomicAdd(&bar[XB_TMO], 1u); break; } }
    }
    nloc = mine > 0u ? mine : 1u; nx = cnt > 0u ? cnt : 1u;
}

__device__ __forceinline__ void xcd_barrier(const XcdBarrier& b) {
    asm volatile("s_waitcnt vmcnt(0)" ::: "memory");
    __syncthreads();
    if (threadIdx.x == 0) {
        unsigned* bar = b.bar;
        __builtin_amdgcn_s_waitcnt(0);
        unsigned nloc = b.st[0], nx = b.st[1];
        if (nloc == 0u) { xcd_barrier_complete(bar, b.x, nloc, nx); b.st[0] = nloc; b.st[1] = nx; }
        const unsigned old = xb_add(&bar[XB_XSUB(b.x)], 1u);
        const unsigned gen = old / nloc;
        if (old + 1u == (gen + 1u) * nloc) {
            __builtin_amdgcn_fence(__ATOMIC_RELEASE, "agent");
            asm volatile("s_waitcnt vmcnt(0)" ::: "memory");
            const unsigned og = xb_add(&bar[XB_TOP], 1u);
            const unsigned tg = og / nx;
            if (og + 1u == (tg + 1u) * nx) xb_add(&bar[XB_TOPGEN], 1u);
            else XB_SPIN(xb_ld(&bar[XB_TOPGEN]) == tg, bar);
            __builtin_amdgcn_fence(__ATOMIC_ACQUIRE, "agent");
            xb_add(&bar[XB_XGEN(b.x)], 1u);
            asm volatile("s_waitcnt vmcnt(0)" ::: "memory");
        } else {
            XB_SPIN(xb_ld(&bar[XB_XGEN(b.x)]) == gen, bar);
            __builtin_amdgcn_fence(__ATOMIC_ACQUIRE, "agent");
            asm volatile("s_waitcnt vmcnt(0)" ::: "memory");
        }
    }
    __syncthreads();
}
struct Frame {
    LAS unsigned char* lds;
    int tid, lane, wave;
    int G, wg, gw, NGW;
};

DI void transpose_item(const float* W, int ldsrc, int coloff, bf16* WT, int K, int row_off, int nblk, LAS float* scr, int item, int lane) {
    const int kb = item / nblk, nb = item % nblk, k0 = 64 * kb, n0 = 32 * nb;
#pragma unroll 8
    for (int i = 0; i < 32; ++i) { const int kk = 2 * i + (lane >> 5); scr[kk * 33 + (lane & 31)] = W[(size_t)(k0 + kk) * ldsrc + coloff + n0 + (lane & 31)]; }
    LDS_WAIT(); asm volatile("" ::: "memory");
    const int c = lane & 7;
#pragma unroll
    for (int j = 0; j < 4; ++j) { const int n = (lane >> 3) + 8 * j; const LAS float* s = scr + (8 * c) * 33 + n;
        v4u o; o.x = pk2(s[0 * 33], s[1 * 33]); o.y = pk2(s[2 * 33], s[3 * 33]); o.z = pk2(s[4 * 33], s[5 * 33]); o.w = pk2(s[6 * 33], s[7 * 33]);
        *(GAS v4u*)(WT + (size_t)(row_off + n0 + n) * K + k0 + 8 * c) = o; }
    LDS_WAIT(); asm volatile("" ::: "memory");
}
DI void transpose_matrix(Frame& F, const float* W, int ldsrc, int coloff, int ncols, int K, bf16* WT, int row_off, unsigned& base) {
    LAS float* scr = (LAS float*)(F.lds + F.wave * 16384);
    const int nblk = ncols / 32, nitems = (K / 64) * nblk;
    int it = (int)(((unsigned)F.gw + (unsigned)F.NGW - (base % (unsigned)F.NGW)) % (unsigned)F.NGW);
    for (; it < nitems; it += F.NGW) transpose_item(W, ldsrc, coloff, WT, K, row_off, nblk, scr, it, F.lane);
    base += (unsigned)nitems;
}
DI void rms_row(const float* xrow, const f32x4 (&g4)[4], f32x4 (&v)[4], int lane) {
    const GAS f32x4* xr = (const GAS f32x4*)xrow + lane; float s = 0.f;
#pragma unroll
    for (int j = 0; j < 4; ++j) { v[j] = xr[64 * j]; s += (v[j].x * v[j].x + v[j].y * v[j].y) + (v[j].z * v[j].z + v[j].w * v[j].w); }
    const float rstd = 1.0f / sqrtf(wave_sum(s) * (1.f / 1024.f) + EPS);
#pragma unroll
    for (int j = 0; j < 4; ++j) v[j] = v[j] * rstd * g4[j];
}
DI void store_row_bf16(bf16* orow, const f32x4 (&v)[4], int lane) {
    GAS unsigned long long* o8 = (GAS unsigned long long*)orow + lane;
#pragma unroll
    for (int j = 0; j < 4; ++j) o8[64 * j] = (unsigned long long)pk2(v[j].x, v[j].y) | ((unsigned long long)pk2(v[j].z, v[j].w) << 32);
}
struct In { const float* p[24]; };
DI void p0_prologue(Frame& F, const In& I, unsigned char* ws) {
    unsigned base = 0;
    for (int l = 0; l < DEPTH; ++l) {
        const int j = l >> 1; unsigned char* wl = ws + WS_W + (size_t)l * W_LAYER;
        if ((l & 1) == 0) {
            transpose_matrix(F, I.p[3] + (size_t)j * D * AB_IN, AB_IN, 0, 1536, D, (bf16*)(wl + WO_WIN), 0, base);
            transpose_matrix(F, I.p[3] + (size_t)j * D * AB_IN, AB_IN, 1544, 1536, D, (bf16*)(wl + WO_WIN), 1536, base);
            transpose_matrix(F, I.p[7] + (size_t)j * D * D, D, 0, D, D, (bf16*)(wl + WO_WOUT), 0, base);
        } else {
            transpose_matrix(F, I.p[8] + (size_t)j * D * C_IN, C_IN, 0, 4096, D, (bf16*)(wl + WO_WIN), 0, base);
            transpose_matrix(F, I.p[13] + (size_t)j * D * D, D, 0, D, D, (bf16*)(wl + WO_WOUT), 0, base);
        }
        transpose_matrix(F, I.p[16] + (size_t)l * D * D, D, 0, D, D, (bf16*)(wl + WO_WQ), 0, base);
        transpose_matrix(F, I.p[19] + (size_t)l * D * D, D, 0, D, D, (bf16*)(wl + WO_WO), 0, base);
        transpose_matrix(F, I.p[17] + (size_t)l * D * D, D, 0, D, D, (bf16*)(ws + WS_WKV), 2048 * l, base);
        transpose_matrix(F, I.p[18] + (size_t)l * D * D, D, 0, D, D, (bf16*)(ws + WS_WKV), 2048 * l + 1024, base);
        transpose_matrix(F, I.p[21] + (size_t)l * D * FF, FF, 0, FF, D, (bf16*)(wl + WO_W1), 0, base);
        transpose_matrix(F, I.p[22] + (size_t)l * FF * D, D, 0, D, FF, (bf16*)(wl + WO_W2), 0, base);
    }
    float* Wg = (float*)(ws + WS_WG);
    for (int idx = F.wg * NTHR + F.tid; idx < DEPTH * 16 * 1024; idx += F.G * NTHR) {
        const int l = idx >> 14, g = (idx >> 10) & 15, k = idx & 1023, j = l >> 1; float v = 0.f;
        if ((l & 1) == 0) { if (g < 8) v = I.p[3][(size_t)j * D * AB_IN + (size_t)k * AB_IN + 1536 + g]; }
        else v = I.p[8][(size_t)j * D * C_IN + (size_t)k * C_IN + 4096 + g];
        Wg[idx] = v;
    }
    { f32x4 g4[4];
#pragma unroll
      for (int j = 0; j < 4; ++j) g4[j] = ((const GAS f32x4*)I.p[15])[F.lane + 64 * j];
      for (int r = F.gw; r < BATCH * MEMLEN; r += F.NGW) { f32x4 v[4]; rms_row(I.p[1] + (size_t)r * D, g4, v, F.lane); store_row_bf16((bf16*)(ws + WS_MEMN) + (size_t)r * D, v, F.lane); } }
}
template <int MODE> DI void norm_phase(Frame& F, const float* xin, const float* gain, bf16* hout, const float* Wg, float* gate, const float* p0, const float* p1) {
    f32x4 g4[4];
#pragma unroll
    for (int j = 0; j < 4; ++j) g4[j] = ((const GAS f32x4*)gain)[F.lane + 64 * j];
    constexpr int NG = MODE == 1 ? 8 : (MODE == 2 ? 16 : 0);
    float par = 0.f;
    if (MODE == 1) { if (F.lane < 4) par = p0[F.lane]; else if (F.lane < 8) par = p1[F.lane - 4]; }
    float par2 = 0.f;
    if (MODE == 2) { if (F.lane >= 8 && F.lane < 16) { par = p0[F.lane - 8]; par2 = p1[F.lane - 8]; } }
    for (int r = F.gw; r < M; r += F.NGW) {
        f32x4 v[4]; rms_row(xin + (size_t)r * D, g4, v, F.lane); store_row_bf16(hout + (size_t)r * D, v, F.lane);
        if (MODE != 0) {
            float keep = 0.f;
#pragma unroll
            for (int g = 0; g < NG; ++g) {
                const GAS f32x4* wr = (const GAS f32x4*)(Wg + g * 1024) + F.lane; float p = 0.f;
#pragma unroll
                for (int j = 0; j < 4; ++j) { const f32x4 w = wr[64 * j]; p += (v[j].x * w.x + v[j].y * w.y) + (v[j].z * w.z + v[j].w * w.w); }
                p = wave_sum(p); if (F.lane == g) keep = p;
            }
            if (MODE == 1 && F.lane < 8) {
                const float a = keep + par; float o;
                if (F.lane < 4) o = 15.0f * tanhf(a * (1.0f / 15.0f));
                else o = fminf(a, 0.f) - log1pf(expf(-fabsf(a)));
                gate[(size_t)r * 16 + F.lane] = o;
            }
            if (MODE == 2 && F.lane < 16) {
                float o;
                if (F.lane < 8) o = 1.0f / (1.0f + expf(-keep));
                else { const float z = keep + par2; const float sp = fmaxf(z, 0.f) + log1pf(expf(-fabsf(z))); o = -expf(par) * sp; }
                gate[(size_t)r * 16 + F.lane] = o;
            }
        }
    }
}
DI void final_norm_phase(Frame& F, float* x, const float* gain) {
    f32x4 g4[4];
#pragma unroll
    for (int j = 0; j < 4; ++j) g4[j] = ((const GAS f32x4*)gain)[F.lane + 64 * j];
    for (int r = F.gw; r < M; r += F.NGW) { f32x4 v[4]; rms_row(x + (size_t)r * D, g4, v, F.lane); GAS f32x4* o = (GAS f32x4*)(x + (size_t)r * D) + F.lane;
#pragma unroll
        for (int j = 0; j < 4; ++j) o[64 * j] = v[j]; }
}
template <bool ODD> DI void headnorm_phase(Frame& F, bf16* mix, const bf16* proj, const float* hg) {
    constexpr int NC = ODD ? 16 : 8;
    for (int r = F.gw; r < M; r += F.NGW) {
        const int c0 = NC * F.lane;
        float x[NC], gt[NC];
#pragma unroll
        for (int q = 0; q < NC / 8; ++q) {
            const v4u raw = *(const GAS v4u*)(mix + (size_t)r * D + c0 + 8 * q);
            const v4u gr = *(const GAS v4u*)(proj + (size_t)r * (ODD ? C_N : AB_N) + (ODD ? 3072 : 1024) + c0 + 8 * q);
            x[8 * q + 0] = bflo(raw.x); x[8 * q + 1] = bfhi(raw.x); x[8 * q + 2] = bflo(raw.y); x[8 * q + 3] = bfhi(raw.y); x[8 * q + 4] = bflo(raw.z); x[8 * q + 5] = bfhi(raw.z); x[8 * q + 6] = bflo(raw.w); x[8 * q + 7] = bfhi(raw.w);
            gt[8 * q + 0] = bflo(gr.x); gt[8 * q + 1] = bfhi(gr.x); gt[8 * q + 2] = bflo(gr.y); gt[8 * q + 3] = bfhi(gr.y); gt[8 * q + 4] = bflo(gr.z); gt[8 * q + 5] = bfhi(gr.z); gt[8 * q + 6] = bflo(gr.w); gt[8 * q + 7] = bfhi(gr.w);
        }
        float ss = 0.f;
#pragma unroll
        for (int i = 0; i < NC; ++i) ss += x[i] * x[i];
        ss += __shfl_xor(ss, 1); ss += __shfl_xor(ss, 2); ss += __shfl_xor(ss, 4); if (!ODD) ss += __shfl_xor(ss, 8);
        const float rstd = 1.0f / sqrtf(ss * (1.f / 128.f) + EPS);
#pragma unroll
        for (int i = 0; i < NC; ++i) { const float g = ODD ? hg[(c0 + i) & 127] : hg[c0 + i]; const float s = sigmoidf_(gt[i]); x[i] = x[i] * rstd * g * (ODD ? gt[i] * s : s); }
#pragma unroll
        for (int q = 0; q < NC / 8; ++q) { v4u o; o.x = pk2(x[8 * q], x[8 * q + 1]); o.y = pk2(x[8 * q + 2], x[8 * q + 3]); o.z = pk2(x[8 * q + 4], x[8 * q + 5]); o.w = pk2(x[8 * q + 6], x[8 * q + 7]);
            *(GAS v4u*)(mix + (size_t)r * D + c0 + 8 * q) = o; }
    }
}
DI void mlstm_chain(Frame& F, const bf16* proj, const float* gate, bf16* mix, int c) {
    const int b = c >> 4, h = (c >> 2) & 3, vq = c & 3, vl = F.tid >> 4, dg = F.tid & 15;
    float C0 = 0.f, C1 = 0.f, C2 = 0.f, C3 = 0.f, n0 = 0.f, n1 = 0.f, n2 = 0.f, n3 = 0.f, m = 0.f;
    const bf16* pq = proj + (size_t)b * T * AB_N + h * 64 + 4 * dg;
    const bf16* pk = pq + 256;
    const bf16* pv = proj + (size_t)b * T * AB_N + 512 + h * 128 + vq * 32 + vl;
    const float* pg = gate + (size_t)b * T * 16 + h;
    bf16* po = mix + (size_t)b * T * D + h * 128 + vq * 32 + vl;
    for (int t0 = 0; t0 < T; t0 += 8) {
        v2u qr[8], kr[8]; unsigned short vr[8]; float li[8], lf[8];
#pragma unroll
        for (int i = 0; i < 8; ++i) { qr[i] = *(const GAS v2u*)(pq + (size_t)(t0 + i) * AB_N); kr[i] = *(const GAS v2u*)(pk + (size_t)(t0 + i) * AB_N); vr[i] = pv[(size_t)(t0 + i) * AB_N];
            li[i] = pg[(size_t)(t0 + i) * 16]; lf[i] = pg[(size_t)(t0 + i) * 16 + 4]; }
#pragma unroll
        for (int i = 0; i < 8; ++i) {
            const float q0 = bflo(qr[i].x), q1 = bfhi(qr[i].x), q2 = bflo(qr[i].y), q3 = bfhi(qr[i].y);
            const float k0 = bflo(kr[i].x) * 0.125f, k1 = bfhi(kr[i].x) * 0.125f, k2 = bflo(kr[i].y) * 0.125f, k3 = bfhi(kr[i].y) * 0.125f;
            const float vv = bf2f(vr[i]);
            const float mn = fmaxf(lf[i] + m, li[i]); const float fp = __expf(lf[i] + m - mn), ip = __expf(li[i] - mn); m = mn;
            const float iv = ip * vv;
            C0 = fp * C0 + iv * k0; C1 = fp * C1 + iv * k1; C2 = fp * C2 + iv * k2; C3 = fp * C3 + iv * k3;
            n0 = fp * n0 + ip * k0; n1 = fp * n1 + ip * k1; n2 = fp * n2 + ip * k2; n3 = fp * n3 + ip * k3;
            float pn = (C0 * q0 + C1 * q1) + (C2 * q2 + C3 * q3), pd = (n0 * q0 + n1 * q1) + (n2 * q2 + n3 * q3);
#pragma unroll
            for (int o = 1; o < 16; o <<= 1) { pn += __shfl_xor(pn, o); pd += __shfl_xor(pd, o); }
            const float hv = pn / fmaxf(fabsf(pd), __expf(-mn));
            if (dg == 0) po[(size_t)(t0 + i) * D] = (bf16)f2bf(hv);
        }
    }
}
DI void gdn_chain(Frame& F, const bf16* proj, const float* gate, const float* convw, bf16* mix, int c) {
    const int b = c >> 5, h = (c >> 2) & 7, vq = c & 3, cc = F.tid >> 4, dg = F.tid & 15;
    LAS float* qs = (LAS float*)F.lds; LAS float* ks = qs + 64 * 128; LAS float* vs = ks + 64 * 128; LAS float* os = vs + 64 * 32; LAS float* bet = os + 64 * 32; LAS float* alp = bet + 64;
    float S[8];
#pragma unroll
    for (int j = 0; j < 8; ++j) S[j] = 0.f;
    for (int t0 = 0; t0 < T; t0 += 64) {
        __syncthreads();
        { const int row = F.tid >> 3, seg = F.tid & 7, t = t0 + row;
#pragma unroll
          for (int which = 0; which < 2; ++which) {
              const int colg = which * 1024 + h * 128 + seg * 16; float a[16];
#pragma unroll
              for (int i = 0; i < 16; ++i) a[i] = 0.f;
#pragma unroll
              for (int j = 0; j < 4; ++j) { const int tt = t - 3 + j;
                  if (tt >= 0) { const bf16* src = proj + (size_t)(b * T + tt) * C_N + colg; const float* w = convw + j * 3072 + colg;
#pragma unroll
                      for (int q = 0; q < 2; ++q) { const v4u raw = *(const GAS v4u*)(src + 8 * q); const f32x4 w0 = *(const GAS f32x4*)(w + 8 * q), w1 = *(const GAS f32x4*)(w + 8 * q + 4);
                          a[8 * q + 0] += bflo(raw.x) * w0.x; a[8 * q + 1] += bfhi(raw.x) * w0.y; a[8 * q + 2] += bflo(raw.y) * w0.z; a[8 * q + 3] += bfhi(raw.y) * w0.w;
                          a[8 * q + 4] += bflo(raw.z) * w1.x; a[8 * q + 5] += bfhi(raw.z) * w1.y; a[8 * q + 6] += bflo(raw.w) * w1.z; a[8 * q + 7] += bfhi(raw.w) * w1.w; } } }
              float ss = 0.f;
#pragma unroll
              for (int i = 0; i < 16; ++i) { a[i] = a[i] * sigmoidf_(a[i]); ss += a[i] * a[i]; }
              ss += __shfl_xor(ss, 1); ss += __shfl_xor(ss, 2); ss += __shfl_xor(ss, 4);
              const float sc = (1.0f / sqrtf(ss + EPS)) * (which == 0 ? 0.08838834764831845f : 1.0f);
              LAS float* dst = (which == 0 ? qs : ks) + row * 128 + seg * 16;
#pragma unroll
              for (int q = 0; q < 4; ++q) *(LAS f32x4*)(dst + 4 * q) = (f32x4){a[4 * q] * sc, a[4 * q + 1] * sc, a[4 * q + 2] * sc, a[4 * q + 3] * sc};
          } }
        if (F.tid < 256) { const int row = F.tid >> 2, seg = F.tid & 3, t = t0 + row; const int colg = 2048 + h * 128 + vq * 32 + seg * 8; float a[8];
#pragma unroll
            for (int i = 0; i < 8; ++i) a[i] = 0.f;
#pragma unroll
            for (int j = 0; j < 4; ++j) { const int tt = t - 3 + j;
                if (tt >= 0) { const v4u raw = *(const GAS v4u*)(proj + (size_t)(b * T + tt) * C_N + colg); const float* w = convw + j * 3072 + colg; const f32x4 w0 = *(const GAS f32x4*)w, w1 = *(const GAS f32x4*)(w + 4);
                    a[0] += bflo(raw.x) * w0.x; a[1] += bfhi(raw.x) * w0.y; a[2] += bflo(raw.y) * w0.z; a[3] += bfhi(raw.y) * w0.w; a[4] += bflo(raw.z) * w1.x; a[5] += bfhi(raw.z) * w1.y; a[6] += bflo(raw.w) * w1.z; a[7] += bfhi(raw.w) * w1.w; } }
#pragma unroll
            for (int i = 0; i < 8; ++i) a[i] = a[i] * sigmoidf_(a[i]);
            *(LAS f32x4*)(vs + row * 32 + seg * 8) = (f32x4){a[0], a[1], a[2], a[3]}; *(LAS f32x4*)(vs + row * 32 + seg * 8 + 4) = (f32x4){a[4], a[5], a[6], a[7]}; }
        if (F.tid < 64) { const float* g = gate + (size_t)(b * T + t0 + F.tid) * 16; bet[F.tid] = g[h]; alp[F.tid] = __expf(g[8 + h]); }
        __syncthreads();
        for (int s = 0; s < 64; ++s) {
            const f32x4 ka = *(const LAS f32x4*)(ks + s * 128 + 8 * dg), kb = *(const LAS f32x4*)(ks + s * 128 + 8 * dg + 4);
            const f32x4 qa = *(const LAS f32x4*)(qs + s * 128 + 8 * dg), qb = *(const LAS f32x4*)(qs + s * 128 + 8 * dg + 4);
            const float vv = vs[s * 32 + cc], be = bet[s], al = alp[s];
            float p = (ka.x * S[0] + ka.y * S[1]) + (ka.z * S[2] + ka.w * S[3]) + (kb.x * S[4] + kb.y * S[5]) + (kb.z * S[6] + kb.w * S[7]);
#pragma unroll
            for (int o = 1; o < 16; o <<= 1) p += __shfl_xor(p, o);
            const float dl = be * (vv - al * p);
            S[0] = al * S[0] + ka.x * dl; S[1] = al * S[1] + ka.y * dl; S[2] = al * S[2] + ka.z * dl; S[3] = al * S[3] + ka.w * dl;
            S[4] = al * S[4] + kb.x * dl; S[5] = al * S[5] + kb.y * dl; S[6] = al * S[6] + kb.z * dl; S[7] = al * S[7] + kb.w * dl;
            float po = (qa.x * S[0] + qa.y * S[1]) + (qa.z * S[2] + qa.w * S[3]) + (qb.x * S[4] + qb.y * S[5]) + (qb.z * S[6] + qb.w * S[7]);
#pragma unroll
            for (int o = 1; o < 16; o <<= 1) po += __shfl_xor(po, o);
            if (dg == 0) os[s * 32 + cc] = po;
        }
        __syncthreads();
        { const int row = F.tid >> 3, c4 = (F.tid & 7) * 4; const f32x4 o = *(const LAS f32x4*)(os + row * 32 + c4);
          *(GAS v2u*)(mix + (size_t)(b * T + t0 + row) * D + h * 128 + vq * 32 + c4) = (v2u){pk2(o.x, o.y), pk2(o.z, o.w)}; }
    }
}
DI void sb_unit(Frame& F, const bf16* proj, bf16* mix, int u) {
    constexpr int LDV = 72;
    const int qt = u & 63, h = (u >> 6) & 3, b = u >> 8;
    LAS bf16* Vt = (LAS bf16*)F.lds;
    volatile LAS unsigned* flag = (volatile LAS unsigned*)(F.lds + MISC_OFF + 64);
    const int w = F.wave, lane = F.lane, r = lane & 15, quad = lane >> 4;
    const int t0 = qt * 128, qpos = t0 + 16 * w + r;
    const size_t rb = (size_t)b * T;
    bf16x8 qf[4];
#pragma unroll
    for (int kk = 0; kk < 4; ++kk) qf[kk] = *(const GAS bf16x8*)(proj + (rb + qpos) * AB_N + 1536 + h * 128 + 32 * kk + 8 * quad);
    f32x4 o[8];
#pragma unroll
    for (int i = 0; i < 8; ++i) o[i] = (f32x4){0.f, 0.f, 0.f, 0.f};
    float carry = 0.f;
    const float scale = 0.08838834764831845f;
    for (int kb = 2 * qt + 1; kb >= 0; --kb) {
        const int k0 = kb * 64;
        __syncthreads();
        { const int key = F.tid >> 3, ds = (F.tid & 7) * 16; const bf16* src = proj + (rb + k0 + key) * AB_N + 2560 + h * 128 + ds;
          const v4u a = *(const GAS v4u*)src, c = *(const GAS v4u*)(src + 8);
          const unsigned ww[8] = {a.x, a.y, a.z, a.w, c.x, c.y, c.z, c.w};
#pragma unroll
          for (int i = 0; i < 8; ++i) { Vt[(ds + 2 * i) * LDV + key] = (bf16)(ww[i] & 0xffffu); Vt[(ds + 2 * i + 1) * LDV + key] = (bf16)(ww[i] >> 16); } }
        if (F.tid == 0) flag[0] = 0u;
        __syncthreads();
        if (k0 < t0 + 16 * w + 15) {
            f32x4 s[4];
#pragma unroll
            for (int mt = 0; mt < 4; ++mt) { s[mt] = (f32x4){0.f, 0.f, 0.f, 0.f};
                const bf16* kp = proj + (rb + k0 + 16 * mt + r) * AB_N + 2048 + h * 128 + 8 * quad;
#pragma unroll
                for (int kk = 0; kk < 4; ++kk) s[mt] = mfma16(*(const GAS bf16x8*)(kp + 32 * kk), qf[kk], s[mt]); }
            float l1[4][4], tot[4];
#pragma unroll
            for (int mt = 0; mt < 4; ++mt) { tot[mt] = 0.f;
#pragma unroll
                for (int j = 0; j < 4; ++j) { const float z = s[mt][j] * scale; const bool valid = (k0 + 16 * mt + 4 * quad + j) < qpos;
                    const float tl = __logf(1.0f + __expf(-fabsf(z)));
                    l1[mt][j] = valid ? (fminf(-z, 0.f) - tl) : 0.f; s[mt][j] = valid ? (fminf(z, 0.f) - tl) : -1e30f; tot[mt] += l1[mt][j]; } }
            float run = carry;
#pragma unroll
            for (int mt = 3; mt >= 0; --mt) {
                const float t1 = __shfl_xor(tot[mt], 16), t2 = __shfl_xor(tot[mt], 32), t3 = __shfl_xor(t1, 32);
                float hi = 0.f;
                hi += ((quad ^ 1) > quad) ? t1 : 0.f; hi += ((quad ^ 2) > quad) ? t2 : 0.f; hi += ((quad ^ 3) > quad) ? t3 : 0.f;
                float acc = run + hi;
#pragma unroll
                for (int j = 3; j >= 0; --j) { const float e = s[mt][j] + acc; s[mt][j] = __expf(e); acc += l1[mt][j]; }
                run += (tot[mt] + t1) + (t2 + t3);
            }
            carry = run;
#pragma unroll
            for (int s2 = 0; s2 < 2; ++s2) {
                v4u pw; pw.x = pk2(s[2 * s2][0], s[2 * s2][1]); pw.y = pk2(s[2 * s2][2], s[2 * s2][3]); pw.z = pk2(s[2 * s2 + 1][0], s[2 * s2 + 1][1]); pw.w = pk2(s[2 * s2 + 1][2], s[2 * s2 + 1][3]);
                const bf16x8 pf = __builtin_bit_cast(bf16x8, pw);
#pragma unroll
                for (int dt = 0; dt < 8; ++dt) { const LAS bf16* vp = Vt + (16 * dt + r) * LDV + 32 * s2 + 4 * quad;
                    const s16x4 lo = *(const LAS s16x4*)vp, hi4 = *(const LAS s16x4*)(vp + 16);
                    o[dt] = mfma16(__builtin_shufflevector(lo, hi4, 0, 1, 2, 3, 4, 5, 6, 7), pf, o[dt]); }
            }
        }
        if (!(carry < -SB_THR)) flag[0] = 1u;
        __syncthreads();
        if (flag[0] == 0u) break;
    }
    bf16* op = mix + (rb + qpos) * D + 512 + h * 128 + 4 * quad;
#pragma unroll
    for (int dt = 0; dt < 8; ++dt) *(GAS v2u*)(op + 16 * dt) = (v2u){pk2(o[dt][0], o[dt][1]), pk2(o[dt][2], o[dt][3])};
}
DI void xattn_phase(Frame& F, const bf16* Q, const bf16* KV, int l, bf16* O) {
    constexpr int LDV = 264;
    LAS bf16* Vt = (LAS bf16*)F.lds;
    const int per = (2048 + F.G - 1) / F.G, u0 = F.wg * per, u1 = (u0 + per < 2048) ? u0 + per : 2048;
    const int w = F.wave, lane = F.lane, r = lane & 15, quad = lane >> 4;
    int cur = -1;
    for (int u = u0; u < u1; ++u) {
        const int bh = u >> 6, qt = u & 63, b = bh >> 2, h = bh & 3;
        if (bh != cur) {
            __syncthreads();
#pragma unroll 4
            for (int it = 0; it < 16; ++it) { const int idx = F.tid + NTHR * it, key = idx >> 5, ds = (idx & 31) * 8;
                const v4u a = *(const GAS v4u*)(KV + (size_t)(b * MEMLEN + key) * 8192 + 2048 * l + 1024 + h * 256 + ds);
                const unsigned ww[4] = {a.x, a.y, a.z, a.w};
#pragma unroll
                for (int i = 0; i < 4; ++i) { Vt[(ds + 2 * i) * LDV + key] = (bf16)(ww[i] & 0xffffu); Vt[(ds + 2 * i + 1) * LDV + key] = (bf16)(ww[i] >> 16); } }
            __syncthreads(); cur = bh;
        }
        const size_t row = (size_t)b * T + qt * 128 + 16 * w + r;
        bf16x8 qf[8];
#pragma unroll
        for (int kk = 0; kk < 8; ++kk) qf[kk] = *(const GAS bf16x8*)(Q + row * D + h * 256 + 32 * kk + 8 * quad);
        f32x4 s[16];
#pragma unroll
        for (int mt = 0; mt < 16; ++mt) { s[mt] = (f32x4){0.f, 0.f, 0.f, 0.f};
            const bf16* kp = KV + (size_t)(b * MEMLEN + 16 * mt + r) * 8192 + 2048 * l + h * 256 + 8 * quad;
#pragma unroll
            for (int kk = 0; kk < 8; ++kk) s[mt] = mfma16(*(const GAS bf16x8*)(kp + 32 * kk), qf[kk], s[mt]); }
        float mx = -1e30f;
#pragma unroll
        for (int mt = 0; mt < 16; ++mt) mx = fmaxf(fmaxf(fmaxf(s[mt][0], s[mt][1]), fmaxf(s[mt][2], s[mt][3])), mx);
        mx = fmaxf(mx, __shfl_xor(mx, 16)); mx = fmaxf(mx, __shfl_xor(mx, 32));
        float sum = 0.f;
#pragma unroll
        for (int mt = 0; mt < 16; ++mt)
#pragma unroll
            for (int j = 0; j < 4; ++j) { const float p = __expf((s[mt][j] - mx) * 0.0625f); s[mt][j] = p; sum += p; }
        sum += __shfl_xor(sum, 16); sum += __shfl_xor(sum, 32);
        const float inv = 1.0f / sum;
        f32x4 o[16];
#pragma unroll
        for (int i = 0; i < 16; ++i) o[i] = (f32x4){0.f, 0.f, 0.f, 0.f};
#pragma unroll
        for (int s2 = 0; s2 < 8; ++s2) {
            v4u pw; pw.x = pk2(s[2 * s2][0], s[2 * s2][1]); pw.y = pk2(s[2 * s2][2], s[2 * s2][3]); pw.z = pk2(s[2 * s2 + 1][0], s[2 * s2 + 1][1]); pw.w = pk2(s[2 * s2 + 1][2], s[2 * s2 + 1][3]);
            const bf16x8 pf = __builtin_bit_cast(bf16x8, pw);
#pragma unroll
            for (int dt = 0; dt < 16; ++dt) { const LAS bf16* vp = Vt + (16 * dt + r) * LDV + 32 * s2 + 4 * quad;
                const s16x4 lo = *(const LAS s16x4*)vp, hi4 = *(const LAS s16x4*)(vp + 16);
                o[dt] = mfma16(__builtin_shufflevector(lo, hi4, 0, 1, 2, 3, 4, 5, 6, 7), pf, o[dt]); }
        }
        bf16* op = O + row * D + h * 256 + 4 * quad;
#pragma unroll
        for (int dt = 0; dt < 16; ++dt) *(GAS v2u*)(op + 16 * dt) = (v2u){pk2(o[dt][0] * inv, o[dt][1] * inv), pk2(o[dt][2] * inv, o[dt][3] * inv)};
    }
}
template <class Epi> DI void run_gemm(Frame& F, const bf16* A, const bf16* Bt, int M_, int N_, int K_, const Epi& E) {
    pg8::Gemm g{A, Bt, M_, N_, K_}; pg8::StaticOrder S; S.init(M_, N_, F.G, F.wg);
    pg8::gemm_phase<Epi, pg8::StaticOrder, PG8_ALIGN, PG8_SP2>(F.lds, g, S, E, F.tid);
}
constexpr int NPHASE = 51, PH_FINAL = 50;
struct Args { In in; float* out; unsigned char* ws; int ph_lo, ph_hi, region, pad; };
__global__ void __launch_bounds__(NTHR, 2) fwd(Args a) {
    extern __shared__ __attribute__((aligned(16))) unsigned char lds_raw[];
    Frame F;
    F.lds = (LAS unsigned char*)lds_raw;
    F.tid = threadIdx.x; F.lane = F.tid & 63; F.wave = __builtin_amdgcn_readfirstlane(F.tid >> 6);
    F.G = gridDim.x; F.wg = blockIdx.x; F.gw = F.wg * NWAVES + F.wave; F.NGW = F.G * NWAVES;
    volatile LAS unsigned* MISC = (volatile LAS unsigned*)(F.lds + MISC_OFF);
    if (F.tid < 32) MISC[F.tid] = 0u;
    __syncthreads();
    const int lo = a.ph_lo, hi = a.ph_hi;
    unsigned char* ws = a.ws; const In& I = a.in;
    XcdBarrier bar; bar.bar = (unsigned*)(ws + WS_CTL) + CW_BAR + a.region * XCD_BAR_WORDS; bar.x = 0; bar.st = MISC + 8;
    if (hi - lo > 1) bar = xcd_barrier_post(bar.bar, MISC + 8);
#define IN(k) (lo <= (k) && (k) < hi)
#define PHASE(k) asm volatile("" : "+v"(F.tid)); F.lane = F.tid & 63; if (IN(k))
#define SEAM(k) do { if (IN(k) && IN((k) + 1)) xcd_barrier(bar); } while (0)
    bf16* H = (bf16*)(ws + WS_H); bf16* MIX = (bf16*)(ws + WS_MIX); bf16* BIG = (bf16*)(ws + WS_BIG); bf16* KVX = (bf16*)(ws + WS_KVX);
    float* GATE = (float*)(ws + WS_GATE); const float* WG = (const float*)(ws + WS_WG);

    PHASE(0) p0_prologue(F, I, ws);
    SEAM(0);
    PHASE(1) run_gemm(F, (const bf16*)(ws + WS_MEMN), (const bf16*)(ws + WS_WKV), BATCH * MEMLEN, 8192, D, pg8::EpiBf16<0>{KVX, 8192});
    SEAM(1);
    for (int l = 0; l < DEPTH; ++l) {
        asm volatile("" : "+v"(F.tid)); F.lane = F.tid & 63;
        const int pb = 2 + 12 * l, j = l >> 1; const bool odd = (l & 1) != 0;
        unsigned char* wl = ws + WS_W + (size_t)l * W_LAYER;
        const float* xcur = (l == 0) ? I.p[0] : a.out;
        PHASE(pb + 0) {
            if (!odd) norm_phase<1>(F, xcur, I.p[2] + l * D, H, WG + l * 16384, GATE, I.p[4] + j * 4, I.p[5] + j * 4);
            else norm_phase<2>(F, xcur, I.p[2] + l * D, H, WG + l * 16384, GATE, I.p[10] + j * 8, I.p[11] + j * 8);
        }
        SEAM(pb + 0);
        PHASE(pb + 1) { const int n = odd ? C_N : AB_N; run_gemm(F, H, (const bf16*)(wl + WO_WIN), M, n, D, pg8::EpiBf16<0>{BIG, n}); }
        SEAM(pb + 1);
        PHASE(pb + 2) {
            if (!odd) {
                const int gh = F.G / 2;
                if (F.wg < gh) { for (int c = F.wg; c < 128; c += gh) mlstm_chain(F, BIG, GATE, MIX, c); }
                else { for (int u = F.wg - gh; u < 2048; u += F.G - gh) sb_unit(F, BIG, MIX, u); }
            } else {
                for (int c = F.wg; c < 256; c += F.G) gdn_chain(F, BIG, GATE, I.p[9] + (size_t)j * 4 * 3072, MIX, c);
            }
        }
        SEAM(pb + 2);
        PHASE(pb + 3) { if (!odd) headnorm_phase<false>(F, MIX, BIG, I.p[6] + j * 512); else headnorm_phase<true>(F, MIX, BIG, I.p[12] + j * 128); }
        SEAM(pb + 3);
        PHASE(pb + 4) run_gemm(F, MIX, (const bf16*)(wl + WO_WOUT), M, D, D, pg8::EpiResid{xcur, a.out, D});
        SEAM(pb + 4);
        PHASE(pb + 5) norm_phase<0>(F, a.out, I.p[14] + l * D, H, nullptr, nullptr, nullptr, nullptr);
        SEAM(pb + 5);
        PHASE(pb + 6) run_gemm(F, H, (const bf16*)(wl + WO_WQ), M, D, D, pg8::EpiBf16<0>{BIG, D});
        SEAM(pb + 6);
        PHASE(pb + 7) xattn_phase(F, BIG, KVX, l, MIX);
        SEAM(pb + 7);
        PHASE(pb + 8) run_gemm(F, MIX, (const bf16*)(wl + WO_WO), M, D, D, pg8::EpiResid{a.out, a.out, D});
        SEAM(pb + 8);
        PHASE(pb + 9) norm_phase<0>(F, a.out, I.p[20] + l * D, H, nullptr, nullptr, nullptr, nullptr);
        SEAM(pb + 9);
        PHASE(pb + 10) run_gemm(F, H, (const bf16*)(wl + WO_W1), M, FF, D, pg8::EpiBf16<2>{BIG, FF});
        SEAM(pb + 10);
        PHASE(pb + 11) run_gemm(F, BIG, (const bf16*)(wl + WO_W2), M, D, FF, pg8::EpiResid{a.out, a.out, D});
        SEAM(pb + 11);
    }
    PHASE(PH_FINAL) final_norm_phase(F, a.out, I.p[23]);
#undef IN
#undef PHASE
#undef SEAM
}

#ifndef MK_SPLIT
#define MK_SPLIT 1
#endif
extern "C" void kernel_launch(void* const* d_in, const int* in_sizes, int n_in, void* d_out, int out_size, void* d_ws, size_t ws_size, hipStream_t stream) {
    static int grid = 0;
    if (grid == 0) {
        if (n_in != 24 || in_sizes[0] != M * D || out_size != M * D || ws_size < WS_END) { fprintf(stderr, "kernel_launch: unexpected shapes (n_in %d, in0 %d, out %d, ws %zu)\n", n_in, n_in > 0 ? in_sizes[0] : -1, out_size, ws_size); grid = -1; return; }
        int dev = 0, cus = 0;
        if (hipGetDevice(&dev) != hipSuccess || hipDeviceGetAttribute(&cus, hipDeviceAttributeMultiprocessorCount, dev) != hipSuccess) { grid = -1; return; }
        if (hipFuncSetAttribute((const void*)fwd, hipFuncAttributeMaxDynamicSharedMemorySize, LDS_BYTES) != hipSuccess) { fprintf(stderr, "kernel_launch: hipFuncSetAttribute failed\n"); grid = -1; return; }
        (void)hipGetLastError();
        grid = cus;
    }
    if (grid < 0) return;
    (void)hipMemsetAsync((char*)d_ws + WS_CTL, 0, CTL_ZERO_BYTES, stream);
    Args a{};
    for (int i = 0; i < 24; ++i) a.in.p[i] = (const float*)d_in[i];
    a.out = (float*)d_out; a.ws = (unsigned char*)d_ws; a.region = 0; a.pad = 0;
#if MK_SPLIT
    for (int p = 0; p < NPHASE; ++p) { a.ph_lo = p; a.ph_hi = p + 1; hipLaunchKernelGGL(fwd, dim3(grid), dim3(NTHR), LDS_BYTES, stream, a); }
#else
    a.ph_lo = 0; a.ph_hi = NPHASE; hipLaunchKernelGGL(fwd, dim3(grid), dim3(NTHR), LDS_BYTES, stream, a);
#endif
}
```

```cpp
#include <hip/hip_runtime.h>
#include <cstdio>
#include <cstdint>
namespace pg8 {
#define PG8_LAS __attribute__((address_space(3)))
typedef unsigned short bf16_t;
typedef short bf16x8 __attribute__((ext_vector_type(8)));
typedef float f32x4 __attribute__((ext_vector_type(4)));
typedef unsigned u32x4 __attribute__((ext_vector_type(4)));
constexpr int BM = 256, BK = 64, HALF = 128, HTB = HALF * BK * 2  , STAGE_BYTES = 8 * HTB, NXCD = 8, WGM = 8;

__host__ __device__ __forceinline__ int lds_byte(int r, int c) { const int st = (r >> 4) * 2 + (c >> 5), rr = r & 15, cc = c & 31, ob = rr * 64 + cc * 2; return st * 1024 + (ob ^ (((ob >> 9) & 1) << 5)); }
__host__ __device__ __forceinline__ void stage_rc(int b, int& R, int& C) { const int st = b / 1024, sb = b % 1024, swz = sb ^ (((sb >> 9) & 1) << 5); R = (st >> 1) * 16 + swz / 64; C = (st & 1) * 32 + (swz % 64) / 2; }
__host__ __device__ __forceinline__ int perm32(int rho) { const int n = rho >> 4, i = rho & 15; return 8 * (i >> 2) + 4 * n + (i & 3); }

struct Unit { int pm, pn; };
struct Gemm { const bf16_t* A; const bf16_t* Bt; int M, N, K; };

struct StaticOrder {
    int nM, nN, nwg, G, c;
    __host__ __device__ void init(int M, int N, int G_, int c_) { nM = M / BM; nN = N / BM; nwg = nM * nN; G = G_; c = c_; }
    __host__ __device__ bool next(int i, Unit& u) const {
        const long L = (long)i * G + c; if (L >= nwg) return false;
        int wgid = (int)L; { const int q = nwg / NXCD, r = nwg % NXCD, xcd = wgid % NXCD, off = wgid / NXCD; wgid = (xcd < r ? xcd * (q + 1) : r * (q + 1) + (xcd - r) * q) + off; }
        const int nig = WGM * nN, gid = wgid / nig, fm = gid * WGM, gsz = (nM - fm) < WGM ? (nM - fm) : WGM;
        u.pm = fm + ((wgid % nig) % gsz); u.pn = (wgid % nig) / gsz; return true;
    }
    __device__ __forceinline__ void a_ready(const Unit&) const {}
    __device__ __forceinline__ void done(const Unit&) const {}
};

__device__ __forceinline__ unsigned cvt_pk_bf16(float lo, float hi) { unsigned r; asm volatile("v_cvt_pk_bf16_f32 %0, %1, %2" : "=v"(r) : "v"(lo), "v"(hi)); return r; }
template <int ACT> struct EpiBf16 {
    static constexpr bool PERM = true, AFTER_DRAIN = false;
    bf16_t* O; int ldc;
    __device__ __forceinline__ void operator()(const f32x4 (&acc)[2][2][4][2], const Unit& u, int wr, int wc, int fr, int fq) const {
        const int row0 = u.pm * BM + wr * 64 + fr; const int col0 = u.pn * BM + wc * 32 + 8 * fq;
#pragma unroll
        for (int ai = 0; ai < 2; ++ai)
#pragma unroll
            for (int m = 0; m < 4; ++m) { bf16_t* rowp = O + (size_t)(row0 + ai * HALF + m * 16) * ldc + col0;
#pragma unroll
                for (int bj = 0; bj < 2; ++bj) { f32x4 v0 = acc[ai][bj][m][0], v1 = acc[ai][bj][m][1];
                    if (ACT == 2) {
#pragma unroll
                        for (int j = 0; j < 4; ++j) { const float a = fmaxf(v0[j], 0.f), b = fmaxf(v1[j], 0.f); v0[j] = a * a; v1[j] = b * b; } }
                    u32x4 w; w.x = cvt_pk_bf16(v0[0], v0[1]); w.y = cvt_pk_bf16(v0[2], v0[3]); w.z = cvt_pk_bf16(v1[0], v1[1]); w.w = cvt_pk_bf16(v1[2], v1[3]);
                    *(u32x4*)(rowp + bj * HALF) = w; } }
    }
};
struct EpiResid {
    static constexpr bool PERM = false, AFTER_DRAIN = false;
    const float* base; float* out; int ldc;
    __device__ __forceinline__ void operator()(const f32x4 (&acc)[2][2][4][2], const Unit& u, int wr, int wc, int fr, int fq) const {
        const int row0 = u.pm * BM + wr * 64 + fr, col0 = u.pn * BM + wc * 32 + 4 * fq;
#pragma unroll
        for (int ai = 0; ai < 2; ++ai)
#pragma unroll
            for (int m = 0; m < 4; ++m) { const size_t off = (size_t)(row0 + ai * HALF + m * 16) * ldc + col0;
#pragma unroll
                for (int bj = 0; bj < 2; ++bj)
#pragma unroll
                    for (int n = 0; n < 2; ++n) { const f32x4 bs = *(const f32x4*)(base + off + bj * HALF + n * 16); *(f32x4*)(out + off + bj * HALF + n * 16) = bs + acc[ai][bj][m][n]; }
                if (m & 1) asm volatile("" ::: "memory"); }
    }
};
template <class Epi, class Sched, bool ALIGN_EPI = false, bool SP2 = false>
__device__ __forceinline__ void gemm_phase(PG8_LAS unsigned char* lds, const Gemm g, const Sched& S, const Epi& E, int tid_in) {
    int tid_ = tid_in; asm volatile("" : "+v"(tid_)); const int tid = tid_, wid = __builtin_amdgcn_readfirstlane(tid >> 6), lane = tid & 63, wr = wid >> 2, wc = wid & 3, fr = lane & 15, fq = lane >> 4;
    const int K = g.K, nt = K / BK;
    unsigned voffA[2], voffB[2];
#pragma unroll
    for (int i = 0; i < 2; ++i) { int R, C; stage_rc(tid * 16 + i * 8192, R, C); const int Rb = Epi::PERM ? ((R & ~31) + perm32(R & 31)) : R;
        voffA[i] = (unsigned)(R * K + C) * 2u; voffB[i] = (unsigned)(Rb * K + C) * 2u; }
    const size_t kstep = (size_t)(BK * 2);
    const size_t hstep = (size_t)HALF * K * 2;
    const size_t tstep = 2 * hstep;
    const unsigned ldsw = (unsigned)wid * 1024u;
    const int aoff = lds_byte(wr * 64 + fr, fq * 8), boff = lds_byte(wc * 32 + fr, fq * 8);
#define PG8_SA(b, h) (((b) * 2 + (h)) * HTB)
#define PG8_SB(b, h) ((4 + (b) * 2 + (h)) * HTB)
#define PG8_STAGE(bufoff, gbase, voff) do { _Pragma("unroll") for (int _i = 0; _i < 2; ++_i) \
        __builtin_amdgcn_global_load_lds((const unsigned*)((const char*)(gbase) + (voff)[_i]), (PG8_LAS unsigned*)(lds + (bufoff) + ldsw + _i * 8192), 16, 0, 0); } while (0)
#define PG8_LDA(dst, b, h) do { _Pragma("unroll") for (int m = 0; m < 4; ++m) _Pragma("unroll") for (int k = 0; k < 2; ++k) dst[m][k] = *(const PG8_LAS bf16x8*)(lds + PG8_SA(b, h) + aoff + m * 2048 + k * 1024); } while (0)
#define PG8_LDB(dst, b, h) do { _Pragma("unroll") for (int n = 0; n < 2; ++n) _Pragma("unroll") for (int k = 0; k < 2; ++k) dst[n][k] = *(const PG8_LAS bf16x8*)(lds + PG8_SB(b, h) + boff + n * 2048 + k * 1024); } while (0)
#define PG8_MMA(ai, bj, At, Bt) do { __builtin_amdgcn_s_setprio(1); _Pragma("unroll") for (int m = 0; m < 4; ++m) _Pragma("unroll") for (int n = 0; n < 2; ++n) _Pragma("unroll") for (int k = 0; k < 2; ++k) \
        acc[ai][bj][m][n] = __builtin_amdgcn_mfma_f32_16x16x32_bf16(Bt[n][k], At[m][k], acc[ai][bj][m][n], 0, 0, 0); __builtin_amdgcn_s_setprio(0); } while (0)
#define PG8_WAIT_V(n) asm volatile("s_waitcnt vmcnt(" #n ")" ::: "memory")
#define PG8_WAIT_L(n) asm volatile("s_waitcnt lgkmcnt(" #n ")" ::: "memory")
#define PG8_BAR __builtin_amdgcn_s_barrier()
#define PG8_SCHED __builtin_amdgcn_sched_barrier(0)
    Unit cur, nxt; int ui = 0;
    if (!S.next(0, cur)) return;
    f32x4 acc[2][2][4][2];
#pragma unroll
    for (int a = 0; a < 2; ++a)
#pragma unroll
        for (int b = 0; b < 2; ++b)
#pragma unroll
            for (int m = 0; m < 4; ++m)
#pragma unroll
                for (int n = 0; n < 2; ++n) acc[a][b][m][n] = (f32x4){0.f, 0.f, 0.f, 0.f};
    bf16x8 At[4][2], B0[2][2], B1[2][2];
    const char* cA = (const char*)g.A + (size_t)cur.pm * tstep; const char* cB = (const char*)g.Bt + (size_t)cur.pn * tstep;
    S.a_ready(cur);
    if constexpr (SP2) {
        PG8_STAGE(PG8_SB(0, 0), cB, voffB); PG8_STAGE(PG8_SB(0, 1), cB + hstep, voffB); PG8_STAGE(PG8_SA(0, 0), cA, voffA); PG8_STAGE(PG8_SA(0, 1), cA + hstep, voffA);
        if (wr == 1) PG8_BAR;
        PG8_WAIT_V(2); PG8_BAR;
        PG8_STAGE(PG8_SB(1, 0), cB + kstep, voffB); PG8_STAGE(PG8_SA(1, 0), cA + kstep, voffA); PG8_STAGE(PG8_SB(1, 1), cB + hstep + kstep, voffB);
        PG8_WAIT_V(6); PG8_BAR;
    } else {
        PG8_STAGE(PG8_SB(0, 0), cB, voffB); PG8_STAGE(PG8_SA(0, 0), cA, voffA); PG8_STAGE(PG8_SB(0, 1), cB + hstep, voffB); PG8_STAGE(PG8_SA(0, 1), cA + hstep, voffA);
        if (wr == 1) PG8_BAR;
        PG8_WAIT_V(4); PG8_BAR;
        PG8_STAGE(PG8_SB(1, 0), cB + kstep, voffB); PG8_STAGE(PG8_SA(1, 0), cA + kstep, voffA); PG8_STAGE(PG8_SB(1, 1), cB + hstep + kstep, voffB);
        PG8_WAIT_V(6); PG8_BAR;
    }
    for (;;) {
        const bool has_next = S.next(ui + 1, nxt);
        const char* nA = has_next ? (const char*)g.A + (size_t)nxt.pm * tstep : cA; const char* nB = has_next ? (const char*)g.Bt + (size_t)nxt.pn * tstep : cB;
        for (int t = 0; t < nt; t += 2) {
            const bool last = (t == nt - 2);
            const char* a1 = cA + (size_t)(t + 1) * kstep;
            const char* a2 = last ? nA : cA + (size_t)(t + 2) * kstep; const char* b2 = last ? nB : cB + (size_t)(t + 2) * kstep;
            const char* a3 = a2 + kstep; const char* b3 = b2 + kstep;
            if (last && has_next) S.a_ready(nxt);
            if constexpr (SP2) {
            PG8_LDB(B0, 0, 0); PG8_LDB(B1, 0, 1); PG8_SCHED; PG8_LDA(At, 0, 0); PG8_STAGE(PG8_SA(1, 1), a1 + hstep, voffA);
            PG8_WAIT_V(8); PG8_WAIT_L(0); PG8_BAR; PG8_MMA(0, 0, At, B0); PG8_MMA(0, 1, At, B1); PG8_BAR; PG8_SCHED;
            PG8_LDA(At, 0, 1); PG8_STAGE(PG8_SB(0, 0), b2, voffB); PG8_STAGE(PG8_SB(0, 1), b2 + hstep, voffB); PG8_STAGE(PG8_SA(0, 0), a2, voffA);
            PG8_WAIT_V(8); PG8_WAIT_L(0); PG8_BAR; PG8_MMA(1, 0, At, B0); PG8_MMA(1, 1, At, B1); PG8_BAR; PG8_SCHED;
            PG8_LDB(B0, 1, 0); PG8_LDB(B1, 1, 1); PG8_SCHED; PG8_LDA(At, 1, 0); PG8_STAGE(PG8_SA(0, 1), a2 + hstep, voffA);
            PG8_WAIT_V(8); PG8_WAIT_L(0); PG8_BAR; PG8_MMA(0, 0, At, B0); PG8_MMA(0, 1, At, B1); PG8_BAR; PG8_SCHED;
            PG8_LDA(At, 1, 1); PG8_STAGE(PG8_SB(1, 0), b3, voffB); PG8_STAGE(PG8_SB(1, 1), b3 + hstep, voffB); PG8_STAGE(PG8_SA(1, 0), a3, voffA);
            PG8_WAIT_V(8); PG8_WAIT_L(0); PG8_BAR; PG8_MMA(1, 0, At, B0); PG8_MMA(1, 1, At, B1); PG8_BAR; PG8_SCHED;
            } else {
            PG8_LDB(B0, 0, 0); PG8_SCHED; PG8_LDA(At, 0, 0); PG8_STAGE(PG8_SA(1, 1), a1 + hstep, voffA);
            PG8_WAIT_L(8); PG8_BAR; PG8_WAIT_L(0); PG8_MMA(0, 0, At, B0); PG8_BAR; PG8_SCHED;
            PG8_LDB(B1, 0, 1); PG8_STAGE(PG8_SB(0, 0), b2, voffB);
            PG8_BAR; PG8_WAIT_L(0); PG8_MMA(0, 1, At, B1); PG8_BAR;
            PG8_LDA(At, 0, 1); PG8_STAGE(PG8_SA(0, 0), a2, voffA);
            PG8_BAR; PG8_WAIT_L(0); PG8_MMA(1, 0, At, B0); PG8_BAR; PG8_SCHED;
            PG8_STAGE(PG8_SB(0, 1), b2 + hstep, voffB);
            PG8_WAIT_V(6); PG8_BAR; PG8_MMA(1, 1, At, B1); PG8_BAR;
            PG8_LDB(B0, 1, 0); PG8_SCHED; PG8_LDA(At, 1, 0); PG8_STAGE(PG8_SA(0, 1), a2 + hstep, voffA);
            PG8_WAIT_L(8); PG8_BAR; PG8_WAIT_L(0); PG8_MMA(0, 0, At, B0); PG8_BAR; PG8_SCHED;
            PG8_LDB(B1, 1, 1); PG8_STAGE(PG8_SB(1, 0), b3, voffB);
            PG8_BAR; PG8_WAIT_L(0); PG8_MMA(0, 1, At, B1); PG8_BAR;
            PG8_LDA(At, 1, 1); PG8_STAGE(PG8_SA(1, 0), a3, voffA);
            PG8_BAR; PG8_WAIT_L(0); PG8_MMA(1, 0, At, B0); PG8_BAR; PG8_SCHED;
            PG8_STAGE(PG8_SB(1, 1), b3 + hstep, voffB);
            PG8_WAIT_V(6); PG8_BAR; PG8_MMA(1, 1, At, B1); PG8_BAR;
            }
        }
        if constexpr (ALIGN_EPI) { if (wr == 0) PG8_BAR; }
        if constexpr (!Epi::AFTER_DRAIN) { E(acc, cur, wr, wc, fr, fq); S.done(cur); }
        if (!has_next) break;
#pragma unroll
        for (int a = 0; a < 2; ++a)
#pragma unroll
            for (int b = 0; b < 2; ++b)
#pragma unroll
                for (int m = 0; m < 4; ++m)
#pragma unroll
                    for (int n = 0; n < 2; ++n) acc[a][b][m][n] = (f32x4){0.f, 0.f, 0.f, 0.f};
        cur = nxt; cA = nA; cB = nB; ++ui;
        if constexpr (ALIGN_EPI) { if (wr == 1) PG8_BAR; }
    }
    PG8_WAIT_V(0);
    if constexpr (!ALIGN_EPI) { if (wr == 0) PG8_BAR; }
    PG8_BAR;
    if constexpr (Epi::AFTER_DRAIN) { E.fused(acc, cur, wr, wc, fr, fq, lds, wid, lane); S.done(cur); }
#undef PG8_SA
#undef PG8_SB
#undef PG8_STAGE
#undef PG8_LDA
#undef PG8_LDB
#undef PG8_MMA
#undef PG8_WAIT_V
#undef PG8_WAIT_L
#undef PG8_BAR
#undef PG8_SCHED
}
}
#ifndef PG8_SP2
#define PG8_SP2 true
#endif
#ifndef PG8_ALIGN
#define PG8_ALIGN true
#endif
constexpr int NWAVES = 8, NTHR = 512;
constexpr int BATCH = 8, T = 8192, D = 1024, DEPTH = 4, MEMLEN = 256, FF = 4096;
constexpr int M = BATCH * T;
constexpr int AB_IN = 3080, AB_N = 3072, C_IN = 4112, C_N = 4096;
constexpr float EPS = 1e-6f;
constexpr float SB_THR = 88.0f;

constexpr size_t MiB = 1u << 20;
constexpr size_t WS_CTL = 0, CTL_ZERO_BYTES = 1 * MiB;
constexpr size_t WS_WG = 1 * MiB;
constexpr size_t WS_MEMN = 2 * MiB;
constexpr size_t WS_WKV = 6 * MiB;
constexpr size_t WS_W = 22 * MiB, W_LAYER = 30 * MiB;
constexpr size_t WO_WIN = 0, WO_WOUT = 8 * MiB, WO_WQ = 10 * MiB, WO_WO = 12 * MiB, WO_W1 = 14 * MiB, WO_W2 = 22 * MiB;
constexpr size_t WS_KVX = 142 * MiB;
constexpr size_t WS_GATE = 174 * MiB;
constexpr size_t WS_H = 178 * MiB;
constexpr size_t WS_MIX = 306 * MiB;
constexpr size_t WS_BIG = 434 * MiB;
constexpr size_t WS_END = 946 * MiB;
constexpr int CW_TMO = 0, CW_BAR = 4096;

constexpr int LDS_BYTES = 147456;
constexpr int MISC_OFF = 140 * 1024;

#define GAS __attribute__((address_space(1)))
#define LAS __attribute__((address_space(3)))
#define DI __device__ __forceinline__
typedef unsigned short bf16;
typedef unsigned v4u __attribute__((ext_vector_type(4)));
typedef unsigned v2u __attribute__((ext_vector_type(2)));
typedef float f32x4 __attribute__((ext_vector_type(4)));
typedef short bf16x8 __attribute__((ext_vector_type(8)));
typedef short s16x4 __attribute__((ext_vector_type(4)));
#define LDS_WAIT() asm volatile("s_waitcnt lgkmcnt(0)" ::: "memory")
DI unsigned f2bf(float f) { unsigned u = __builtin_bit_cast(unsigned, f); return (u + 0x7fffu + ((u >> 16) & 1u)) >> 16; }
DI unsigned pk2(float lo, float hi) { return f2bf(lo) | (f2bf(hi) << 16); }
DI float bf2f(unsigned short b) { return __builtin_bit_cast(float, ((unsigned)b) << 16); }
DI float bflo(unsigned u) { return __builtin_bit_cast(float, u << 16); }
DI float bfhi(unsigned u) { return __builtin_bit_cast(float, u & 0xffff0000u); }
DI float wave_sum(float v) {
#pragma unroll
    for (int o = 1; o < 64; o <<= 1) v += __shfl_xor(v, o);
    return v;
}
DI float sigmoidf_(float x) { return 1.0f / (1.0f + __expf(-x)); }
DI f32x4 mfma16(bf16x8 a, bf16x8 b, f32x4 c) { return __builtin_amdgcn_mfma_f32_16x16x32_bf16(a, b, c, 0, 0, 0); }
#define XB_TMO      128
#define XB_XCNT(j)  (256  + 64 * (j))
#define XB_XSUB(j)  (1280 + 64 * (j))
#define XB_XGEN(j)  (2304 + 64 * (j))
#define XB_TOP      3328
#define XB_TOPGEN   3392
#define XCD_BAR_WORDS 3456
#define XB_SPIN_CAP (1u << 22)

__device__ __forceinline__ unsigned xb_ld(unsigned* p)              { return __hip_atomic_load(p, __ATOMIC_RELAXED, __HIP_MEMORY_SCOPE_AGENT); }
__device__ __forceinline__ unsigned xb_add(unsigned* p, unsigned v) { return __hip_atomic_fetch_add(p, v, __ATOMIC_RELAXED, __HIP_MEMORY_SCOPE_AGENT); }
__device__ __forceinline__ unsigned xb_xcc_id() { return (unsigned)__builtin_amdgcn_s_getreg((3 << 11) | 20) & 0xFu; }
#define XB_SPIN(cond, bar) do { unsigned _sp = 0; while (cond) { __builtin_amdgcn_s_sleep(1); \
    if ((++_sp & 255u) == 0u) { if (xb_ld(&(bar)[XB_TMO])) break; if (_sp > XB_SPIN_CAP) { atomicAdd(&(bar)[XB_TMO], 1u); break; } } } } while (0)

struct XcdBarrier {
    unsigned* bar; unsigned x;
    volatile LAS unsigned* st;
};

__device__ __forceinline__ XcdBarrier xcd_barrier_post(unsigned* bar, volatile LAS unsigned* st) {
    XcdBarrier b; b.bar = bar; b.x = xb_xcc_id(); b.st = st;
    if (threadIdx.x == 0) (void)xb_add(&bar[XB_XCNT(b.x)], 1u);
    return b;
}
__device__ __forceinline__ void xcd_barrier_complete(unsigned* bar, unsigned x, unsigned& nloc, unsigned& nx) {
    const unsigned G = gridDim.x * gridDim.y * gridDim.z;
    unsigned sum, cnt, mine, sp = 0u;
    for (;;) {
        sum = 0u; cnt = 0u; mine = 0u;
#pragma unroll
        for (unsigned j = 0; j < 16; ++j) { const unsigned c = xb_ld(&bar[XB_XCNT(j)]); sum += c; cnt += (c > 0u) ? 1u : 0u; mine = (j == x) ? c : mine; }
        if (sum == G) break;
        __builtin_amdgcn_s_sleep(1);
        if ((++sp & 255u) == 0u) { if (xb_ld(&bar[XB_TMO])) break; if (sp > XB_SPIN_CAP) { atomicAdd(&bar[XB_TMO], 1u); break; } }
    }
    nloc = mine > 0u ? mine : 1u; nx = cnt > 0u ? cnt : 1u;
}

__device__ __forceinline__ void xcd_barrier(const XcdBarrier& b) {
    asm volatile("s_waitcnt vmcnt(0)" ::: "memory");
    __syncthreads();
    if (threadIdx.x == 0) {
        unsigned* bar = b.bar;
        __builtin_amdgcn_s_waitcnt(0);
        unsigned nloc = b.st[0], nx = b.st[1];
        if (nloc == 0u) { xcd_barrier_complete(bar, b.x, nloc, nx); b.st[0] = nloc; b.st[1] = nx; }
        const unsigned old = xb_add(&bar[XB_XSUB(b.x)], 1u);
        const unsigned gen = old / nloc;
        if (old + 1u == (gen + 1u) * nloc) {
            __builtin_amdgcn_fence(__ATOMIC_RELEASE, "agent");
            asm volatile("s_waitcnt vmcnt(0)" ::: "memory");
            const unsigned og = xb_add(&bar[XB_TOP], 1u);
            const unsigned tg = og / nx;
            if (og + 1u == (tg + 1u) * nx) xb_add(&bar[XB_TOPGEN], 1u);
            else XB_SPIN(xb_ld(&bar[XB_TOPGEN]) == tg, bar);
            __builtin_amdgcn_fence(__ATOMIC_ACQUIRE, "agent");
            xb_add(&bar[XB_XGEN(b.x)], 1u);
            asm volatile("s_waitcnt vmcnt(0)" ::: "memory");
        } else {
            XB_SPIN(xb_ld(&bar[XB_XGEN(b.x)]) == gen, bar);
            __builtin_amdgcn_fence(__ATOMIC_ACQUIRE, "agent");
            asm volatile("s_waitcnt vmcnt(0)" ::: "memory");
        }
    }
    __syncthreads();
}
struct Frame {
    LAS unsigned char* lds;
    int tid, lane, wave;
    int G, wg, gw, NGW;
};

DI void transpose_item(const float* W, int ldsrc, int coloff, bf16* WT, int K, int row_off, int nblk, LAS float* scr, int item, int lane) {
    const int kb = item / nblk, nb = item % nblk, k0 = 64 * kb, n0 = 32 * nb;
#pragma unroll 8
    for (int i = 0; i < 32; ++i) { const int kk = 2 * i + (lane >> 5); scr[kk * 33 + (lane & 31)] = W[(size_t)(k0 + kk) * ldsrc + coloff + n0 + (lane & 31)]; }
    LDS_WAIT(); asm volatile("" ::: "memory");
    const int c = lane & 7;
#pragma unroll
    for (int j = 0; j < 4; ++j) { const int n = (lane >> 3) + 8 * j; const LAS float* s = scr + (8 * c) * 33 + n;
        v4u o; o.x = pk2(s[0 * 33], s[1 * 33]); o.y = pk2(s[2 * 33], s[3 * 33]); o.z = pk2(s[4 * 33], s[5 * 33]); o.w = pk2(s[6 * 33], s[7 * 33]);
        *(GAS v4u*)(WT + (size_t)(row_off + n0 + n) * K + k0 + 8 * c) = o; }
    LDS_WAIT(); asm volatile("" ::: "memory");
}
DI void transpose_matrix(Frame& F, const float* W, int ldsrc, int coloff, int ncols, int K, bf16* WT, int row_off, unsigned& base) {
    LAS float* scr = (LAS float*)(F.lds + F.wave * 16384);
    const int nblk = ncols / 32, nitems = (K / 64) * nblk;
    int it = (int)(((unsigned)F.gw + (unsigned)F.NGW - (base % (unsigned)F.NGW)) % (unsigned)F.NGW);
    for (; it < nitems; it += F.NGW) transpose_item(W, ldsrc, coloff, WT, K, row_off, nblk, scr, it, F.lane);
    base += (unsigned)nitems;
}
DI void rms_row(const float* xrow, const f32x4 (&g4)[4], f32x4 (&v)[4], int lane) {
    const GAS f32x4* xr = (const GAS f32x4*)xrow + lane; float s = 0.f;
#pragma unroll
    for (int j = 0; j < 4; ++j) { v[j] = xr[64 * j]; s += (v[j].x * v[j].x + v[j].y * v[j].y) + (v[j].z * v[j].z + v[j].w * v[j].w); }
    const float rstd = 1.0f / sqrtf(wave_sum(s) * (1.f / 1024.f) + EPS);
#pragma unroll
    for (int j = 0; j < 4; ++j) v[j] = v[j] * rstd * g4[j];
}
DI void store_row_bf16(bf16* orow, const f32x4 (&v)[4], int lane) {
    GAS unsigned long long* o8 = (GAS unsigned long long*)orow + lane;
#pragma unroll
    for (int j = 0; j < 4; ++j) o8[64 * j] = (unsigned long long)pk2(v[j].x, v[j].y) | ((unsigned long long)pk2(v[j].z, v[j].w) << 32);
}
struct In { const float* p[24]; };
DI void p0_prologue(Frame& F, const In& I, unsigned char* ws) {
    unsigned base = 0;
    for (int l = 0; l < DEPTH; ++l) {
        const int j = l >> 1; unsigned char* wl = ws + WS_W + (size_t)l * W_LAYER;
        if ((l & 1) == 0) {
            transpose_matrix(F, I.p[3] + (size_t)j * D * AB_IN, AB_IN, 0, 1536, D, (bf16*)(wl + WO_WIN), 0, base);
            transpose_matrix(F, I.p[3] + (size_t)j * D * AB_IN, AB_IN, 1544, 1536, D, (bf16*)(wl + WO_WIN), 1536, base);
            transpose_matrix(F, I.p[7] + (size_t)j * D * D, D, 0, D, D, (bf16*)(wl + WO_WOUT), 0, base);
        } else {
            transpose_matrix(F, I.p[8] + (size_t)j * D * C_IN, C_IN, 0, 4096, D, (bf16*)(wl + WO_WIN), 0, base);
            transpose_matrix(F, I.p[13] + (size_t)j * D * D, D, 0, D, D, (bf16*)(wl + WO_WOUT), 0, base);
        }
        transpose_matrix(F, I.p[16] + (size_t)l * D * D, D, 0, D, D, (bf16*)(wl + WO_WQ), 0, base);
        transpose_matrix(F, I.p[19] + (size_t)l * D * D, D, 0, D, D, (bf16*)(wl + WO_WO), 0, base);
        transpose_matrix(F, I.p[17] + (size_t)l * D * D, D, 0, D, D, (bf16*)(ws + WS_WKV), 2048 * l, base);
        transpose_matrix(F, I.p[18] + (size_t)l * D * D, D, 0, D, D, (bf16*)(ws + WS_WKV), 2048 * l + 1024, base);
        transpose_matrix(F, I.p[21] + (size_t)l * D * FF, FF, 0, FF, D, (bf16*)(wl + WO_W1), 0, base);
        transpose_matrix(F, I.p[22] + (size_t)l * FF * D, D, 0, D, FF, (bf16*)(wl + WO_W2), 0, base);
    }
    float* Wg = (float*)(ws + WS_WG);
    for (int idx = F.wg * NTHR + F.tid; idx < DEPTH * 16 * 1024; idx += F.G * NTHR) {
        const int l = idx >> 14, g = (idx >> 10) & 15, k = idx & 1023, j = l >> 1; float v = 0.f;
        if ((l & 1) == 0) { if (g < 8) v = I.p[3][(size_t)j * D * AB_IN + (size_t)k * AB_IN + 1536 + g]; }
        else v = I.p[8][(size_t)j * D * C_IN + (size_t)k * C_IN + 4096 + g];
        Wg[idx] = v;
    }
    { f32x4 g4[4];
#pragma unroll
      for (int j = 0; j < 4; ++j) g4[j] = ((const GAS f32x4*)I.p[15])[F.lane + 64 * j];
      for (int r = F.gw; r < BATCH * MEMLEN; r += F.NGW) { f32x4 v[4]; rms_row(I.p[1] + (size_t)r * D, g4, v, F.lane); store_row_bf16((bf16*)(ws + WS_MEMN) + (size_t)r * D, v, F.lane); } }
}
template <int MODE> DI void norm_phase(Frame& F, const float* xin, const float* gain, bf16* hout, const float* Wg, float* gate, const float* p0, const float* p1) {
    f32x4 g4[4];
#pragma unroll
    for (int j = 0; j < 4; ++j) g4[j] = ((const GAS f32x4*)gain)[F.lane + 64 * j];
    constexpr int NG = MODE == 1 ? 8 : (MODE == 2 ? 16 : 0);
    float par = 0.f;
    if (MODE == 1) { if (F.lane < 4) par = p0[F.lane]; else if (F.lane < 8) par = p1[F.lane - 4]; }
    float par2 = 0.f;
    if (MODE == 2) { if (F.lane >= 8 && F.lane < 16) { par = p0[F.lane - 8]; par2 = p1[F.lane - 8]; } }
    for (int r = F.gw; r < M; r += F.NGW) {
        f32x4 v[4]; rms_row(xin + (size_t)r * D, g4, v, F.lane); store_row_bf16(hout + (size_t)r * D, v, F.lane);
        if (MODE != 0) {
            float keep = 0.f;
#pragma unroll
            for (int g = 0; g < NG; ++g) {
                const GAS f32x4* wr = (const GAS f32x4*)(Wg + g * 1024) + F.lane; float p = 0.f;
#pragma unroll
                for (int j = 0; j < 4; ++j) { const f32x4 w = wr[64 * j]; p += (v[j].x * w.x + v[j].y * w.y) + (v[j].z * w.z + v[j].w * w.w); }
                p = wave_sum(p); if (F.lane == g) keep = p;
            }
            if (MODE == 1 && F.lane < 8) {
                const float a = keep + par; float o;
                if (F.lane < 4) o = 15.0f * tanhf(a * (1.0f / 15.0f));
                else o = fminf(a, 0.f) - log1pf(expf(-fabsf(a)));
                gate[(size_t)r * 16 + F.lane] = o;
            }
            if (MODE == 2 && F.lane < 16) {
                float o;
                if (F.lane < 8) o = 1.0f / (1.0f + expf(-keep));
                else { const float z = keep + par2; const float sp = fmaxf(z, 0.f) + log1pf(expf(-fabsf(z))); o = -expf(par) * sp; }
                gate[(size_t)r * 16 + F.lane] = o;
            }
        }
    }
}
DI void final_norm_phase(Frame& F, float* x, const float* gain) {
    f32x4 g4[4];
#pragma unroll
    for (int j = 0; j < 4; ++j) g4[j] = ((const GAS f32x4*)gain)[F.lane + 64 * j];
    for (int r = F.gw; r < M; r += F.NGW) { f32x4 v[4]; rms_row(x + (size_t)r * D, g4, v, F.lane); GAS f32x4* o = (GAS f32x4*)(x + (size_t)r * D) + F.lane;
#pragma unroll
        for (int j = 0; j < 4; ++j) o[64 * j] = v[j]; }
}
template <bool ODD> DI void headnorm_phase(Frame& F, bf16* mix, const bf16* proj, const float* hg) {
    constexpr int NC = ODD ? 16 : 8;
    for (int r = F.gw; r < M; r += F.NGW) {
        const int c0 = NC * F.lane;
        float x[NC], gt[NC];
#pragma unroll
        for (int q = 0; q < NC / 8; ++q) {
            const v4u raw = *(const GAS v4u*)(mix + (size_t)r * D + c0 + 8 * q);
            const v4u gr = *(const GAS v4u*)(proj + (size_t)r * (ODD ? C_N : AB_N) + (ODD ? 3072 : 1024) + c0 + 8 * q);
            x[8 * q + 0] = bflo(raw.x); x[8 * q + 1] = bfhi(raw.x); x[8 * q + 2] = bflo(raw.y); x[8 * q + 3] = bfhi(raw.y); x[8 * q + 4] = bflo(raw.z); x[8 * q + 5] = bfhi(raw.z); x[8 * q + 6] = bflo(raw.w); x[8 * q + 7] = bfhi(raw.w);
            gt[8 * q + 0] = bflo(gr.x); gt[8 * q + 1] = bfhi(gr.x); gt[8 * q + 2] = bflo(gr.y); gt[8 * q + 3] = bfhi(gr.y); gt[8 * q + 4] = bflo(gr.z); gt[8 * q + 5] = bfhi(gr.z); gt[8 * q + 6] = bflo(gr.w); gt[8 * q + 7] = bfhi(gr.w);
        }
        float ss = 0.f;
#pragma unroll
        for (int i = 0; i < NC; ++i) ss += x[i] * x[i];
        ss += __shfl_xor(ss, 1); ss += __shfl_xor(ss, 2); ss += __shfl_xor(ss, 4); if (!ODD) ss += __shfl_xor(ss, 8);
        const float rstd = 1.0f / sqrtf(ss * (1.f / 128.f) + EPS);
#pragma unroll
        for (int i = 0; i < NC; ++i) { const float g = ODD ? hg[(c0 + i) & 127] : hg[c0 + i]; const float s = sigmoidf_(gt[i]); x[i] = x[i] * rstd * g * (ODD ? gt[i] * s : s); }
#pragma unroll
        for (int q = 0; q < NC / 8; ++q) { v4u o; o.x = pk2(x[8 * q], x[8 * q + 1]); o.y = pk2(x[8 * q + 2], x[8 * q + 3]); o.z = pk2(x[8 * q + 4], x[8 * q + 5]); o.w = pk2(x[8 * q + 6], x[8 * q + 7]);
            *(GAS v4u*)(mix + (size_t)r * D + c0 + 8 * q) = o; }
    }
}
DI void mlstm_chain(Frame& F, const bf16* proj, const float* gate, bf16* mix, int c) {
    const int b = c >> 4, h = (c >> 2) & 3, vq = c & 3, vl = F.tid >> 4, dg = F.tid & 15;
    float C0 = 0.f, C1 = 0.f, C2 = 0.f, C3 = 0.f, n0 = 0.f, n1 = 0.f, n2 = 0.f, n3 = 0.f, m = 0.f;
    const bf16* pq = proj + (size_t)b * T * AB_N + h * 64 + 4 * dg;
    const bf16* pk = pq + 256;
    const bf16* pv = proj + (size_t)b * T * AB_N + 512 + h * 128 + vq * 32 + vl;
    const float* pg = gate + (size_t)b * T * 16 + h;
    bf16* po = mix + (size_t)b * T * D + h * 128 + vq * 32 + vl;
    for (int t0 = 0; t0 < T; t0 += 8) {
        v2u qr[8], kr[8]; unsigned short vr[8]; float li[8], lf[8];
#pragma unroll
        for (int i = 0; i < 8; ++i) { qr[i] = *(const GAS v2u*)(pq + (size_t)(t0 + i) * AB_N); kr[i] = *(const GAS v2u*)(pk + (size_t)(t0 + i) * AB_N); vr[i] = pv[(size_t)(t0 + i) * AB_N];
            li[i] = pg[(size_t)(t0 + i) * 16]; lf[i] = pg[(size_t)(t0 + i) * 16 + 4]; }
#pragma unroll
        for (int i = 0; i < 8; ++i) {
            const float q0 = bflo(qr[i].x), q1 = bfhi(qr[i].x), q2 = bflo(qr[i].y), q3 = bfhi(qr[i].y);
            const float k0 = bflo(kr[i].x) * 0.125f, k1 = bfhi(kr[i].x) * 0.125f, k2 = bflo(kr[i].y) * 0.125f, k3 = bfhi(kr[i].y) * 0.125f;
            const float vv = bf2f(vr[i]);
            const float mn = fmaxf(lf[i] + m, li[i]); const float fp = __expf(lf[i] + m - mn), ip = __expf(li[i] - mn); m = mn;
            const float iv = ip * vv;
            C0 = fp * C0 + iv * k0; C1 = fp * C1 + iv * k1; C2 = fp * C2 + iv * k2; C3 = fp * C3 + iv * k3;
            n0 = fp * n0 + ip * k0; n1 = fp * n1 + ip * k1; n2 = fp * n2 + ip * k2; n3 = fp * n3 + ip * k3;
            float pn = (C0 * q0 + C1 * q1) + (C2 * q2 + C3 * q3), pd = (n0 * q0 + n1 * q1) + (n2 * q2 + n3 * q3);
#pragma unroll
            for (int o = 1; o < 16; o <<= 1) { pn += __shfl_xor(pn, o); pd += __shfl_xor(pd, o); }
            const float hv = pn / fmaxf(fabsf(pd), __expf(-mn));
            if (dg == 0) po[(size_t)(t0 + i) * D] = (bf16)f2bf(hv);
        }
    }
}
DI void gdn_chain(Frame& F, const bf16* proj, const float* gate, const float* convw, bf16* mix, int c) {
    const int b = c >> 5, h = (c >> 2) & 7, vq = c & 3, cc = F.tid >> 4, dg = F.tid & 15;
    LAS float* qs = (LAS float*)F.lds; LAS float* ks = qs + 64 * 128; LAS float* vs = ks + 64 * 128; LAS float* os = vs + 64 * 32; LAS float* bet = os + 64 * 32; LAS float* alp = bet + 64;
    float S[8];
#pragma unroll
    for (int j = 0; j < 8; ++j) S[j] = 0.f;
    for (int t0 = 0; t0 < T; t0 += 64) {
        __syncthreads();
        { const int row = F.tid >> 3, seg = F.tid & 7, t = t0 + row;
#pragma unroll
          for (int which = 0; which < 2; ++which) {
              const int colg = which * 1024 + h * 128 + seg * 16; float a[16];
#pragma unroll
              for (int i = 0; i < 16; ++i) a[i] = 0.f;
#pragma unroll
              for (int j = 0; j < 4; ++j) { const int tt = t - 3 + j;
                  if (tt >= 0) { const bf16* src = proj + (size_t)(b * T + tt) * C_N + colg; const float* w = convw + j * 3072 + colg;
#pragma unroll
                      for (int q = 0; q < 2; ++q) { const v4u raw = *(const GAS v4u*)(src + 8 * q); const f32x4 w0 = *(const GAS f32x4*)(w + 8 * q), w1 = *(const GAS f32x4*)(w + 8 * q + 4);
                          a[8 * q + 0] += bflo(raw.x) * w0.x; a[8 * q + 1] += bfhi(raw.x) * w0.y; a[8 * q + 2] += bflo(raw.y) * w0.z; a[8 * q + 3] += bfhi(raw.y) * w0.w;
                          a[8 * q + 4] += bflo(raw.z) * w1.x; a[8 * q + 5] += bfhi(raw.z) * w1.y; a[8 * q + 6] += bflo(raw.w) * w1.z; a[8 * q + 7] += bfhi(raw.w) * w1.w; } } }
              float ss = 0.f;
#pragma unroll
              for (int i = 0; i < 16; ++i) { a[i] = a[i] * sigmoidf_(a[i]); ss += a[i] * a[i]; }
              ss += __shfl_xor(ss, 1); ss += __shfl_xor(ss, 2); ss += __shfl_xor(ss, 4);
              const float sc = (1.0f / sqrtf(ss + EPS)) * (which == 0 ? 0.08838834764831845f : 1.0f);
              LAS float* dst = (which == 0 ? qs : ks) + row * 128 + seg * 16;
#pragma unroll
              for (int q = 0; q < 4; ++q) *(LAS f32x4*)(dst + 4 * q) = (f32x4){a[4 * q] * sc, a[4 * q + 1] * sc, a[4 * q + 2] * sc, a[4 * q + 3] * sc};
          } }
        if (F.tid < 256) { const int row = F.tid >> 2, seg = F.tid & 3, t = t0 + row; const int colg = 2048 + h * 128 + vq * 32 + seg * 8; float a[8];
#pragma unroll
            for (int i = 0; i < 8; ++i) a[i] = 0.f;
#pragma unroll
            for (int j = 0; j < 4; ++j) { const int tt = t - 3 + j;
                if (tt >= 0) { const v4u raw = *(const GAS v4u*)(proj + (size_t)(b * T + tt) * C_N + colg); const float* w = convw + j * 3072 + colg; const f32x4 w0 = *(const GAS f32x4*)w, w1 = *(const GAS f32x4*)(w + 4);
                    a[0] += bflo(raw.x) * w0.x; a[1] += bfhi(raw.x) * w0.y; a[2] += bflo(raw.y) * w0.z; a[3] += bfhi(raw.y) * w0.w; a[4] += bflo(raw.z) * w1.x; a[5] += bfhi(raw.z) * w1.y; a[6] += bflo(raw.w) * w1.z; a[7] += bfhi(raw.w) * w1.w; } }
#pragma unroll
            for (int i = 0; i < 8; ++i) a[i] = a[i] * sigmoidf_(a[i]);
            *(LAS f32x4*)(vs + row * 32 + seg * 8) = (f32x4){a[0], a[1], a[2], a[3]}; *(LAS f32x4*)(vs + row * 32 + seg * 8 + 4) = (f32x4){a[4], a[5], a[6], a[7]}; }
        if (F.tid < 64) { const float* g = gate + (size_t)(b * T + t0 + F.tid) * 16; bet[F.tid] = g[h]; alp[F.tid] = __expf(g[8 + h]); }
        __syncthreads();
        for (int s = 0; s < 64; ++s) {
            const f32x4 ka = *(const LAS f32x4*)(ks + s * 128 + 8 * dg), kb = *(const LAS f32x4*)(ks + s * 128 + 8 * dg + 4);
            const f32x4 qa = *(const LAS f32x4*)(qs + s * 128 + 8 * dg), qb = *(const LAS f32x4*)(qs + s * 128 + 8 * dg + 4);
            const float vv = vs[s * 32 + cc], be = bet[s], al = alp[s];
            float p = (ka.x * S[0] + ka.y * S[1]) + (ka.z * S[2] + ka.w * S[3]) + (kb.x * S[4] + kb.y * S[5]) + (kb.z * S[6] + kb.w * S[7]);
#pragma unroll
            for (int o = 1; o < 16; o <<= 1) p += __shfl_xor(p, o);
            const float dl = be * (vv - al * p);
            S[0] = al * S[0] + ka.x * dl; S[1] = al * S[1] + ka.y * dl; S[2] = al * S[2] + ka.z * dl; S[3] = al * S[3] + ka.w * dl;
            S[4] = al * S[4] + kb.x * dl; S[5] = al * S[5] + kb.y * dl; S[6] = al * S[6] + kb.z * dl; S[7] = al * S[7] + kb.w * dl;
            float po = (qa.x * S[0] + qa.y * S[1]) + (qa.z * S[2] + qa.w * S[3]) + (qb.x * S[4] + qb.y * S[5]) + (qb.z * S[6] + qb.w * S[7]);
#pragma unroll
            for (int o = 1; o < 16; o <<= 1) po += __shfl_xor(po, o);
            if (dg == 0) os[s * 32 + cc] = po;
        }
        __syncthreads();
        { const int row = F.tid >> 3, c4 = (F.tid & 7) * 4; const f32x4 o = *(const LAS f32x4*)(os + row * 32 + c4);
          *(GAS v2u*)(mix + (size_t)(b * T + t0 + row) * D + h * 128 + vq * 32 + c4) = (v2u){pk2(o.x, o.y), pk2(o.z, o.w)}; }
    }
}
DI void sb_unit(Frame& F, const bf16* proj, bf16* mix, int u) {
    constexpr int LDV = 72;
    const int qt = u & 63, h = (u >> 6) & 3, b = u >> 8;
    LAS bf16* Vt = (LAS bf16*)F.lds;
    volatile LAS unsigned* flag = (volatile LAS unsigned*)(F.lds + MISC_OFF + 64);
    const int w = F.wave, lane = F.lane, r = lane & 15, quad = lane >> 4;
    const int t0 = qt * 128, qpos = t0 + 16 * w + r;
    const size_t rb = (size_t)b * T;
    bf16x8 qf[4];
#pragma unroll
    for (int kk = 0; kk < 4; ++kk) qf[kk] = *(const GAS bf16x8*)(proj + (rb + qpos) * AB_N + 1536 + h * 128 + 32 * kk + 8 * quad);
    f32x4 o[8];
#pragma unroll
    for (int i = 0; i < 8; ++i) o[i] = (f32x4){0.f, 0.f, 0.f, 0.f};
    float carry = 0.f;
    const float scale = 0.08838834764831845f;
    for (int kb = 2 * qt + 1; kb >= 0; --kb) {
        const int k0 = kb * 64;
        __syncthreads();
        { const int key = F.tid >> 3, ds = (F.tid & 7) * 16; const bf16* src = proj + (rb + k0 + key) * AB_N + 2560 + h * 128 + ds;
          const v4u a = *(const GAS v4u*)src, c = *(const GAS v4u*)(src + 8);
          const unsigned ww[8] = {a.x, a.y, a.z, a.w, c.x, c.y, c.z, c.w};
#pragma unroll
          for (int i = 0; i < 8; ++i) { Vt[(ds + 2 * i) * LDV + key] = (bf16)(ww[i] & 0xffffu); Vt[(ds + 2 * i + 1) * LDV + key] = (bf16)(ww[i] >> 16); } }
        if (F.tid == 0) flag[0] = 0u;
        __syncthreads();
        if (k0 < t0 + 16 * w + 15) {
            f32x4 s[4];
#pragma unroll
            for (int mt = 0; mt < 4; ++mt) { s[mt] = (f32x4){0.f, 0.f, 0.f, 0.f};
                const bf16* kp = proj + (rb + k0 + 16 * mt + r) * AB_N + 2048 + h * 128 + 8 * quad;
#pragma unroll
                for (int kk = 0; kk < 4; ++kk) s[mt] = mfma16(*(const GAS bf16x8*)(kp + 32 * kk), qf[kk], s[mt]); }
            float l1[4][4], tot[4];
#pragma unroll
            for (int mt = 0; mt < 4; ++mt) { tot[mt] = 0.f;
#pragma unroll
                for (int j = 0; j < 4; ++j) { const float z = s[mt][j] * scale; const bool valid = (k0 + 16 * mt + 4 * quad + j) < qpos;
                    const float tl = __logf(1.0f + __expf(-fabsf(z)));
                    l1[mt][j] = valid ? (fminf(-z, 0.f) - tl) : 0.f; s[mt][j] = valid ? (fminf(z, 0.f) - tl) : -1e30f; tot[mt] += l1[mt][j]; } }
            float run = carry;
#pragma unroll
            for (int mt = 3; mt >= 0; --mt) {
                const float t1 = __shfl_xor(tot[mt], 16), t2 = __shfl_xor(tot[mt], 32), t3 = __shfl_xor(t1, 32);
                float hi = 0.f;
                hi += ((quad ^ 1) > quad) ? t1 : 0.f; hi += ((quad ^ 2) > quad) ? t2 : 0.f; hi += ((quad ^ 3) > quad) ? t3 : 0.f;
                float acc = run + hi;
#pragma unroll
                for (int j = 3; j >= 0; --j) { const float e = s[mt][j] + acc; s[mt][j] = __expf(e); acc += l1[mt][j]; }
                run += (tot[mt] + t1) + (t2 + t3);
            }
            carry = run;
#pragma unroll
            for (int s2 = 0; s2 < 2; ++s2) {
                v4u pw; pw.x = pk2(s[2 * s2][0], s[2 * s2][1]); pw.y = pk2(s[2 * s2][2], s[2 * s2][3]); pw.z = pk2(s[2 * s2 + 1][0], s[2 * s2 + 1][1]); pw.w = pk2(s[2 * s2 + 1][2], s[2 * s2 + 1][3]);
                const bf16x8 pf = __builtin_bit_cast(bf16x8, pw);
#pragma unroll
                for (int dt = 0; dt < 8; ++dt) { const LAS bf16* vp = Vt + (16 * dt + r) * LDV + 32 * s2 + 4 * quad;
                    const s16x4 lo = *(const LAS s16x4*)vp, hi4 = *(const LAS s16x4*)(vp + 16);
                    o[dt] = mfma16(__builtin_shufflevector(lo, hi4, 0, 1, 2, 3, 4, 5, 6, 7), pf, o[dt]); }
            }
        }
        if (!(carry < -SB_THR)) flag[0] = 1u;
        __syncthreads();
        if (flag[0] == 0u) break;
    }
    bf16* op = mix + (rb + qpos) * D + 512 + h * 128 + 4 * quad;
#pragma unroll
    for (int dt = 0; dt < 8; ++dt) *(GAS v2u*)(op + 16 * dt) = (v2u){pk2(o[dt][0], o[dt][1]), pk2(o[dt][2], o[dt][3])};
}
DI void xattn_phase(Frame& F, const bf16* Q, const bf16* KV, int l, bf16* O) {
    constexpr int LDV = 264;
    LAS bf16* Vt = (LAS bf16*)F.lds;
    const int per = (2048 + F.G - 1) / F.G, u0 = F.wg * per, u1 = (u0 + per < 2048) ? u0 + per : 2048;
    const int w = F.wave, lane = F.lane, r = lane & 15, quad = lane >> 4;
    int cur = -1;
    for (int u = u0; u < u1; ++u) {
        const int bh = u >> 6, qt = u & 63, b = bh >> 2, h = bh & 3;
        if (bh != cur) {
            __syncthreads();
#pragma unroll 4
            for (int it = 0; it < 16; ++it) { const int idx = F.tid + NTHR * it, key = idx >> 5, ds = (idx & 31) * 8;
                const v4u a = *(const GAS v4u*)(KV + (size_t)(b * MEMLEN + key) * 8192 + 2048 * l + 1024 + h * 256 + ds);
                const unsigned ww[4] = {a.x, a.y, a.z, a.w};
#pragma unroll
                for (int i = 0; i < 4; ++i) { Vt[(ds + 2 * i) * LDV + key] = (bf16)(ww[i] & 0xffffu); Vt[(ds + 2 * i + 1) * LDV + key] = (bf16)(ww[i] >> 16); } }
            __syncthreads(); cur = bh;
        }
        const size_t row = (size_t)b * T + qt * 128 + 16 * w + r;
        bf16x8 qf[8];
#pragma unroll
        for (int kk = 0; kk < 8; ++kk) qf[kk] = *(const GAS bf16x8*)(Q + row * D + h * 256 + 32 * kk + 8 * quad);
        f32x4 s[16];
#pragma unroll
        for (int mt = 0; mt < 16; ++mt) { s[mt] = (f32x4){0.f, 0.f, 0.f, 0.f};
            const bf16* kp = KV + (size_t)(b * MEMLEN + 16 * mt + r) * 8192 + 2048 * l + h * 256 + 8 * quad;
#pragma unroll
            for (int kk = 0; kk < 8; ++kk) s[mt] = mfma16(*(const GAS bf16x8*)(kp + 32 * kk), qf[kk], s[mt]); }
        float mx = -1e30f;
#pragma unroll
        for (int mt = 0; mt < 16; ++mt) mx = fmaxf(fmaxf(fmaxf(s[mt][0], s[mt][1]), fmaxf(s[mt][2], s[mt][3])), mx);
        mx = fmaxf(mx, __shfl_xor(mx, 16)); mx = fmaxf(mx, __shfl_xor(mx, 32));
        float sum = 0.f;
#pragma unroll
        for (int mt = 0; mt < 16; ++mt)
#pragma unroll
            for (int j = 0; j < 4; ++j) { const float p = __expf((s[mt][j] - mx) * 0.0625f); s[mt][j] = p; sum += p; }
        sum += __shfl_xor(sum, 16); sum += __shfl_xor(sum, 32);
        const float inv = 1.0f / sum;
        f32x4 o[16];
#pragma unroll
        for (int i = 0; i < 16; ++i) o[i] = (f32x4){0.f, 0.f, 0.f, 0.f};
#pragma unroll
        for (int s2 = 0; s2 < 8; ++s2) {
            v4u pw; pw.x = pk2(s[2 * s2][0], s[2 * s2][1]); pw.y = pk2(s[2 * s2][2], s[2 * s2][3]); pw.z = pk2(s[2 * s2 + 1][0], s[2 * s2 + 1][1]); pw.w = pk2(s[2 * s2 + 1][2], s[2 * s2 + 1][3]);
            const bf16x8 pf = __builtin_bit_cast(bf16x8, pw);
#pragma unroll
            for (int dt = 0; dt < 16; ++dt) { const LAS bf16* vp = Vt + (16 * dt + r) * LDV + 32 * s2 + 4 * quad;
                const s16x4 lo = *(const LAS s16x4*)vp, hi4 = *(const LAS s16x4*)(vp + 16);
                o[dt] = mfma16(__builtin_shufflevector(lo, hi4, 0, 1, 2, 3, 4, 5, 6, 7), pf, o[dt]); }
        }
        bf16* op = O + row * D + h * 256 + 4 * quad;
#pragma unroll
        for (int dt = 0; dt < 16; ++dt) *(GAS v2u*)(op + 16 * dt) = (v2u){pk2(o[dt][0] * inv, o[dt][1] * inv), pk2(o[dt][2] * inv, o[dt][3] * inv)};
    }
}
template <class Epi> DI void run_gemm(Frame& F, const bf16* A, const bf16* Bt, int M_, int N_, int K_, const Epi& E) {
    pg8::Gemm g{A, Bt, M_, N_, K_}; pg8::StaticOrder S; S.init(M_, N_, F.G, F.wg);
    pg8::gemm_phase<Epi, pg8::StaticOrder, PG8_ALIGN, PG8_SP2>(F.lds, g, S, E, F.tid);
}
constexpr int NPHASE = 51, PH_FINAL = 50;
struct Args { In in; float* out; unsigned char* ws; int ph_lo, ph_hi, region, pad; };
__global__ void __launch_bounds__(NTHR, 2) fwd(Args a) {
    extern __shared__ __attribute__((aligned(16))) unsigned char lds_raw[];
    Frame F;
    F.lds = (LAS unsigned char*)lds_raw;
    F.tid = threadIdx.x; F.lane = F.tid & 63; F.wave = __builtin_amdgcn_readfirstlane(F.tid >> 6);
    F.G = gridDim.x; F.wg = blockIdx.x; F.gw = F.wg * NWAVES + F.wave; F.NGW = F.G * NWAVES;
    volatile LAS unsigned* MISC = (volatile LAS unsigned*)(F.lds + MISC_OFF);
    if (F.tid < 32) MISC[F.tid] = 0u;
    __syncthreads();
    const int lo = a.ph_lo, hi = a.ph_hi;
    unsigned char* ws = a.ws; const In& I = a.in;
    XcdBarrier bar; bar.bar = (unsigned*)(ws + WS_CTL) + CW_BAR + a.region * XCD_BAR_WORDS; bar.x = 0; bar.st = MISC + 8;
    if (hi - lo > 1) bar = xcd_barrier_post(bar.bar, MISC + 8);
#define IN(k) (lo <= (k) && (k) < hi)
#define PHASE(k) asm volatile("" : "+v"(F.tid)); F.lane = F.tid & 63; if (IN(k))
#define SEAM(k) do { if (IN(k) && IN((k) + 1)) xcd_barrier(bar); } while (0)
    bf16* H = (bf16*)(ws + WS_H); bf16* MIX = (bf16*)(ws + WS_MIX); bf16* BIG = (bf16*)(ws + WS_BIG); bf16* KVX = (bf16*)(ws + WS_KVX);
    float* GATE = (float*)(ws + WS_GATE); const float* WG = (const float*)(ws + WS_WG);

    PHASE(0) p0_prologue(F, I, ws);
    SEAM(0);
    PHASE(1) run_gemm(F, (const bf16*)(ws + WS_MEMN), (const bf16*)(ws + WS_WKV), BATCH * MEMLEN, 8192, D, pg8::EpiBf16<0>{KVX, 8192});
    SEAM(1);
    for (int l = 0; l < DEPTH; ++l) {
        asm volatile("" : "+v"(F.tid)); F.lane = F.tid & 63;
        const int pb = 2 + 12 * l, j = l >> 1; const bool odd = (l & 1) != 0;
        unsigned char* wl = ws + WS_W + (size_t)l * W_LAYER;
        const float* xcur = (l == 0) ? I.p[0] : a.out;
        PHASE(pb + 0) {
            if (!odd) norm_phase<1>(F, xcur, I.p[2] + l * D, H, WG + l * 16384, GATE, I.p[4] + j * 4, I.p[5] + j * 4);
            else norm_phase<2>(F, xcur, I.p[2] + l * D, H, WG + l * 16384, GATE, I.p[10] + j * 8, I.p[11] + j * 8);
        }
        SEAM(pb + 0);
        PHASE(pb + 1) { const int n = odd ? C_N : AB_N; run_gemm(F, H, (const bf16*)(wl + WO_WIN), M, n, D, pg8::EpiBf16<0>{BIG, n}); }
        SEAM(pb + 1);
        PHASE(pb + 2) {
            if (!odd) {
                const int gh = F.G / 2;
                if (F.wg < gh) { for (int c = F.wg; c < 128; c += gh) mlstm_chain(F, BIG, GATE, MIX, c); }
                else { for (int u = F.wg - gh; u < 2048; u += F.G - gh) sb_unit(F, BIG, MIX, u); }
            } else {
                for (int c = F.wg; c < 256; c += F.G) gdn_chain(F, BIG, GATE, I.p[9] + (size_t)j * 4 * 3072, MIX, c);
            }
        }
        SEAM(pb + 2);
        PHASE(pb + 3) { if (!odd) headnorm_phase<false>(F, MIX, BIG, I.p[6] + j * 512); else headnorm_phase<true>(F, MIX, BIG, I.p[12] + j * 128); }
        SEAM(pb + 3);
        PHASE(pb + 4) run_gemm(F, MIX, (const bf16*)(wl + WO_WOUT), M, D, D, pg8::EpiResid{xcur, a.out, D});
        SEAM(pb + 4);
        PHASE(pb + 5) norm_phase<0>(F, a.out, I.p[14] + l * D, H, nullptr, nullptr, nullptr, nullptr);
        SEAM(pb + 5);
        PHASE(pb + 6) run_gemm(F, H, (const bf16*)(wl + WO_WQ), M, D, D, pg8::EpiBf16<0>{BIG, D});
        SEAM(pb + 6);
        PHASE(pb + 7) xattn_phase(F, BIG, KVX, l, MIX);
        SEAM(pb + 7);
        PHASE(pb + 8) run_gemm(F, MIX, (const bf16*)(wl + WO_WO), M, D, D, pg8::EpiResid{a.out, a.out, D});
        SEAM(pb + 8);
        PHASE(pb + 9) norm_phase<0>(F, a.out, I.p[20] + l * D, H, nullptr, nullptr, nullptr, nullptr);
        SEAM(pb + 9);
        PHASE(pb + 10) run_gemm(F, H, (const bf16*)(wl + WO_W1), M, FF, D, pg8::EpiBf16<2>{BIG, FF});
        SEAM(pb + 10);
        PHASE(pb + 11) run_gemm(F, BIG, (const bf16*)(wl + WO_W2), M, D, FF, pg8::EpiResid{a.out, a.out, D});
        SEAM(pb + 11);
    }
    PHASE(PH_FINAL) final_norm_phase(F, a.out, I.p[23]);
#undef IN
#undef PHASE
#undef SEAM
}

#ifndef MK_SPLIT
#define MK_SPLIT 0
#endif
extern "C" void kernel_launch(void* const* d_in, const int* in_sizes, int n_in, void* d_out, int out_size, void* d_ws, size_t ws_size, hipStream_t stream) {
    static int grid = 0;
    if (grid == 0) {
        if (n_in != 24 || in_sizes[0] != M * D || out_size != M * D || ws_size < WS_END) { fprintf(stderr, "kernel_launch: unexpected shapes (n_in %d, in0 %d, out %d, ws %zu)\n", n_in, n_in > 0 ? in_sizes[0] : -1, out_size, ws_size); grid = -1; return; }
        int dev = 0, cus = 0;
        if (hipGetDevice(&dev) != hipSuccess || hipDeviceGetAttribute(&cus, hipDeviceAttributeMultiprocessorCount, dev) != hipSuccess) { grid = -1; return; }
        if (hipFuncSetAttribute((const void*)fwd, hipFuncAttributeMaxDynamicSharedMemorySize, LDS_BYTES) != hipSuccess) { fprintf(stderr, "kernel_launch: hipFuncSetAttribute failed\n"); grid = -1; return; }
        (void)hipGetLastError();
        grid = cus;
    }
    if (grid < 0) return;
    (void)hipMemsetAsync((char*)d_ws + WS_CTL, 0, CTL_ZERO_BYTES, stream);
    Args a{};
    for (int i = 0; i < 24; ++i) a.in.p[i] = (const float*)d_in[i];
    a.out = (float*)d_out; a.ws = (unsigned char*)d_ws; a.region = 0; a.pad = 0;
#if MK_SPLIT
    for (int p = 0; p < NPHASE; ++p) { a.ph_lo = p; a.ph_hi = p + 1; hipLaunchKernelGGL(fwd, dim3(grid), dim3(NTHR), LDS_BYTES, stream, a); }
#else
    a.ph_lo = 0; a.ph_hi = NPHASE; hipLaunchKernelGGL(fwd, dim3(grid), dim3(NTHR), LDS_BYTES, stream, a);
#endif
}
```

```cpp
#include <hip/hip_runtime.h>
#include <cstdio>
#include <cstdint>
namespace pg8 {
#define PG8_LAS __attribute__((address_space(3)))
typedef unsigned short bf16_t;
typedef short bf16x8 __attribute__((ext_vector_type(8)));
typedef float f32x4 __attribute__((ext_vector_type(4)));
typedef unsigned u32x4 __attribute__((ext_vector_type(4)));
constexpr int BM = 256, BK = 64, HALF = 128, HTB = HALF * BK * 2  , STAGE_BYTES = 8 * HTB, NXCD = 8, WGM = 8;

__host__ __device__ __forceinline__ int lds_byte(int r, int c) { const int st = (r >> 4) * 2 + (c >> 5), rr = r & 15, cc = c & 31, ob = rr * 64 + cc * 2; return st * 1024 + (ob ^ (((ob >> 9) & 1) << 5)); }
__host__ __device__ __forceinline__ void stage_rc(int b, int& R, int& C) { const int st = b / 1024, sb = b % 1024, swz = sb ^ (((sb >> 9) & 1) << 5); R = (st >> 1) * 16 + swz / 64; C = (st & 1) * 32 + (swz % 64) / 2; }
__host__ __device__ __forceinline__ int perm32(int rho) { const int n = rho >> 4, i = rho & 15; return 8 * (i >> 2) + 4 * n + (i & 3); }

struct Unit { int pm, pn; };
struct Gemm { const bf16_t* A; const bf16_t* Bt; int M, N, K; };

struct StaticOrder {
    int nM, nN, nwg, G, c;
    __host__ __device__ void init(int M, int N, int G_, int c_) { nM = M / BM; nN = N / BM; nwg = nM * nN; G = G_; c = c_; }
    __host__ __device__ bool next(int i, Unit& u) const {
        const long L = (long)i * G + c; if (L >= nwg) return false;
        int wgid = (int)L; { const int q = nwg / NXCD, r = nwg % NXCD, xcd = wgid % NXCD, off = wgid / NXCD; wgid = (xcd < r ? xcd * (q + 1) : r * (q + 1) + (xcd - r) * q) + off; }
        const int nig = WGM * nN, gid = wgid / nig, fm = gid * WGM, gsz = (nM - fm) < WGM ? (nM - fm) : WGM;
        u.pm = fm + ((wgid % nig) % gsz); u.pn = (wgid % nig) / gsz; return true;
    }
    __device__ __forceinline__ void a_ready(const Unit&) const {}
    __device__ __forceinline__ void done(const Unit&) const {}
};

__device__ __forceinline__ unsigned cvt_pk_bf16(float lo, float hi) { unsigned r; asm volatile("v_cvt_pk_bf16_f32 %0, %1, %2" : "=v"(r) : "v"(lo), "v"(hi)); return r; }
template <int ACT> struct EpiBf16 {
    static constexpr bool PERM = true, AFTER_DRAIN = false;
    bf16_t* O; int ldc; bf16_t* halo;
    __device__ __forceinline__ void operator()(const f32x4 (&acc)[2][2][4][2], const Unit& u, int wr, int wc, int fr, int fq) const {
        const int row0 = u.pm * BM + wr * 64 + fr; const int col0 = u.pn * BM + wc * 32 + 8 * fq;
        const bool dohalo = (halo != nullptr) && (fr >= 13) && (u.pn < 12);
#pragma unroll
        for (int ai = 0; ai < 2; ++ai)
#pragma unroll
            for (int m = 0; m < 4; ++m) { bf16_t* rowp = O + (size_t)(row0 + ai * HALF + m * 16) * ldc + col0;
#pragma unroll
                for (int bj = 0; bj < 2; ++bj) { f32x4 v0 = acc[ai][bj][m][0], v1 = acc[ai][bj][m][1];
                    if (ACT == 2) {
#pragma unroll
                        for (int j = 0; j < 4; ++j) { const float a = fmaxf(v0[j], 0.f), b = fmaxf(v1[j], 0.f); v0[j] = a * a; v1[j] = b * b; } }
                    u32x4 w; w.x = cvt_pk_bf16(v0[0], v0[1]); w.y = cvt_pk_bf16(v0[2], v0[3]); w.z = cvt_pk_bf16(v1[0], v1[1]); w.w = cvt_pk_bf16(v1[2], v1[3]);
                    *(u32x4*)(rowp + bj * HALF) = w;
                    if (m == 3 && dohalo) *(u32x4*)(halo + ((size_t)((row0 + ai * HALF + 48) >> 6) * 3 + (fr - 13)) * 3072 + col0 + bj * HALF) = w; } }
    }
};
struct EpiResid {
    static constexpr bool PERM = false, AFTER_DRAIN = false;
    const float* base; float* out; int ldc;
    __device__ __forceinline__ void operator()(const f32x4 (&acc)[2][2][4][2], const Unit& u, int wr, int wc, int fr, int fq) const {
        const int row0 = u.pm * BM + wr * 64 + fr, col0 = u.pn * BM + wc * 32 + 4 * fq;
#pragma unroll
        for (int ai = 0; ai < 2; ++ai)
#pragma unroll
            for (int m = 0; m < 4; ++m) { const size_t off = (size_t)(row0 + ai * HALF + m * 16) * ldc + col0;
#pragma unroll
                for (int bj = 0; bj < 2; ++bj)
#pragma unroll
                    for (int n = 0; n < 2; ++n) { const f32x4 bs = *(const f32x4*)(base + off + bj * HALF + n * 16); *(f32x4*)(out + off + bj * HALF + n * 16) = bs + acc[ai][bj][m][n]; }
                if (m & 1) asm volatile("" ::: "memory"); }
    }
};
template <class Epi, class Sched, bool ALIGN_EPI = false, bool SP2 = false>
__device__ __forceinline__ void gemm_phase(PG8_LAS unsigned char* lds, const Gemm g, const Sched& S, const Epi& E, int tid_in) {
    int tid_ = tid_in; asm volatile("" : "+v"(tid_)); const int tid = tid_, wid = __builtin_amdgcn_readfirstlane(tid >> 6), lane = tid & 63, wr = wid >> 2, wc = wid & 3, fr = lane & 15, fq = lane >> 4;
    const int K = g.K, nt = K / BK;
    unsigned voffA[2], voffB[2];
#pragma unroll
    for (int i = 0; i < 2; ++i) { int R, C; stage_rc(tid * 16 + i * 8192, R, C); const int Rb = Epi::PERM ? ((R & ~31) + perm32(R & 31)) : R;
        voffA[i] = (unsigned)(R * K + C) * 2u; voffB[i] = (unsigned)(Rb * K + C) * 2u; }
    const size_t kstep = (size_t)(BK * 2);
    const size_t hstep = (size_t)HALF * K * 2;
    const size_t tstep = 2 * hstep;
    const unsigned ldsw = (unsigned)wid * 1024u;
    const int aoff = lds_byte(wr * 64 + fr, fq * 8), boff = lds_byte(wc * 32 + fr, fq * 8);
#define PG8_SA(b, h) (((b) * 2 + (h)) * HTB)
#define PG8_SB(b, h) ((4 + (b) * 2 + (h)) * HTB)
#define PG8_STAGE(bufoff, gbase, voff) do { _Pragma("unroll") for (int _i = 0; _i < 2; ++_i) \
        __builtin_amdgcn_global_load_lds((const unsigned*)((const char*)(gbase) + (voff)[_i]), (PG8_LAS unsigned*)(lds + (bufoff) + ldsw + _i * 8192), 16, 0, 0); } while (0)
#define PG8_LDA(dst, b, h) do { _Pragma("unroll") for (int m = 0; m < 4; ++m) _Pragma("unroll") for (int k = 0; k < 2; ++k) dst[m][k] = *(const PG8_LAS bf16x8*)(lds + PG8_SA(b, h) + aoff + m * 2048 + k * 1024); } while (0)
#define PG8_LDB(dst, b, h) do { _Pragma("unroll") for (int n = 0; n < 2; ++n) _Pragma("unroll") for (int k = 0; k < 2; ++k) dst[n][k] = *(const PG8_LAS bf16x8*)(lds + PG8_SB(b, h) + boff + n * 2048 + k * 1024); } while (0)
#define PG8_MMA(ai, bj, At, Bt) do { __builtin_amdgcn_s_setprio(1); _Pragma("unroll") for (int m = 0; m < 4; ++m) _Pragma("unroll") for (int n = 0; n < 2; ++n) _Pragma("unroll") for (int k = 0; k < 2; ++k) \
        acc[ai][bj][m][n] = __builtin_amdgcn_mfma_f32_16x16x32_bf16(Bt[n][k], At[m][k], acc[ai][bj][m][n], 0, 0, 0); __builtin_amdgcn_s_setprio(0); } while (0)
#define PG8_WAIT_V(n) asm volatile("s_waitcnt vmcnt(" #n ")" ::: "memory")
#define PG8_WAIT_L(n) asm volatile("s_waitcnt lgkmcnt(" #n ")" ::: "memory")
#define PG8_BAR __builtin_amdgcn_s_barrier()
#define PG8_SCHED __builtin_amdgcn_sched_barrier(0)
    Unit cur, nxt; int ui = 0;
    if (!S.next(0, cur)) return;
    f32x4 acc[2][2][4][2];
#pragma unroll
    for (int a = 0; a < 2; ++a)
#pragma unroll
        for (int b = 0; b < 2; ++b)
#pragma unroll
            for (int m = 0; m < 4; ++m)
#pragma unroll
                for (int n = 0; n < 2; ++n) acc[a][b][m][n] = (f32x4){0.f, 0.f, 0.f, 0.f};
    bf16x8 At[4][2], B0[2][2], B1[2][2];
    const char* cA = (const char*)g.A + (size_t)cur.pm * tstep; const char* cB = (const char*)g.Bt + (size_t)cur.pn * tstep;
    S.a_ready(cur);
    if constexpr (SP2) {
        PG8_STAGE(PG8_SB(0, 0), cB, voffB); PG8_STAGE(PG8_SB(0, 1), cB + hstep, voffB); PG8_STAGE(PG8_SA(0, 0), cA, voffA); PG8_STAGE(PG8_SA(0, 1), cA + hstep, voffA);
        if (wr == 1) PG8_BAR;
        PG8_WAIT_V(2); PG8_BAR;
        PG8_STAGE(PG8_SB(1, 0), cB + kstep, voffB); PG8_STAGE(PG8_SA(1, 0), cA + kstep, voffA); PG8_STAGE(PG8_SB(1, 1), cB + hstep + kstep, voffB);
        PG8_WAIT_V(6); PG8_BAR;
    } else {
        PG8_STAGE(PG8_SB(0, 0), cB, voffB); PG8_STAGE(PG8_SA(0, 0), cA, voffA); PG8_STAGE(PG8_SB(0, 1), cB + hstep, voffB); PG8_STAGE(PG8_SA(0, 1), cA + hstep, voffA);
        if (wr == 1) PG8_BAR;
        PG8_WAIT_V(4); PG8_BAR;
        PG8_STAGE(PG8_SB(1, 0), cB + kstep, voffB); PG8_STAGE(PG8_SA(1, 0), cA + kstep, voffA); PG8_STAGE(PG8_SB(1, 1), cB + hstep + kstep, voffB);
        PG8_WAIT_V(6); PG8_BAR;
    }
    for (;;) {
        const bool has_next = S.next(ui + 1, nxt);
        const char* nA = has_next ? (const char*)g.A + (size_t)nxt.pm * tstep : cA; const char* nB = has_next ? (const char*)g.Bt + (size_t)nxt.pn * tstep : cB;
        for (int t = 0; t < nt; t += 2) {
            const bool last = (t == nt - 2);
            const char* a1 = cA + (size_t)(t + 1) * kstep;
            const char* a2 = last ? nA : cA + (size_t)(t + 2) * kstep; const char* b2 = last ? nB : cB + (size_t)(t + 2) * kstep;
            const char* a3 = a2 + kstep; const char* b3 = b2 + kstep;
            if (last && has_next) S.a_ready(nxt);
            if constexpr (SP2) {
            PG8_LDB(B0, 0, 0); PG8_LDB(B1, 0, 1); PG8_SCHED; PG8_LDA(At, 0, 0); PG8_STAGE(PG8_SA(1, 1), a1 + hstep, voffA);
            PG8_WAIT_V(8); PG8_WAIT_L(0); PG8_BAR; PG8_MMA(0, 0, At, B0); PG8_MMA(0, 1, At, B1); PG8_BAR; PG8_SCHED;
            PG8_LDA(At, 0, 1); PG8_STAGE(PG8_SB(0, 0), b2, voffB); PG8_STAGE(PG8_SB(0, 1), b2 + hstep, voffB); PG8_STAGE(PG8_SA(0, 0), a2, voffA);
            PG8_WAIT_V(8); PG8_WAIT_L(0); PG8_BAR; PG8_MMA(1, 0, At, B0); PG8_MMA(1, 1, At, B1); PG8_BAR; PG8_SCHED;
            PG8_LDB(B0, 1, 0); PG8_LDB(B1, 1, 1); PG8_SCHED; PG8_LDA(At, 1, 0); PG8_STAGE(PG8_SA(0, 1), a2 + hstep, voffA);
            PG8_WAIT_V(8); PG8_WAIT_L(0); PG8_BAR; PG8_MMA(0, 0, At, B0); PG8_MMA(0, 1, At, B1); PG8_BAR; PG8_SCHED;
            PG8_LDA(At, 1, 1); PG8_STAGE(PG8_SB(1, 0), b3, voffB); PG8_STAGE(PG8_SB(1, 1), b3 + hstep, voffB); PG8_STAGE(PG8_SA(1, 0), a3, voffA);
            PG8_WAIT_V(8); PG8_WAIT_L(0); PG8_BAR; PG8_MMA(1, 0, At, B0); PG8_MMA(1, 1, At, B1); PG8_BAR; PG8_SCHED;
            } else {
            PG8_LDB(B0, 0, 0); PG8_SCHED; PG8_LDA(At, 0, 0); PG8_STAGE(PG8_SA(1, 1), a1 + hstep, voffA);
            PG8_WAIT_L(8); PG8_BAR; PG8_WAIT_L(0); PG8_MMA(0, 0, At, B0); PG8_BAR; PG8_SCHED;
            PG8_LDB(B1, 0, 1); PG8_STAGE(PG8_SB(0, 0), b2, voffB);
            PG8_BAR; PG8_WAIT_L(0); PG8_MMA(0, 1, At, B1); PG8_BAR;
            PG8_LDA(At, 0, 1); PG8_STAGE(PG8_SA(0, 0), a2, voffA);
            PG8_BAR; PG8_WAIT_L(0); PG8_MMA(1, 0, At, B0); PG8_BAR; PG8_SCHED;
            PG8_STAGE(PG8_SB(0, 1), b2 + hstep, voffB);
            PG8_WAIT_V(6); PG8_BAR; PG8_MMA(1, 1, At, B1); PG8_BAR;
            PG8_LDB(B0, 1, 0); PG8_SCHED; PG8_LDA(At, 1, 0); PG8_STAGE(PG8_SA(0, 1), a2 + hstep, voffA);
            PG8_WAIT_L(8); PG8_BAR; PG8_WAIT_L(0); PG8_MMA(0, 0, At, B0); PG8_BAR; PG8_SCHED;
            PG8_LDB(B1, 1, 1); PG8_STAGE(PG8_SB(1, 0), b3, voffB);
            PG8_BAR; PG8_WAIT_L(0); PG8_MMA(0, 1, At, B1); PG8_BAR;
            PG8_LDA(At, 1, 1); PG8_STAGE(PG8_SA(1, 0), a3, voffA);
            PG8_BAR; PG8_WAIT_L(0); PG8_MMA(1, 0, At, B0); PG8_BAR; PG8_SCHED;
            PG8_STAGE(PG8_SB(1, 1), b3 + hstep, voffB);
            PG8_WAIT_V(6); PG8_BAR; PG8_MMA(1, 1, At, B1); PG8_BAR;
            }
        }
        if constexpr (ALIGN_EPI) { if (wr == 0) PG8_BAR; }
        if constexpr (!Epi::AFTER_DRAIN) { E(acc, cur, wr, wc, fr, fq); S.done(cur); }
        if (!has_next) break;
#pragma unroll
        for (int a = 0; a < 2; ++a)
#pragma unroll
            for (int b = 0; b < 2; ++b)
#pragma unroll
                for (int m = 0; m < 4; ++m)
#pragma unroll
                    for (int n = 0; n < 2; ++n) acc[a][b][m][n] = (f32x4){0.f, 0.f, 0.f, 0.f};
        cur = nxt; cA = nA; cB = nB; ++ui;
        if constexpr (ALIGN_EPI) { if (wr == 1) PG8_BAR; }
    }
    PG8_WAIT_V(0);
    if constexpr (!ALIGN_EPI) { if (wr == 0) PG8_BAR; }
    PG8_BAR;
    if constexpr (Epi::AFTER_DRAIN) { E.fused(acc, cur, wr, wc, fr, fq, lds, wid, lane); S.done(cur); }
#undef PG8_SA
#undef PG8_SB
#undef PG8_STAGE
#undef PG8_LDA
#undef PG8_LDB
#undef PG8_MMA
#undef PG8_WAIT_V
#undef PG8_WAIT_L
#undef PG8_BAR
#undef PG8_SCHED
}
}
#ifndef PG8_SP2
#define PG8_SP2 true
#endif
#ifndef PG8_ALIGN
#define PG8_ALIGN true
#endif
constexpr int NWAVES = 8, NTHR = 512;
constexpr int BATCH = 8, T = 8192, D = 1024, DEPTH = 4, MEMLEN = 256, FF = 4096;
constexpr int M = BATCH * T;
constexpr int AB_IN = 3080, AB_N = 3072, C_IN = 4112, C_N = 4096;
constexpr float EPS = 1e-6f;
constexpr float SB_THR = 88.0f;

constexpr size_t MiB = 1u << 20;
constexpr size_t WS_CTL = 0, CTL_ZERO_BYTES = 1 * MiB;
constexpr size_t WS_WG = 1 * MiB;
constexpr size_t WS_MEMN = 2 * MiB;
constexpr size_t WS_WKV = 6 * MiB;
constexpr size_t WS_W = 22 * MiB, W_LAYER = 30 * MiB;
constexpr size_t WO_WIN = 0, WO_WOUT = 8 * MiB, WO_WQ = 10 * MiB, WO_WO = 12 * MiB, WO_W1 = 14 * MiB, WO_W2 = 22 * MiB;
constexpr size_t WS_KVX = 142 * MiB;
constexpr size_t WS_GATE = 174 * MiB;
constexpr size_t WS_H = 178 * MiB;
constexpr size_t WS_MIX = 306 * MiB;
constexpr size_t WS_BIG = 434 * MiB;
constexpr size_t WS_END = 946 * MiB;
constexpr int CW_TMO = 0, CW_BAR = 4096;

constexpr int LDS_BYTES = 147456;
constexpr int MISC_OFF = 140 * 1024;

#define GAS __attribute__((address_space(1)))
#define LAS __attribute__((address_space(3)))
#define DI __device__ __forceinline__
typedef unsigned short bf16;
typedef unsigned v4u __attribute__((ext_vector_type(4)));
typedef unsigned v2u __attribute__((ext_vector_type(2)));
typedef float f32x4 __attribute__((ext_vector_type(4)));
typedef short bf16x8 __attribute__((ext_vector_type(8)));
typedef short s16x4 __attribute__((ext_vector_type(4)));
#define LDS_WAIT() asm volatile("s_waitcnt lgkmcnt(0)" ::: "memory")
DI unsigned f2bf(float f) { unsigned u = __builtin_bit_cast(unsigned, f); return (u + 0x7fffu + ((u >> 16) & 1u)) >> 16; }
DI unsigned pk2(float lo, float hi) { return f2bf(lo) | (f2bf(hi) << 16); }
DI float bf2f(unsigned short b) { return __builtin_bit_cast(float, ((unsigned)b) << 16); }
DI float bflo(unsigned u) { return __builtin_bit_cast(float, u << 16); }
DI float bfhi(unsigned u) { return __builtin_bit_cast(float, u & 0xffff0000u); }
DI float wave_sum(float v) {
#pragma unroll
    for (int o = 1; o < 64; o <<= 1) v += __shfl_xor(v, o);
    return v;
}
DI float sigmoidf_(float x) { return 1.0f / (1.0f + __expf(-x)); }
DI f32x4 mfma16(bf16x8 a, bf16x8 b, f32x4 c) { return __builtin_amdgcn_mfma_f32_16x16x32_bf16(a, b, c, 0, 0, 0); }
#define XB_TMO      128
#define XB_XCNT(j)  (256  + 64 * (j))
#define XB_XSUB(j)  (1280 + 64 * (j))
#define XB_XGEN(j)  (2304 + 64 * (j))
#define XB_TOP      3328
#define XB_TOPGEN   3392
#define XCD_BAR_WORDS 3456
#define XB_SPIN_CAP (1u << 22)

__device__ __forceinline__ unsigned xb_ld(unsigned* p)              { return __hip_atomic_load(p, __ATOMIC_RELAXED, __HIP_MEMORY_SCOPE_AGENT); }
__device__ __forceinline__ unsigned xb_add(unsigned* p, unsigned v) { return __hip_atomic_fetch_add(p, v, __ATOMIC_RELAXED, __HIP_MEMORY_SCOPE_AGENT); }
__device__ __forceinline__ unsigned xb_xcc_id() { return (unsigned)__builtin_amdgcn_s_getreg((3 << 11) | 20) & 0xFu; }
#define XB_SPIN(cond, bar) do { unsigned _sp = 0; while (cond) { __builtin_amdgcn_s_sleep(1); \
    if ((++_sp & 255u) == 0u) { if (xb_ld(&(bar)[XB_TMO])) break; if (_sp > XB_SPIN_CAP) { atomicAdd(&(bar)[XB_TMO], 1u); break; } } } } while (0)

struct XcdBarrier {
    unsigned* bar; unsigned x;
    volatile LAS unsigned* st;
};

__device__ __forceinline__ XcdBarrier xcd_barrier_post(unsigned* bar, volatile LAS unsigned* st) {
    XcdBarrier b; b.bar = bar; b.x = xb_xcc_id(); b.st = st;
    if (threadIdx.x == 0) (void)xb_add(&bar[XB_XCNT(b.x)], 1u);
    return b;
}
__device__ __forceinline__ void xcd_barrier_complete(unsigned* bar, unsigned x, unsigned& nloc, unsigned& nx) {
    const unsigned G = gridDim.x * gridDim.y * gridDim.z;
    unsigned sum, cnt, mine, sp = 0u;
    for (;;) {
        sum = 0u; cnt = 0u; mine = 0u;
#pragma unroll
        for (unsigned j = 0; j < 16; ++j) { const unsigned c = xb_ld(&bar[XB_XCNT(j)]); sum += c; cnt += (c > 0u) ? 1u : 0u; mine = (j == x) ? c : mine; }
        if (sum == G) break;
        __builtin_amdgcn_s_sleep(1);
        if ((++sp & 255u) == 0u) { if (xb_ld(&bar[XB_TMO])) break; if (sp > XB_SPIN_CAP) { atomicAdd(&bar[XB_TMO], 1u); break; } }
    }
    nloc = mine > 0u ? mine : 1u; nx = cnt > 0u ? cnt : 1u;
}

__device__ __forceinline__ void xcd_barrier(const XcdBarrier& b) {
    asm volatile("s_waitcnt vmcnt(0)" ::: "memory");
    __syncthreads();
    if (threadIdx.x == 0) {
        unsigned* bar = b.bar;
        __builtin_amdgcn_s_waitcnt(0);
        unsigned nloc = b.st[0], nx = b.st[1];
        if (nloc == 0u) { xcd_barrier_complete(bar, b.x, nloc, nx); b.st[0] = nloc; b.st[1] = nx; }
        const unsigned old = xb_add(&bar[XB_XSUB(b.x)], 1u);
        const unsigned gen = old / nloc;
        if (old + 1u == (gen + 1u) * nloc) {
            __builtin_amdgcn_fence(__ATOMIC_RELEASE, "agent");
            asm volatile("s_waitcnt vmcnt(0)" ::: "memory");
            const unsigned og = xb_add(&bar[XB_TOP], 1u);
            const unsigned tg = og / nx;
            if (og + 1u == (tg + 1u) * nx) xb_add(&bar[XB_TOPGEN], 1u);
            else XB_SPIN(xb_ld(&bar[XB_TOPGEN]) == tg, bar);
            __builtin_amdgcn_fence(__ATOMIC_ACQUIRE, "agent");
            xb_add(&bar[XB_XGEN(b.x)], 1u);
            asm volatile("s_waitcnt vmcnt(0)" ::: "memory");
        } else {
            XB_SPIN(xb_ld(&bar[XB_XGEN(b.x)]) == gen, bar);
            __builtin_amdgcn_fence(__ATOMIC_ACQUIRE, "agent");
            asm volatile("s_waitcnt vmcnt(0)" ::: "memory");
        }
    }
    __syncthreads();
}
struct Frame {
    LAS unsigned char* lds;
    int tid, lane, wave;
    int G, wg, gw, NGW;
};

DI void transpose_item(const float* W, int ldsrc, int coloff, bf16* WT, int K, int row_off, int nblk, LAS float* scr, int item, int lane) {
    const int kb = item / nblk, nb = item % nblk, k0 = 64 * kb, n0 = 32 * nb;
#pragma unroll 8
    for (int i = 0; i < 32; ++i) { const int kk = 2 * i + (lane >> 5); scr[kk * 33 + (lane & 31)] = W[(size_t)(k0 + kk) * ldsrc + coloff + n0 + (lane & 31)]; }
    LDS_WAIT(); asm volatile("" ::: "memory");
    const int c = lane & 7;
#pragma unroll
    for (int j = 0; j < 4; ++j) { const int n = (lane >> 3) + 8 * j; const LAS float* s = scr + (8 * c) * 33 + n;
        v4u o; o.x = pk2(s[0 * 33], s[1 * 33]); o.y = pk2(s[2 * 33], s[3 * 33]); o.z = pk2(s[4 * 33], s[5 * 33]); o.w = pk2(s[6 * 33], s[7 * 33]);
        *(GAS v4u*)(WT + (size_t)(row_off + n0 + n) * K + k0 + 8 * c) = o; }
    LDS_WAIT(); asm volatile("" ::: "memory");
}
DI void transpose_matrix(Frame& F, const float* W, int ldsrc, int coloff, int ncols, int K, bf16* WT, int row_off, unsigned& base) {
    LAS float* scr = (LAS float*)(F.lds + F.wave * 16384);
    const int nblk = ncols / 32, nitems = (K / 64) * nblk;
    int it = (int)(((unsigned)F.gw + (unsigned)F.NGW - (base % (unsigned)F.NGW)) % (unsigned)F.NGW);
    for (; it < nitems; it += F.NGW) transpose_item(W, ldsrc, coloff, WT, K, row_off, nblk, scr, it, F.lane);
    base += (unsigned)nitems;
}
DI void rms_row(const float* xrow, const f32x4 (&g4)[4], f32x4 (&v)[4], int lane) {
    const GAS f32x4* xr = (const GAS f32x4*)xrow + lane; float s = 0.f;
#pragma unroll
    for (int j = 0; j < 4; ++j) { v[j] = xr[64 * j]; s += (v[j].x * v[j].x + v[j].y * v[j].y) + (v[j].z * v[j].z + v[j].w * v[j].w); }
    const float rstd = 1.0f / sqrtf(wave_sum(s) * (1.f / 1024.f) + EPS);
#pragma unroll
    for (int j = 0; j < 4; ++j) v[j] = v[j] * rstd * g4[j];
}
DI void store_row_bf16(bf16* orow, const f32x4 (&v)[4], int lane) {
    GAS unsigned long long* o8 = (GAS unsigned long long*)orow + lane;
#pragma unroll
    for (int j = 0; j < 4; ++j) o8[64 * j] = (unsigned long long)pk2(v[j].x, v[j].y) | ((unsigned long long)pk2(v[j].z, v[j].w) << 32);
}
struct In { const float* p[24]; };
DI void p0_prologue(Frame& F, const In& I, unsigned char* ws) {
    unsigned base = 0;
    for (int l = 0; l < DEPTH; ++l) {
        const int j = l >> 1; unsigned char* wl = ws + WS_W + (size_t)l * W_LAYER;
        if ((l & 1) == 0) {
            transpose_matrix(F, I.p[3] + (size_t)j * D * AB_IN, AB_IN, 0, 1536, D, (bf16*)(wl + WO_WIN), 0, base);
            transpose_matrix(F, I.p[3] + (size_t)j * D * AB_IN, AB_IN, 1544, 1536, D, (bf16*)(wl + WO_WIN), 1536, base);
            transpose_matrix(F, I.p[7] + (size_t)j * D * D, D, 0, D, D, (bf16*)(wl + WO_WOUT), 0, base);
        } else {
            transpose_matrix(F, I.p[8] + (size_t)j * D * C_IN, C_IN, 0, 4096, D, (bf16*)(wl + WO_WIN), 0, base);
            transpose_matrix(F, I.p[13] + (size_t)j * D * D, D, 0, D, D, (bf16*)(wl + WO_WOUT), 0, base);
        }
        transpose_matrix(F, I.p[16] + (size_t)l * D * D, D, 0, D, D, (bf16*)(wl + WO_WQ), 0, base);
        transpose_matrix(F, I.p[19] + (size_t)l * D * D, D, 0, D, D, (bf16*)(wl + WO_WO), 0, base);
        transpose_matrix(F, I.p[17] + (size_t)l * D * D, D, 0, D, D, (bf16*)(ws + WS_WKV), 2048 * l, base);
        transpose_matrix(F, I.p[18] + (size_t)l * D * D, D, 0, D, D, (bf16*)(ws + WS_WKV), 2048 * l + 1024, base);
        transpose_matrix(F, I.p[21] + (size_t)l * D * FF, FF, 0, FF, D, (bf16*)(wl + WO_W1), 0, base);
        transpose_matrix(F, I.p[22] + (size_t)l * FF * D, D, 0, D, FF, (bf16*)(wl + WO_W2), 0, base);
    }
    float* Wg = (float*)(ws + WS_WG);
    for (int idx = F.wg * NTHR + F.tid; idx < DEPTH * 16 * 1024; idx += F.G * NTHR) {
        const int l = idx >> 14, g = (idx >> 10) & 15, k = idx & 1023, j = l >> 1; float v = 0.f;
        if ((l & 1) == 0) { if (g < 8) v = I.p[3][(size_t)j * D * AB_IN + (size_t)k * AB_IN + 1536 + g]; }
        else v = I.p[8][(size_t)j * D * C_IN + (size_t)k * C_IN + 4096 + g];
        Wg[idx] = v;
    }
    { f32x4 g4[4];
#pragma unroll
      for (int j = 0; j < 4; ++j) g4[j] = ((const GAS f32x4*)I.p[15])[F.lane + 64 * j];
      for (int r = F.gw; r < BATCH * MEMLEN; r += F.NGW) { f32x4 v[4]; rms_row(I.p[1] + (size_t)r * D, g4, v, F.lane); store_row_bf16((bf16*)(ws + WS_MEMN) + (size_t)r * D, v, F.lane); } }
}
template <int MODE> DI void norm_phase(Frame& F, const float* xin, const float* gain, bf16* hout, const float* Wg, float* gate, const float* p0, const float* p1) {
    f32x4 g4[4];
#pragma unroll
    for (int j = 0; j < 4; ++j) g4[j] = ((const GAS f32x4*)gain)[F.lane + 64 * j];
    constexpr int NG = MODE == 1 ? 8 : (MODE == 2 ? 16 : 0);
    float par = 0.f;
    if (MODE == 1) { if (F.lane < 4) par = p0[F.lane]; else if (F.lane < 8) par = p1[F.lane - 4]; }
    float par2 = 0.f;
    if (MODE == 2) { if (F.lane >= 8 && F.lane < 16) { par = p0[F.lane - 8]; par2 = p1[F.lane - 8]; } }
    for (int r = F.gw; r < M; r += F.NGW) {
        f32x4 v[4]; rms_row(xin + (size_t)r * D, g4, v, F.lane); store_row_bf16(hout + (size_t)r * D, v, F.lane);
        if (MODE != 0) {
            float keep = 0.f;
#pragma unroll
            for (int g = 0; g < NG; ++g) {
                const GAS f32x4* wr = (const GAS f32x4*)(Wg + g * 1024) + F.lane; float p = 0.f;
#pragma unroll
                for (int j = 0; j < 4; ++j) { const f32x4 w = wr[64 * j]; p += (v[j].x * w.x + v[j].y * w.y) + (v[j].z * w.z + v[j].w * w.w); }
                p = wave_sum(p); if (F.lane == g) keep = p;
            }
            if (MODE == 1 && F.lane < 8) {
                const float a = keep + par; float o;
                if (F.lane < 4) o = 15.0f * tanhf(a * (1.0f / 15.0f));
                else o = fminf(a, 0.f) - log1pf(expf(-fabsf(a)));
                gate[(size_t)r * 16 + F.lane] = o;
            }
            if (MODE == 2 && F.lane < 16) {
                float o;
                if (F.lane < 8) o = 1.0f / (1.0f + expf(-keep));
                else { const float z = keep + par2; const float sp = fmaxf(z, 0.f) + log1pf(expf(-fabsf(z))); o = -expf(par) * sp; }
                gate[(size_t)r * 16 + F.lane] = o;
            }
        }
    }
}
DI void final_norm_phase(Frame& F, float* x, const float* gain) {
    f32x4 g4[4];
#pragma unroll
    for (int j = 0; j < 4; ++j) g4[j] = ((const GAS f32x4*)gain)[F.lane + 64 * j];
    for (int r = F.gw; r < M; r += F.NGW) { f32x4 v[4]; rms_row(x + (size_t)r * D, g4, v, F.lane); GAS f32x4* o = (GAS f32x4*)(x + (size_t)r * D) + F.lane;
#pragma unroll
        for (int j = 0; j < 4; ++j) o[64 * j] = v[j]; }
}
template <bool ODD> DI void headnorm_phase(Frame& F, const bf16* src, bf16* mix, const bf16* proj, const float* hg) {
    constexpr int NC = ODD ? 16 : 8;
    for (int r = F.gw; r < M; r += F.NGW) {
        const int c0 = NC * F.lane;
        float x[NC], gt[NC];
#pragma unroll
        for (int q = 0; q < NC / 8; ++q) {
            const v4u raw = *(const GAS v4u*)(src + (size_t)r * D + c0 + 8 * q);
            const v4u gr = *(const GAS v4u*)(proj + (size_t)r * (ODD ? C_N : AB_N) + (ODD ? 3072 : 1024) + c0 + 8 * q);
            x[8 * q + 0] = bflo(raw.x); x[8 * q + 1] = bfhi(raw.x); x[8 * q + 2] = bflo(raw.y); x[8 * q + 3] = bfhi(raw.y); x[8 * q + 4] = bflo(raw.z); x[8 * q + 5] = bfhi(raw.z); x[8 * q + 6] = bflo(raw.w); x[8 * q + 7] = bfhi(raw.w);
            gt[8 * q + 0] = bflo(gr.x); gt[8 * q + 1] = bfhi(gr.x); gt[8 * q + 2] = bflo(gr.y); gt[8 * q + 3] = bfhi(gr.y); gt[8 * q + 4] = bflo(gr.z); gt[8 * q + 5] = bfhi(gr.z); gt[8 * q + 6] = bflo(gr.w); gt[8 * q + 7] = bfhi(gr.w);
        }
        float ss = 0.f;
#pragma unroll
        for (int i = 0; i < NC; ++i) ss += x[i] * x[i];
        ss += __shfl_xor(ss, 1); ss += __shfl_xor(ss, 2); ss += __shfl_xor(ss, 4); if (!ODD) ss += __shfl_xor(ss, 8);
        const float rstd = 1.0f / sqrtf(ss * (1.f / 128.f) + EPS);
#pragma unroll
        for (int i = 0; i < NC; ++i) { const float g = ODD ? hg[(c0 + i) & 127] : hg[c0 + i]; const float s = sigmoidf_(gt[i]); x[i] = x[i] * rstd * g * (ODD ? gt[i] * s : s); }
#pragma unroll
        for (int q = 0; q < NC / 8; ++q) { v4u o; o.x = pk2(x[8 * q], x[8 * q + 1]); o.y = pk2(x[8 * q + 2], x[8 * q + 3]); o.z = pk2(x[8 * q + 4], x[8 * q + 5]); o.w = pk2(x[8 * q + 6], x[8 * q + 7]);
            *(GAS v4u*)(mix + (size_t)r * D + c0 + 8 * q) = o; }
    }
}
DI void mlstm_chain(Frame& F, const bf16* proj, const float* gate, bf16* mix, int c) {
    const int b = c >> 4, h = (c >> 2) & 3, vq = c & 3, vl = F.tid >> 4, dg = F.tid & 15;
    float C0 = 0.f, C1 = 0.f, C2 = 0.f, C3 = 0.f, n0 = 0.f, n1 = 0.f, n2 = 0.f, n3 = 0.f, m = 0.f;
    const bf16* pq = proj + (size_t)b * T * AB_N + h * 64 + 4 * dg;
    const bf16* pk = pq + 256;
    const bf16* pv = proj + (size_t)b * T * AB_N + 512 + h * 128 + vq * 32 + vl;
    const float* pg = gate + (size_t)b * T * 16 + h;
    bf16* po = mix + (size_t)b * T * D + h * 128 + vq * 32 + vl;
    for (int t0 = 0; t0 < T; t0 += 8) {
        v2u qr[8], kr[8]; unsigned short vr[8]; float li[8], lf[8];
#pragma unroll
        for (int i = 0; i < 8; ++i) { qr[i] = *(const GAS v2u*)(pq + (size_t)(t0 + i) * AB_N); kr[i] = *(const GAS v2u*)(pk + (size_t)(t0 + i) * AB_N); vr[i] = pv[(size_t)(t0 + i) * AB_N];
            li[i] = pg[(size_t)(t0 + i) * 16]; lf[i] = pg[(size_t)(t0 + i) * 16 + 4]; }
#pragma unroll
        for (int i = 0; i < 8; ++i) {
            const float q0 = bflo(qr[i].x), q1 = bfhi(qr[i].x), q2 = bflo(qr[i].y), q3 = bfhi(qr[i].y);
            const float k0 = bflo(kr[i].x) * 0.125f, k1 = bfhi(kr[i].x) * 0.125f, k2 = bflo(kr[i].y) * 0.125f, k3 = bfhi(kr[i].y) * 0.125f;
            const float vv = bf2f(vr[i]);
            const float mn = fmaxf(lf[i] + m, li[i]); const float fp = __expf(lf[i] + m - mn), ip = __expf(li[i] - mn); m = mn;
            const float iv = ip * vv;
            C0 = fp * C0 + iv * k0; C1 = fp * C1 + iv * k1; C2 = fp * C2 + iv * k2; C3 = fp * C3 + iv * k3;
            n0 = fp * n0 + ip * k0; n1 = fp * n1 + ip * k1; n2 = fp * n2 + ip * k2; n3 = fp * n3 + ip * k3;
            float pn = (C0 * q0 + C1 * q1) + (C2 * q2 + C3 * q3), pd = (n0 * q0 + n1 * q1) + (n2 * q2 + n3 * q3);
#pragma unroll
            for (int o = 1; o < 16; o <<= 1) { pn += __shfl_xor(pn, o); pd += __shfl_xor(pd, o); }
            const float hv = pn / fmaxf(fabsf(pd), __expf(-mn));
            if (dg == 0) po[(size_t)(t0 + i) * D] = (bf16)f2bf(hv);
        }
    }
}
DI void gdn_chain(Frame& F, const bf16* proj, const float* gate, const float* convw, bf16* mix, int c) {
    const int b = c >> 5, h = (c >> 2) & 7, vq = c & 3, cc = F.tid >> 4, dg = F.tid & 15;
    LAS float* qs = (LAS float*)F.lds; LAS float* ks = qs + 64 * 128; LAS float* vs = ks + 64 * 128; LAS float* os = vs + 64 * 32; LAS float* bet = os + 64 * 32; LAS float* alp = bet + 64;
    float S[8];
#pragma unroll
    for (int j = 0; j < 8; ++j) S[j] = 0.f;
    for (int t0 = 0; t0 < T; t0 += 64) {
        __syncthreads();
        { const int row = F.tid >> 3, seg = F.tid & 7, t = t0 + row;
#pragma unroll
          for (int which = 0; which < 2; ++which) {
              const int colg = which * 1024 + h * 128 + seg * 16; float a[16];
#pragma unroll
              for (int i = 0; i < 16; ++i) a[i] = 0.f;
#pragma unroll
              for (int j = 0; j < 4; ++j) { const int tt = t - 3 + j;
                  if (tt >= 0) { const bf16* src = proj + (size_t)(b * T + tt) * C_N + colg; const float* w = convw + j * 3072 + colg;
#pragma unroll
                      for (int q = 0; q < 2; ++q) { const v4u raw = *(const GAS v4u*)(src + 8 * q); const f32x4 w0 = *(const GAS f32x4*)(w + 8 * q), w1 = *(const GAS f32x4*)(w + 8 * q + 4);
                          a[8 * q + 0] += bflo(raw.x) * w0.x; a[8 * q + 1] += bfhi(raw.x) * w0.y; a[8 * q + 2] += bflo(raw.y) * w0.z; a[8 * q + 3] += bfhi(raw.y) * w0.w;
                          a[8 * q + 4] += bflo(raw.z) * w1.x; a[8 * q + 5] += bfhi(raw.z) * w1.y; a[8 * q + 6] += bflo(raw.w) * w1.z; a[8 * q + 7] += bfhi(raw.w) * w1.w; } } }
              float ss = 0.f;
#pragma unroll
              for (int i = 0; i < 16; ++i) { a[i] = a[i] * sigmoidf_(a[i]); ss += a[i] * a[i]; }
              ss += __shfl_xor(ss, 1); ss += __shfl_xor(ss, 2); ss += __shfl_xor(ss, 4);
              const float sc = (1.0f / sqrtf(ss + EPS)) * (which == 0 ? 0.08838834764831845f : 1.0f);
              LAS float* dst = (which == 0 ? qs : ks) + row * 128 + seg * 16;
#pragma unroll
              for (int q = 0; q < 4; ++q) *(LAS f32x4*)(dst + 4 * q) = (f32x4){a[4 * q] * sc, a[4 * q + 1] * sc, a[4 * q + 2] * sc, a[4 * q + 3] * sc};
          } }
        if (F.tid < 256) { const int row = F.tid >> 2, seg = F.tid & 3, t = t0 + row; const int colg = 2048 + h * 128 + vq * 32 + seg * 8; float a[8];
#pragma unroll
            for (int i = 0; i < 8; ++i) a[i] = 0.f;
#pragma unroll
            for (int j = 0; j < 4; ++j) { const int tt = t - 3 + j;
                if (tt >= 0) { const v4u raw = *(const GAS v4u*)(proj + (size_t)(b * T + tt) * C_N + colg); const float* w = convw + j * 3072 + colg; const f32x4 w0 = *(const GAS f32x4*)w, w1 = *(const GAS f32x4*)(w + 4);
                    a[0] += bflo(raw.x) * w0.x; a[1] += bfhi(raw.x) * w0.y; a[2] += bflo(raw.y) * w0.z; a[3] += bfhi(raw.y) * w0.w; a[4] += bflo(raw.z) * w1.x; a[5] += bfhi(raw.z) * w1.y; a[6] += bflo(raw.w) * w1.z; a[7] += bfhi(raw.w) * w1.w; } }
#pragma unroll
            for (int i = 0; i < 8; ++i) a[i] = a[i] * sigmoidf_(a[i]);
            *(LAS f32x4*)(vs + row * 32 + seg * 8) = (f32x4){a[0], a[1], a[2], a[3]}; *(LAS f32x4*)(vs + row * 32 + seg * 8 + 4) = (f32x4){a[4], a[5], a[6], a[7]}; }
        if (F.tid < 64) { const float* g = gate + (size_t)(b * T + t0 + F.tid) * 16; bet[F.tid] = g[h]; alp[F.tid] = __expf(g[8 + h]); }
        __syncthreads();
        for (int s = 0; s < 64; ++s) {
            const f32x4 ka = *(const LAS f32x4*)(ks + s * 128 + 8 * dg), kb = *(const LAS f32x4*)(ks + s * 128 + 8 * dg + 4);
            const f32x4 qa = *(const LAS f32x4*)(qs + s * 128 + 8 * dg), qb = *(const LAS f32x4*)(qs + s * 128 + 8 * dg + 4);
            const float vv = vs[s * 32 + cc], be = bet[s], al = alp[s];
            float p = (ka.x * S[0] + ka.y * S[1]) + (ka.z * S[2] + ka.w * S[3]) + (kb.x * S[4] + kb.y * S[5]) + (kb.z * S[6] + kb.w * S[7]);
#pragma unroll
            for (int o = 1; o < 16; o <<= 1) p += __shfl_xor(p, o);
            const float dl = be * (vv - al * p);
            S[0] = al * S[0] + ka.x * dl; S[1] = al * S[1] + ka.y * dl; S[2] = al * S[2] + ka.z * dl; S[3] = al * S[3] + ka.w * dl;
            S[4] = al * S[4] + kb.x * dl; S[5] = al * S[5] + kb.y * dl; S[6] = al * S[6] + kb.z * dl; S[7] = al * S[7] + kb.w * dl;
            float po = (qa.x * S[0] + qa.y * S[1]) + (qa.z * S[2] + qa.w * S[3]) + (qb.x * S[4] + qb.y * S[5]) + (qb.z * S[6] + qb.w * S[7]);
#pragma unroll
            for (int o = 1; o < 16; o <<= 1) po += __shfl_xor(po, o);
            if (dg == 0) os[s * 32 + cc] = po;
        }
        __syncthreads();
        { const int row = F.tid >> 3, c4 = (F.tid & 7) * 4; const f32x4 o = *(const LAS f32x4*)(os + row * 32 + c4);
          *(GAS v2u*)(mix + (size_t)(b * T + t0 + row) * D + h * 128 + vq * 32 + c4) = (v2u){pk2(o.x, o.y), pk2(o.z, o.w)}; }
    }
}
struct MlChunkRegs { v4u q, k, v0, v1, o0, o1; float li, lf; };
DI void ml_load(MlChunkRegs& R, const bf16* proj, const float* gate, size_t r0, int h, int tid) {
    const int row = tid >> 3, seg = tid & 7; const bf16* p = proj + (r0 + row) * AB_N;
    R.q = *(const GAS v4u*)(p + h * 64 + 8 * seg); R.k = *(const GAS v4u*)(p + 256 + h * 64 + 8 * seg);
    R.v0 = *(const GAS v4u*)(p + 512 + h * 128 + 16 * seg); R.v1 = *(const GAS v4u*)(p + 512 + h * 128 + 16 * seg + 8);
    R.o0 = *(const GAS v4u*)(p + 1024 + h * 128 + 16 * seg); R.o1 = *(const GAS v4u*)(p + 1024 + h * 128 + 16 * seg + 8);
    R.li = 0.f; R.lf = 0.f;
    if (tid < 64) { const float* g = gate + (r0 + tid) * 16; R.li = g[h]; R.lf = g[4 + h]; }
}
DI unsigned scale_pk(unsigned u, float s) { return pk2(bflo(u) * s, bfhi(u) * s); }
DI void mlstm_chunked(Frame& F, const bf16* proj, const float* gate, const float* hgain, bf16* mix, int c) {
    constexpr int LD = 72, HLD = 132;
    const int b = c >> 2, h = c & 3;
    const int tid = F.tid, lane = F.lane, w = F.wave, r = lane & 15, quad = lane >> 4, row = tid >> 3, seg = tid & 7;
    LAS bf16* qs = (LAS bf16*)F.lds; LAS bf16* qw = qs + 64 * LD; LAS bf16* ks = qw + 64 * LD; LAS bf16* kTs = ks + 64 * LD; LAS bf16* Sd = kTs + 64 * LD;
    LAS bf16* vT = Sd + 64 * LD; LAS bf16* Cb = vT + 128 * LD;
    LAS float* hbuf = (LAS float*)(Cb + 128 * LD);
    LAS float* sA = hbuf + 64 * HLD; LAS float* sM = sA + 64; LAS float* sWi = sM + 64; LAS float* sWs = sWi + 64; LAS float* sEm = sWs + 64; LAS float* sN = sEm + 64  ; LAS float* sMisc = sN + 128;
    __syncthreads();
    for (int i = tid; i < 128 * LD / 2; i += NTHR) ((LAS unsigned*)Cb)[i] = 0u;
    if (tid < 128) sN[tid] = 0.f;
    f32x4 accC[4];
#pragma unroll
    for (int i = 0; i < 4; ++i) accC[i] = (f32x4){0.f, 0.f, 0.f, 0.f};
    float nreg = 0.f, mprev = 0.f;
    float gn[16];
#pragma unroll
    for (int i = 0; i < 16; ++i) gn[i] = hgain[h * 128 + 16 * seg + i];
    const size_t rb = (size_t)b * T;
    MlChunkRegs cur, nxt; ml_load(cur, proj, gate, rb, h, tid); nxt = cur;
    for (int ch = 0; ch < T / 64; ++ch) {
        const size_t r0 = rb + (size_t)ch * 64;
        if (ch + 1 < T / 64) ml_load(nxt, proj, gate, r0 + 64, h, tid);
        __syncthreads();
        *(LAS v4u*)(qs + row * LD + 8 * seg) = cur.q;
        { v4u kk; kk.x = scale_pk(cur.k.x, 0.125f); kk.y = scale_pk(cur.k.y, 0.125f); kk.z = scale_pk(cur.k.z, 0.125f); kk.w = scale_pk(cur.k.w, 0.125f); cur.k = kk; *(LAS v4u*)(ks + row * LD + 8 * seg) = kk; }
        { const unsigned vv[8] = {cur.v0.x, cur.v0.y, cur.v0.z, cur.v0.w, cur.v1.x, cur.v1.y, cur.v1.z, cur.v1.w};
#pragma unroll
          for (int i = 0; i < 8; ++i) { vT[(16 * seg + 2 * i) * LD + row] = (bf16)(vv[i] & 0xffffu); vT[(16 * seg + 2 * i + 1) * LD + row] = (bf16)(vv[i] >> 16); } }
        if (w == 0) {
            float bb = cur.lf;
#pragma unroll
            for (int o = 1; o < 64; o <<= 1) { const float t = __shfl_up(bb, o); if (lane >= o) bb += t; }
            const float a = cur.li - bb; float cm = a;
#pragma unroll
            for (int o = 1; o < 64; o <<= 1) { const float t = __shfl_up(cm, o); if (lane >= o) cm = fmaxf(cm, t); }
            const float Mx = fmaxf(mprev, cm);
            const float b63 = __shfl(bb, 63), Mx63 = __shfl(Mx, 63);
            sA[lane] = a; sM[lane] = Mx; sWi[lane] = __expf(mprev - Mx); sWs[lane] = __expf(a - Mx63); sEm[lane] = __expf(-(bb + Mx));
            if (lane == 0) sMisc[0] = __expf(mprev - Mx63);
            mprev = b63 + Mx63;
        }
        __syncthreads();
        { const float wi = sWi[row], wsr = sWs[row];
          v4u t; t.x = scale_pk(cur.q.x, wi); t.y = scale_pk(cur.q.y, wi); t.z = scale_pk(cur.q.z, wi); t.w = scale_pk(cur.q.w, wi); *(LAS v4u*)(qw + row * LD + 8 * seg) = t;
          const unsigned kk[4] = {cur.k.x, cur.k.y, cur.k.z, cur.k.w};
#pragma unroll
          for (int i = 0; i < 4; ++i) { kTs[(8 * seg + 2 * i) * LD + row] = (bf16)f2bf(bflo(kk[i]) * wsr); kTs[(8 * seg + 2 * i + 1) * LD + row] = (bf16)f2bf(bfhi(kk[i]) * wsr); } }
        { const int mt = w >> 1;
          const bf16x8 a0 = *(const LAS bf16x8*)(qs + (16 * mt + r) * LD + 8 * quad), a1 = *(const LAS bf16x8*)(qs + (16 * mt + r) * LD + 32 + 8 * quad);
#pragma unroll
          for (int tt = 0; tt < 2; ++tt) { const int nt = 2 * (w & 1) + tt; f32x4 acc = (f32x4){0.f, 0.f, 0.f, 0.f};
              if (nt <= mt) { const bf16x8 b0 = *(const LAS bf16x8*)(ks + (16 * nt + r) * LD + 8 * quad), b1 = *(const LAS bf16x8*)(ks + (16 * nt + r) * LD + 32 + 8 * quad);
                  acc = mfma16(a0, b0, acc); acc = mfma16(a1, b1, acc); }
              const int s = 16 * nt + r; const float as = sA[s];
#pragma unroll
              for (int j = 0; j < 4; ++j) { const int t = 16 * mt + 4 * quad + j; const float v = (s <= t) ? acc[j] * __expf(as - sM[t]) : 0.f; Sd[t * LD + s] = (bf16)f2bf(v); } } }
        __syncthreads();
        const bf16x8 vf0 = *(const LAS bf16x8*)(vT + (16 * w + r) * LD + 8 * quad), vf1 = *(const LAS bf16x8*)(vT + (16 * w + r) * LD + 32 + 8 * quad);
        { const bf16x8 cf0 = *(const LAS bf16x8*)(Cb + (16 * w + r) * LD + 8 * quad), cf1 = *(const LAS bf16x8*)(Cb + (16 * w + r) * LD + 32 + 8 * quad);
#pragma unroll
          for (int mt = 0; mt < 4; ++mt) { f32x4 acc = (f32x4){0.f, 0.f, 0.f, 0.f};
              acc = mfma16(*(const LAS bf16x8*)(Sd + (16 * mt + r) * LD + 8 * quad), vf0, acc); acc = mfma16(*(const LAS bf16x8*)(Sd + (16 * mt + r) * LD + 32 + 8 * quad), vf1, acc);
              acc = mfma16(*(const LAS bf16x8*)(qw + (16 * mt + r) * LD + 8 * quad), cf0, acc); acc = mfma16(*(const LAS bf16x8*)(qw + (16 * mt + r) * LD + 32 + 8 * quad), cf1, acc);
#pragma unroll
              for (int j = 0; j < 4; ++j) hbuf[(16 * mt + 4 * quad + j) * HLD + 16 * w + r] = acc[j]; } }
        __syncthreads();
        { const float wold = sMisc[0];
#pragma unroll
          for (int nt = 0; nt < 4; ++nt) { f32x4 acc = accC[nt] * wold;
              acc = mfma16(vf0, *(const LAS bf16x8*)(kTs + (16 * nt + r) * LD + 8 * quad), acc); acc = mfma16(vf1, *(const LAS bf16x8*)(kTs + (16 * nt + r) * LD + 32 + 8 * quad), acc);
              accC[nt] = acc;
#pragma unroll
              for (int j = 0; j < 4; ++j) Cb[(16 * w + 4 * quad + j) * LD + 16 * nt + r] = (bf16)f2bf(acc[j]); }
          if (w == 0) { float sum = 0.f;
#pragma unroll
              for (int q8 = 0; q8 < 8; ++q8) { const v4u t = *(const LAS v4u*)(kTs + lane * LD + 8 * q8); sum += (bflo(t.x) + bfhi(t.x)) + (bflo(t.y) + bfhi(t.y)) + (bflo(t.z) + bfhi(t.z)) + (bflo(t.w) + bfhi(t.w)); }
              nreg = wold * nreg + sum; sN[((ch + 1) & 1) * 64 + lane] = nreg; } }
        { const LAS float* nv = sN + (ch & 1) * 64 + 8 * seg;
          const v4u sd = *(const LAS v4u*)(Sd + row * LD + 8 * seg);
          float p = (bflo(sd.x) + bfhi(sd.x)) + (bflo(sd.y) + bfhi(sd.y)) + (bflo(sd.z) + bfhi(sd.z)) + (bflo(sd.w) + bfhi(sd.w));
          const float qn = (bflo(cur.q.x) * nv[0] + bfhi(cur.q.x) * nv[1]) + (bflo(cur.q.y) * nv[2] + bfhi(cur.q.y) * nv[3]) + (bflo(cur.q.z) * nv[4] + bfhi(cur.q.z) * nv[5]) + (bflo(cur.q.w) * nv[6] + bfhi(cur.q.w) * nv[7]);
          p += sWi[row] * qn;
          p += __shfl_xor(p, 1); p += __shfl_xor(p, 2); p += __shfl_xor(p, 4);
          const float dinv = 1.0f / fmaxf(fabsf(p), sEm[row]);
          float hv[16]; float ss = 0.f;
#pragma unroll
          for (int q4 = 0; q4 < 4; ++q4) { const f32x4 t = *(const LAS f32x4*)(hbuf + row * HLD + 16 * seg + 4 * q4); hv[4 * q4] = t.x * dinv; hv[4 * q4 + 1] = t.y * dinv; hv[4 * q4 + 2] = t.z * dinv; hv[4 * q4 + 3] = t.w * dinv; }
#pragma unroll
          for (int i = 0; i < 16; ++i) ss += hv[i] * hv[i];
          ss += __shfl_xor(ss, 1); ss += __shfl_xor(ss, 2); ss += __shfl_xor(ss, 4);
          const float rstd = 1.0f / sqrtf(ss * (1.f / 128.f) + EPS);
          const unsigned og[8] = {cur.o0.x, cur.o0.y, cur.o0.z, cur.o0.w, cur.o1.x, cur.o1.y, cur.o1.z, cur.o1.w}; unsigned ow[8];
#pragma unroll
          for (int i = 0; i < 8; ++i) ow[i] = pk2(hv[2 * i] * rstd * gn[2 * i] * sigmoidf_(bflo(og[i])), hv[2 * i + 1] * rstd * gn[2 * i + 1] * sigmoidf_(bfhi(og[i])));
          bf16* op = mix + (r0 + row) * D + h * 128 + 16 * seg;
          *(GAS v4u*)op = (v4u){ow[0], ow[1], ow[2], ow[3]}; *(GAS v4u*)(op + 8) = (v4u){ow[4], ow[5], ow[6], ow[7]}; }
        cur = nxt;
    }
}
constexpr size_t MIX_AT = 0, MIX_HALO = 64 * MiB, MIX_GL = 96 * MiB;
DI void gdn_g1_unit(Frame& F, bf16* big, const bf16* halo, const float* gate, const float* convw, bf16* Hb, bf16* At, float* GL, int U) {
    constexpr int LQ = 136, LX = 72, LR = 264;
    const int ch = U & 127, h = (U >> 7) & 7, b = U >> 10;
    const size_t r0 = (size_t)b * T + (size_t)ch * 64;
    const int tid = F.tid, lane = F.lane, w = F.wave, r = lane & 15, quad = lane >> 4, row = tid >> 3, seg = tid & 7;
    LAS bf16* qn = (LAS bf16*)F.lds; LAS bf16* kn = qn + 64 * LQ; LAS bf16* vn = kn + 64 * LQ; LAS bf16* knT = vn + 64 * LQ;
    LAS bf16* Lb = knT + 128 * LX; LAS float* Lf = (LAS float*)(Lb + 64 * LX);
    LAS bf16* Db = (LAS bf16*)(Lf + 4 * 16 * 17); LAS bf16* Xt = Db + 4 * 16 * 20;
    LAS bf16* Xr = qn;
    LAS float* sG = (LAS float*)(Xt + 256 * LX); LAS float* sBeta = sG + 64; LAS float* sEg = sBeta + 64;
    __syncthreads();
#pragma unroll
    for (int which = 0; which < 3; ++which) {
        const int colg = which * 1024 + h * 128 + 16 * seg; float a[16];
#pragma unroll
        for (int i = 0; i < 16; ++i) a[i] = 0.f;
#pragma unroll
        for (int j = 0; j < 4; ++j) { const int rr = row - 3 + j; const bf16* src = nullptr;
            if (rr >= 0) src = big + (r0 + rr) * C_N + colg; else if (ch > 0) src = halo + ((size_t)(b * 128 + ch - 1) * 3 + (3 + rr)) * 3072 + colg;
            if (src) { const float* wp = convw + j * 3072 + colg;
#pragma unroll
                for (int q = 0; q < 2; ++q) { const v4u raw = *(const GAS v4u*)(src + 8 * q); const f32x4 w0 = *(const GAS f32x4*)(wp + 8 * q), w1 = *(const GAS f32x4*)(wp + 8 * q + 4);
                    a[8 * q + 0] += bflo(raw.x) * w0.x; a[8 * q + 1] += bfhi(raw.x) * w0.y; a[8 * q + 2] += bflo(raw.y) * w0.z; a[8 * q + 3] += bfhi(raw.y) * w0.w;
                    a[8 * q + 4] += bflo(raw.z) * w1.x; a[8 * q + 5] += bfhi(raw.z) * w1.y; a[8 * q + 6] += bflo(raw.w) * w1.z; a[8 * q + 7] += bfhi(raw.w) * w1.w; } } }
        float ss = 0.f;
#pragma unroll
        for (int i = 0; i < 16; ++i) { a[i] = a[i] * sigmoidf_(a[i]); ss += a[i] * a[i]; }
        float sc = 1.0f;
        if (which < 2) { ss += __shfl_xor(ss, 1); ss += __shfl_xor(ss, 2); ss += __shfl_xor(ss, 4); sc = (1.0f / sqrtf(ss + EPS)) * (which == 0 ? 0.08838834764831845f : 1.0f); }
        unsigned pw[8];
#pragma unroll
        for (int i = 0; i < 8; ++i) pw[i] = pk2(a[2 * i] * sc, a[2 * i + 1] * sc);
        LAS bf16* dst = (which == 0 ? qn : (which == 1 ? kn : vn)) + row * LQ + 16 * seg;
        *(LAS v4u*)dst = (v4u){pw[0], pw[1], pw[2], pw[3]}; *(LAS v4u*)(dst + 8) = (v4u){pw[4], pw[5], pw[6], pw[7]};
        if (which == 1) {
#pragma unroll
            for (int i = 0; i < 8; ++i) { knT[(16 * seg + 2 * i) * LX + row] = (bf16)(pw[i] & 0xffffu); knT[(16 * seg + 2 * i + 1) * LX + row] = (bf16)(pw[i] >> 16); } }
    }
    if (w == 0) { const float* g = gate + (r0 + lane) * 16; float gg = g[8 + h]; const float be = g[h];
#pragma unroll
        for (int o = 1; o < 64; o <<= 1) { const float t = __shfl_up(gg, o); if (lane >= o) gg += t; }
        sG[lane] = gg; sBeta[lane] = be; sEg[lane] = __expf(gg); }
    __syncthreads();
    { const int mt = w >> 1;
#pragma unroll
      for (int tt = 0; tt < 2; ++tt) { const int nt = 2 * (w & 1) + tt; f32x4 ak = (f32x4){0.f, 0.f, 0.f, 0.f}, aq = ak;
          if (nt <= mt) {
#pragma unroll
              for (int kk = 0; kk < 4; ++kk) { const bf16x8 bk = *(const LAS bf16x8*)(kn + (16 * nt + r) * LQ + 32 * kk + 8 * quad);
                  ak = mfma16(*(const LAS bf16x8*)(kn + (16 * mt + r) * LQ + 32 * kk + 8 * quad), bk, ak); aq = mfma16(*(const LAS bf16x8*)(qn + (16 * mt + r) * LQ + 32 * kk + 8 * quad), bk, aq); } }
          const int s = 16 * nt + r; const float gs = sG[s];
#pragma unroll
          for (int j = 0; j < 4; ++j) { const int t = 16 * mt + 4 * quad + j; const float dec = (s <= t) ? __expf(sG[t] - gs) : 0.f;
              const float lv = (s < t) ? sBeta[t] * ak[j] * dec : 0.f;
              if (nt <= mt) { Lb[t * LX + s] = (bf16)f2bf(lv); if (nt == mt) Lf[(mt * 16 + 4 * quad + j) * 17 + r] = lv; }
              At[(size_t)U * 4096 + t * 64 + s] = (bf16)f2bf(aq[j] * dec); } } }
    float R[4][2][4];
#pragma unroll
    for (int i = 0; i < 4; ++i)
#pragma unroll
        for (int ct = 0; ct < 2; ++ct)
#pragma unroll
            for (int j = 0; j < 4; ++j) { const int t = 16 * i + 4 * quad + j, cc = 32 * (w & 3) + 16 * ct + r;
                R[i][ct][j] = (w < 4) ? sBeta[t] * bf2f(vn[t * LQ + cc]) : sBeta[t] * sEg[t] * bf2f(kn[t * LQ + cc]); }
    __syncthreads();
    if (w == 0) { const int i = lane >> 4, cI = lane & 15; const LAS float* N = Lf + i * 16 * 17; float x[16];
#pragma unroll
        for (int rr = 0; rr < 16; ++rr) { float v = (rr == cI) ? 1.f : 0.f;
#pragma unroll
            for (int m = 0; m < rr; ++m) v -= N[rr * 17 + m] * x[m];
            x[rr] = v; Db[(i * 16 + rr) * 20 + cI] = (bf16)f2bf(v); }
    } else { const float gl = sG[63];
        for (int idx = tid - 64; idx < 2048; idx += NTHR - 64) {
            if (idx < 1024) { const int t = idx >> 4, c8 = (idx & 15) * 8; const v4u v = *(const LAS v4u*)(qn + t * LQ + c8); const float e = sEg[t];
                *(GAS v4u*)(big + (r0 + t) * C_N + 2048 + h * 128 + c8) = (v4u){scale_pk(v.x, e), scale_pk(v.y, e), scale_pk(v.z, e), scale_pk(v.w, e)}; }
            else { const int i2 = idx - 1024, d = i2 >> 3, s8 = (i2 & 7) * 8; const v4u v = *(const LAS v4u*)(knT + d * LX + s8); float e[8];
#pragma unroll
                for (int q = 0; q < 8; ++q) e[q] = __expf(gl - sG[s8 + q]);
                *(GAS v4u*)(big + (r0 + (d >> 1)) * C_N + 1024 + h * 128 + (d & 1) * 64 + s8) = (v4u){pk2(bflo(v.x) * e[0], bfhi(v.x) * e[1]), pk2(bflo(v.y) * e[2], bfhi(v.y) * e[3]), pk2(bflo(v.z) * e[4], bfhi(v.z) * e[5]), pk2(bflo(v.w) * e[6], bfhi(v.w) * e[7])}; } }
        if (tid == 64) GL[U] = __expf(gl); }
    __syncthreads();
#pragma unroll
    for (int i = 0; i < 4; ++i) {
#pragma unroll
        for (int ct = 0; ct < 2; ++ct) { const int col = 32 * w + 16 * ct + r; f32x4 acc = (f32x4){0.f, 0.f, 0.f, 0.f};
            if (i > 0) {
#pragma unroll
                for (int kk = 0; kk < 2; ++kk) if (32 * kk < 16 * i) {
                    bf16x8 af = *(const LAS bf16x8*)(Lb + (16 * i + r) * LX + 32 * kk + 8 * quad);
                    if (32 * kk + 8 * quad >= 16 * i) af = (bf16x8){0, 0, 0, 0, 0, 0, 0, 0};
                    acc = mfma16(af, *(const LAS bf16x8*)(Xt + col * LX + 32 * kk + 8 * quad), acc); } }
            const v2u bp = (v2u){pk2(R[i][ct][0] - acc[0], R[i][ct][1] - acc[1]), pk2(R[i][ct][2] - acc[2], R[i][ct][3] - acc[3])};
            const v2u ap = *(const LAS v2u*)(Db + (i * 16 + r) * 20 + 4 * quad);
            const f32x4 y = mfma16(__builtin_bit_cast(bf16x8, (v4u){ap.x, ap.y, 0u, 0u}), __builtin_bit_cast(bf16x8, (v4u){bp.x, bp.y, 0u, 0u}), (f32x4){0.f, 0.f, 0.f, 0.f});
            *(LAS v2u*)(Xt + col * LX + 16 * i + 4 * quad) = (v2u){pk2(y[0], y[1]), pk2(y[2], y[3])};
#pragma unroll
            for (int j = 0; j < 4; ++j) Xr[(16 * i + 4 * quad + j) * LR + col] = (bf16)f2bf(y[j]); }
        __syncthreads();
    }
    { const v4u u0 = *(const LAS v4u*)(Xr + row * LR + 16 * seg), u1 = *(const LAS v4u*)(Xr + row * LR + 16 * seg + 8), w0 = *(const LAS v4u*)(Xr + row * LR + 128 + 16 * seg), w1 = *(const LAS v4u*)(Xr + row * LR + 128 + 16 * seg + 8);
      bf16* up = Hb + (r0 + row) * D + h * 128 + 16 * seg; *(GAS v4u*)up = u0; *(GAS v4u*)(up + 8) = u1;
      bf16* wp = big + (r0 + row) * C_N + h * 128 + 16 * seg; *(GAS v4u*)wp = w0; *(GAS v4u*)(wp + 8) = w1; }
}
DI void gdn_g1_phase(Frame& F, bf16* big, const bf16* halo, const float* gate, const float* convw, bf16* Hb, bf16* At, float* GL) {
    LAS unsigned* xt = (LAS unsigned*)(F.lds + (3 * 64 * 136 + 128 * 72 + 64 * 72) * 2 + 4 * 16 * 17 * 4 + 4 * 16 * 20 * 2);
    __syncthreads();
    for (int i = F.tid; i < 256 * 72 / 2; i += NTHR) xt[i] = 0u;
    const int per = (8192 + F.G - 1) / F.G, u0 = F.wg * per, u1 = (u0 + per < 8192) ? u0 + per : 8192;
    for (int U = u0; U < u1; ++U) gdn_g1_unit(F, big, halo, gate, convw, Hb, At, GL, U);
}
struct G2Regs { bf16x8 wf[4], qf[4], af[2], kf[2]; unsigned short u[4]; float gl; };
DI void g2_load(G2Regs& R, const bf16* big, const bf16* Hb, const bf16* At, const float* GL, int b, int h, int vq, int ch, int w, int r, int quad) {
    const size_t r0 = (size_t)b * T + (size_t)ch * 64; const int U = (b * 8 + h) * 128 + ch; const int mt = w >> 1, nt = w & 1;
    const bf16* pw = big + (r0 + 16 * mt + r) * C_N + h * 128 + 8 * quad;
#pragma unroll
    for (int kk = 0; kk < 4; ++kk) { R.wf[kk] = *(const GAS bf16x8*)(pw + 32 * kk); R.qf[kk] = *(const GAS bf16x8*)(pw + 2048 + 32 * kk); }
    const bf16* pa = At + (size_t)U * 4096 + (16 * mt + r) * 64 + 8 * quad;
    R.af[0] = *(const GAS bf16x8*)pa; R.af[1] = *(const GAS bf16x8*)(pa + 32);
    const int d = 16 * w + r; const bf16* pk = big + (r0 + (d >> 1)) * C_N + 1024 + h * 128 + (d & 1) * 64 + 8 * quad;
    R.kf[0] = *(const GAS bf16x8*)pk; R.kf[1] = *(const GAS bf16x8*)(pk + 32);
    const bf16* pu = Hb + (r0 + 16 * mt + 4 * quad) * D + h * 128 + vq * 32 + 16 * nt + r;
#pragma unroll
    for (int j = 0; j < 4; ++j) R.u[j] = pu[(size_t)j * D];
    R.gl = GL[U];
}
DI void gdn_g2_chain(Frame& F, const bf16* big, bf16* Hb, const bf16* At, const float* GL, int c) {
    constexpr int LS = 136, LV = 72;
    const int b = c >> 5, h = (c >> 2) & 7, vq = c & 3;
    const int tid = F.tid, lane = F.lane, w = F.wave, r = lane & 15, quad = lane >> 4, mt = w >> 1, nt = w & 1;
    LAS bf16* St = (LAS bf16*)F.lds;
    LAS bf16* vnT = St + 32 * LS;
    __syncthreads();
    for (int i = tid; i < 32 * LS / 2; i += NTHR) ((LAS unsigned*)St)[i] = 0u;
    f32x4 accS[2]; accS[0] = (f32x4){0.f, 0.f, 0.f, 0.f}; accS[1] = accS[0];
    G2Regs cur, nxt; g2_load(cur, big, Hb, At, GL, b, h, vq, 0, w, r, quad); nxt = cur;
    __syncthreads();
    for (int ch = 0; ch < T / 64; ++ch) {
        if (ch + 1 < T / 64) g2_load(nxt, big, Hb, At, GL, b, h, vq, ch + 1, w, r, quad);
        f32x4 av = (f32x4){0.f, 0.f, 0.f, 0.f}, ao = av;
#pragma unroll
        for (int kk = 0; kk < 4; ++kk) { const bf16x8 sf = *(const LAS bf16x8*)(St + (16 * nt + r) * LS + 32 * kk + 8 * quad); av = mfma16(cur.wf[kk], sf, av); ao = mfma16(cur.qf[kk], sf, ao); }
        *(LAS v2u*)(vnT + (16 * nt + r) * LV + 16 * mt + 4 * quad) = (v2u){pk2(bf2f(cur.u[0]) - av[0], bf2f(cur.u[1]) - av[1]), pk2(bf2f(cur.u[2]) - av[2], bf2f(cur.u[3]) - av[3])};
        __syncthreads();
#pragma unroll
        for (int kk = 0; kk < 2; ++kk) ao = mfma16(cur.af[kk], *(const LAS bf16x8*)(vnT + (16 * nt + r) * LV + 32 * kk + 8 * quad), ao);
        { const size_t r0 = (size_t)b * T + (size_t)ch * 64; bf16* po = Hb + (r0 + 16 * mt + 4 * quad) * D + h * 128 + vq * 32 + 16 * nt + r;
#pragma unroll
          for (int j = 0; j < 4; ++j) po[(size_t)j * D] = (bf16)f2bf(ao[j]); }
#pragma unroll
        for (int n2 = 0; n2 < 2; ++n2) { f32x4 a = accS[n2] * cur.gl;
#pragma unroll
            for (int kk = 0; kk < 2; ++kk) a = mfma16(cur.kf[kk], *(const LAS bf16x8*)(vnT + (16 * n2 + r) * LV + 32 * kk + 8 * quad), a);
            accS[n2] = a; *(LAS v2u*)(St + (16 * n2 + r) * LS + 16 * w + 4 * quad) = (v2u){pk2(a[0], a[1]), pk2(a[2], a[3])}; }
        __syncthreads();
        cur = nxt;
    }
}
DI void sb_unit(Frame& F, const bf16* proj, bf16* mix, int u) {
    constexpr int LDV = 72;
    const int qt = u & 63, h = (u >> 6) & 3, b = u >> 8;
    LAS bf16* Vt = (LAS bf16*)F.lds;
    volatile LAS unsigned* flag = (volatile LAS unsigned*)(F.lds + MISC_OFF + 64);
    const int w = F.wave, lane = F.lane, r = lane & 15, quad = lane >> 4;
    const int t0 = qt * 128, qpos = t0 + 16 * w + r;
    const size_t rb = (size_t)b * T;
    bf16x8 qf[4];
#pragma unroll
    for (int kk = 0; kk < 4; ++kk) qf[kk] = *(const GAS bf16x8*)(proj + (rb + qpos) * AB_N + 1536 + h * 128 + 32 * kk + 8 * quad);
    f32x4 o[8];
#pragma unroll
    for (int i = 0; i < 8; ++i) o[i] = (f32x4){0.f, 0.f, 0.f, 0.f};
    float carry = 0.f;
    const float scale = 0.08838834764831845f;
    for (int kb = 2 * qt + 1; kb >= 0; --kb) {
        const int k0 = kb * 64;
        __syncthreads();
        { const int key = F.tid >> 3, ds = (F.tid & 7) * 16; const bf16* src = proj + (rb + k0 + key) * AB_N + 2560 + h * 128 + ds;
          const v4u a = *(const GAS v4u*)src, c = *(const GAS v4u*)(src + 8);
          const unsigned ww[8] = {a.x, a.y, a.z, a.w, c.x, c.y, c.z, c.w};
#pragma unroll
          for (int i = 0; i < 8; ++i) { Vt[(ds + 2 * i) * LDV + key] = (bf16)(ww[i] & 0xffffu); Vt[(ds + 2 * i + 1) * LDV + key] = (bf16)(ww[i] >> 16); } }
        if (F.tid == 0) flag[0] = 0u;
        __syncthreads();
        if (k0 < t0 + 16 * w + 15) {
            f32x4 s[4];
#pragma unroll
            for (int mt = 0; mt < 4; ++mt) { s[mt] = (f32x4){0.f, 0.f, 0.f, 0.f};
                const bf16* kp = proj + (rb + k0 + 16 * mt + r) * AB_N + 2048 + h * 128 + 8 * quad;
#pragma unroll
                for (int kk = 0; kk < 4; ++kk) s[mt] = mfma16(*(const GAS bf16x8*)(kp + 32 * kk), qf[kk], s[mt]); }
            float l1[4][4], tot[4];
#pragma unroll
            for (int mt = 0; mt < 4; ++mt) { tot[mt] = 0.f;
#pragma unroll
                for (int j = 0; j < 4; ++j) { const float z = s[mt][j] * scale; const bool valid = (k0 + 16 * mt + 4 * quad + j) < qpos;
                    const float tl = __logf(1.0f + __expf(-fabsf(z)));
                    l1[mt][j] = valid ? (fminf(-z, 0.f) - tl) : 0.f; s[mt][j] = valid ? (fminf(z, 0.f) - tl) : -1e30f; tot[mt] += l1[mt][j]; } }
            float run = carry;
#pragma unroll
            for (int mt = 3; mt >= 0; --mt) {
                const float t1 = __shfl_xor(tot[mt], 16), t2 = __shfl_xor(tot[mt], 32), t3 = __shfl_xor(t1, 32);
                float hi = 0.f;
                hi += ((quad ^ 1) > quad) ? t1 : 0.f; hi += ((quad ^ 2) > quad) ? t2 : 0.f; hi += ((quad ^ 3) > quad) ? t3 : 0.f;
                float acc = run + hi;
#pragma unroll
                for (int j = 3; j >= 0; --j) { const float e = s[mt][j] + acc; s[mt][j] = __expf(e); acc += l1[mt][j]; }
                run += (tot[mt] + t1) + (t2 + t3);
            }
            carry = run;
#pragma unroll
            for (int s2 = 0; s2 < 2; ++s2) {
                v4u pw; pw.x = pk2(s[2 * s2][0], s[2 * s2][1]); pw.y = pk2(s[2 * s2][2], s[2 * s2][3]); pw.z = pk2(s[2 * s2 + 1][0], s[2 * s2 + 1][1]); pw.w = pk2(s[2 * s2 + 1][2], s[2 * s2 + 1][3]);
                const bf16x8 pf = __builtin_bit_cast(bf16x8, pw);
#pragma unroll
                for (int dt = 0; dt < 8; ++dt) { const LAS bf16* vp = Vt + (16 * dt + r) * LDV + 32 * s2 + 4 * quad;
                    const s16x4 lo = *(const LAS s16x4*)vp, hi4 = *(const LAS s16x4*)(vp + 16);
                    o[dt] = mfma16(__builtin_shufflevector(lo, hi4, 0, 1, 2, 3, 4, 5, 6, 7), pf, o[dt]); }
            }
        }
        if (!(carry < -SB_THR)) flag[0] = 1u;
        __syncthreads();
        if (flag[0] == 0u) break;
    }
    bf16* op = mix + (rb + qpos) * D + 512 + h * 128 + 4 * quad;
#pragma unroll
    for (int dt = 0; dt < 8; ++dt) *(GAS v2u*)(op + 16 * dt) = (v2u){pk2(o[dt][0], o[dt][1]), pk2(o[dt][2], o[dt][3])};
}
DI void xattn_phase(Frame& F, const bf16* Q, const bf16* KV, int l, bf16* O) {
    constexpr int LDV = 264;
    LAS bf16* Vt = (LAS bf16*)F.lds;
    const int per = (2048 + F.G - 1) / F.G, u0 = F.wg * per, u1 = (u0 + per < 2048) ? u0 + per : 2048;
    const int w = F.wave, lane = F.lane, r = lane & 15, quad = lane >> 4;
    int cur = -1;
    for (int u = u0; u < u1; ++u) {
        const int bh = u >> 6, qt = u & 63, b = bh >> 2, h = bh & 3;
        if (bh != cur) {
            __syncthreads();
#pragma unroll 4
            for (int it = 0; it < 16; ++it) { const int idx = F.tid + NTHR * it, key = idx >> 5, ds = (idx & 31) * 8;
                const v4u a = *(const GAS v4u*)(KV + (size_t)(b * MEMLEN + key) * 8192 + 2048 * l + 1024 + h * 256 + ds);
                const unsigned ww[4] = {a.x, a.y, a.z, a.w};
#pragma unroll
                for (int i = 0; i < 4; ++i) { Vt[(ds + 2 * i) * LDV + key] = (bf16)(ww[i] & 0xffffu); Vt[(ds + 2 * i + 1) * LDV + key] = (bf16)(ww[i] >> 16); } }
            __syncthreads(); cur = bh;
        }
        const size_t row = (size_t)b * T + qt * 128 + 16 * w + r;
        bf16x8 qf[8];
#pragma unroll
        for (int kk = 0; kk < 8; ++kk) qf[kk] = *(const GAS bf16x8*)(Q + row * D + h * 256 + 32 * kk + 8 * quad);
        f32x4 s[16];
#pragma unroll
        for (int mt = 0; mt < 16; ++mt) { s[mt] = (f32x4){0.f, 0.f, 0.f, 0.f};
            const bf16* kp = KV + (size_t)(b * MEMLEN + 16 * mt + r) * 8192 + 2048 * l + h * 256 + 8 * quad;
#pragma unroll
            for (int kk = 0; kk < 8; ++kk) s[mt] = mfma16(*(const GAS bf16x8*)(kp + 32 * kk), qf[kk], s[mt]); }
        float mx = -1e30f;
#pragma unroll
        for (int mt = 0; mt < 16; ++mt) mx = fmaxf(fmaxf(fmaxf(s[mt][0], s[mt][1]), fmaxf(s[mt][2], s[mt][3])), mx);
        mx = fmaxf(mx, __shfl_xor(mx, 16)); mx = fmaxf(mx, __shfl_xor(mx, 32));
        float sum = 0.f;
#pragma unroll
        for (int mt = 0; mt < 16; ++mt)
#pragma unroll
            for (int j = 0; j < 4; ++j) { const float p = __expf((s[mt][j] - mx) * 0.0625f); s[mt][j] = p; sum += p; }
        sum += __shfl_xor(sum, 16); sum += __shfl_xor(sum, 32);
        const float inv = 1.0f / sum;
        f32x4 o[16];
#pragma unroll
        for (int i = 0; i < 16; ++i) o[i] = (f32x4){0.f, 0.f, 0.f, 0.f};
#pragma unroll
        for (int s2 = 0; s2 < 8; ++s2) {
            v4u pw; pw.x = pk2(s[2 * s2][0], s[2 * s2][1]); pw.y = pk2(s[2 * s2][2], s[2 * s2][3]); pw.z = pk2(s[2 * s2 + 1][0], s[2 * s2 + 1][1]); pw.w = pk2(s[2 * s2 + 1][2], s[2 * s2 + 1][3]);
            const bf16x8 pf = __builtin_bit_cast(bf16x8, pw);
#pragma unroll
            for (int dt = 0; dt < 16; ++dt) { const LAS bf16* vp = Vt + (16 * dt + r) * LDV + 32 * s2 + 4 * quad;
                const s16x4 lo = *(const LAS s16x4*)vp, hi4 = *(const LAS s16x4*)(vp + 16);
                o[dt] = mfma16(__builtin_shufflevector(lo, hi4, 0, 1, 2, 3, 4, 5, 6, 7), pf, o[dt]); }
        }
        bf16* op = O + row * D + h * 256 + 4 * quad;
#pragma unroll
        for (int dt = 0; dt < 16; ++dt) *(GAS v2u*)(op + 16 * dt) = (v2u){pk2(o[dt][0] * inv, o[dt][1] * inv), pk2(o[dt][2] * inv, o[dt][3] * inv)};
    }
}
template <class Epi> DI void run_gemm(Frame& F, const bf16* A, const bf16* Bt, int M_, int N_, int K_, const Epi& E) {
    pg8::Gemm g{A, Bt, M_, N_, K_}; pg8::StaticOrder S; S.init(M_, N_, F.G, F.wg);
    pg8::gemm_phase<Epi, pg8::StaticOrder, PG8_ALIGN, PG8_SP2>(F.lds, g, S, E, F.tid);
}
constexpr int NPHASE = 55, PH_FINAL = 54, PPL = 13;
struct Args { In in; float* out; unsigned char* ws; int ph_lo, ph_hi, region, pad; };
__global__ void __launch_bounds__(NTHR, 2) fwd(Args a) {
    extern __shared__ __attribute__((aligned(16))) unsigned char lds_raw[];
    Frame F;
    F.lds = (LAS unsigned char*)lds_raw;
    F.tid = threadIdx.x; F.lane = F.tid & 63; F.wave = __builtin_amdgcn_readfirstlane(F.tid >> 6);
    F.G = gridDim.x; F.wg = blockIdx.x; F.gw = F.wg * NWAVES + F.wave; F.NGW = F.G * NWAVES;
    volatile LAS unsigned* MISC = (volatile LAS unsigned*)(F.lds + MISC_OFF);
    if (F.tid < 32) MISC[F.tid] = 0u;
    __syncthreads();
    const int lo = a.ph_lo, hi = a.ph_hi;
    unsigned char* ws = a.ws; const In& I = a.in;
    XcdBarrier bar; bar.bar = (unsigned*)(ws + WS_CTL) + CW_BAR + a.region * XCD_BAR_WORDS; bar.x = 0; bar.st = MISC + 8;
    if (hi - lo > 1) bar = xcd_barrier_post(bar.bar, MISC + 8);
#define IN(k) (lo <= (k) && (k) < hi)
#ifndef PROBE_DOUBLE
#define PROBE_DOUBLE -1
#endif
#ifndef PROBE_PAR
#define PROBE_PAR -1
#endif
#define NREP(k) ((PROBE_DOUBLE >= 0 && (k) >= 2 && (k) < PH_FINAL && ((k) - 2) % PPL == PROBE_DOUBLE && (PROBE_PAR < 0 || ((((k) - 2) / PPL) & 1) == PROBE_PAR)) ? 2 : 1)
#define PHASE(k) asm volatile("" : "+v"(F.tid)); F.lane = F.tid & 63; for (int rep_ = 0; rep_ < (IN(k) ? NREP(k) : 0); ++rep_)
#define SEAM(k) do { if (IN(k) && IN((k) + 1)) xcd_barrier(bar); } while (0)
    bf16* H = (bf16*)(ws + WS_H); bf16* MIX = (bf16*)(ws + WS_MIX); bf16* BIG = (bf16*)(ws + WS_BIG); bf16* KVX = (bf16*)(ws + WS_KVX);
    float* GATE = (float*)(ws + WS_GATE); const float* WG = (const float*)(ws + WS_WG);

    PHASE(0) p0_prologue(F, I, ws);
    SEAM(0);
    PHASE(1) run_gemm(F, (const bf16*)(ws + WS_MEMN), (const bf16*)(ws + WS_WKV), BATCH * MEMLEN, 8192, D, pg8::EpiBf16<0>{KVX, 8192, nullptr});
    SEAM(1);
    for (int l = 0; l < DEPTH; ++l) {
        asm volatile("" : "+v"(F.tid)); F.lane = F.tid & 63;
        const int pb = 2 + PPL * l, j = l >> 1; const bool odd = (l & 1) != 0;
        unsigned char* wl = ws + WS_W + (size_t)l * W_LAYER;
        const float* xcur = (l == 0) ? I.p[0] : a.out;
        PHASE(pb + 0) {
            if (!odd) norm_phase<1>(F, xcur, I.p[2] + l * D, H, WG + l * 16384, GATE, I.p[4] + j * 4, I.p[5] + j * 4);
            else norm_phase<2>(F, xcur, I.p[2] + l * D, H, WG + l * 16384, GATE, I.p[10] + j * 8, I.p[11] + j * 8);
        }
        SEAM(pb + 0);
        PHASE(pb + 1) { const int n = odd ? C_N : AB_N; run_gemm(F, H, (const bf16*)(wl + WO_WIN), M, n, D, pg8::EpiBf16<0>{BIG, n, odd ? (bf16*)(ws + WS_MIX + MIX_HALO) : nullptr}); }
        SEAM(pb + 1);
        PHASE(pb + 2) {
            if (!odd) {
                const int gh = F.G >= 64 ? 32 : F.G / 2;
                if (F.wg < gh) { for (int c = F.wg; c < 32; c += gh) mlstm_chunked(F, BIG, GATE, I.p[6] + j * 512, MIX, c); }
                else { for (int u = F.wg - gh; u < 2048; u += F.G - gh) sb_unit(F, BIG, MIX, u); }
            } else {
                gdn_g1_phase(F, BIG, (const bf16*)(ws + WS_MIX + MIX_HALO), GATE, I.p[9] + (size_t)j * 4 * 3072, H, (bf16*)(ws + WS_MIX + MIX_AT), (float*)(ws + WS_MIX + MIX_GL));
            }
        }
        SEAM(pb + 2);
        PHASE(pb + 3) { if (odd) { for (int c = F.wg; c < 256; c += F.G) gdn_g2_chain(F, BIG, H, (const bf16*)(ws + WS_MIX + MIX_AT), (const float*)(ws + WS_MIX + MIX_GL), c); } }
        if (odd) SEAM(pb + 3);
        PHASE(pb + 4) { if (odd) headnorm_phase<true>(F, H, MIX, BIG, I.p[12] + j * 128); }
        if (odd) SEAM(pb + 4);
        PHASE(pb + 5) run_gemm(F, MIX, (const bf16*)(wl + WO_WOUT), M, D, D, pg8::EpiResid{xcur, a.out, D});
        SEAM(pb + 5);
        PHASE(pb + 6) norm_phase<0>(F, a.out, I.p[14] + l * D, H, nullptr, nullptr, nullptr, nullptr);
        SEAM(pb + 6);
        PHASE(pb + 7) run_gemm(F, H, (const bf16*)(wl + WO_WQ), M, D, D, pg8::EpiBf16<0>{BIG, D, nullptr});
        SEAM(pb + 7);
        PHASE(pb + 8) xattn_phase(F, BIG, KVX, l, MIX);
        SEAM(pb + 8);
        PHASE(pb + 9) run_gemm(F, MIX, (const bf16*)(wl + WO_WO), M, D, D, pg8::EpiResid{a.out, a.out, D});
        SEAM(pb + 9);
        PHASE(pb + 10) norm_phase<0>(F, a.out, I.p[20] + l * D, H, nullptr, nullptr, nullptr, nullptr);
        SEAM(pb + 10);
        PHASE(pb + 11) run_gemm(F, H, (const bf16*)(wl + WO_W1), M, FF, D, pg8::EpiBf16<2>{BIG, FF, nullptr});
        SEAM(pb + 11);
        PHASE(pb + 12) run_gemm(F, BIG, (const bf16*)(wl + WO_W2), M, D, FF, pg8::EpiResid{a.out, a.out, D});
        SEAM(pb + 12);
    }
    PHASE(PH_FINAL) final_norm_phase(F, a.out, I.p[23]);
#undef IN
#undef PHASE
#undef SEAM
}

#ifndef MK_SPLIT
#define MK_SPLIT 0
#endif
extern "C" void kernel_launch(void* const* d_in, const int* in_sizes, int n_in, void* d_out, int out_size, void* d_ws, size_t ws_size, hipStream_t stream) {
    static int grid = 0;
    if (grid == 0) {
        if (n_in != 24 || in_sizes[0] != M * D || out_size != M * D || ws_size < WS_END) { fprintf(stderr, "kernel_launch: unexpected shapes (n_in %d, in0 %d, out %d, ws %zu)\n", n_in, n_in > 0 ? in_sizes[0] : -1, out_size, ws_size); grid = -1; return; }
        int dev = 0, cus = 0;
        if (hipGetDevice(&dev) != hipSuccess || hipDeviceGetAttribute(&cus, hipDeviceAttributeMultiprocessorCount, dev) != hipSuccess) { grid = -1; return; }
        if (hipFuncSetAttribute((const void*)fwd, hipFuncAttributeMaxDynamicSharedMemorySize, LDS_BYTES) != hipSuccess) { fprintf(stderr, "kernel_launch: hipFuncSetAttribute failed\n"); grid = -1; return; }
        (void)hipGetLastError();
        grid = cus;
    }
    if (grid < 0) return;
    (void)hipMemsetAsync((char*)d_ws + WS_CTL, 0, CTL_ZERO_BYTES, stream);
    Args a{};
    for (int i = 0; i < 24; ++i) a.in.p[i] = (const float*)d_in[i];
    a.out = (float*)d_out; a.ws = (unsigned char*)d_ws; a.region = 0; a.pad = 0;
#if MK_SPLIT
    for (int p = 0; p < NPHASE; ++p) { a.ph_lo = p; a.ph_hi = p + 1; hipLaunchKernelGGL(fwd, dim3(grid), dim3(NTHR), LDS_BYTES, stream, a); }
#else
    a.ph_lo = 0; a.ph_hi = NPHASE; hipLaunchKernelGGL(fwd, dim3(grid), dim3(NTHR), LDS_BYTES, stream, a);
#endif
}
```

```cpp
#include <hip/hip_runtime.h>
#include <cstdio>
#include <cstdint>
namespace pg8 {
#define PG8_LAS __attribute__((address_space(3)))
typedef unsigned short bf16_t;
typedef short bf16x8 __attribute__((ext_vector_type(8)));
typedef float f32x4 __attribute__((ext_vector_type(4)));
typedef unsigned u32x4 __attribute__((ext_vector_type(4)));
constexpr int BM = 256, BK = 64, HALF = 128, HTB = HALF * BK * 2  , STAGE_BYTES = 8 * HTB, NXCD = 8, WGM = 8;

__host__ __device__ __forceinline__ int lds_byte(int r, int c) { const int st = (r >> 4) * 2 + (c >> 5), rr = r & 15, cc = c & 31, ob = rr * 64 + cc * 2; return st * 1024 + (ob ^ (((ob >> 9) & 1) << 5)); }
__host__ __device__ __forceinline__ void stage_rc(int b, int& R, int& C) { const int st = b / 1024, sb = b % 1024, swz = sb ^ (((sb >> 9) & 1) << 5); R = (st >> 1) * 16 + swz / 64; C = (st & 1) * 32 + (swz % 64) / 2; }
__host__ __device__ __forceinline__ int perm32(int rho) { const int n = rho >> 4, i = rho & 15; return 8 * (i >> 2) + 4 * n + (i & 3); }

struct Unit { int pm, pn; };
struct Gemm { const bf16_t* A; const bf16_t* Bt; int M, N, K; };

struct StaticOrder {
    int nM, nN, nwg, G, c;
    __host__ __device__ void init(int M, int N, int G_, int c_) { nM = M / BM; nN = N / BM; nwg = nM * nN; G = G_; c = c_; }
    __host__ __device__ bool next(int i, Unit& u) const {
        const long L = (long)i * G + c; if (L >= nwg) return false;
        int wgid = (int)L; { const int q = nwg / NXCD, r = nwg % NXCD, xcd = wgid % NXCD, off = wgid / NXCD; wgid = (xcd < r ? xcd * (q + 1) : r * (q + 1) + (xcd - r) * q) + off; }
        const int nig = WGM * nN, gid = wgid / nig, fm = gid * WGM, gsz = (nM - fm) < WGM ? (nM - fm) : WGM;
        u.pm = fm + ((wgid % nig) % gsz); u.pn = (wgid % nig) / gsz; return true;
    }
    __device__ __forceinline__ void a_ready(const Unit&) const {}
    __device__ __forceinline__ void done(const Unit&) const {}
};

__device__ __forceinline__ unsigned cvt_pk_bf16(float lo, float hi) { unsigned r; asm volatile("v_cvt_pk_bf16_f32 %0, %1, %2" : "=v"(r) : "v"(lo), "v"(hi)); return r; }
template <int ACT> struct EpiBf16 {
    static constexpr bool PERM = true, AFTER_DRAIN = false;
    bf16_t* O; int ldc; bf16_t* halo;
    __device__ __forceinline__ void operator()(const f32x4 (&acc)[2][2][4][2], const Unit& u, int wr, int wc, int fr, int fq) const {
        const int row0 = u.pm * BM + wr * 64 + fr; const int col0 = u.pn * BM + wc * 32 + 8 * fq;
        const bool dohalo = (halo != nullptr) && (fr >= 13) && (u.pn < 12);
#pragma unroll
        for (int ai = 0; ai < 2; ++ai)
#pragma unroll
            for (int m = 0; m < 4; ++m) { bf16_t* rowp = O + (size_t)(row0 + ai * HALF + m * 16) * ldc + col0;
#pragma unroll
                for (int bj = 0; bj < 2; ++bj) { f32x4 v0 = acc[ai][bj][m][0], v1 = acc[ai][bj][m][1];
                    if (ACT == 2) {
#pragma unroll
                        for (int j = 0; j < 4; ++j) { const float a = fmaxf(v0[j], 0.f), b = fmaxf(v1[j], 0.f); v0[j] = a * a; v1[j] = b * b; } }
                    u32x4 w; w.x = cvt_pk_bf16(v0[0], v0[1]); w.y = cvt_pk_bf16(v0[2], v0[3]); w.z = cvt_pk_bf16(v1[0], v1[1]); w.w = cvt_pk_bf16(v1[2], v1[3]);
                    *(u32x4*)(rowp + bj * HALF) = w;
                    if (m == 3 && dohalo) *(u32x4*)(halo + ((size_t)((row0 + ai * HALF + 48) >> 6) * 3 + (fr - 13)) * 3072 + col0 + bj * HALF) = w; } }
    }
};

struct EpiBlk {
    static constexpr bool PERM = true, AFTER_DRAIN = false;
    bf16_t* O; bf16_t* halo; int LAYOUT;
    __device__ __forceinline__ void operator()(const f32x4 (&acc)[2][2][4][2], const Unit& u, int wr, int wc, int fr, int fq) const {
        constexpr int TT = 8192; constexpr size_t MTOT = 65536;
        const int row0 = u.pm * BM + wr * 64 + fr; const int b = row0 >> 13, t0 = row0 & (TT - 1);
        const int col0 = u.pn * BM + wc * 32 + 8 * fq;
        const bool dohalo = (LAYOUT == 2) && (halo != nullptr) && (fr >= 13) && (u.pn < 12);
#pragma unroll
        for (int bj = 0; bj < 2; ++bj) {
            const int cb = u.pn * BM + bj * HALF + wc * 32;
            size_t base; int w;
            if (LAYOUT == 2) { const int c0 = cb & ~1023, h = (cb >> 7) & 7; w = 128; base = MTOT * c0 + (size_t)((b * 8 + h) * TT) * 128 + (cb & 127) + 8 * fq; }
            else if (cb < 512) { const int c0 = cb & ~255, h = (cb >> 6) & 3; w = 64; base = MTOT * c0 + (size_t)((b * 4 + h) * TT) * 64 + (cb & 63) + 8 * fq; }
            else { const int c0 = 512 + ((cb - 512) & ~511), h = ((cb - 512) >> 7) & 3; w = 128; base = MTOT * c0 + (size_t)((b * 4 + h) * TT) * 128 + (cb & 127) + 8 * fq; }
#pragma unroll
            for (int ai = 0; ai < 2; ++ai)
#pragma unroll
                for (int m = 0; m < 4; ++m) { const int t = t0 + ai * HALF + m * 16;
                    const f32x4 v0 = acc[ai][bj][m][0], v1 = acc[ai][bj][m][1];
                    u32x4 ww; ww.x = cvt_pk_bf16(v0[0], v0[1]); ww.y = cvt_pk_bf16(v0[2], v0[3]); ww.z = cvt_pk_bf16(v1[0], v1[1]); ww.w = cvt_pk_bf16(v1[2], v1[3]);
                    *(u32x4*)(O + base + (size_t)t * w) = ww;
                    if (m == 3 && dohalo) *(u32x4*)(halo + ((size_t)((row0 + ai * HALF + 48) >> 6) * 3 + (fr - 13)) * 3072 + col0 + bj * HALF) = ww; }
        }
    }
};
struct EpiResid {
    static constexpr bool PERM = false, AFTER_DRAIN = false;
    const float* base; float* out; int ldc;
    __device__ __forceinline__ void operator()(const f32x4 (&acc)[2][2][4][2], const Unit& u, int wr, int wc, int fr, int fq) const {
        const int row0 = u.pm * BM + wr * 64 + fr, col0 = u.pn * BM + wc * 32 + 4 * fq;
#pragma unroll
        for (int ai = 0; ai < 2; ++ai)
#pragma unroll
            for (int m = 0; m < 4; ++m) { const size_t off = (size_t)(row0 + ai * HALF + m * 16) * ldc + col0;
#pragma unroll
                for (int bj = 0; bj < 2; ++bj)
#pragma unroll
                    for (int n = 0; n < 2; ++n) { const f32x4 bs = *(const f32x4*)(base + off + bj * HALF + n * 16); *(f32x4*)(out + off + bj * HALF + n * 16) = bs + acc[ai][bj][m][n]; }
                if (m & 1) asm volatile("" ::: "memory"); }
    }
};
template <class Epi, class Sched, bool ALIGN_EPI = false, bool SP2 = false>
__device__ __forceinline__ void gemm_phase(PG8_LAS unsigned char* lds, const Gemm g, const Sched& S, const Epi& E, int tid_in) {
    int tid_ = tid_in; asm volatile("" : "+v"(tid_)); const int tid = tid_, wid = __builtin_amdgcn_readfirstlane(tid >> 6), lane = tid & 63, wr = wid >> 2, wc = wid & 3, fr = lane & 15, fq = lane >> 4;
    const int K = g.K, nt = K / BK;
    unsigned voffA[2], voffB[2];
#pragma unroll
    for (int i = 0; i < 2; ++i) { int R, C; stage_rc(tid * 16 + i * 8192, R, C); const int Rb = Epi::PERM ? ((R & ~31) + perm32(R & 31)) : R;
        voffA[i] = (unsigned)(R * K + C) * 2u; voffB[i] = (unsigned)(Rb * K + C) * 2u; }
    const size_t kstep = (size_t)(BK * 2);
    const size_t hstep = (size_t)HALF * K * 2;
    const size_t tstep = 2 * hstep;
    const unsigned ldsw = (unsigned)wid * 1024u;
    const int aoff = lds_byte(wr * 64 + fr, fq * 8), boff = lds_byte(wc * 32 + fr, fq * 8);
#define PG8_SA(b, h) (((b) * 2 + (h)) * HTB)
#define PG8_SB(b, h) ((4 + (b) * 2 + (h)) * HTB)
#define PG8_STAGE(bufoff, gbase, voff) do { _Pragma("unroll") for (int _i = 0; _i < 2; ++_i) \
        __builtin_amdgcn_global_load_lds((const unsigned*)((const char*)(gbase) + (voff)[_i]), (PG8_LAS unsigned*)(lds + (bufoff) + ldsw + _i * 8192), 16, 0, 0); } while (0)
#define PG8_LDA(dst, b, h) do { _Pragma("unroll") for (int m = 0; m < 4; ++m) _Pragma("unroll") for (int k = 0; k < 2; ++k) dst[m][k] = *(const PG8_LAS bf16x8*)(lds + PG8_SA(b, h) + aoff + m * 2048 + k * 1024); } while (0)
#define PG8_LDB(dst, b, h) do { _Pragma("unroll") for (int n = 0; n < 2; ++n) _Pragma("unroll") for (int k = 0; k < 2; ++k) dst[n][k] = *(const PG8_LAS bf16x8*)(lds + PG8_SB(b, h) + boff + n * 2048 + k * 1024); } while (0)
#define PG8_MMA(ai, bj, At, Bt) do { __builtin_amdgcn_s_setprio(1); _Pragma("unroll") for (int m = 0; m < 4; ++m) _Pragma("unroll") for (int n = 0; n < 2; ++n) _Pragma("unroll") for (int k = 0; k < 2; ++k) \
        acc[ai][bj][m][n] = __builtin_amdgcn_mfma_f32_16x16x32_bf16(Bt[n][k], At[m][k], acc[ai][bj][m][n], 0, 0, 0); __builtin_amdgcn_s_setprio(0); } while (0)
#define PG8_WAIT_V(n) asm volatile("s_waitcnt vmcnt(" #n ")" ::: "memory")
#define PG8_WAIT_L(n) asm volatile("s_waitcnt lgkmcnt(" #n ")" ::: "memory")
#define PG8_BAR __builtin_amdgcn_s_barrier()
#define PG8_SCHED __builtin_amdgcn_sched_barrier(0)
    Unit cur, nxt; int ui = 0;
    if (!S.next(0, cur)) return;
    f32x4 acc[2][2][4][2];
#pragma unroll
    for (int a = 0; a < 2; ++a)
#pragma unroll
        for (int b = 0; b < 2; ++b)
#pragma unroll
            for (int m = 0; m < 4; ++m)
#pragma unroll
                for (int n = 0; n < 2; ++n) acc[a][b][m][n] = (f32x4){0.f, 0.f, 0.f, 0.f};
    bf16x8 At[4][2], B0[2][2], B1[2][2];
    const char* cA = (const char*)g.A + (size_t)cur.pm * tstep; const char* cB = (const char*)g.Bt + (size_t)cur.pn * tstep;
    S.a_ready(cur);
    if constexpr (SP2) {
        PG8_STAGE(PG8_SB(0, 0), cB, voffB); PG8_STAGE(PG8_SB(0, 1), cB + hstep, voffB); PG8_STAGE(PG8_SA(0, 0), cA, voffA); PG8_STAGE(PG8_SA(0, 1), cA + hstep, voffA);
        if (wr == 1) PG8_BAR;
        PG8_WAIT_V(2); PG8_BAR;
        PG8_STAGE(PG8_SB(1, 0), cB + kstep, voffB); PG8_STAGE(PG8_SA(1, 0), cA + kstep, voffA); PG8_STAGE(PG8_SB(1, 1), cB + hstep + kstep, voffB);
        PG8_WAIT_V(6); PG8_BAR;
    } else {
        PG8_STAGE(PG8_SB(0, 0), cB, voffB); PG8_STAGE(PG8_SA(0, 0), cA, voffA); PG8_STAGE(PG8_SB(0, 1), cB + hstep, voffB); PG8_STAGE(PG8_SA(0, 1), cA + hstep, voffA);
        if (wr == 1) PG8_BAR;
        PG8_WAIT_V(4); PG8_BAR;
        PG8_STAGE(PG8_SB(1, 0), cB + kstep, voffB); PG8_STAGE(PG8_SA(1, 0), cA + kstep, voffA); PG8_STAGE(PG8_SB(1, 1), cB + hstep + kstep, voffB);
        PG8_WAIT_V(6); PG8_BAR;
    }
    for (;;) {
        const bool has_next = S.next(ui + 1, nxt);
        const char* nA = has_next ? (const char*)g.A + (size_t)nxt.pm * tstep : cA; const char* nB = has_next ? (const char*)g.Bt + (size_t)nxt.pn * tstep : cB;
        for (int t = 0; t < nt; t += 2) {
            const bool last = (t == nt - 2);
            const char* a1 = cA + (size_t)(t + 1) * kstep;
            const char* a2 = last ? nA : cA + (size_t)(t + 2) * kstep; const char* b2 = last ? nB : cB + (size_t)(t + 2) * kstep;
            const char* a3 = a2 + kstep; const char* b3 = b2 + kstep;
            if (last && has_next) S.a_ready(nxt);
            if constexpr (SP2) {
            PG8_LDB(B0, 0, 0); PG8_LDB(B1, 0, 1); PG8_SCHED; PG8_LDA(At, 0, 0); PG8_STAGE(PG8_SA(1, 1), a1 + hstep, voffA);
            PG8_WAIT_V(8); PG8_WAIT_L(0); PG8_BAR; PG8_MMA(0, 0, At, B0); PG8_MMA(0, 1, At, B1); PG8_BAR; PG8_SCHED;
            PG8_LDA(At, 0, 1); PG8_STAGE(PG8_SB(0, 0), b2, voffB); PG8_STAGE(PG8_SB(0, 1), b2 + hstep, voffB); PG8_STAGE(PG8_SA(0, 0), a2, voffA);
            PG8_WAIT_V(8); PG8_WAIT_L(0); PG8_BAR; PG8_MMA(1, 0, At, B0); PG8_MMA(1, 1, At, B1); PG8_BAR; PG8_SCHED;
            PG8_LDB(B0, 1, 0); PG8_LDB(B1, 1, 1); PG8_SCHED; PG8_LDA(At, 1, 0); PG8_STAGE(PG8_SA(0, 1), a2 + hstep, voffA);
            PG8_WAIT_V(8); PG8_WAIT_L(0); PG8_BAR; PG8_MMA(0, 0, At, B0); PG8_MMA(0, 1, At, B1); PG8_BAR; PG8_SCHED;
            PG8_LDA(At, 1, 1); PG8_STAGE(PG8_SB(1, 0), b3, voffB); PG8_STAGE(PG8_SB(1, 1), b3 + hstep, voffB); PG8_STAGE(PG8_SA(1, 0), a3, voffA);
            PG8_WAIT_V(8); PG8_WAIT_L(0); PG8_BAR; PG8_MMA(1, 0, At, B0); PG8_MMA(1, 1, At, B1); PG8_BAR; PG8_SCHED;
            } else {
            PG8_LDB(B0, 0, 0); PG8_SCHED; PG8_LDA(At, 0, 0); PG8_STAGE(PG8_SA(1, 1), a1 + hstep, voffA);
            PG8_WAIT_L(8); PG8_BAR; PG8_WAIT_L(0); PG8_MMA(0, 0, At, B0); PG8_BAR; PG8_SCHED;
            PG8_LDB(B1, 0, 1); PG8_STAGE(PG8_SB(0, 0), b2, voffB);
            PG8_BAR; PG8_WAIT_L(0); PG8_MMA(0, 1, At, B1); PG8_BAR;
            PG8_LDA(At, 0, 1); PG8_STAGE(PG8_SA(0, 0), a2, voffA);
            PG8_BAR; PG8_WAIT_L(0); PG8_MMA(1, 0, At, B0); PG8_BAR; PG8_SCHED;
            PG8_STAGE(PG8_SB(0, 1), b2 + hstep, voffB);
            PG8_WAIT_V(6); PG8_BAR; PG8_MMA(1, 1, At, B1); PG8_BAR;
            PG8_LDB(B0, 1, 0); PG8_SCHED; PG8_LDA(At, 1, 0); PG8_STAGE(PG8_SA(0, 1), a2 + hstep, voffA);
            PG8_WAIT_L(8); PG8_BAR; PG8_WAIT_L(0); PG8_MMA(0, 0, At, B0); PG8_BAR; PG8_SCHED;
            PG8_LDB(B1, 1, 1); PG8_STAGE(PG8_SB(1, 0), b3, voffB);
            PG8_BAR; PG8_WAIT_L(0); PG8_MMA(0, 1, At, B1); PG8_BAR;
            PG8_LDA(At, 1, 1); PG8_STAGE(PG8_SA(1, 0), a3, voffA);
            PG8_BAR; PG8_WAIT_L(0); PG8_MMA(1, 0, At, B0); PG8_BAR; PG8_SCHED;
            PG8_STAGE(PG8_SB(1, 1), b3 + hstep, voffB);
            PG8_WAIT_V(6); PG8_BAR; PG8_MMA(1, 1, At, B1); PG8_BAR;
            }
        }
        if constexpr (ALIGN_EPI) { if (wr == 0) PG8_BAR; }
        if constexpr (!Epi::AFTER_DRAIN) { E(acc, cur, wr, wc, fr, fq); S.done(cur); }
        if (!has_next) break;
#pragma unroll
        for (int a = 0; a < 2; ++a)
#pragma unroll
            for (int b = 0; b < 2; ++b)
#pragma unroll
                for (int m = 0; m < 4; ++m)
#pragma unroll
                    for (int n = 0; n < 2; ++n) acc[a][b][m][n] = (f32x4){0.f, 0.f, 0.f, 0.f};
        cur = nxt; cA = nA; cB = nB; ++ui;
        if constexpr (ALIGN_EPI) { if (wr == 1) PG8_BAR; }
    }
    PG8_WAIT_V(0);
    if constexpr (!ALIGN_EPI) { if (wr == 0) PG8_BAR; }
    PG8_BAR;
    if constexpr (Epi::AFTER_DRAIN) { E.fused(acc, cur, wr, wc, fr, fq, lds, wid, lane); S.done(cur); }
#undef PG8_SA
#undef PG8_SB
#undef PG8_STAGE
#undef PG8_LDA
#undef PG8_LDB
#undef PG8_MMA
#undef PG8_WAIT_V
#undef PG8_WAIT_L
#undef PG8_BAR
#undef PG8_SCHED
}
}
#ifndef PG8_SP2
#define PG8_SP2 true
#endif
#ifndef PG8_ALIGN
#define PG8_ALIGN true
#endif
constexpr int NWAVES = 8, NTHR = 512;
constexpr int BATCH = 8, T = 8192, D = 1024, DEPTH = 4, MEMLEN = 256, FF = 4096;
constexpr int M = BATCH * T;
constexpr int AB_IN = 3080, AB_N = 3072, C_IN = 4112, C_N = 4096;
constexpr float EPS = 1e-6f;
constexpr float SB_THR = 88.0f;

constexpr size_t MiB = 1u << 20;
constexpr size_t WS_CTL = 0, CTL_ZERO_BYTES = 1 * MiB;
constexpr size_t WS_WG = 1 * MiB;
constexpr size_t WS_MEMN = 2 * MiB;
constexpr size_t WS_WKV = 6 * MiB;
constexpr size_t WS_W = 22 * MiB, W_LAYER = 30 * MiB;
constexpr size_t WO_WIN = 0, WO_WOUT = 8 * MiB, WO_WQ = 10 * MiB, WO_WO = 12 * MiB, WO_W1 = 14 * MiB, WO_W2 = 22 * MiB;
constexpr size_t WS_KVX = 142 * MiB;
constexpr size_t WS_GATE = 174 * MiB;
constexpr size_t WS_H = 178 * MiB;
constexpr size_t WS_MIX = 306 * MiB;
constexpr size_t WS_BIG = 434 * MiB;
constexpr size_t WS_END = 946 * MiB;
constexpr int CW_TMO = 0, CW_BAR = 4096;

constexpr int LDS_BYTES = 147456;
constexpr int MISC_OFF = 140 * 1024;

#define GAS __attribute__((address_space(1)))
#define LAS __attribute__((address_space(3)))
#define DI __device__ __forceinline__
typedef unsigned short bf16;
typedef unsigned v4u __attribute__((ext_vector_type(4)));
typedef unsigned v2u __attribute__((ext_vector_type(2)));
typedef float f32x4 __attribute__((ext_vector_type(4)));
typedef short bf16x8 __attribute__((ext_vector_type(8)));
typedef short s16x4 __attribute__((ext_vector_type(4)));
#define LDS_WAIT() asm volatile("s_waitcnt lgkmcnt(0)" ::: "memory")
typedef float f32x2_ __attribute__((ext_vector_type(2)));
typedef __bf16 bf16x2_ __attribute__((ext_vector_type(2)));
DI unsigned pk2(float lo, float hi) { const f32x2_ v = {lo, hi}; return __builtin_bit_cast(unsigned, __builtin_convertvector(v, bf16x2_)); }
DI unsigned f2bf(float f) { return pk2(f, f) & 0xffffu; }
DI float bf2f(unsigned short b) { return __builtin_bit_cast(float, ((unsigned)b) << 16); }
DI float bflo(unsigned u) { return __builtin_bit_cast(float, u << 16); }
DI float bfhi(unsigned u) { return __builtin_bit_cast(float, u & 0xffff0000u); }
DI float wave_sum(float v) {
#pragma unroll
    for (int o = 1; o < 64; o <<= 1) v += __shfl_xor(v, o);
    return v;
}
DI float rcp_(float x) { return __builtin_amdgcn_rcpf(x); }
DI float rsq_(float x) { return __builtin_amdgcn_rsqf(x); }
DI float sigmoidf_(float x) { return rcp_(1.0f + __expf(-x)); }
DI void lds_barrier() { asm volatile("s_waitcnt lgkmcnt(0)" ::: "memory"); __builtin_amdgcn_s_barrier(); asm volatile("" ::: "memory"); }
#ifndef PROBE_STG
#define PROBE_STG -1
#endif
#define STG_T0() unsigned long long stg_t_ = (PROBE_STG >= 0) ? __builtin_amdgcn_s_memrealtime() : 0ull
#define STG(n) do { if (PROBE_STG >= 0) { const unsigned long long t_ = __builtin_amdgcn_s_memrealtime(); if (PROBE_STG == (n)) F.tacc += t_ - stg_t_; stg_t_ = t_; } } while (0)
DI f32x4 mfma16(bf16x8 a, bf16x8 b, f32x4 c) { return __builtin_amdgcn_mfma_f32_16x16x32_bf16(a, b, c, 0, 0, 0); }
#define XB_TMO      128
#define XB_XCNT(j)  (256  + 64 * (j))
#define XB_XSUB(j)  (1280 + 64 * (j))
#define XB_XGEN(j)  (2304 + 64 * (j))
#define XB_TOP      3328
#define XB_TOPGEN   3392
#define XCD_BAR_WORDS 3456
#define XB_SPIN_CAP (1u << 22)

__device__ __forceinline__ unsigned xb_ld(unsigned* p)              { return __hip_atomic_load(p, __ATOMIC_RELAXED, __HIP_MEMORY_SCOPE_AGENT); }
__device__ __forceinline__ unsigned xb_add(unsigned* p, unsigned v) { return __hip_atomic_fetch_add(p, v, __ATOMIC_RELAXED, __HIP_MEMORY_SCOPE_AGENT); }
__device__ __forceinline__ unsigned xb_xcc_id() { return (unsigned)__builtin_amdgcn_s_getreg((3 << 11) | 20) & 0xFu; }
#define XB_SPIN(cond, bar) do { unsigned _sp = 0; while (cond) { __builtin_amdgcn_s_sleep(1); \
    if ((++_sp & 255u) == 0u) { if (xb_ld(&(bar)[XB_TMO])) break; if (_sp > XB_SPIN_CAP) { atomicAdd(&(bar)[XB_TMO], 1u); break; } } } } while (0)

struct XcdBarrier {
    unsigned* bar; unsigned x;
    volatile LAS unsigned* st;
};

__device__ __forceinline__ XcdBarrier xcd_barrier_post(unsigned* bar, volatile LAS unsigned* st) {
    XcdBarrier b; b.bar = bar; b.x = xb_xcc_id(); b.st = st;
    if (threadIdx.x == 0) (void)xb_add(&bar[XB_XCNT(b.x)], 1u);
    return b;
}
__device__ __forceinline__ void xcd_barrier_complete(unsigned* bar, unsigned x, unsigned& nloc, unsigned& nx) {
    const unsigned G = gridDim.x * gridDim.y * gridDim.z;
    unsigned sum, cnt, mine, sp = 0u;
    for (;;) {
        sum = 0u; cnt = 0u; mine = 0u;
#pragma unroll
        for (unsigned j = 0; j < 16; ++j) { const unsigned c = xb_ld(&bar[XB_XCNT(j)]); sum += c; cnt += (c > 0u) ? 1u : 0u; mine = (j == x) ? c : mine; }
        if (sum == G) break;
        __builtin_amdgcn_s_sleep(1);
        if ((++sp & 255u) == 0u) { if (xb_ld(&bar[XB_TMO])) break; if (sp > XB_SPIN_CAP) { atomicAdd(&bar[XB_TMO], 1u); break; } }
    }
    nloc = mine > 0u ? mine : 1u; nx = cnt > 0u ? cnt : 1u;
}

__device__ __forceinline__ void xcd_barrier(const XcdBarrier& b) {
    asm volatile("s_waitcnt vmcnt(0)" ::: "memory");
    __syncthreads();
    if (threadIdx.x == 0) {
        unsigned* bar = b.bar;
        __builtin_amdgcn_s_waitcnt(0);
        unsigned nloc = b.st[0], nx = b.st[1];
        if (nloc == 0u) { xcd_barrier_complete(bar, b.x, nloc, nx); b.st[0] = nloc; b.st[1] = nx; }
        const unsigned old = xb_add(&bar[XB_XSUB(b.x)], 1u);
        const unsigned gen = old / nloc;
        if (old + 1u == (gen + 1u) * nloc) {
            __builtin_amdgcn_fence(__ATOMIC_RELEASE, "agent");
            asm volatile("s_waitcnt vmcnt(0)" ::: "memory");
            const unsigned og = xb_add(&bar[XB_TOP], 1u);
            const unsigned tg = og / nx;
            if (og + 1u == (tg + 1u) * nx) xb_add(&bar[XB_TOPGEN], 1u);
            else XB_SPIN(xb_ld(&bar[XB_TOPGEN]) == tg, bar);
            __builtin_amdgcn_fence(__ATOMIC_ACQUIRE, "agent");
            xb_add(&bar[XB_XGEN(b.x)], 1u);
            asm volatile("s_waitcnt vmcnt(0)" ::: "memory");
        } else {
            XB_SPIN(xb_ld(&bar[XB_XGEN(b.x)]) == gen, bar);
            __builtin_amdgcn_fence(__ATOMIC_ACQUIRE, "agent");
            asm volatile("s_waitcnt vmcnt(0)" ::: "memory");
        }
    }
    __syncthreads();
}
struct Frame {
    LAS unsigned char* lds;
    int tid, lane, wave;
    int G, wg, gw, NGW;
    unsigned long long tacc;
};

DI void transpose_item(const float* W, int ldsrc, int coloff, bf16* WT, int K, int row_off, int nblk, LAS float* scr, int item, int lane) {
    const int kb = item / nblk, nb = item % nblk, k0 = 64 * kb, n0 = 32 * nb;
#pragma unroll 8
    for (int i = 0; i < 32; ++i) { const int kk = 2 * i + (lane >> 5); scr[kk * 33 + (lane & 31)] = W[(size_t)(k0 + kk) * ldsrc + coloff + n0 + (lane & 31)]; }
    LDS_WAIT(); asm volatile("" ::: "memory");
    const int c = lane & 7;
#pragma unroll
    for (int j = 0; j < 4; ++j) { const int n = (lane >> 3) + 8 * j; const LAS float* s = scr + (8 * c) * 33 + n;
        v4u o; o.x = pk2(s[0 * 33], s[1 * 33]); o.y = pk2(s[2 * 33], s[3 * 33]); o.z = pk2(s[4 * 33], s[5 * 33]); o.w = pk2(s[6 * 33], s[7 * 33]);
        *(GAS v4u*)(WT + (size_t)(row_off + n0 + n) * K + k0 + 8 * c) = o; }
    LDS_WAIT(); asm volatile("" ::: "memory");
}
DI void transpose_matrix(Frame& F, const float* W, int ldsrc, int coloff, int ncols, int K, bf16* WT, int row_off, unsigned& base) {
    LAS float* scr = (LAS float*)(F.lds + F.wave * 16384);
    const int nblk = ncols / 32, nitems = (K / 64) * nblk;
    int it = (int)(((unsigned)F.gw + (unsigned)F.NGW - (base % (unsigned)F.NGW)) % (unsigned)F.NGW);
    for (; it < nitems; it += F.NGW) transpose_item(W, ldsrc, coloff, WT, K, row_off, nblk, scr, it, F.lane);
    base += (unsigned)nitems;
}
DI void rms_row(const float* xrow, const f32x4 (&g4)[4], f32x4 (&v)[4], int lane) {
    const GAS f32x4* xr = (const GAS f32x4*)xrow + lane; float s = 0.f;
#pragma unroll
    for (int j = 0; j < 4; ++j) { v[j] = xr[64 * j]; s += (v[j].x * v[j].x + v[j].y * v[j].y) + (v[j].z * v[j].z + v[j].w * v[j].w); }
    const float rstd = rsq_(wave_sum(s) * (1.f / 1024.f) + EPS);
#pragma unroll
    for (int j = 0; j < 4; ++j) v[j] = v[j] * rstd * g4[j];
}
DI void store_row_bf16(bf16* orow, const f32x4 (&v)[4], int lane) {
    GAS unsigned long long* o8 = (GAS unsigned long long*)orow + lane;
#pragma unroll
    for (int j = 0; j < 4; ++j) o8[64 * j] = (unsigned long long)pk2(v[j].x, v[j].y) | ((unsigned long long)pk2(v[j].z, v[j].w) << 32);
}
struct In { const float* p[24]; };
DI void p0_prologue(Frame& F, const In& I, unsigned char* ws) {
    unsigned base = 0;
    for (int l = 0; l < DEPTH; ++l) {
        const int j = l >> 1; unsigned char* wl = ws + WS_W + (size_t)l * W_LAYER;
        if ((l & 1) == 0) {
            transpose_matrix(F, I.p[3] + (size_t)j * D * AB_IN, AB_IN, 0, 1536, D, (bf16*)(wl + WO_WIN), 0, base);
            transpose_matrix(F, I.p[3] + (size_t)j * D * AB_IN, AB_IN, 1544, 1536, D, (bf16*)(wl + WO_WIN), 1536, base);
            transpose_matrix(F, I.p[7] + (size_t)j * D * D, D, 0, D, D, (bf16*)(wl + WO_WOUT), 0, base);
        } else {
            transpose_matrix(F, I.p[8] + (size_t)j * D * C_IN, C_IN, 0, 4096, D, (bf16*)(wl + WO_WIN), 0, base);
            transpose_matrix(F, I.p[13] + (size_t)j * D * D, D, 0, D, D, (bf16*)(wl + WO_WOUT), 0, base);
        }
        transpose_matrix(F, I.p[16] + (size_t)l * D * D, D, 0, D, D, (bf16*)(wl + WO_WQ), 0, base);
        transpose_matrix(F, I.p[19] + (size_t)l * D * D, D, 0, D, D, (bf16*)(wl + WO_WO), 0, base);
        transpose_matrix(F, I.p[17] + (size_t)l * D * D, D, 0, D, D, (bf16*)(ws + WS_WKV), 2048 * l, base);
        transpose_matrix(F, I.p[18] + (size_t)l * D * D, D, 0, D, D, (bf16*)(ws + WS_WKV), 2048 * l + 1024, base);
        transpose_matrix(F, I.p[21] + (size_t)l * D * FF, FF, 0, FF, D, (bf16*)(wl + WO_W1), 0, base);
        transpose_matrix(F, I.p[22] + (size_t)l * FF * D, D, 0, D, FF, (bf16*)(wl + WO_W2), 0, base);
    }
    float* Wg = (float*)(ws + WS_WG);
    for (int idx = F.wg * NTHR + F.tid; idx < DEPTH * 16 * 1024; idx += F.G * NTHR) {
        const int l = idx >> 14, g = (idx >> 10) & 15, k = idx & 1023, j = l >> 1; float v = 0.f;
        if ((l & 1) == 0) { if (g < 8) v = I.p[3][(size_t)j * D * AB_IN + (size_t)k * AB_IN + 1536 + g]; }
        else v = I.p[8][(size_t)j * D * C_IN + (size_t)k * C_IN + 4096 + g];
        Wg[idx] = v;
    }
    { f32x4 g4[4];
#pragma unroll
      for (int j = 0; j < 4; ++j) g4[j] = ((const GAS f32x4*)I.p[15])[F.lane + 64 * j];
      for (int r = F.gw; r < BATCH * MEMLEN; r += F.NGW) { f32x4 v[4]; rms_row(I.p[1] + (size_t)r * D, g4, v, F.lane); store_row_bf16((bf16*)(ws + WS_MEMN) + (size_t)r * D, v, F.lane); } }
}
template <int MODE> DI void norm_phase(Frame& F, const float* xin, const float* gain, bf16* hout, const float* Wg, float* gate, const float* p0, const float* p1) {
    f32x4 g4[4];
#pragma unroll
    for (int j = 0; j < 4; ++j) g4[j] = ((const GAS f32x4*)gain)[F.lane + 64 * j];
    constexpr int NG = MODE == 1 ? 8 : (MODE == 2 ? 16 : 0);
    float par = 0.f;
    if (MODE == 1) { if (F.lane < 4) par = p0[F.lane]; else if (F.lane < 8) par = p1[F.lane - 4]; }
    float par2 = 0.f;
    if (MODE == 2) { if (F.lane >= 8 && F.lane < 16) { par = p0[F.lane - 8]; par2 = p1[F.lane - 8]; } }
    for (int r = F.gw; r < M; r += F.NGW) {
        f32x4 v[4]; rms_row(xin + (size_t)r * D, g4, v, F.lane); store_row_bf16(hout + (size_t)r * D, v, F.lane);
        if (MODE != 0) {
            float keep = 0.f;
#pragma unroll
            for (int g = 0; g < NG; ++g) {
                const GAS f32x4* wr = (const GAS f32x4*)(Wg + g * 1024) + F.lane; float p = 0.f;
#pragma unroll
                for (int j = 0; j < 4; ++j) { const f32x4 w = wr[64 * j]; p += (v[j].x * w.x + v[j].y * w.y) + (v[j].z * w.z + v[j].w * w.w); }
                p = wave_sum(p); if (F.lane == g) keep = p;
            }
            if (MODE == 1 && F.lane < 8) {
                const float a = keep + par; float o;
                if (F.lane < 4) o = 15.0f * tanhf(a * (1.0f / 15.0f));
                else o = fminf(a, 0.f) - log1pf(expf(-fabsf(a)));
                gate[(size_t)r * 16 + F.lane] = o;
            }
            if (MODE == 2 && F.lane < 16) {
                float o;
                if (F.lane < 8) o = 1.0f / (1.0f + expf(-keep));
                else { const float z = keep + par2; const float sp = fmaxf(z, 0.f) + log1pf(expf(-fabsf(z))); o = -expf(par) * sp; }
                gate[(size_t)r * 16 + F.lane] = o;
            }
        }
    }
}
DI void final_norm_phase(Frame& F, float* x, const float* gain) {
    f32x4 g4[4];
#pragma unroll
    for (int j = 0; j < 4; ++j) g4[j] = ((const GAS f32x4*)gain)[F.lane + 64 * j];
    for (int r = F.gw; r < M; r += F.NGW) { f32x4 v[4]; rms_row(x + (size_t)r * D, g4, v, F.lane); GAS f32x4* o = (GAS f32x4*)(x + (size_t)r * D) + F.lane;
#pragma unroll
        for (int j = 0; j < 4; ++j) o[64 * j] = v[j]; }
}
template <bool ODD> DI void headnorm_phase(Frame& F, const bf16* src, bf16* mix, const bf16* proj, const float* hg) {
    constexpr int NC = ODD ? 16 : 8;
    for (int r = F.gw; r < M; r += F.NGW) {
        const int c0 = NC * F.lane;
        float x[NC], gt[NC];
#pragma unroll
        for (int q = 0; q < NC / 8; ++q) {
            const size_t hoff = ((size_t)((r >> 13) * 8 + ((c0 + 8 * q) >> 7)) * T + (r & (T - 1))) * 128 + ((c0 + 8 * q) & 127);
            const v4u raw = ODD ? *(const GAS v4u*)(src + hoff) : *(const GAS v4u*)(src + (size_t)r * D + c0 + 8 * q);
            const v4u gr = ODD ? *(const GAS v4u*)(proj + (size_t)M * 3072 + hoff) : *(const GAS v4u*)(proj + (size_t)r * AB_N + 1024 + c0 + 8 * q);
            x[8 * q + 0] = bflo(raw.x); x[8 * q + 1] = bfhi(raw.x); x[8 * q + 2] = bflo(raw.y); x[8 * q + 3] = bfhi(raw.y); x[8 * q + 4] = bflo(raw.z); x[8 * q + 5] = bfhi(raw.z); x[8 * q + 6] = bflo(raw.w); x[8 * q + 7] = bfhi(raw.w);
            gt[8 * q + 0] = bflo(gr.x); gt[8 * q + 1] = bfhi(gr.x); gt[8 * q + 2] = bflo(gr.y); gt[8 * q + 3] = bfhi(gr.y); gt[8 * q + 4] = bflo(gr.z); gt[8 * q + 5] = bfhi(gr.z); gt[8 * q + 6] = bflo(gr.w); gt[8 * q + 7] = bfhi(gr.w);
        }
        float ss = 0.f;
#pragma unroll
        for (int i = 0; i < NC; ++i) ss += x[i] * x[i];
        ss += __shfl_xor(ss, 1); ss += __shfl_xor(ss, 2); ss += __shfl_xor(ss, 4); if (!ODD) ss += __shfl_xor(ss, 8);
        const float rstd = rsq_(ss * (1.f / 128.f) + EPS);
#pragma unroll
        for (int i = 0; i < NC; ++i) { const float g = ODD ? hg[(c0 + i) & 127] : hg[c0 + i]; const float s = sigmoidf_(gt[i]); x[i] = x[i] * rstd * g * (ODD ? gt[i] * s : s); }
#pragma unroll
        for (int q = 0; q < NC / 8; ++q) { v4u o; o.x = pk2(x[8 * q], x[8 * q + 1]); o.y = pk2(x[8 * q + 2], x[8 * q + 3]); o.z = pk2(x[8 * q + 4], x[8 * q + 5]); o.w = pk2(x[8 * q + 6], x[8 * q + 7]);
            *(GAS v4u*)(mix + (size_t)r * D + c0 + 8 * q) = o; }
    }
}
DI void mlstm_chain(Frame& F, const bf16* proj, const float* gate, bf16* mix, int c) {
    const int b = c >> 4, h = (c >> 2) & 3, vq = c & 3, vl = F.tid >> 4, dg = F.tid & 15;
    float C0 = 0.f, C1 = 0.f, C2 = 0.f, C3 = 0.f, n0 = 0.f, n1 = 0.f, n2 = 0.f, n3 = 0.f, m = 0.f;
    const bf16* pq = proj + (size_t)b * T * AB_N + h * 64 + 4 * dg;
    const bf16* pk = pq + 256;
    const bf16* pv = proj + (size_t)b * T * AB_N + 512 + h * 128 + vq * 32 + vl;
    const float* pg = gate + (size_t)b * T * 16 + h;
    bf16* po = mix + (size_t)b * T * D + h * 128 + vq * 32 + vl;
    for (int t0 = 0; t0 < T; t0 += 8) {
        v2u qr[8], kr[8]; unsigned short vr[8]; float li[8], lf[8];
#pragma unroll
        for (int i = 0; i < 8; ++i) { qr[i] = *(const GAS v2u*)(pq + (size_t)(t0 + i) * AB_N); kr[i] = *(const GAS v2u*)(pk + (size_t)(t0 + i) * AB_N); vr[i] = pv[(size_t)(t0 + i) * AB_N];
            li[i] = pg[(size_t)(t0 + i) * 16]; lf[i] = pg[(size_t)(t0 + i) * 16 + 4]; }
#pragma unroll
        for (int i = 0; i < 8; ++i) {
            const float q0 = bflo(qr[i].x), q1 = bfhi(qr[i].x), q2 = bflo(qr[i].y), q3 = bfhi(qr[i].y);
            const float k0 = bflo(kr[i].x) * 0.125f, k1 = bfhi(kr[i].x) * 0.125f, k2 = bflo(kr[i].y) * 0.125f, k3 = bfhi(kr[i].y) * 0.125f;
            const float vv = bf2f(vr[i]);
            const float mn = fmaxf(lf[i] + m, li[i]); const float fp = __expf(lf[i] + m - mn), ip = __expf(li[i] - mn); m = mn;
            const float iv = ip * vv;
            C0 = fp * C0 + iv * k0; C1 = fp * C1 + iv * k1; C2 = fp * C2 + iv * k2; C3 = fp * C3 + iv * k3;
            n0 = fp * n0 + ip * k0; n1 = fp * n1 + ip * k1; n2 = fp * n2 + ip * k2; n3 = fp * n3 + ip * k3;
            float pn = (C0 * q0 + C1 * q1) + (C2 * q2 + C3 * q3), pd = (n0 * q0 + n1 * q1) + (n2 * q2 + n3 * q3);
#pragma unroll
            for (int o = 1; o < 16; o <<= 1) { pn += __shfl_xor(pn, o); pd += __shfl_xor(pd, o); }
            const float hv = pn / fmaxf(fabsf(pd), __expf(-mn));
            if (dg == 0) po[(size_t)(t0 + i) * D] = (bf16)f2bf(hv);
        }
    }
}
DI void gdn_chain(Frame& F, const bf16* proj, const float* gate, const float* convw, bf16* mix, int c) {
    const int b = c >> 5, h = (c >> 2) & 7, vq = c & 3, cc = F.tid >> 4, dg = F.tid & 15;
    LAS float* qs = (LAS float*)F.lds; LAS float* ks = qs + 64 * 128; LAS float* vs = ks + 64 * 128; LAS float* os = vs + 64 * 32; LAS float* bet = os + 64 * 32; LAS float* alp = bet + 64;
    float S[8];
#pragma unroll
    for (int j = 0; j < 8; ++j) S[j] = 0.f;
    for (int t0 = 0; t0 < T; t0 += 64) {
        __syncthreads();
        { const int row = F.tid >> 3, seg = F.tid & 7, t = t0 + row;
#pragma unroll
          for (int which = 0; which < 2; ++which) {
              const int colg = which * 1024 + h * 128 + seg * 16; float a[16];
#pragma unroll
              for (int i = 0; i < 16; ++i) a[i] = 0.f;
#pragma unroll
              for (int j = 0; j < 4; ++j) { const int tt = t - 3 + j;
                  if (tt >= 0) { const bf16* src = proj + (size_t)(b * T + tt) * C_N + colg; const float* w = convw + j * 3072 + colg;
#pragma unroll
                      for (int q = 0; q < 2; ++q) { const v4u raw = *(const GAS v4u*)(src + 8 * q); const f32x4 w0 = *(const GAS f32x4*)(w + 8 * q), w1 = *(const GAS f32x4*)(w + 8 * q + 4);
                          a[8 * q + 0] += bflo(raw.x) * w0.x; a[8 * q + 1] += bfhi(raw.x) * w0.y; a[8 * q + 2] += bflo(raw.y) * w0.z; a[8 * q + 3] += bfhi(raw.y) * w0.w;
                          a[8 * q + 4] += bflo(raw.z) * w1.x; a[8 * q + 5] += bfhi(raw.z) * w1.y; a[8 * q + 6] += bflo(raw.w) * w1.z; a[8 * q + 7] += bfhi(raw.w) * w1.w; } } }
              float ss = 0.f;
#pragma unroll
              for (int i = 0; i < 16; ++i) { a[i] = a[i] * sigmoidf_(a[i]); ss += a[i] * a[i]; }
              ss += __shfl_xor(ss, 1); ss += __shfl_xor(ss, 2); ss += __shfl_xor(ss, 4);
              const float sc = rsq_(ss + EPS) * (which == 0 ? 0.08838834764831845f : 1.0f);
              LAS float* dst = (which == 0 ? qs : ks) + row * 128 + seg * 16;
#pragma unroll
              for (int q = 0; q < 4; ++q) *(LAS f32x4*)(dst + 4 * q) = (f32x4){a[4 * q] * sc, a[4 * q + 1] * sc, a[4 * q + 2] * sc, a[4 * q + 3] * sc};
          } }
        if (F.tid < 256) { const int row = F.tid >> 2, seg = F.tid & 3, t = t0 + row; const int colg = 2048 + h * 128 + vq * 32 + seg * 8; float a[8];
#pragma unroll
            for (int i = 0; i < 8; ++i) a[i] = 0.f;
#pragma unroll
            for (int j = 0; j < 4; ++j) { const int tt = t - 3 + j;
                if (tt >= 0) { const v4u raw = *(const GAS v4u*)(proj + (size_t)(b * T + tt) * C_N + colg); const float* w = convw + j * 3072 + colg; const f32x4 w0 = *(const GAS f32x4*)w, w1 = *(const GAS f32x4*)(w + 4);
                    a[0] += bflo(raw.x) * w0.x; a[1] += bfhi(raw.x) * w0.y; a[2] += bflo(raw.y) * w0.z; a[3] += bfhi(raw.y) * w0.w; a[4] += bflo(raw.z) * w1.x; a[5] += bfhi(raw.z) * w1.y; a[6] += bflo(raw.w) * w1.z; a[7] += bfhi(raw.w) * w1.w; } }
#pragma unroll
            for (int i = 0; i < 8; ++i) a[i] = a[i] * sigmoidf_(a[i]);
            *(LAS f32x4*)(vs + row * 32 + seg * 8) = (f32x4){a[0], a[1], a[2], a[3]}; *(LAS f32x4*)(vs + row * 32 + seg * 8 + 4) = (f32x4){a[4], a[5], a[6], a[7]}; }
        if (F.tid < 64) { const float* g = gate + (size_t)(b * T + t0 + F.tid) * 16; bet[F.tid] = g[h]; alp[F.tid] = __expf(g[8 + h]); }
        __syncthreads();
        for (int s = 0; s < 64; ++s) {
            const f32x4 ka = *(const LAS f32x4*)(ks + s * 128 + 8 * dg), kb = *(const LAS f32x4*)(ks + s * 128 + 8 * dg + 4);
            const f32x4 qa = *(const LAS f32x4*)(qs + s * 128 + 8 * dg), qb = *(const LAS f32x4*)(qs + s * 128 + 8 * dg + 4);
            const float vv = vs[s * 32 + cc], be = bet[s], al = alp[s];
            float p = (ka.x * S[0] + ka.y * S[1]) + (ka.z * S[2] + ka.w * S[3]) + (kb.x * S[4] + kb.y * S[5]) + (kb.z * S[6] + kb.w * S[7]);
#pragma unroll
            for (int o = 1; o < 16; o <<= 1) p += __shfl_xor(p, o);
            const float dl = be * (vv - al * p);
            S[0] = al * S[0] + ka.x * dl; S[1] = al * S[1] + ka.y * dl; S[2] = al * S[2] + ka.z * dl; S[3] = al * S[3] + ka.w * dl;
            S[4] = al * S[4] + kb.x * dl; S[5] = al * S[5] + kb.y * dl; S[6] = al * S[6] + kb.z * dl; S[7] = al * S[7] + kb.w * dl;
            float po = (qa.x * S[0] + qa.y * S[1]) + (qa.z * S[2] + qa.w * S[3]) + (qb.x * S[4] + qb.y * S[5]) + (qb.z * S[6] + qb.w * S[7]);
#pragma unroll
            for (int o = 1; o < 16; o <<= 1) po += __shfl_xor(po, o);
            if (dg == 0) os[s * 32 + cc] = po;
        }
        __syncthreads();
        { const int row = F.tid >> 3, c4 = (F.tid & 7) * 4; const f32x4 o = *(const LAS f32x4*)(os + row * 32 + c4);
          *(GAS v2u*)(mix + (size_t)(b * T + t0 + row) * D + h * 128 + vq * 32 + c4) = (v2u){pk2(o.x, o.y), pk2(o.z, o.w)}; }
    }
}
struct MlChunkRegs { v4u q, k, v0, v1, o0, o1; float li, lf; };
DI void ml_load(MlChunkRegs& R, const bf16* proj, const float* gate, int b, int h, int tc, int tid) {
    const int row = tid >> 3, seg = tid & 7; const size_t hb = (size_t)(b * 4 + h) * T + tc + row;
    R.q = *(const GAS v4u*)(proj + hb * 64 + 8 * seg); R.k = *(const GAS v4u*)(proj + (size_t)M * 256 + hb * 64 + 8 * seg);
    const bf16* pv = proj + (size_t)M * 512 + hb * 128 + 16 * seg; R.v0 = *(const GAS v4u*)pv; R.v1 = *(const GAS v4u*)(pv + 8);
    const bf16* po = proj + (size_t)M * 1024 + hb * 128 + 16 * seg; R.o0 = *(const GAS v4u*)po; R.o1 = *(const GAS v4u*)(po + 8);
    R.li = 0.f; R.lf = 0.f;
    if (tid < 64) { const float* g = gate + ((size_t)b * T + tc + tid) * 16; R.li = g[h]; R.lf = g[4 + h]; }
}
DI unsigned scale_pk(unsigned u, float s) { return pk2(bflo(u) * s, bfhi(u) * s); }
DI void mlstm_chunked(Frame& F, const bf16* proj, const float* gate, const float* hgain, bf16* mix, int c) {
    constexpr int LD = 72, HLD = 132;
    const int b = c >> 2, h = c & 3;
    const int tid = F.tid, lane = F.lane, w = F.wave, r = lane & 15, quad = lane >> 4, row = tid >> 3, seg = tid & 7;
    LAS bf16* qs = (LAS bf16*)F.lds; LAS bf16* qw = qs + 64 * LD; LAS bf16* ks = qw + 64 * LD; LAS bf16* kTs = ks + 64 * LD; LAS bf16* Sd = kTs + 64 * LD;
    LAS bf16* vT = Sd + 64 * LD; LAS bf16* Cb = vT + 128 * LD;
    LAS float* hbuf = (LAS float*)(Cb + 128 * LD);
    LAS float* sA = hbuf + 64 * HLD; LAS float* sM = sA + 64; LAS float* sWi = sM + 64; LAS float* sWs = sWi + 64; LAS float* sEm = sWs + 64; LAS float* sN = sEm + 64  ; LAS float* sMisc = sN + 128;
    lds_barrier();
    for (int i = tid; i < 128 * LD / 2; i += NTHR) ((LAS unsigned*)Cb)[i] = 0u;
    if (tid < 128) sN[tid] = 0.f;
    f32x4 accC[4];
#pragma unroll
    for (int i = 0; i < 4; ++i) accC[i] = (f32x4){0.f, 0.f, 0.f, 0.f};
    float nreg = 0.f, mprev = 0.f;
    float gn[16];
#pragma unroll
    for (int i = 0; i < 16; ++i) gn[i] = hgain[h * 128 + 16 * seg + i];
    const size_t rb = (size_t)b * T;
    MlChunkRegs cur, nxt; ml_load(cur, proj, gate, b, h, 0, tid); nxt = cur;
    for (int ch = 0; ch < T / 64; ++ch) {
        const size_t r0 = rb + (size_t)ch * 64;
        if (ch + 1 < T / 64) ml_load(nxt, proj, gate, b, h, (ch + 1) * 64, tid);
        STG_T0();
        lds_barrier();
        STG(0);
        *(LAS v4u*)(qs + row * LD + 8 * seg) = cur.q;
        { v4u kk; kk.x = scale_pk(cur.k.x, 0.125f); kk.y = scale_pk(cur.k.y, 0.125f); kk.z = scale_pk(cur.k.z, 0.125f); kk.w = scale_pk(cur.k.w, 0.125f); cur.k = kk; *(LAS v4u*)(ks + row * LD + 8 * seg) = kk; }
        { const unsigned vv[8] = {cur.v0.x, cur.v0.y, cur.v0.z, cur.v0.w, cur.v1.x, cur.v1.y, cur.v1.z, cur.v1.w};
#pragma unroll
          for (int i = 0; i < 8; ++i) { vT[(16 * seg + 2 * i) * LD + row] = (bf16)(vv[i] & 0xffffu); vT[(16 * seg + 2 * i + 1) * LD + row] = (bf16)(vv[i] >> 16); } }
        if (w == 0) {
            float bb = cur.lf;
#pragma unroll
            for (int o = 1; o < 64; o <<= 1) { const float t = __shfl_up(bb, o); if (lane >= o) bb += t; }
            const float a = cur.li - bb; float cm = a;
#pragma unroll
            for (int o = 1; o < 64; o <<= 1) { const float t = __shfl_up(cm, o); if (lane >= o) cm = fmaxf(cm, t); }
            const float Mx = fmaxf(mprev, cm);
            const float b63 = __shfl(bb, 63), Mx63 = __shfl(Mx, 63);
            sA[lane] = a; sM[lane] = Mx; sWi[lane] = __expf(mprev - Mx); sWs[lane] = __expf(a - Mx63); sEm[lane] = __expf(-(bb + Mx));
            if (lane == 0) sMisc[0] = __expf(mprev - Mx63);
            mprev = b63 + Mx63;
        }
        STG(1);
        lds_barrier();
        STG(2);
        { const float wi = sWi[row], wsr = sWs[row];
          v4u t; t.x = scale_pk(cur.q.x, wi); t.y = scale_pk(cur.q.y, wi); t.z = scale_pk(cur.q.z, wi); t.w = scale_pk(cur.q.w, wi); *(LAS v4u*)(qw + row * LD + 8 * seg) = t;
          const unsigned kk[4] = {cur.k.x, cur.k.y, cur.k.z, cur.k.w};
#pragma unroll
          for (int i = 0; i < 4; ++i) { kTs[(8 * seg + 2 * i) * LD + row] = (bf16)f2bf(bflo(kk[i]) * wsr); kTs[(8 * seg + 2 * i + 1) * LD + row] = (bf16)f2bf(bfhi(kk[i]) * wsr); } }
        { const int mt = w >> 1;
          const bf16x8 a0 = *(const LAS bf16x8*)(qs + (16 * mt + r) * LD + 8 * quad), a1 = *(const LAS bf16x8*)(qs + (16 * mt + r) * LD + 32 + 8 * quad);
#pragma unroll
          for (int tt = 0; tt < 2; ++tt) { const int nt = 2 * (w & 1) + tt; f32x4 acc = (f32x4){0.f, 0.f, 0.f, 0.f};
              if (nt <= mt) { const bf16x8 b0 = *(const LAS bf16x8*)(ks + (16 * nt + r) * LD + 8 * quad), b1 = *(const LAS bf16x8*)(ks + (16 * nt + r) * LD + 32 + 8 * quad);
                  acc = mfma16(a0, b0, acc); acc = mfma16(a1, b1, acc); }
              const int s = 16 * nt + r; const float as = sA[s];
#pragma unroll
              for (int j = 0; j < 4; ++j) { const int t = 16 * mt + 4 * quad + j; const float v = (s <= t) ? acc[j] * __expf(as - sM[t]) : 0.f; Sd[t * LD + s] = (bf16)f2bf(v); } } }
        STG(3);
        lds_barrier();
        STG(4);
        const bf16x8 vf0 = *(const LAS bf16x8*)(vT + (16 * w + r) * LD + 8 * quad), vf1 = *(const LAS bf16x8*)(vT + (16 * w + r) * LD + 32 + 8 * quad);
        { const bf16x8 cf0 = *(const LAS bf16x8*)(Cb + (16 * w + r) * LD + 8 * quad), cf1 = *(const LAS bf16x8*)(Cb + (16 * w + r) * LD + 32 + 8 * quad);
#pragma unroll
          for (int mt = 0; mt < 4; ++mt) { f32x4 acc = (f32x4){0.f, 0.f, 0.f, 0.f};
              acc = mfma16(*(const LAS bf16x8*)(Sd + (16 * mt + r) * LD + 8 * quad), vf0, acc); acc = mfma16(*(const LAS bf16x8*)(Sd + (16 * mt + r) * LD + 32 + 8 * quad), vf1, acc);
              acc = mfma16(*(const LAS bf16x8*)(qw + (16 * mt + r) * LD + 8 * quad), cf0, acc); acc = mfma16(*(const LAS bf16x8*)(qw + (16 * mt + r) * LD + 32 + 8 * quad), cf1, acc);
#pragma unroll
              for (int j = 0; j < 4; ++j) hbuf[(16 * mt + 4 * quad + j) * HLD + 16 * w + r] = acc[j]; } }
        STG(5);
        lds_barrier();
        STG(6);
        { const float wold = sMisc[0];
#pragma unroll
          for (int nt = 0; nt < 4; ++nt) { f32x4 acc = accC[nt] * wold;
              acc = mfma16(vf0, *(const LAS bf16x8*)(kTs + (16 * nt + r) * LD + 8 * quad), acc); acc = mfma16(vf1, *(const LAS bf16x8*)(kTs + (16 * nt + r) * LD + 32 + 8 * quad), acc);
              accC[nt] = acc;
#pragma unroll
              for (int j = 0; j < 4; ++j) Cb[(16 * w + 4 * quad + j) * LD + 16 * nt + r] = (bf16)f2bf(acc[j]); }
          if (w == 0) { float sum = 0.f;
#pragma unroll
              for (int q8 = 0; q8 < 8; ++q8) { const v4u t = *(const LAS v4u*)(kTs + lane * LD + 8 * q8); sum += (bflo(t.x) + bfhi(t.x)) + (bflo(t.y) + bfhi(t.y)) + (bflo(t.z) + bfhi(t.z)) + (bflo(t.w) + bfhi(t.w)); }
              nreg = wold * nreg + sum; sN[((ch + 1) & 1) * 64 + lane] = nreg; } }
        { const LAS float* nv = sN + (ch & 1) * 64 + 8 * seg;
          const v4u sd = *(const LAS v4u*)(Sd + row * LD + 8 * seg);
          float p = (bflo(sd.x) + bfhi(sd.x)) + (bflo(sd.y) + bfhi(sd.y)) + (bflo(sd.z) + bfhi(sd.z)) + (bflo(sd.w) + bfhi(sd.w));
          const float qn = (bflo(cur.q.x) * nv[0] + bfhi(cur.q.x) * nv[1]) + (bflo(cur.q.y) * nv[2] + bfhi(cur.q.y) * nv[3]) + (bflo(cur.q.z) * nv[4] + bfhi(cur.q.z) * nv[5]) + (bflo(cur.q.w) * nv[6] + bfhi(cur.q.w) * nv[7]);
          p += sWi[row] * qn;
          p += __shfl_xor(p, 1); p += __shfl_xor(p, 2); p += __shfl_xor(p, 4);
          const float dinv = rcp_(fmaxf(fabsf(p), sEm[row]));
          float hv[16]; float ss = 0.f;
#pragma unroll
          for (int q4 = 0; q4 < 4; ++q4) { const f32x4 t = *(const LAS f32x4*)(hbuf + row * HLD + 16 * seg + 4 * q4); hv[4 * q4] = t.x * dinv; hv[4 * q4 + 1] = t.y * dinv; hv[4 * q4 + 2] = t.z * dinv; hv[4 * q4 + 3] = t.w * dinv; }
#pragma unroll
          for (int i = 0; i < 16; ++i) ss += hv[i] * hv[i];
          ss += __shfl_xor(ss, 1); ss += __shfl_xor(ss, 2); ss += __shfl_xor(ss, 4);
          const float rstd = rsq_(ss * (1.f / 128.f) + EPS);
          const unsigned og[8] = {cur.o0.x, cur.o0.y, cur.o0.z, cur.o0.w, cur.o1.x, cur.o1.y, cur.o1.z, cur.o1.w}; unsigned ow[8];
#pragma unroll
          for (int i = 0; i < 8; ++i) ow[i] = pk2(hv[2 * i] * rstd * gn[2 * i] * sigmoidf_(bflo(og[i])), hv[2 * i + 1] * rstd * gn[2 * i + 1] * sigmoidf_(bfhi(og[i])));
          bf16* op = mix + (r0 + row) * D + h * 128 + 16 * seg;
          *(GAS v4u*)op = (v4u){ow[0], ow[1], ow[2], ow[3]}; *(GAS v4u*)(op + 8) = (v4u){ow[4], ow[5], ow[6], ow[7]}; }
        STG(7);
        cur = nxt;
    }
}
constexpr size_t MIX_AT = 0, MIX_HALO = 64 * MiB, MIX_GL = 96 * MiB;
struct G1Raw { v2u raw[3][7]; };
struct G1Cw { float w[3][4][4]; };
DI void g1_load_raw(G1Raw& R, const bf16* big, const bf16* halo, int U, int tid) {
    const int ch = U & 127, h = (U >> 7) & 7, b = U >> 10, cg = tid & 31, rs = tid >> 5;
    const size_t hb0 = (size_t)(b * 8 + h) * T + (size_t)ch * 64;
#pragma unroll
    for (int which = 0; which < 3; ++which)
#pragma unroll
        for (int i = 0; i < 7; ++i) { const int rr = 4 * rs - 3 + i; v2u t = (v2u){0u, 0u};
            if (rr >= 0) t = *(const GAS v2u*)(big + (size_t)M * 1024 * which + (hb0 + rr) * 128 + 4 * cg);
            else if (ch > 0) t = *(const GAS v2u*)(halo + ((size_t)(b * 128 + ch - 1) * 3 + (3 + rr)) * 3072 + which * 1024 + h * 128 + 4 * cg);
            R.raw[which][i] = t; }
}
DI void g1_load_cw(G1Cw& C, const float* convw, int h, int tid) {
    const int cg = tid & 31;
#pragma unroll
    for (int which = 0; which < 3; ++which)
#pragma unroll
        for (int j = 0; j < 4; ++j) { const f32x4 t = *(const GAS f32x4*)(convw + j * 3072 + which * 1024 + h * 128 + 4 * cg); C.w[which][j][0] = t.x; C.w[which][j][1] = t.y; C.w[which][j][2] = t.z; C.w[which][j][3] = t.w; }
}
DI void gdn_g1_unit(Frame& F, bf16* big, const bf16* halo, const float* gate, G1Raw& RW, const float* convw, bf16* Hb, bf16* At, float* GL, int U, int Uend, bool st) {
    constexpr int LQ = 136, LX = 72, LR = 264;
    const int ch = U & 127, h = (U >> 7) & 7, b = U >> 10;
    const size_t r0 = (size_t)b * T + (size_t)ch * 64, hb0 = (size_t)(b * 8 + h) * T + (size_t)ch * 64;
    int tid_ = F.tid; asm volatile("" : "+v"(tid_));
    const int tid = tid_, lane = tid & 63, w = F.wave, r = lane & 15, quad = lane >> 4, row = tid >> 3, seg = tid & 7;
    const size_t hb = hb0 + row;
    LAS bf16* qn = (LAS bf16*)F.lds; LAS bf16* kn = qn + 64 * LQ; LAS bf16* vn = kn + 64 * LQ; LAS bf16* knT = vn + 64 * LQ;
    LAS bf16* Lb = knT + 128 * LX; LAS float* Lf = (LAS float*)(Lb + 64 * LX);
    LAS bf16* Db = (LAS bf16*)(Lf + 4 * 16 * 17); LAS bf16* Xt = Db + 4 * 16 * 20;
    LAS bf16* Xr = qn;
    LAS bf16* Ats = Xt;
    LAS float* sG = (LAS float*)(Xt + 256 * LX); LAS float* sBeta = sG + 64; LAS float* sEg = sBeta + 64;
    STG_T0();
    lds_barrier();
    STG(10);
    {
        const int cg = tid & 31, rs = tid >> 5;
#pragma unroll
        for (int which = 0; which < 3; ++which) {
            __builtin_amdgcn_sched_barrier(0);
            f32x4 cw[4];
#pragma unroll
            for (int j = 0; j < 4; ++j) cw[j] = *(const GAS f32x4*)(convw + j * 3072 + which * 1024 + h * 128 + 4 * cg);
            float x[7][4];
#pragma unroll
            for (int i = 0; i < 7; ++i) { const v2u t = RW.raw[which][i]; x[i][0] = bflo(t.x); x[i][1] = bfhi(t.x); x[i][2] = bflo(t.y); x[i][3] = bfhi(t.y); }
            float o[4][4]; float ss[4];
#pragma unroll
            for (int rr = 0; rr < 4; ++rr) { ss[rr] = 0.f;
#pragma unroll
                for (int c = 0; c < 4; ++c) { float a = cw[0][c] * x[rr][c]; a += cw[1][c] * x[rr + 1][c]; a += cw[2][c] * x[rr + 2][c]; a += cw[3][c] * x[rr + 3][c];
                    a = a * sigmoidf_(a); o[rr][c] = a; ss[rr] += a * a; } }
            if (which < 2) {
#pragma unroll
                for (int rr = 0; rr < 4; ++rr) { float t = ss[rr]; t += __shfl_xor(t, 1); t += __shfl_xor(t, 2); t += __shfl_xor(t, 4); t += __shfl_xor(t, 8); t += __shfl_xor(t, 16);
                    const float sc = rsq_(t + EPS) * (which == 0 ? 0.08838834764831845f : 1.0f);
#pragma unroll
                    for (int c = 0; c < 4; ++c) o[rr][c] *= sc; } }
            LAS bf16* dst = (which == 0 ? qn : (which == 1 ? kn : vn));
#pragma unroll
            for (int rr = 0; rr < 4; ++rr) *(LAS v2u*)(dst + (4 * rs + rr) * LQ + 4 * cg) = (v2u){pk2(o[rr][0], o[rr][1]), pk2(o[rr][2], o[rr][3])};
            if (which == 1) {
#pragma unroll
                for (int c = 0; c < 4; ++c) *(LAS v2u*)(knT + (4 * cg + c) * LX + ((4 * rs) ^ (8 * (cg & 7)))) = (v2u){pk2(o[0][c], o[1][c]), pk2(o[2][c], o[3][c])}; }
        }
    }
    if (U + 1 < Uend) g1_load_raw(RW, big, halo, U + 1, tid);
    if (w == 0) { const float* g = gate + (r0 + lane) * 16; float gg = g[8 + h]; const float be = g[h];
#pragma unroll
        for (int o = 1; o < 64; o <<= 1) { const float t = __shfl_up(gg, o); if (lane >= o) gg += t; }
        sG[lane] = gg; sBeta[lane] = be; sEg[lane] = __expf(gg); }
    STG(11);
    lds_barrier();
    STG(12);
    { const int mt = w >> 1;
#pragma unroll
      for (int tt = 0; tt < 2; ++tt) { const int nt = 2 * (w & 1) + tt; f32x4 ak = (f32x4){0.f, 0.f, 0.f, 0.f}, aq = ak;
          if (nt <= mt) {
#pragma unroll
              for (int kk = 0; kk < 4; ++kk) { const bf16x8 bk = *(const LAS bf16x8*)(kn + (16 * nt + r) * LQ + 32 * kk + 8 * quad);
                  ak = mfma16(*(const LAS bf16x8*)(kn + (16 * mt + r) * LQ + 32 * kk + 8 * quad), bk, ak); aq = mfma16(*(const LAS bf16x8*)(qn + (16 * mt + r) * LQ + 32 * kk + 8 * quad), bk, aq); } }
          const int s = 16 * nt + r; const float gs = sG[s];
#pragma unroll
          for (int j = 0; j < 4; ++j) { const int t = 16 * mt + 4 * quad + j; const float dec = (s <= t) ? __expf(sG[t] - gs) : 0.f;
              const float lv = (s < t) ? sBeta[t] * ak[j] * dec : 0.f;
              if (nt <= mt) { Lb[t * LX + s] = (bf16)f2bf(lv); if (nt == mt) Lf[(mt * 16 + 4 * quad + j) * 17 + r] = lv; }
              Ats[t * LX + s] = (bf16)f2bf(aq[j] * dec); } } }
    float R[4][2][4];
#pragma unroll
    for (int i = 0; i < 4; ++i)
#pragma unroll
        for (int ct = 0; ct < 2; ++ct)
#pragma unroll
            for (int j = 0; j < 4; ++j) { const int t = 16 * i + 4 * quad + j, cc = 32 * (w & 3) + 16 * ct + r;
                R[i][ct][j] = (w < 4) ? sBeta[t] * bf2f(vn[t * LQ + cc]) : sBeta[t] * sEg[t] * bf2f(kn[t * LQ + cc]); }
    STG(13);
    lds_barrier();
    STG(14);
    if (w == 0) { const int i = lane >> 4, cI = lane & 15; const LAS float* N = Lf + i * 16 * 17; float x[16];
#pragma unroll
        for (int rr = 0; rr < 16; ++rr) { float v = (rr == cI) ? 1.f : 0.f;
#pragma unroll
            for (int m = 0; m < rr; ++m) v -= N[rr * 17 + m] * x[m];
            x[rr] = v; Db[(i * 16 + rr) * 20 + cI] = (bf16)f2bf(v); }
    } else { const float gl = sG[63];
        if (st) for (int idx = tid - 64; idx < 2560; idx += NTHR - 64) {
            if (idx < 1024) { const int t = idx >> 4, c8 = (idx & 15) * 8; const v4u v = *(const LAS v4u*)(qn + t * LQ + c8); const float e = sEg[t];
                *(GAS v4u*)(big + (size_t)M * 2048 + (hb0 + t) * 128 + c8) = (v4u){scale_pk(v.x, e), scale_pk(v.y, e), scale_pk(v.z, e), scale_pk(v.w, e)}; }
            else if (idx >= 2048) { const int i3 = idx - 2048, t = i3 >> 3, s8 = (i3 & 7) * 8; *(GAS v4u*)(At + (size_t)U * 4096 + t * 64 + s8) = *(const LAS v4u*)(Ats + t * LX + s8); }
            else { const int i2 = idx - 1024, d = i2 >> 3, s8 = (i2 & 7) * 8; const v4u v = *(const LAS v4u*)(knT + d * LX + (s8 ^ (8 * ((d >> 2) & 7)))); float e[8];
#pragma unroll
                for (int q = 0; q < 8; ++q) e[q] = __expf(gl - sG[s8 + q]);
                *(GAS v4u*)(big + (size_t)M * 1024 + hb0 * 128 + d * 64 + s8) = (v4u){pk2(bflo(v.x) * e[0], bfhi(v.x) * e[1]), pk2(bflo(v.y) * e[2], bfhi(v.y) * e[3]), pk2(bflo(v.z) * e[4], bfhi(v.z) * e[5]), pk2(bflo(v.w) * e[6], bfhi(v.w) * e[7])}; } }
        if (st && tid == 64) GL[U] = __expf(gl); }
    STG(15);
    lds_barrier();
    STG(16);
#pragma unroll
    for (int i = 0; i < 4; ++i) {
#pragma unroll
        for (int ct = 0; ct < 2; ++ct) { const int col = 32 * w + 16 * ct + r; f32x4 acc = (f32x4){0.f, 0.f, 0.f, 0.f};
            if (i > 0) {
#pragma unroll
                for (int kk = 0; kk < 2; ++kk) if (32 * kk < 16 * i) {
                    bf16x8 af = *(const LAS bf16x8*)(Lb + (16 * i + r) * LX + 32 * kk + 8 * quad);
                    if (32 * kk + 8 * quad >= 16 * i) af = (bf16x8){0, 0, 0, 0, 0, 0, 0, 0};
                    acc = mfma16(af, *(const LAS bf16x8*)(Xt + col * LX + 32 * kk + 8 * quad), acc); } }
            const v2u bp = (v2u){pk2(R[i][ct][0] - acc[0], R[i][ct][1] - acc[1]), pk2(R[i][ct][2] - acc[2], R[i][ct][3] - acc[3])};
            const v2u ap = *(const LAS v2u*)(Db + (i * 16 + r) * 20 + 4 * quad);
            const f32x4 y = mfma16(__builtin_bit_cast(bf16x8, (v4u){ap.x, ap.y, 0u, 0u}), __builtin_bit_cast(bf16x8, (v4u){bp.x, bp.y, 0u, 0u}), (f32x4){0.f, 0.f, 0.f, 0.f});
            *(LAS v2u*)(Xt + col * LX + 16 * i + 4 * quad) = (v2u){pk2(y[0], y[1]), pk2(y[2], y[3])};
#pragma unroll
            for (int j = 0; j < 4; ++j) Xr[(16 * i + 4 * quad + j) * LR + col] = (bf16)f2bf(y[j]); }
        asm volatile("s_waitcnt lgkmcnt(0)" ::: "memory");
    }
    lds_barrier();
    STG(17);
    if (st) { const v4u u0 = *(const LAS v4u*)(Xr + row * LR + 16 * seg), u1 = *(const LAS v4u*)(Xr + row * LR + 16 * seg + 8), w0 = *(const LAS v4u*)(Xr + row * LR + 128 + 16 * seg), w1 = *(const LAS v4u*)(Xr + row * LR + 128 + 16 * seg + 8);
      bf16* up = Hb + hb * 128 + 16 * seg; *(GAS v4u*)up = u0; *(GAS v4u*)(up + 8) = u1;
      bf16* wp = big + hb * 128 + 16 * seg; *(GAS v4u*)wp = w0; *(GAS v4u*)(wp + 8) = w1; }
    STG(18);
}
DI void gdn_g1_phase(Frame& F, bf16* big, const bf16* halo, const float* gate, const float* convw, bf16* Hb, bf16* At, float* GL, bool st) {
    LAS unsigned* xt = (LAS unsigned*)(F.lds + (3 * 64 * 136 + 128 * 72 + 64 * 72) * 2 + 4 * 16 * 17 * 4 + 4 * 16 * 20 * 2);
    lds_barrier();
    for (int i = F.tid; i < 256 * 72 / 2; i += NTHR) xt[i] = 0u;
    const int per = (8192 + F.G - 1) / F.G, u0 = F.wg * per, u1 = (u0 + per < 8192) ? u0 + per : 8192;
    if (u0 >= u1) return;
    G1Raw RW;
    g1_load_raw(RW, big, halo, u0, F.tid);
    for (int U = u0; U < u1; ++U) gdn_g1_unit(F, big, halo, gate, RW, convw, Hb, At, GL, U, u1, st);
}
struct G2Regs { bf16x8 wf[4], qf[4], af[2], kf[2]; unsigned u[4]; float gl; };
DI void g2_load(G2Regs& R, const bf16* big, const bf16* Hb, const bf16* At, const float* GL, int b, int h, int vq, int ch, int w, int r, int quad) {
    const size_t hb0 = (size_t)(b * 8 + h) * T + (size_t)ch * 64; const int U = (b * 8 + h) * 128 + ch; const int mt = w >> 1, nt = w & 1;
    const bf16* pw = big + (hb0 + 16 * mt + r) * 128 + 8 * quad;
#pragma unroll
    for (int kk = 0; kk < 4; ++kk) { R.wf[kk] = *(const GAS bf16x8*)(pw + 32 * kk); R.qf[kk] = *(const GAS bf16x8*)(pw + (size_t)M * 2048 + 32 * kk); }
    const bf16* pa = At + (size_t)U * 4096 + (16 * mt + r) * 64 + 8 * quad;
    R.af[0] = *(const GAS bf16x8*)pa; R.af[1] = *(const GAS bf16x8*)(pa + 32);
    const int d = 16 * w + r; const bf16* pk = big + (size_t)M * 1024 + hb0 * 128 + d * 64 + 8 * quad;
    R.kf[0] = *(const GAS bf16x8*)pk; R.kf[1] = *(const GAS bf16x8*)(pk + 32);
    const bf16* pu = Hb + (hb0 + 16 * mt + 4 * quad) * 128 + vq * 32 + 16 * nt + r;
#pragma unroll
    for (int j = 0; j < 4; ++j) R.u[j] = pu[(size_t)j * 128];
    R.gl = GL[U];
}
DI void gdn_g2_chain(Frame& F, const bf16* big, bf16* Hb, const bf16* At, const float* GL, int c, bool st) {
    constexpr int LS = 136, LV = 72;
    const int b = c >> 5, h = (c >> 2) & 7, vq = c & 3;
    const int tid = F.tid, lane = F.lane, w = F.wave, r = lane & 15, quad = lane >> 4, mt = w >> 1, nt = w & 1;
    LAS bf16* St = (LAS bf16*)F.lds;
    LAS bf16* vnT = St + 32 * LS;
    lds_barrier();
    for (int i = tid; i < 32 * LS / 2; i += NTHR) ((LAS unsigned*)St)[i] = 0u;
    f32x4 accS[2]; accS[0] = (f32x4){0.f, 0.f, 0.f, 0.f}; accS[1] = accS[0];
    G2Regs cur, nxt; g2_load(cur, big, Hb, At, GL, b, h, vq, 0, w, r, quad); nxt = cur;
    lds_barrier();
    unsigned short opend[4] = {0, 0, 0, 0};
    for (int ch = 0; ch < T / 64; ++ch) {
        if (ch > 0 && st) { const size_t hbp = (size_t)(b * 8 + h) * T + (size_t)(ch - 1) * 64; bf16* po = Hb + (hbp + 16 * mt + 4 * quad) * 128 + vq * 32 + 16 * nt + r;
#pragma unroll
            for (int j = 0; j < 4; ++j) po[(size_t)j * 128] = opend[j]; }
        if (ch + 1 < T / 64) g2_load(nxt, big, Hb, At, GL, b, h, vq, ch + 1, w, r, quad);
        STG_T0();
        f32x4 av = (f32x4){0.f, 0.f, 0.f, 0.f}, ao = av;
#pragma unroll
        for (int kk = 0; kk < 4; ++kk) { const bf16x8 sf = *(const LAS bf16x8*)(St + (16 * nt + r) * LS + 32 * kk + 8 * quad); av = mfma16(cur.wf[kk], sf, av); ao = mfma16(cur.qf[kk], sf, ao); }
        *(LAS v2u*)(vnT + (16 * nt + r) * LV + 16 * mt + 4 * quad) = (v2u){pk2(bflo(cur.u[0]) - av[0], bflo(cur.u[1]) - av[1]), pk2(bflo(cur.u[2]) - av[2], bflo(cur.u[3]) - av[3])};
        STG(20);
        lds_barrier();
        STG(21);
#pragma unroll
        for (int kk = 0; kk < 2; ++kk) ao = mfma16(cur.af[kk], *(const LAS bf16x8*)(vnT + (16 * nt + r) * LV + 32 * kk + 8 * quad), ao);
#pragma unroll
        for (int j = 0; j < 4; ++j) opend[j] = (unsigned short)f2bf(ao[j]);
#pragma unroll
        for (int n2 = 0; n2 < 2; ++n2) { f32x4 a = accS[n2] * cur.gl;
#pragma unroll
            for (int kk = 0; kk < 2; ++kk) a = mfma16(cur.kf[kk], *(const LAS bf16x8*)(vnT + (16 * n2 + r) * LV + 32 * kk + 8 * quad), a);
            accS[n2] = a; *(LAS v2u*)(St + (16 * n2 + r) * LS + 16 * w + 4 * quad) = (v2u){pk2(a[0], a[1]), pk2(a[2], a[3])}; }
        STG(22);
        lds_barrier();
        STG(23);
        cur = nxt;
    }
    if (st) { const size_t hbp = (size_t)(b * 8 + h) * T + (size_t)(T / 64 - 1) * 64; bf16* po = Hb + (hbp + 16 * mt + 4 * quad) * 128 + vq * 32 + 16 * nt + r;
#pragma unroll
        for (int j = 0; j < 4; ++j) po[(size_t)j * 128] = opend[j]; }
}
DI void sb_unit(Frame& F, const bf16* proj, bf16* mix, int u) {
    constexpr int LDV = 72;
    const int qt = u & 63, h = (u >> 6) & 3, b = u >> 8;
    LAS bf16* Vt = (LAS bf16*)F.lds;
    volatile LAS unsigned* flag = (volatile LAS unsigned*)(F.lds + MISC_OFF + 64);
    const int w = F.wave, lane = F.lane, r = lane & 15, quad = lane >> 4;
    const int t0 = qt * 128, qpos = t0 + 16 * w + r;
    const size_t rb = (size_t)b * T;
    bf16x8 qf[4];
#pragma unroll
    for (int kk = 0; kk < 4; ++kk) qf[kk] = *(const GAS bf16x8*)(proj + (size_t)M * 1536 + ((size_t)(b * 4 + h) * T + qpos) * 128 + 32 * kk + 8 * quad);
    f32x4 o[8];
#pragma unroll
    for (int i = 0; i < 8; ++i) o[i] = (f32x4){0.f, 0.f, 0.f, 0.f};
    float carry = 0.f;
    const float scale = 0.08838834764831845f;
    for (int kb = 2 * qt + 1; kb >= 0; --kb) {
        const int k0 = kb * 64;
        lds_barrier();
        { const int key = F.tid >> 3, ds = (F.tid & 7) * 16; const bf16* src = proj + (size_t)M * 2560 + ((size_t)(b * 4 + h) * T + k0 + key) * 128 + ds;
          const v4u a = *(const GAS v4u*)src, c = *(const GAS v4u*)(src + 8);
          const unsigned ww[8] = {a.x, a.y, a.z, a.w, c.x, c.y, c.z, c.w};
#pragma unroll
          for (int i = 0; i < 8; ++i) { Vt[(ds + 2 * i) * LDV + key] = (bf16)(ww[i] & 0xffffu); Vt[(ds + 2 * i + 1) * LDV + key] = (bf16)(ww[i] >> 16); } }
        if (F.tid == 0) flag[0] = 0u;
        lds_barrier();
        if (k0 < t0 + 16 * w + 15) {
            f32x4 s[4];
#pragma unroll
            for (int mt = 0; mt < 4; ++mt) { s[mt] = (f32x4){0.f, 0.f, 0.f, 0.f};
                const bf16* kp = proj + (size_t)M * 2048 + ((size_t)(b * 4 + h) * T + k0 + 16 * mt + r) * 128 + 8 * quad;
#pragma unroll
                for (int kk = 0; kk < 4; ++kk) s[mt] = mfma16(*(const GAS bf16x8*)(kp + 32 * kk), qf[kk], s[mt]); }
            float l1[4][4], tot[4];
#pragma unroll
            for (int mt = 0; mt < 4; ++mt) { tot[mt] = 0.f;
#pragma unroll
                for (int j = 0; j < 4; ++j) { const float z = s[mt][j] * scale; const bool valid = (k0 + 16 * mt + 4 * quad + j) < qpos;
                    const float tl = __logf(1.0f + __expf(-fabsf(z)));
                    l1[mt][j] = valid ? (fminf(-z, 0.f) - tl) : 0.f; s[mt][j] = valid ? (fminf(z, 0.f) - tl) : -1e30f; tot[mt] += l1[mt][j]; } }
            float run = carry;
#pragma unroll
            for (int mt = 3; mt >= 0; --mt) {
                const float t1 = __shfl_xor(tot[mt], 16), t2 = __shfl_xor(tot[mt], 32), t3 = __shfl_xor(t1, 32);
                float hi = 0.f;
                hi += ((quad ^ 1) > quad) ? t1 : 0.f; hi += ((quad ^ 2) > quad) ? t2 : 0.f; hi += ((quad ^ 3) > quad) ? t3 : 0.f;
                float acc = run + hi;
#pragma unroll
                for (int j = 3; j >= 0; --j) { const float e = s[mt][j] + acc; s[mt][j] = __expf(e); acc += l1[mt][j]; }
                run += (tot[mt] + t1) + (t2 + t3);
            }
            carry = run;
#pragma unroll
            for (int s2 = 0; s2 < 2; ++s2) {
                v4u pw; pw.x = pk2(s[2 * s2][0], s[2 * s2][1]); pw.y = pk2(s[2 * s2][2], s[2 * s2][3]); pw.z = pk2(s[2 * s2 + 1][0], s[2 * s2 + 1][1]); pw.w = pk2(s[2 * s2 + 1][2], s[2 * s2 + 1][3]);
                const bf16x8 pf = __builtin_bit_cast(bf16x8, pw);
#pragma unroll
                for (int dt = 0; dt < 8; ++dt) { const LAS bf16* vp = Vt + (16 * dt + r) * LDV + 32 * s2 + 4 * quad;
                    const s16x4 lo = *(const LAS s16x4*)vp, hi4 = *(const LAS s16x4*)(vp + 16);
                    o[dt] = mfma16(__builtin_shufflevector(lo, hi4, 0, 1, 2, 3, 4, 5, 6, 7), pf, o[dt]); }
            }
        }
        if (!(carry < -SB_THR)) flag[0] = 1u;
        lds_barrier();
        if (flag[0] == 0u) break;
    }
    bf16* op = mix + (rb + qpos) * D + 512 + h * 128 + 4 * quad;
#pragma unroll
    for (int dt = 0; dt < 8; ++dt) *(GAS v2u*)(op + 16 * dt) = (v2u){pk2(o[dt][0], o[dt][1]), pk2(o[dt][2], o[dt][3])};
}
DI void xattn_phase(Frame& F, const bf16* Q, const bf16* KV, int l, bf16* O) {
    constexpr int LDV = 264;
    LAS bf16* Vt = (LAS bf16*)F.lds;
    const int per = (2048 + F.G - 1) / F.G, u0 = F.wg * per, u1 = (u0 + per < 2048) ? u0 + per : 2048;
    const int w = F.wave, lane = F.lane, r = lane & 15, quad = lane >> 4;
    int cur = -1;
    for (int u = u0; u < u1; ++u) {
        const int bh = u >> 6, qt = u & 63, b = bh >> 2, h = bh & 3;
        if (bh != cur) {
            lds_barrier();
#pragma unroll 4
            for (int it = 0; it < 16; ++it) { const int idx = F.tid + NTHR * it, key = idx >> 5, ds = (idx & 31) * 8;
                const v4u a = *(const GAS v4u*)(KV + (size_t)(b * MEMLEN + key) * 8192 + 2048 * l + 1024 + h * 256 + ds);
                const unsigned ww[4] = {a.x, a.y, a.z, a.w};
#pragma unroll
                for (int i = 0; i < 4; ++i) { Vt[(ds + 2 * i) * LDV + key] = (bf16)(ww[i] & 0xffffu); Vt[(ds + 2 * i + 1) * LDV + key] = (bf16)(ww[i] >> 16); } }
            lds_barrier(); cur = bh;
        }
        const size_t row = (size_t)b * T + qt * 128 + 16 * w + r;
        bf16x8 qf[8];
#pragma unroll
        for (int kk = 0; kk < 8; ++kk) qf[kk] = *(const GAS bf16x8*)(Q + row * D + h * 256 + 32 * kk + 8 * quad);
        f32x4 s[16];
#pragma unroll
        for (int mt = 0; mt < 16; ++mt) { s[mt] = (f32x4){0.f, 0.f, 0.f, 0.f};
            const bf16* kp = KV + (size_t)(b * MEMLEN + 16 * mt + r) * 8192 + 2048 * l + h * 256 + 8 * quad;
#pragma unroll
            for (int kk = 0; kk < 8; ++kk) s[mt] = mfma16(*(const GAS bf16x8*)(kp + 32 * kk), qf[kk], s[mt]); }
        float mx = -1e30f;
#pragma unroll
        for (int mt = 0; mt < 16; ++mt) mx = fmaxf(fmaxf(fmaxf(s[mt][0], s[mt][1]), fmaxf(s[mt][2], s[mt][3])), mx);
        mx = fmaxf(mx, __shfl_xor(mx, 16)); mx = fmaxf(mx, __shfl_xor(mx, 32));
        float sum = 0.f;
#pragma unroll
        for (int mt = 0; mt < 16; ++mt)
#pragma unroll
            for (int j = 0; j < 4; ++j) { const float p = __expf((s[mt][j] - mx) * 0.0625f); s[mt][j] = p; sum += p; }
        sum += __shfl_xor(sum, 16); sum += __shfl_xor(sum, 32);
        const float inv = 1.0f / sum;
        f32x4 o[16];
#pragma unroll
        for (int i = 0; i < 16; ++i) o[i] = (f32x4){0.f, 0.f, 0.f, 0.f};
#pragma unroll
        for (int s2 = 0; s2 < 8; ++s2) {
            v4u pw; pw.x = pk2(s[2 * s2][0], s[2 * s2][1]); pw.y = pk2(s[2 * s2][2], s[2 * s2][3]); pw.z = pk2(s[2 * s2 + 1][0], s[2 * s2 + 1][1]); pw.w = pk2(s[2 * s2 + 1][2], s[2 * s2 + 1][3]);
            const bf16x8 pf = __builtin_bit_cast(bf16x8, pw);
#pragma unroll
            for (int dt = 0; dt < 16; ++dt) { const LAS bf16* vp = Vt + (16 * dt + r) * LDV + 32 * s2 + 4 * quad;
                const s16x4 lo = *(const LAS s16x4*)vp, hi4 = *(const LAS s16x4*)(vp + 16);
                o[dt] = mfma16(__builtin_shufflevector(lo, hi4, 0, 1, 2, 3, 4, 5, 6, 7), pf, o[dt]); }
        }
        bf16* op = O + row * D + h * 256 + 4 * quad;
#pragma unroll
        for (int dt = 0; dt < 16; ++dt) *(GAS v2u*)(op + 16 * dt) = (v2u){pk2(o[dt][0] * inv, o[dt][1] * inv), pk2(o[dt][2] * inv, o[dt][3] * inv)};
    }
}
template <class Epi> DI void run_gemm(Frame& F, const bf16* A, const bf16* Bt, int M_, int N_, int K_, const Epi& E) {
    pg8::Gemm g{A, Bt, M_, N_, K_}; pg8::StaticOrder S; S.init(M_, N_, F.G, F.wg);
    pg8::gemm_phase<Epi, pg8::StaticOrder, PG8_ALIGN, PG8_SP2>(F.lds, g, S, E, F.tid);
}
constexpr int NPHASE = 55, PH_FINAL = 54, PPL = 13;
struct Args { In in; float* out; unsigned char* ws; int ph_lo, ph_hi, region, pad; };
__global__ void __launch_bounds__(NTHR, 2) fwd(Args a) {
    extern __shared__ __attribute__((aligned(16))) unsigned char lds_raw[];
    Frame F;
    F.lds = (LAS unsigned char*)lds_raw;
    F.tid = threadIdx.x; F.lane = F.tid & 63; F.wave = __builtin_amdgcn_readfirstlane(F.tid >> 6);
    F.G = gridDim.x; F.wg = blockIdx.x; F.gw = F.wg * NWAVES + F.wave; F.NGW = F.G * NWAVES;
    volatile LAS unsigned* MISC = (volatile LAS unsigned*)(F.lds + MISC_OFF);
    if (F.tid < 32) MISC[F.tid] = 0u;
    __syncthreads();
    const int lo = a.ph_lo, hi = a.ph_hi;
    unsigned char* ws = a.ws; const In& I = a.in;
    XcdBarrier bar; bar.bar = (unsigned*)(ws + WS_CTL) + CW_BAR + a.region * XCD_BAR_WORDS; bar.x = 0; bar.st = MISC + 8;
    if (hi - lo > 1) bar = xcd_barrier_post(bar.bar, MISC + 8);
#define IN(k) (lo <= (k) && (k) < hi)
#ifndef PROBE_DOUBLE
#define PROBE_DOUBLE -1
#endif
#ifndef PROBE_PAR
#define PROBE_PAR -1
#endif
#define PHASE(k) asm volatile("" : "+v"(F.tid)); F.lane = F.tid & 63; if (IN(k))
#define DUPQ(c) ((c) == PROBE_DOUBLE && (PROBE_PAR < 0 || (l & 1) == PROBE_PAR))
#ifndef PROBE_SEL
#define PROBE_SEL -1
#endif
    F.tacc = 0ull;
    unsigned long long tacc = 0ull, tlast = (PROBE_SEL >= 0) ? __builtin_amdgcn_s_memrealtime() : 0ull;
#define SELQ(k) ((PROBE_SEL >= 0 && PROBE_SEL <= 12) ? ((k) >= 2 && (k) < PH_FINAL && ((k) - 2) % PPL == PROBE_SEL && (PROBE_PAR < 0 || ((((k) - 2) / PPL) & 1) == PROBE_PAR)) : (PROBE_SEL == 101 ? (k) == 0 : (PROBE_SEL == 102 ? (k) == 1 : (PROBE_SEL == 103 ? (k) == PH_FINAL : false))))
#define SEAM(k) do { if (IN(k) && IN((k) + 1)) { \
        if (PROBE_SEL >= 0) { const unsigned long long tn_ = __builtin_amdgcn_s_memrealtime(); if (SELQ(k)) tacc += tn_ - tlast; tlast = tn_; } \
        xcd_barrier(bar); \
        if (PROBE_SEL >= 0) { const unsigned long long tn_ = __builtin_amdgcn_s_memrealtime(); if (PROBE_SEL == 100 || (PROBE_SEL >= 200 && (k) >= 2 && (k) < PH_FINAL && ((k) - 2) % PPL == PROBE_SEL - 200 && (PROBE_PAR < 0 || ((((k) - 2) / PPL) & 1) == PROBE_PAR))) tacc += tn_ - tlast; tlast = tn_; } } } while (0)
    bf16* H = (bf16*)(ws + WS_H); bf16* MIX = (bf16*)(ws + WS_MIX); bf16* BIG = (bf16*)(ws + WS_BIG); bf16* KVX = (bf16*)(ws + WS_KVX);
    float* GATE = (float*)(ws + WS_GATE); const float* WG = (const float*)(ws + WS_WG);

    PHASE(0) { p0_prologue(F, I, ws);
#ifdef PROBE_P0
        p0_prologue(F, I, ws);
#endif
    }
    SEAM(0);
    PHASE(1) run_gemm(F, (const bf16*)(ws + WS_MEMN), (const bf16*)(ws + WS_WKV), BATCH * MEMLEN, 8192, D, pg8::EpiBf16<0>{KVX, 8192, nullptr});
    SEAM(1);
    for (int l = 0; l < DEPTH; ++l) {
        asm volatile("" : "+v"(F.tid)); F.lane = F.tid & 63;
        const int pb = 2 + PPL * l, j = l >> 1; const bool odd = (l & 1) != 0;
        unsigned char* wl = ws + WS_W + (size_t)l * W_LAYER;
        const float* xcur = (l == 0) ? I.p[0] : a.out;
        PHASE(pb + 0) {
            if (!odd) norm_phase<1>(F, xcur, I.p[2] + l * D, H, WG + l * 16384, GATE, I.p[4] + j * 4, I.p[5] + j * 4);
            else norm_phase<2>(F, xcur, I.p[2] + l * D, H, WG + l * 16384, GATE, I.p[10] + j * 8, I.p[11] + j * 8);
        }
        SEAM(pb + 0);
        PHASE(pb + 1) { const int n = odd ? C_N : AB_N; run_gemm(F, H, (const bf16*)(wl + WO_WIN), M, n, D, pg8::EpiBlk{BIG, odd ? (bf16*)(ws + WS_MIX + MIX_HALO) : nullptr, odd ? 2 : 1}); if (DUPQ(1)) { run_gemm(F, H, (const bf16*)(wl + WO_WIN), M, n, D, pg8::EpiBlk{BIG, odd ? (bf16*)(ws + WS_MIX + MIX_HALO) : nullptr, odd ? 2 : 1}); } }
        SEAM(pb + 1);
        PHASE(pb + 2) {
            if (!odd) {
                const int gh = F.G >= 64 ? 32 : F.G / 2;
                if (F.wg < gh) { for (int c = F.wg; c < 32; c += gh) mlstm_chunked(F, BIG, GATE, I.p[6] + j * 512, MIX, c); }
                else { for (int u = F.wg - gh; u < 2048; u += F.G - gh) sb_unit(F, BIG, MIX, u); }
            } else {
#ifdef PROBE_G1
                gdn_g1_phase(F, BIG, (const bf16*)(ws + WS_MIX + MIX_HALO), GATE, I.p[9] + (size_t)j * 4 * 3072, H, (bf16*)(ws + WS_MIX + MIX_AT), (float*)(ws + WS_MIX + MIX_GL), a.pad != 0);
#endif
                gdn_g1_phase(F, BIG, (const bf16*)(ws + WS_MIX + MIX_HALO), GATE, I.p[9] + (size_t)j * 4 * 3072, H, (bf16*)(ws + WS_MIX + MIX_AT), (float*)(ws + WS_MIX + MIX_GL), true);
            }
        }
        SEAM(pb + 2);
        PHASE(pb + 3) { if (odd) { for (int c0_ = F.wg; c0_ < 256; c0_ += F.G) { const int c = (F.G == 256) ? ((((c0_ >> 3) >> 2) * 8 + (c0_ & 7)) * 4 + ((c0_ >> 3) & 3)) : c0_;
            gdn_g2_chain(F, BIG, H, (const bf16*)(ws + WS_MIX + MIX_AT), (const float*)(ws + WS_MIX + MIX_GL), c, true); } }
#ifdef PROBE_G2
            if (odd) { for (int c = F.wg; c < 256; c += F.G) gdn_g2_chain(F, BIG, H, (const bf16*)(ws + WS_MIX + MIX_AT), (const float*)(ws + WS_MIX + MIX_GL), c, a.pad != 0); }
#endif
        }
        if (odd) SEAM(pb + 3);
        PHASE(pb + 4) { if (odd) headnorm_phase<true>(F, H, MIX, BIG, I.p[12] + j * 128); }
        if (odd) SEAM(pb + 4);
        PHASE(pb + 5) { run_gemm(F, MIX, (const bf16*)(wl + WO_WOUT), M, D, D, pg8::EpiResid{xcur, a.out, D}); if (DUPQ(5)) { run_gemm(F, MIX, (const bf16*)(wl + WO_WOUT), M, D, D, pg8::EpiResid{xcur, a.out, D}); } }
        SEAM(pb + 5);
        PHASE(pb + 6) { norm_phase<0>(F, a.out, I.p[14] + l * D, H, nullptr, nullptr, nullptr, nullptr); if (DUPQ(6)) { norm_phase<0>(F, a.out, I.p[14] + l * D, H, nullptr, nullptr, nullptr, nullptr); } }
        SEAM(pb + 6);
        PHASE(pb + 7) { run_gemm(F, H, (const bf16*)(wl + WO_WQ), M, D, D, pg8::EpiBf16<0>{BIG, D, nullptr}); if (DUPQ(7)) { run_gemm(F, H, (const bf16*)(wl + WO_WQ), M, D, D, pg8::EpiBf16<0>{BIG, D, nullptr}); } }
        SEAM(pb + 7);
        PHASE(pb + 8) { xattn_phase(F, BIG, KVX, l, MIX); if (DUPQ(8)) { xattn_phase(F, BIG, KVX, l, MIX); } }
        SEAM(pb + 8);
        PHASE(pb + 9) { run_gemm(F, MIX, (const bf16*)(wl + WO_WO), M, D, D, pg8::EpiResid{a.out, a.out, D}); if (DUPQ(9)) { run_gemm(F, MIX, (const bf16*)(wl + WO_WO), M, D, D, pg8::EpiResid{a.out, a.out, D}); } }
        SEAM(pb + 9);
        PHASE(pb + 10) { norm_phase<0>(F, a.out, I.p[20] + l * D, H, nullptr, nullptr, nullptr, nullptr); if (DUPQ(10)) { norm_phase<0>(F, a.out, I.p[20] + l * D, H, nullptr, nullptr, nullptr, nullptr); } }
        SEAM(pb + 10);
        PHASE(pb + 11) { run_gemm(F, H, (const bf16*)(wl + WO_W1), M, FF, D, pg8::EpiBf16<2>{BIG, FF, nullptr}); if (DUPQ(11)) { run_gemm(F, H, (const bf16*)(wl + WO_W1), M, FF, D, pg8::EpiBf16<2>{BIG, FF, nullptr}); } }
        SEAM(pb + 11);
        PHASE(pb + 12) {
#ifdef PROBE_W2
            run_gemm(F, BIG, (const bf16*)(wl + WO_W2), M, D, FF, pg8::EpiResid{a.out, (float*)(ws + WS_H), D});
#endif
            run_gemm(F, BIG, (const bf16*)(wl + WO_W2), M, D, FF, pg8::EpiResid{a.out, a.out, D}); if (DUPQ(12)) { run_gemm(F, BIG, (const bf16*)(wl + WO_W2), M, D, FF, pg8::EpiResid{a.out, a.out, D}); } }
        SEAM(pb + 12);
    }
    PHASE(PH_FINAL) final_norm_phase(F, a.out, I.p[23]);
    if (PROBE_SEL >= 0) { const unsigned long long te = __builtin_amdgcn_s_memrealtime(); if (SELQ(PH_FINAL)) tacc += te - tlast;

#ifdef PROBE_WGLO
        if (!(F.wg >= PROBE_WGLO && F.wg < PROBE_WGHI)) tacc = 0ull;
#endif
        if (PROBE_STG >= 0) tacc = F.tacc;
        while (__builtin_amdgcn_s_memrealtime() - te < tacc) __builtin_amdgcn_s_sleep(16); }
#undef IN
#undef PHASE
#undef SEAM
}

#ifndef MK_SPLIT
#define MK_SPLIT 0
#endif
extern "C" void kernel_launch(void* const* d_in, const int* in_sizes, int n_in, void* d_out, int out_size, void* d_ws, size_t ws_size, hipStream_t stream) {
    static int grid = 0;
    if (grid == 0) {
        if (n_in != 24 || in_sizes[0] != M * D || out_size != M * D || ws_size < WS_END) { fprintf(stderr, "kernel_launch: unexpected shapes (n_in %d, in0 %d, out %d, ws %zu)\n", n_in, n_in > 0 ? in_sizes[0] : -1, out_size, ws_size); grid = -1; return; }
        int dev = 0, cus = 0;
        if (hipGetDevice(&dev) != hipSuccess || hipDeviceGetAttribute(&cus, hipDeviceAttributeMultiprocessorCount, dev) != hipSuccess) { grid = -1; return; }
        if (hipFuncSetAttribute((const void*)fwd, hipFuncAttributeMaxDynamicSharedMemorySize, LDS_BYTES) != hipSuccess) { fprintf(stderr, "kernel_launch: hipFuncSetAttribute failed\n"); grid = -1; return; }
        (void)hipGetLastError();
        grid = cus;
    }
    if (grid < 0) return;
    (void)hipMemsetAsync((char*)d_ws + WS_CTL, 0, CTL_ZERO_BYTES, stream);
    Args a{};
    for (int i = 0; i < 24; ++i) a.in.p[i] = (const float*)d_in[i];
    a.out = (float*)d_out; a.ws = (unsigned char*)d_ws; a.region = 0; a.pad = 0;
#if MK_SPLIT
    for (int p = 0; p < NPHASE; ++p) { a.ph_lo = p; a.ph_hi = p + 1; hipLaunchKernelGGL(fwd, dim3(grid), dim3(NTHR), LDS_BYTES, stream, a); }
#else
    a.ph_lo = 0; a.ph_hi = NPHASE; hipLaunchKernelGGL(fwd, dim3(grid), dim3(NTHR), LDS_BYTES, stream, a);
#endif
}
```

```cpp
#include <hip/hip_runtime.h>
#include <cstdio>
#include <cstdint>
namespace pg8 {
#define PG8_LAS __attribute__((address_space(3)))
typedef unsigned short bf16_t;
typedef short bf16x8 __attribute__((ext_vector_type(8)));
typedef float f32x4 __attribute__((ext_vector_type(4)));
typedef unsigned u32x4 __attribute__((ext_vector_type(4)));
constexpr int BM = 256, BK = 64, HALF = 128, HTB = HALF * BK * 2  , STAGE_BYTES = 8 * HTB, NXCD = 8, WGM = 8;

__host__ __device__ __forceinline__ int lds_byte(int r, int c) { const int st = (r >> 4) * 2 + (c >> 5), rr = r & 15, cc = c & 31, ob = rr * 64 + cc * 2; return st * 1024 + (ob ^ (((ob >> 9) & 1) << 5)); }
__host__ __device__ __forceinline__ void stage_rc(int b, int& R, int& C) { const int st = b / 1024, sb = b % 1024, swz = sb ^ (((sb >> 9) & 1) << 5); R = (st >> 1) * 16 + swz / 64; C = (st & 1) * 32 + (swz % 64) / 2; }
__host__ __device__ __forceinline__ int perm32(int rho) { const int n = rho >> 4, i = rho & 15; return 8 * (i >> 2) + 4 * n + (i & 3); }

struct Unit { int pm, pn; };
struct Gemm { const bf16_t* A; const bf16_t* Bt; int M, N, K; };

struct StaticOrder {
    int nM, nN, nwg, G, c;
    __host__ __device__ void init(int M, int N, int G_, int c_) { nM = M / BM; nN = N / BM; nwg = nM * nN; G = G_; c = c_; }
    __host__ __device__ bool next(int i, Unit& u) const {
        const long L = (long)i * G + c; if (L >= nwg) return false;
        int wgid = (int)L; { const int q = nwg / NXCD, r = nwg % NXCD, xcd = wgid % NXCD, off = wgid / NXCD; wgid = (xcd < r ? xcd * (q + 1) : r * (q + 1) + (xcd - r) * q) + off; }
        const int nig = WGM * nN, gid = wgid / nig, fm = gid * WGM, gsz = (nM - fm) < WGM ? (nM - fm) : WGM;
        u.pm = fm + ((wgid % nig) % gsz); u.pn = (wgid % nig) / gsz; return true;
    }
    __device__ __forceinline__ void a_ready(const Unit&) const {}
    __device__ __forceinline__ void done(const Unit&) const {}
};

__device__ __forceinline__ unsigned cvt_pk_bf16(float lo, float hi) { unsigned r; asm volatile("v_cvt_pk_bf16_f32 %0, %1, %2" : "=v"(r) : "v"(lo), "v"(hi)); return r; }
typedef unsigned long long rs_t;
__device__ __forceinline__ rs_t rs_fix(float ss) { return (rs_t)(ss * 16777216.0f + 0.5f); }
__device__ __forceinline__ float row_rstd(const rs_t* rs, int row) { return __builtin_amdgcn_rsqf((float)__hip_atomic_load(rs + row, __ATOMIC_RELAXED, __HIP_MEMORY_SCOPE_AGENT) * (1.0f / (16777216.0f * 1024.0f)) + 1e-6f); }
template <int ACT> struct EpiBf16 {
    static constexpr bool PERM = true, AFTER_DRAIN = false;
    bf16_t* O; int ldc; const rs_t* rs;
    __device__ __forceinline__ void operator()(const f32x4 (&acc)[2][2][4][2], const Unit& u, int wr, int wc, int fr, int fq) const {
        const int row0 = u.pm * BM + wr * 64 + fr; const int col0 = u.pn * BM + wc * 32 + 8 * fq;
#pragma unroll
        for (int ai = 0; ai < 2; ++ai)
#pragma unroll
            for (int m = 0; m < 4; ++m) { bf16_t* rowp = O + (size_t)(row0 + ai * HALF + m * 16) * ldc + col0;
                const float sc = rs ? row_rstd(rs, row0 + ai * HALF + m * 16) : 1.0f;
#pragma unroll
                for (int bj = 0; bj < 2; ++bj) { f32x4 v0 = acc[ai][bj][m][0] * sc, v1 = acc[ai][bj][m][1] * sc;
                    if (ACT == 2) {
#pragma unroll
                        for (int j = 0; j < 4; ++j) { const float a = fmaxf(v0[j], 0.f), b = fmaxf(v1[j], 0.f); v0[j] = a * a; v1[j] = b * b; } }
                    u32x4 w; w.x = cvt_pk_bf16(v0[0], v0[1]); w.y = cvt_pk_bf16(v0[2], v0[3]); w.z = cvt_pk_bf16(v1[0], v1[1]); w.w = cvt_pk_bf16(v1[2], v1[3]);
                    *(u32x4*)(rowp + bj * HALF) = w; }
                if (m & 1) asm volatile("" ::: "memory"); }
    }
};

struct EpiBlk {
    static constexpr bool PERM = true, AFTER_DRAIN = false;
    bf16_t* O; bf16_t* halo; int LAYOUT; const rs_t* rs;
    __device__ __forceinline__ void operator()(const f32x4 (&acc)[2][2][4][2], const Unit& u, int wr, int wc, int fr, int fq) const {
        constexpr int TT = 8192; constexpr size_t MTOT = 65536;
        const int row0 = u.pm * BM + wr * 64 + fr; const int b = row0 >> 13, t0 = row0 & (TT - 1);
        const int col0 = u.pn * BM + wc * 32 + 8 * fq;
        const bool dohalo = (LAYOUT == 2) && (halo != nullptr) && (fr >= 13) && (u.pn < 12);
        size_t base[2]; int wv[2];
#pragma unroll
        for (int bj = 0; bj < 2; ++bj) {
            const int cb = u.pn * BM + bj * HALF + wc * 32;
            if (LAYOUT == 2) { const int c0 = cb & ~1023, h = (cb >> 7) & 7; wv[bj] = 128; base[bj] = MTOT * c0 + (size_t)((b * 8 + h) * TT) * 128 + (cb & 127) + 8 * fq; }
            else if (cb < 512) { const int c0 = cb & ~255, h = (cb >> 6) & 3; wv[bj] = 64; base[bj] = MTOT * c0 + (size_t)((b * 4 + h) * TT) * 64 + (cb & 63) + 8 * fq; }
            else { const int c0 = 512 + ((cb - 512) & ~511), h = ((cb - 512) >> 7) & 3; wv[bj] = 128; base[bj] = MTOT * c0 + (size_t)((b * 4 + h) * TT) * 128 + (cb & 127) + 8 * fq; }
        }
#pragma unroll
        for (int ai = 0; ai < 2; ++ai)
#pragma unroll
            for (int m = 0; m < 4; ++m) { const int t = t0 + ai * HALF + m * 16; const float sc = row_rstd(rs, row0 + ai * HALF + m * 16);
#pragma unroll
                for (int bj = 0; bj < 2; ++bj) {
                    const f32x4 v0 = acc[ai][bj][m][0] * sc, v1 = acc[ai][bj][m][1] * sc;
                    u32x4 ww; ww.x = cvt_pk_bf16(v0[0], v0[1]); ww.y = cvt_pk_bf16(v0[2], v0[3]); ww.z = cvt_pk_bf16(v1[0], v1[1]); ww.w = cvt_pk_bf16(v1[2], v1[3]);
                    *(u32x4*)(O + base[bj] + (size_t)t * wv[bj]) = ww;
                    if (m == 3 && dohalo) *(u32x4*)(halo + ((size_t)((row0 + ai * HALF + 48) >> 6) * 3 + (fr - 13)) * 3072 + col0 + bj * HALF) = ww; }
                if (m & 1) asm volatile("" ::: "memory"); }
    }
};
struct EpiResidN {
    static constexpr bool PERM = false, AFTER_DRAIN = false;
    const float* base; float* out; bf16_t* xb; rs_t* rs;
    __device__ __forceinline__ void operator()(const f32x4 (&acc)[2][2][4][2], const Unit& u, int wr, int wc, int fr, int fq) const {
        const int row0 = u.pm * BM + wr * 64 + fr, col0 = u.pn * BM + wc * 32 + 4 * fq;
#pragma unroll
        for (int ai = 0; ai < 2; ++ai)
#pragma unroll
            for (int m = 0; m < 4; ++m) { const int row = row0 + ai * HALF + m * 16; const size_t off = (size_t)row * 1024 + col0; float ss = 0.f;
#pragma unroll
                for (int bj = 0; bj < 2; ++bj)
#pragma unroll
                    for (int n = 0; n < 2; ++n) { const f32x4 bs = *(const f32x4*)(base + off + bj * HALF + n * 16); const f32x4 o = bs + acc[ai][bj][m][n];
                        *(f32x4*)(out + off + bj * HALF + n * 16) = o; ss += (o[0] * o[0] + o[1] * o[1]) + (o[2] * o[2] + o[3] * o[3]);
                        typedef unsigned u32x2_ __attribute__((ext_vector_type(2))); u32x2_ w; w.x = cvt_pk_bf16(o[0], o[1]); w.y = cvt_pk_bf16(o[2], o[3]);
                        *(u32x2_*)(xb + off + bj * HALF + n * 16) = w; }
                ss += __shfl_xor(ss, 16); ss += __shfl_xor(ss, 32);
                if (fq == 0) __hip_atomic_fetch_add(rs + row, rs_fix(ss), __ATOMIC_RELAXED, __HIP_MEMORY_SCOPE_AGENT);
                if (m & 1) asm volatile("" ::: "memory"); }
    }
};
struct EpiResid {
    static constexpr bool PERM = false, AFTER_DRAIN = false;
    const float* base; float* out; int ldc;
    __device__ __forceinline__ void operator()(const f32x4 (&acc)[2][2][4][2], const Unit& u, int wr, int wc, int fr, int fq) const {
        const int row0 = u.pm * BM + wr * 64 + fr, col0 = u.pn * BM + wc * 32 + 4 * fq;
#pragma unroll
        for (int ai = 0; ai < 2; ++ai)
#pragma unroll
            for (int m = 0; m < 4; ++m) { const size_t off = (size_t)(row0 + ai * HALF + m * 16) * ldc + col0;
#pragma unroll
                for (int bj = 0; bj < 2; ++bj)
#pragma unroll
                    for (int n = 0; n < 2; ++n) { const f32x4 bs = *(const f32x4*)(base + off + bj * HALF + n * 16); *(f32x4*)(out + off + bj * HALF + n * 16) = bs + acc[ai][bj][m][n]; }
                if (m & 1) asm volatile("" ::: "memory"); }
    }
};
template <class Epi, class Sched, bool ALIGN_EPI = false, bool SP2 = false>
__device__ __forceinline__ void gemm_phase(PG8_LAS unsigned char* lds, const Gemm g, const Sched& S, const Epi& E, int tid_in) {
    int tid_ = tid_in; asm volatile("" : "+v"(tid_)); const int tid = tid_, wid = __builtin_amdgcn_readfirstlane(tid >> 6), lane = tid & 63, wr = wid >> 2, wc = wid & 3, fr = lane & 15, fq = lane >> 4;
    const int K = g.K, nt = K / BK;
    unsigned voffA[2], voffB[2];
#pragma unroll
    for (int i = 0; i < 2; ++i) { int R, C; stage_rc(tid * 16 + i * 8192, R, C); const int Rb = Epi::PERM ? ((R & ~31) + perm32(R & 31)) : R;
        voffA[i] = (unsigned)(R * K + C) * 2u; voffB[i] = (unsigned)(Rb * K + C) * 2u; }
    const size_t kstep = (size_t)(BK * 2);
    const size_t hstep = (size_t)HALF * K * 2;
    const size_t tstep = 2 * hstep;
    const unsigned ldsw = (unsigned)wid * 1024u;
    const int aoff = lds_byte(wr * 64 + fr, fq * 8), boff = lds_byte(wc * 32 + fr, fq * 8);
#define PG8_SA(b, h) (((b) * 2 + (h)) * HTB)
#define PG8_SB(b, h) ((4 + (b) * 2 + (h)) * HTB)
#define PG8_STAGE(bufoff, gbase, voff) do { _Pragma("unroll") for (int _i = 0; _i < 2; ++_i) \
        __builtin_amdgcn_global_load_lds((const unsigned*)((const char*)(gbase) + (voff)[_i]), (PG8_LAS unsigned*)(lds + (bufoff) + ldsw + _i * 8192), 16, 0, 0); } while (0)
#define PG8_LDA(dst, b, h) do { _Pragma("unroll") for (int m = 0; m < 4; ++m) _Pragma("unroll") for (int k = 0; k < 2; ++k) dst[m][k] = *(const PG8_LAS bf16x8*)(lds + PG8_SA(b, h) + aoff + m * 2048 + k * 1024); } while (0)
#define PG8_LDB(dst, b, h) do { _Pragma("unroll") for (int n = 0; n < 2; ++n) _Pragma("unroll") for (int k = 0; k < 2; ++k) dst[n][k] = *(const PG8_LAS bf16x8*)(lds + PG8_SB(b, h) + boff + n * 2048 + k * 1024); } while (0)
#define PG8_MMA(ai, bj, At, Bt) do { __builtin_amdgcn_s_setprio(1); _Pragma("unroll") for (int m = 0; m < 4; ++m) _Pragma("unroll") for (int n = 0; n < 2; ++n) _Pragma("unroll") for (int k = 0; k < 2; ++k) \
        acc[ai][bj][m][n] = __builtin_amdgcn_mfma_f32_16x16x32_bf16(Bt[n][k], At[m][k], acc[ai][bj][m][n], 0, 0, 0); __builtin_amdgcn_s_setprio(0); } while (0)
#define PG8_WAIT_V(n) asm volatile("s_waitcnt vmcnt(" #n ")" ::: "memory")
#define PG8_WAIT_L(n) asm volatile("s_waitcnt lgkmcnt(" #n ")" ::: "memory")
#define PG8_BAR __builtin_amdgcn_s_barrier()
#define PG8_SCHED __builtin_amdgcn_sched_barrier(0)
    Unit cur, nxt; int ui = 0;
    if (!S.next(0, cur)) return;
    f32x4 acc[2][2][4][2];
#pragma unroll
    for (int a = 0; a < 2; ++a)
#pragma unroll
        for (int b = 0; b < 2; ++b)
#pragma unroll
            for (int m = 0; m < 4; ++m)
#pragma unroll
                for (int n = 0; n < 2; ++n) acc[a][b][m][n] = (f32x4){0.f, 0.f, 0.f, 0.f};
    bf16x8 At[4][2], B0[2][2], B1[2][2];
    const char* cA = (const char*)g.A + (size_t)cur.pm * tstep; const char* cB = (const char*)g.Bt + (size_t)cur.pn * tstep;
    S.a_ready(cur);
    if constexpr (SP2) {
        PG8_STAGE(PG8_SB(0, 0), cB, voffB); PG8_STAGE(PG8_SB(0, 1), cB + hstep, voffB); PG8_STAGE(PG8_SA(0, 0), cA, voffA); PG8_STAGE(PG8_SA(0, 1), cA + hstep, voffA);
        if (wr == 1) PG8_BAR;
        PG8_WAIT_V(2); PG8_BAR;
        PG8_STAGE(PG8_SB(1, 0), cB + kstep, voffB); PG8_STAGE(PG8_SA(1, 0), cA + kstep, voffA); PG8_STAGE(PG8_SB(1, 1), cB + hstep + kstep, voffB);
        PG8_WAIT_V(6); PG8_BAR;
    } else {
        PG8_STAGE(PG8_SB(0, 0), cB, voffB); PG8_STAGE(PG8_SA(0, 0), cA, voffA); PG8_STAGE(PG8_SB(0, 1), cB + hstep, voffB); PG8_STAGE(PG8_SA(0, 1), cA + hstep, voffA);
        if (wr == 1) PG8_BAR;
        PG8_WAIT_V(4); PG8_BAR;
        PG8_STAGE(PG8_SB(1, 0), cB + kstep, voffB); PG8_STAGE(PG8_SA(1, 0), cA + kstep, voffA); PG8_STAGE(PG8_SB(1, 1), cB + hstep + kstep, voffB);
        PG8_WAIT_V(6); PG8_BAR;
    }
    for (;;) {
        const bool has_next = S.next(ui + 1, nxt);
        const char* nA = has_next ? (const char*)g.A + (size_t)nxt.pm * tstep : cA; const char* nB = has_next ? (const char*)g.Bt + (size_t)nxt.pn * tstep : cB;
        for (int t = 0; t < nt; t += 2) {
            const bool last = (t == nt - 2);
            const char* a1 = cA + (size_t)(t + 1) * kstep;
            const char* a2 = last ? nA : cA + (size_t)(t + 2) * kstep; const char* b2 = last ? nB : cB + (size_t)(t + 2) * kstep;
            const char* a3 = a2 + kstep; const char* b3 = b2 + kstep;
            if (last && has_next) S.a_ready(nxt);
            if constexpr (SP2) {
            PG8_LDB(B0, 0, 0); PG8_LDB(B1, 0, 1); PG8_SCHED; PG8_LDA(At, 0, 0); PG8_STAGE(PG8_SA(1, 1), a1 + hstep, voffA);
            PG8_WAIT_V(8); PG8_WAIT_L(0); PG8_BAR; PG8_MMA(0, 0, At, B0); PG8_MMA(0, 1, At, B1); PG8_BAR; PG8_SCHED;
            PG8_LDA(At, 0, 1); PG8_STAGE(PG8_SB(0, 0), b2, voffB); PG8_STAGE(PG8_SB(0, 1), b2 + hstep, voffB); PG8_STAGE(PG8_SA(0, 0), a2, voffA);
            PG8_WAIT_V(8); PG8_WAIT_L(0); PG8_BAR; PG8_MMA(1, 0, At, B0); PG8_MMA(1, 1, At, B1); PG8_BAR; PG8_SCHED;
            PG8_LDB(B0, 1, 0); PG8_LDB(B1, 1, 1); PG8_SCHED; PG8_LDA(At, 1, 0); PG8_STAGE(PG8_SA(0, 1), a2 + hstep, voffA);
            PG8_WAIT_V(8); PG8_WAIT_L(0); PG8_BAR; PG8_MMA(0, 0, At, B0); PG8_MMA(0, 1, At, B1); PG8_BAR; PG8_SCHED;
            PG8_LDA(At, 1, 1); PG8_STAGE(PG8_SB(1, 0), b3, voffB); PG8_STAGE(PG8_SB(1, 1), b3 + hstep, voffB); PG8_STAGE(PG8_SA(1, 0), a3, voffA);
            PG8_WAIT_V(8); PG8_WAIT_L(0); PG8_BAR; PG8_MMA(1, 0, At, B0); PG8_MMA(1, 1, At, B1); PG8_BAR; PG8_SCHED;
            } else {
            PG8_LDB(B0, 0, 0); PG8_SCHED; PG8_LDA(At, 0, 0); PG8_STAGE(PG8_SA(1, 1), a1 + hstep, voffA);
            PG8_WAIT_L(8); PG8_BAR; PG8_WAIT_L(0); PG8_MMA(0, 0, At, B0); PG8_BAR; PG8_SCHED;
            PG8_LDB(B1, 0, 1); PG8_STAGE(PG8_SB(0, 0), b2, voffB);
            PG8_BAR; PG8_WAIT_L(0); PG8_MMA(0, 1, At, B1); PG8_BAR;
            PG8_LDA(At, 0, 1); PG8_STAGE(PG8_SA(0, 0), a2, voffA);
            PG8_BAR; PG8_WAIT_L(0); PG8_MMA(1, 0, At, B0); PG8_BAR; PG8_SCHED;
            PG8_STAGE(PG8_SB(0, 1), b2 + hstep, voffB);
            PG8_WAIT_V(6); PG8_BAR; PG8_MMA(1, 1, At, B1); PG8_BAR;
            PG8_LDB(B0, 1, 0); PG8_SCHED; PG8_LDA(At, 1, 0); PG8_STAGE(PG8_SA(0, 1), a2 + hstep, voffA);
            PG8_WAIT_L(8); PG8_BAR; PG8_WAIT_L(0); PG8_MMA(0, 0, At, B0); PG8_BAR; PG8_SCHED;
            PG8_LDB(B1, 1, 1); PG8_STAGE(PG8_SB(1, 0), b3, voffB);
            PG8_BAR; PG8_WAIT_L(0); PG8_MMA(0, 1, At, B1); PG8_BAR;
            PG8_LDA(At, 1, 1); PG8_STAGE(PG8_SA(1, 0), a3, voffA);
            PG8_BAR; PG8_WAIT_L(0); PG8_MMA(1, 0, At, B0); PG8_BAR; PG8_SCHED;
            PG8_STAGE(PG8_SB(1, 1), b3 + hstep, voffB);
            PG8_WAIT_V(6); PG8_BAR; PG8_MMA(1, 1, At, B1); PG8_BAR;
            }
        }
        if constexpr (ALIGN_EPI) { if (wr == 0) PG8_BAR; }
        if constexpr (!Epi::AFTER_DRAIN) { E(acc, cur, wr, wc, fr, fq); S.done(cur); }
        if (!has_next) break;
#pragma unroll
        for (int a = 0; a < 2; ++a)
#pragma unroll
            for (int b = 0; b < 2; ++b)
#pragma unroll
                for (int m = 0; m < 4; ++m)
#pragma unroll
                    for (int n = 0; n < 2; ++n) acc[a][b][m][n] = (f32x4){0.f, 0.f, 0.f, 0.f};
        cur = nxt; cA = nA; cB = nB; ++ui;
        if constexpr (ALIGN_EPI) { if (wr == 1) PG8_BAR; }
    }
    PG8_WAIT_V(0);
    if constexpr (!ALIGN_EPI) { if (wr == 0) PG8_BAR; }
    PG8_BAR;
    if constexpr (Epi::AFTER_DRAIN) { E.fused(acc, cur, wr, wc, fr, fq, lds, wid, lane); S.done(cur); }
#undef PG8_SA
#undef PG8_SB
#undef PG8_STAGE
#undef PG8_LDA
#undef PG8_LDB
#undef PG8_MMA
#undef PG8_WAIT_V
#undef PG8_WAIT_L
#undef PG8_BAR
#undef PG8_SCHED
}
}
#ifndef PG8_SP2
#define PG8_SP2 true
#endif
#ifndef PG8_ALIGN
#define PG8_ALIGN true
#endif
constexpr int NWAVES = 8, NTHR = 512;
constexpr int BATCH = 8, T = 8192, D = 1024, DEPTH = 4, MEMLEN = 256, FF = 4096;
constexpr int M = BATCH * T;
constexpr int AB_IN = 3080, AB_N = 3072, C_IN = 4112, C_N = 4096;
constexpr float EPS = 1e-6f;
constexpr float SB_THR = 88.0f;

constexpr size_t MiB = 1u << 20;
constexpr size_t WS_CTL = 0, CTL_ZERO_BYTES = 1 * MiB;
constexpr size_t WS_WG = 1 * MiB;
constexpr size_t WS_MEMN = 2 * MiB;
constexpr size_t WS_WKV = 6 * MiB;
constexpr size_t WS_W = 22 * MiB, W_LAYER = 30 * MiB;
constexpr size_t WO_WIN = 0, WO_WOUT = 8 * MiB, WO_WQ = 10 * MiB, WO_WO = 12 * MiB, WO_W1 = 14 * MiB, WO_W2 = 22 * MiB;
constexpr size_t WS_KVX = 142 * MiB;
constexpr size_t WS_GATE = 174 * MiB;
constexpr size_t WS_H = 178 * MiB;
constexpr size_t WS_MIX = 306 * MiB;
constexpr size_t WS_BIG = 434 * MiB;
constexpr size_t WS_RS = 946 * MiB;
constexpr size_t WS_END = 950 * MiB;
constexpr int CW_TMO = 0, CW_BAR = 4096;

constexpr int LDS_BYTES = 147456;
constexpr int MISC_OFF = 140 * 1024;

#define GAS __attribute__((address_space(1)))
#define LAS __attribute__((address_space(3)))
#define DI __device__ __forceinline__
typedef unsigned short bf16;
typedef unsigned v4u __attribute__((ext_vector_type(4)));
typedef unsigned v2u __attribute__((ext_vector_type(2)));
typedef float f32x4 __attribute__((ext_vector_type(4)));
typedef short bf16x8 __attribute__((ext_vector_type(8)));
typedef short s16x4 __attribute__((ext_vector_type(4)));
#define LDS_WAIT() asm volatile("s_waitcnt lgkmcnt(0)" ::: "memory")
typedef float f32x2_ __attribute__((ext_vector_type(2)));
typedef __bf16 bf16x2_ __attribute__((ext_vector_type(2)));
DI unsigned pk2(float lo, float hi) { const f32x2_ v = {lo, hi}; return __builtin_bit_cast(unsigned, __builtin_convertvector(v, bf16x2_)); }
DI unsigned f2bf(float f) { return pk2(f, f) & 0xffffu; }
DI float bf2f(unsigned short b) { return __builtin_bit_cast(float, ((unsigned)b) << 16); }
DI float bflo(unsigned u) { return __builtin_bit_cast(float, u << 16); }
DI float bfhi(unsigned u) { return __builtin_bit_cast(float, u & 0xffff0000u); }
DI float wave_sum(float v) {
#pragma unroll
    for (int o = 1; o < 64; o <<= 1) v += __shfl_xor(v, o);
    return v;
}
DI float rcp_(float x) { return __builtin_amdgcn_rcpf(x); }
DI float rsq_(float x) { return __builtin_amdgcn_rsqf(x); }
DI float sigmoidf_(float x) { return rcp_(1.0f + __expf(-x)); }
DI void lds_barrier() { asm volatile("s_waitcnt lgkmcnt(0)" ::: "memory"); __builtin_amdgcn_s_barrier(); asm volatile("" ::: "memory"); }
#ifndef PROBE_STG
#define PROBE_STG -1
#endif
#define STG_T0() unsigned long long stg_t_ = (PROBE_STG >= 0) ? __builtin_amdgcn_s_memrealtime() : 0ull
#define STG(n) do { if (PROBE_STG >= 0) { const unsigned long long t_ = __builtin_amdgcn_s_memrealtime(); if (PROBE_STG == (n)) F.tacc += t_ - stg_t_; stg_t_ = t_; } } while (0)
DI f32x4 mfma16(bf16x8 a, bf16x8 b, f32x4 c) { return __builtin_amdgcn_mfma_f32_16x16x32_bf16(a, b, c, 0, 0, 0); }
#define XB_TMO      128
#define XB_XCNT(j)  (256  + 64 * (j))
#define XB_XSUB(j)  (1280 + 64 * (j))
#define XB_XGEN(j)  (2304 + 64 * (j))
#define XB_TOP      3328
#define XB_TOPGEN   3392
#define XCD_BAR_WORDS 3456
#define XB_SPIN_CAP (1u << 22)

__device__ __forceinline__ unsigned xb_ld(unsigned* p)              { return __hip_atomic_load(p, __ATOMIC_RELAXED, __HIP_MEMORY_SCOPE_AGENT); }
__device__ __forceinline__ unsigned xb_add(unsigned* p, unsigned v) { return __hip_atomic_fetch_add(p, v, __ATOMIC_RELAXED, __HIP_MEMORY_SCOPE_AGENT); }
__device__ __forceinline__ unsigned xb_xcc_id() { return (unsigned)__builtin_amdgcn_s_getreg((3 << 11) | 20) & 0xFu; }
#define XB_SPIN(cond, bar) do { unsigned _sp = 0; while (cond) { __builtin_amdgcn_s_sleep(1); \
    if ((++_sp & 255u) == 0u) { if (xb_ld(&(bar)[XB_TMO])) break; if (_sp > XB_SPIN_CAP) { atomicAdd(&(bar)[XB_TMO], 1u); break; } } } } while (0)

struct XcdBarrier {
    unsigned* bar; unsigned x;
    volatile LAS unsigned* st;
};

__device__ __forceinline__ XcdBarrier xcd_barrier_post(unsigned* bar, volatile LAS unsigned* st) {
    XcdBarrier b; b.bar = bar; b.x = xb_xcc_id(); b.st = st;
    if (threadIdx.x == 0) (void)xb_add(&bar[XB_XCNT(b.x)], 1u);
    return b;
}
__device__ __forceinline__ void xcd_barrier_complete(unsigned* bar, unsigned x, unsigned& nloc, unsigned& nx) {
    const unsigned G = gridDim.x * gridDim.y * gridDim.z;
    unsigned sum, cnt, mine, sp = 0u;
    for (;;) {
        sum = 0u; cnt = 0u; mine = 0u;
#pragma unroll
        for (unsigned j = 0; j < 16; ++j) { const unsigned c = xb_ld(&bar[XB_XCNT(j)]); sum += c; cnt += (c > 0u) ? 1u : 0u; mine = (j == x) ? c : mine; }
        if (sum == G) break;
        __builtin_amdgcn_s_sleep(1);
        if ((++sp & 255u) == 0u) { if (xb_ld(&bar[XB_TMO])) break; if (sp > XB_SPIN_CAP) { atomicAdd(&bar[XB_TMO], 1u); break; } }
    }
    nloc = mine > 0u ? mine : 1u; nx = cnt > 0u ? cnt : 1u;
}

__device__ __forceinline__ void xcd_barrier(const XcdBarrier& b) {
    asm volatile("s_waitcnt vmcnt(0)" ::: "memory");
    __syncthreads();
    if (threadIdx.x == 0) {
        unsigned* bar = b.bar;
        __builtin_amdgcn_s_waitcnt(0);
        unsigned nloc = b.st[0], nx = b.st[1];
        if (nloc == 0u) { xcd_barrier_complete(bar, b.x, nloc, nx); b.st[0] = nloc; b.st[1] = nx; }
        const unsigned old = xb_add(&bar[XB_XSUB(b.x)], 1u);
        const unsigned gen = old / nloc;
        if (old + 1u == (gen + 1u) * nloc) {
            __builtin_amdgcn_fence(__ATOMIC_RELEASE, "agent");
            asm volatile("s_waitcnt vmcnt(0)" ::: "memory");
            const unsigned og = xb_add(&bar[XB_TOP], 1u);
            const unsigned tg = og / nx;
            if (og + 1u == (tg + 1u) * nx) xb_add(&bar[XB_TOPGEN], 1u);
            else XB_SPIN(xb_ld(&bar[XB_TOPGEN]) == tg, bar);
            __builtin_amdgcn_fence(__ATOMIC_ACQUIRE, "agent");
            xb_add(&bar[XB_XGEN(b.x)], 1u);
            asm volatile("s_waitcnt vmcnt(0)" ::: "memory");
        } else {
            XB_SPIN(xb_ld(&bar[XB_XGEN(b.x)]) == gen, bar);
            __builtin_amdgcn_fence(__ATOMIC_ACQUIRE, "agent");
            asm volatile("s_waitcnt vmcnt(0)" ::: "memory");
        }
    }
    __syncthreads();
}
struct Frame {
    LAS unsigned char* lds;
    int tid, lane, wave;
    int G, wg, gw, NGW;
    unsigned long long tacc;
};

DI void transpose_item(const float* W, int ldsrc, int coloff, bf16* WT, int K, int row_off, int nblk, LAS float* scr, int item, int lane, const float* gain) {
    const int kb = item / nblk, nb = item % nblk, k0 = 64 * kb, n0 = 32 * nb;
#pragma unroll 8
    for (int i = 0; i < 32; ++i) { const int kk = 2 * i + (lane >> 5); scr[kk * 33 + (lane & 31)] = W[(size_t)(k0 + kk) * ldsrc + coloff + n0 + (lane & 31)] * (gain ? gain[k0 + kk] : 1.0f); }
    LDS_WAIT(); asm volatile("" ::: "memory");
    const int c = lane & 7;
#pragma unroll
    for (int j = 0; j < 4; ++j) { const int n = (lane >> 3) + 8 * j; const LAS float* s = scr + (8 * c) * 33 + n;
        v4u o; o.x = pk2(s[0 * 33], s[1 * 33]); o.y = pk2(s[2 * 33], s[3 * 33]); o.z = pk2(s[4 * 33], s[5 * 33]); o.w = pk2(s[6 * 33], s[7 * 33]);
        *(GAS v4u*)(WT + (size_t)(row_off + n0 + n) * K + k0 + 8 * c) = o; }
    LDS_WAIT(); asm volatile("" ::: "memory");
}
DI void transpose_matrix(Frame& F, const float* W, int ldsrc, int coloff, int ncols, int K, bf16* WT, int row_off, unsigned& base, const float* gain = nullptr) {
    LAS float* scr = (LAS float*)(F.lds + F.wave * 16384);
    const int nblk = ncols / 32, nitems = (K / 64) * nblk;
    int it = (int)(((unsigned)F.gw + (unsigned)F.NGW - (base % (unsigned)F.NGW)) % (unsigned)F.NGW);
    for (; it < nitems; it += F.NGW) transpose_item(W, ldsrc, coloff, WT, K, row_off, nblk, scr, it, F.lane, gain);
    base += (unsigned)nitems;
}
DI void rms_row(const float* xrow, const f32x4 (&g4)[4], f32x4 (&v)[4], int lane) {
    const GAS f32x4* xr = (const GAS f32x4*)xrow + lane; float s = 0.f;
#pragma unroll
    for (int j = 0; j < 4; ++j) { v[j] = xr[64 * j]; s += (v[j].x * v[j].x + v[j].y * v[j].y) + (v[j].z * v[j].z + v[j].w * v[j].w); }
    const float rstd = rsq_(wave_sum(s) * (1.f / 1024.f) + EPS);
#pragma unroll
    for (int j = 0; j < 4; ++j) v[j] = v[j] * rstd * g4[j];
}
DI void store_row_bf16(bf16* orow, const f32x4 (&v)[4], int lane) {
    GAS unsigned long long* o8 = (GAS unsigned long long*)orow + lane;
#pragma unroll
    for (int j = 0; j < 4; ++j) o8[64 * j] = (unsigned long long)pk2(v[j].x, v[j].y) | ((unsigned long long)pk2(v[j].z, v[j].w) << 32);
}
struct In { const float* p[24]; };
DI void p0_prologue(Frame& F, const In& I, unsigned char* ws) {
    unsigned base = 0;
    for (int l = 0; l < DEPTH; ++l) {
        const int j = l >> 1; unsigned char* wl = ws + WS_W + (size_t)l * W_LAYER;
        if ((l & 1) == 0) {
            transpose_matrix(F, I.p[3] + (size_t)j * D * AB_IN, AB_IN, 0, 1536, D, (bf16*)(wl + WO_WIN), 0, base, I.p[2] + l * D);
            transpose_matrix(F, I.p[3] + (size_t)j * D * AB_IN, AB_IN, 1544, 1536, D, (bf16*)(wl + WO_WIN), 1536, base, I.p[2] + l * D);
            transpose_matrix(F, I.p[7] + (size_t)j * D * D, D, 0, D, D, (bf16*)(wl + WO_WOUT), 0, base);
        } else {
            transpose_matrix(F, I.p[8] + (size_t)j * D * C_IN, C_IN, 0, 4096, D, (bf16*)(wl + WO_WIN), 0, base, I.p[2] + l * D);
            transpose_matrix(F, I.p[13] + (size_t)j * D * D, D, 0, D, D, (bf16*)(wl + WO_WOUT), 0, base);
        }
        transpose_matrix(F, I.p[16] + (size_t)l * D * D, D, 0, D, D, (bf16*)(wl + WO_WQ), 0, base, I.p[14] + l * D);
        transpose_matrix(F, I.p[19] + (size_t)l * D * D, D, 0, D, D, (bf16*)(wl + WO_WO), 0, base);
        transpose_matrix(F, I.p[17] + (size_t)l * D * D, D, 0, D, D, (bf16*)(ws + WS_WKV), 2048 * l, base);
        transpose_matrix(F, I.p[18] + (size_t)l * D * D, D, 0, D, D, (bf16*)(ws + WS_WKV), 2048 * l + 1024, base);
        transpose_matrix(F, I.p[21] + (size_t)l * D * FF, FF, 0, FF, D, (bf16*)(wl + WO_W1), 0, base, I.p[20] + l * D);
        transpose_matrix(F, I.p[22] + (size_t)l * FF * D, D, 0, D, FF, (bf16*)(wl + WO_W2), 0, base);
    }
    for (int idx = F.wg * NTHR + F.tid; idx < DEPTH * 16 * 1024; idx += F.G * NTHR) {
        const int l = idx >> 14, g = (idx >> 10) & 15, k = idx & 1023, j = l >> 1; float v = 0.f;
        if ((l & 1) == 0) { if (g < 8) v = I.p[3][(size_t)j * D * AB_IN + (size_t)k * AB_IN + 1536 + g]; }
        else v = I.p[8][(size_t)j * D * C_IN + (size_t)k * C_IN + 4096 + g];
        ((bf16*)(ws + WS_WG))[idx] = (bf16)f2bf(v * I.p[2][l * D + k]);
    }
    { f32x4 g4[4];
#pragma unroll
      for (int j = 0; j < 4; ++j) g4[j] = ((const GAS f32x4*)I.p[15])[F.lane + 64 * j];
      for (int r = F.gw; r < BATCH * MEMLEN; r += F.NGW) { f32x4 v[4]; rms_row(I.p[1] + (size_t)r * D, g4, v, F.lane); store_row_bf16((bf16*)(ws + WS_MEMN) + (size_t)r * D, v, F.lane); } }
    for (int r = F.gw; r < M; r += F.NGW) { const GAS f32x4* xr = (const GAS f32x4*)(I.p[0] + (size_t)r * D) + F.lane; f32x4 v[4]; float s = 0.f;
#pragma unroll
        for (int j = 0; j < 4; ++j) { v[j] = xr[64 * j]; s += (v[j].x * v[j].x + v[j].y * v[j].y) + (v[j].z * v[j].z + v[j].w * v[j].w); }
        s = wave_sum(s); store_row_bf16((bf16*)(ws + WS_H) + (size_t)r * D, v, F.lane);
        if (F.lane == 0) { __hip_atomic_store((pg8::rs_t*)(ws + WS_RS) + r, pg8::rs_fix(s), __ATOMIC_RELAXED, __HIP_MEMORY_SCOPE_AGENT); __hip_atomic_store((pg8::rs_t*)(ws + WS_RS) + M + r, (pg8::rs_t)0, __ATOMIC_RELAXED, __HIP_MEMORY_SCOPE_AGENT); } }
}
template <int MODE> DI void gates_phase(Frame& F, const bf16* xb, const pg8::rs_t* rs, const bf16* WgB, float* gate, const float* p0, const float* p1) {
    constexpr int LW = 1032;
    LAS bf16* wl = (LAS bf16*)F.lds;
    const int r = F.lane & 15, quad = F.lane >> 4;
    lds_barrier();
    for (int i = F.tid; i < 2048; i += NTHR) { const int g = i >> 7, c8 = (i & 127) * 8; *(LAS v4u*)(wl + g * LW + c8) = *(const GAS v4u*)(WgB + g * 1024 + c8); }
    float par = 0.f, par2 = 0.f;
    if (MODE == 1) { if (r < 4) par = p0[r]; else if (r < 8) par = p1[r - 4]; }
    if (MODE == 2) { if (r >= 8) { par = p0[r - 8]; par2 = p1[r - 8]; } }
    lds_barrier();
    for (int g = F.gw; g < M / 16; g += F.NGW) {
        const bf16* xa = xb + (size_t)(16 * g + r) * D + 8 * quad; f32x4 acc = (f32x4){0.f, 0.f, 0.f, 0.f};
#pragma unroll 8
        for (int kk = 0; kk < 32; ++kk) acc = mfma16(*(const GAS bf16x8*)(xa + 32 * kk), *(const LAS bf16x8*)(wl + r * LW + 32 * kk + 8 * quad), acc);
#pragma unroll
        for (int j = 0; j < 4; ++j) { const int row = 16 * g + 4 * quad + j; const float keep = acc[j] * pg8::row_rstd(rs, row); float o = 0.f;
            if (MODE == 1) { const float v = keep + par; o = (r < 4) ? 15.0f * tanhf(v * (1.0f / 15.0f)) : (fminf(v, 0.f) - log1pf(expf(-fabsf(v)))); }
            if (MODE == 2) { if (r < 8) o = 1.0f / (1.0f + expf(-keep)); else { const float z = keep + par2; o = -expf(par) * (fmaxf(z, 0.f) + log1pf(expf(-fabsf(z)))); } }
            if (MODE == 2 || r < 8) gate[(size_t)row * 16 + r] = o; }
    }
    lds_barrier();
}
DI void final_norm_phase(Frame& F, float* x, const float* gain) {
    f32x4 g4[4];
#pragma unroll
    for (int j = 0; j < 4; ++j) g4[j] = ((const GAS f32x4*)gain)[F.lane + 64 * j];
    for (int r = F.gw; r < M; r += F.NGW) { f32x4 v[4]; rms_row(x + (size_t)r * D, g4, v, F.lane); GAS f32x4* o = (GAS f32x4*)(x + (size_t)r * D) + F.lane;
#pragma unroll
        for (int j = 0; j < 4; ++j) o[64 * j] = v[j]; }
}
template <bool ODD> DI void headnorm_phase(Frame& F, const bf16* src, bf16* mix, const bf16* proj, const float* hg) {
    constexpr int NC = ODD ? 16 : 8;
    for (int r = F.gw; r < M; r += F.NGW) {
        const int c0 = NC * F.lane;
        float x[NC], gt[NC];
#pragma unroll
        for (int q = 0; q < NC / 8; ++q) {
            const size_t hoff = ((size_t)((r >> 13) * 8 + ((c0 + 8 * q) >> 7)) * T + (r & (T - 1))) * 128 + ((c0 + 8 * q) & 127);
            const v4u raw = ODD ? *(const GAS v4u*)(src + hoff) : *(const GAS v4u*)(src + (size_t)r * D + c0 + 8 * q);
            const v4u gr = ODD ? *(const GAS v4u*)(proj + (size_t)M * 3072 + hoff) : *(const GAS v4u*)(proj + (size_t)r * AB_N + 1024 + c0 + 8 * q);
            x[8 * q + 0] = bflo(raw.x); x[8 * q + 1] = bfhi(raw.x); x[8 * q + 2] = bflo(raw.y); x[8 * q + 3] = bfhi(raw.y); x[8 * q + 4] = bflo(raw.z); x[8 * q + 5] = bfhi(raw.z); x[8 * q + 6] = bflo(raw.w); x[8 * q + 7] = bfhi(raw.w);
            gt[8 * q + 0] = bflo(gr.x); gt[8 * q + 1] = bfhi(gr.x); gt[8 * q + 2] = bflo(gr.y); gt[8 * q + 3] = bfhi(gr.y); gt[8 * q + 4] = bflo(gr.z); gt[8 * q + 5] = bfhi(gr.z); gt[8 * q + 6] = bflo(gr.w); gt[8 * q + 7] = bfhi(gr.w);
        }
        float ss = 0.f;
#pragma unroll
        for (int i = 0; i < NC; ++i) ss += x[i] * x[i];
        ss += __shfl_xor(ss, 1); ss += __shfl_xor(ss, 2); ss += __shfl_xor(ss, 4); if (!ODD) ss += __shfl_xor(ss, 8);
        const float rstd = rsq_(ss * (1.f / 128.f) + EPS);
#pragma unroll
        for (int i = 0; i < NC; ++i) { const float g = ODD ? hg[(c0 + i) & 127] : hg[c0 + i]; const float s = sigmoidf_(gt[i]); x[i] = x[i] * rstd * g * (ODD ? gt[i] * s : s); }
#pragma unroll
        for (int q = 0; q < NC / 8; ++q) { v4u o; o.x = pk2(x[8 * q], x[8 * q + 1]); o.y = pk2(x[8 * q + 2], x[8 * q + 3]); o.z = pk2(x[8 * q + 4], x[8 * q + 5]); o.w = pk2(x[8 * q + 6], x[8 * q + 7]);
            *(GAS v4u*)(mix + (size_t)r * D + c0 + 8 * q) = o; }
    }
}
DI void mlstm_chain(Frame& F, const bf16* proj, const float* gate, bf16* mix, int c) {
    const int b = c >> 4, h = (c >> 2) & 3, vq = c & 3, vl = F.tid >> 4, dg = F.tid & 15;
    float C0 = 0.f, C1 = 0.f, C2 = 0.f, C3 = 0.f, n0 = 0.f, n1 = 0.f, n2 = 0.f, n3 = 0.f, m = 0.f;
    const bf16* pq = proj + (size_t)b * T * AB_N + h * 64 + 4 * dg;
    const bf16* pk = pq + 256;
    const bf16* pv = proj + (size_t)b * T * AB_N + 512 + h * 128 + vq * 32 + vl;
    const float* pg = gate + (size_t)b * T * 16 + h;
    bf16* po = mix + (size_t)b * T * D + h * 128 + vq * 32 + vl;
    for (int t0 = 0; t0 < T; t0 += 8) {
        v2u qr[8], kr[8]; unsigned short vr[8]; float li[8], lf[8];
#pragma unroll
        for (int i = 0; i < 8; ++i) { qr[i] = *(const GAS v2u*)(pq + (size_t)(t0 + i) * AB_N); kr[i] = *(const GAS v2u*)(pk + (size_t)(t0 + i) * AB_N); vr[i] = pv[(size_t)(t0 + i) * AB_N];
            li[i] = pg[(size_t)(t0 + i) * 16]; lf[i] = pg[(size_t)(t0 + i) * 16 + 4]; }
#pragma unroll
        for (int i = 0; i < 8; ++i) {
            const float q0 = bflo(qr[i].x), q1 = bfhi(qr[i].x), q2 = bflo(qr[i].y), q3 = bfhi(qr[i].y);
            const float k0 = bflo(kr[i].x) * 0.125f, k1 = bfhi(kr[i].x) * 0.125f, k2 = bflo(kr[i].y) * 0.125f, k3 = bfhi(kr[i].y) * 0.125f;
            const float vv = bf2f(vr[i]);
            const float mn = fmaxf(lf[i] + m, li[i]); const float fp = __expf(lf[i] + m - mn), ip = __expf(li[i] - mn); m = mn;
            const float iv = ip * vv;
            C0 = fp * C0 + iv * k0; C1 = fp * C1 + iv * k1; C2 = fp * C2 + iv * k2; C3 = fp * C3 + iv * k3;
            n0 = fp * n0 + ip * k0; n1 = fp * n1 + ip * k1; n2 = fp * n2 + ip * k2; n3 = fp * n3 + ip * k3;
            float pn = (C0 * q0 + C1 * q1) + (C2 * q2 + C3 * q3), pd = (n0 * q0 + n1 * q1) + (n2 * q2 + n3 * q3);
#pragma unroll
            for (int o = 1; o < 16; o <<= 1) { pn += __shfl_xor(pn, o); pd += __shfl_xor(pd, o); }
            const float hv = pn / fmaxf(fabsf(pd), __expf(-mn));
            if (dg == 0) po[(size_t)(t0 + i) * D] = (bf16)f2bf(hv);
        }
    }
}
DI void gdn_chain(Frame& F, const bf16* proj, const float* gate, const float* convw, bf16* mix, int c) {
    const int b = c >> 5, h = (c >> 2) & 7, vq = c & 3, cc = F.tid >> 4, dg = F.tid & 15;
    LAS float* qs = (LAS float*)F.lds; LAS float* ks = qs + 64 * 128; LAS float* vs = ks + 64 * 128; LAS float* os = vs + 64 * 32; LAS float* bet = os + 64 * 32; LAS float* alp = bet + 64;
    float S[8];
#pragma unroll
    for (int j = 0; j < 8; ++j) S[j] = 0.f;
    for (int t0 = 0; t0 < T; t0 += 64) {
        __syncthreads();
        { const int row = F.tid >> 3, seg = F.tid & 7, t = t0 + row;
#pragma unroll
          for (int which = 0; which < 2; ++which) {
              const int colg = which * 1024 + h * 128 + seg * 16; float a[16];
#pragma unroll
              for (int i = 0; i < 16; ++i) a[i] = 0.f;
#pragma unroll
              for (int j = 0; j < 4; ++j) { const int tt = t - 3 + j;
                  if (tt >= 0) { const bf16* src = proj + (size_t)(b * T + tt) * C_N + colg; const float* w = convw + j * 3072 + colg;
#pragma unroll
                      for (int q = 0; q < 2; ++q) { const v4u raw = *(const GAS v4u*)(src + 8 * q); const f32x4 w0 = *(const GAS f32x4*)(w + 8 * q), w1 = *(const GAS f32x4*)(w + 8 * q + 4);
                          a[8 * q + 0] += bflo(raw.x) * w0.x; a[8 * q + 1] += bfhi(raw.x) * w0.y; a[8 * q + 2] += bflo(raw.y) * w0.z; a[8 * q + 3] += bfhi(raw.y) * w0.w;
                          a[8 * q + 4] += bflo(raw.z) * w1.x; a[8 * q + 5] += bfhi(raw.z) * w1.y; a[8 * q + 6] += bflo(raw.w) * w1.z; a[8 * q + 7] += bfhi(raw.w) * w1.w; } } }
              float ss = 0.f;
#pragma unroll
              for (int i = 0; i < 16; ++i) { a[i] = a[i] * sigmoidf_(a[i]); ss += a[i] * a[i]; }
              ss += __shfl_xor(ss, 1); ss += __shfl_xor(ss, 2); ss += __shfl_xor(ss, 4);
              const float sc = rsq_(ss + EPS) * (which == 0 ? 0.08838834764831845f : 1.0f);
              LAS float* dst = (which == 0 ? qs : ks) + row * 128 + seg * 16;
#pragma unroll
              for (int q = 0; q < 4; ++q) *(LAS f32x4*)(dst + 4 * q) = (f32x4){a[4 * q] * sc, a[4 * q + 1] * sc, a[4 * q + 2] * sc, a[4 * q + 3] * sc};
          } }
        if (F.tid < 256) { const int row = F.tid >> 2, seg = F.tid & 3, t = t0 + row; const int colg = 2048 + h * 128 + vq * 32 + seg * 8; float a[8];
#pragma unroll
            for (int i = 0; i < 8; ++i) a[i] = 0.f;
#pragma unroll
            for (int j = 0; j < 4; ++j) { const int tt = t - 3 + j;
                if (tt >= 0) { const v4u raw = *(const GAS v4u*)(proj + (size_t)(b * T + tt) * C_N + colg); const float* w = convw + j * 3072 + colg; const f32x4 w0 = *(const GAS f32x4*)w, w1 = *(const GAS f32x4*)(w + 4);
                    a[0] += bflo(raw.x) * w0.x; a[1] += bfhi(raw.x) * w0.y; a[2] += bflo(raw.y) * w0.z; a[3] += bfhi(raw.y) * w0.w; a[4] += bflo(raw.z) * w1.x; a[5] += bfhi(raw.z) * w1.y; a[6] += bflo(raw.w) * w1.z; a[7] += bfhi(raw.w) * w1.w; } }
#pragma unroll
            for (int i = 0; i < 8; ++i) a[i] = a[i] * sigmoidf_(a[i]);
            *(LAS f32x4*)(vs + row * 32 + seg * 8) = (f32x4){a[0], a[1], a[2], a[3]}; *(LAS f32x4*)(vs + row * 32 + seg * 8 + 4) = (f32x4){a[4], a[5], a[6], a[7]}; }
        if (F.tid < 64) { const float* g = gate + (size_t)(b * T + t0 + F.tid) * 16; bet[F.tid] = g[h]; alp[F.tid] = __expf(g[8 + h]); }
        __syncthreads();
        for (int s = 0; s < 64; ++s) {
            const f32x4 ka = *(const LAS f32x4*)(ks + s * 128 + 8 * dg), kb = *(const LAS f32x4*)(ks + s * 128 + 8 * dg + 4);
            const f32x4 qa = *(const LAS f32x4*)(qs + s * 128 + 8 * dg), qb = *(const LAS f32x4*)(qs + s * 128 + 8 * dg + 4);
            const float vv = vs[s * 32 + cc], be = bet[s], al = alp[s];
            float p = (ka.x * S[0] + ka.y * S[1]) + (ka.z * S[2] + ka.w * S[3]) + (kb.x * S[4] + kb.y * S[5]) + (kb.z * S[6] + kb.w * S[7]);
#pragma unroll
            for (int o = 1; o < 16; o <<= 1) p += __shfl_xor(p, o);
            const float dl = be * (vv - al * p);
            S[0] = al * S[0] + ka.x * dl; S[1] = al * S[1] + ka.y * dl; S[2] = al * S[2] + ka.z * dl; S[3] = al * S[3] + ka.w * dl;
            S[4] = al * S[4] + kb.x * dl; S[5] = al * S[5] + kb.y * dl; S[6] = al * S[6] + kb.z * dl; S[7] = al * S[7] + kb.w * dl;
            float po = (qa.x * S[0] + qa.y * S[1]) + (qa.z * S[2] + qa.w * S[3]) + (qb.x * S[4] + qb.y * S[5]) + (qb.z * S[6] + qb.w * S[7]);
#pragma unroll
            for (int o = 1; o < 16; o <<= 1) po += __shfl_xor(po, o);
            if (dg == 0) os[s * 32 + cc] = po;
        }
        __syncthreads();
        { const int row = F.tid >> 3, c4 = (F.tid & 7) * 4; const f32x4 o = *(const LAS f32x4*)(os + row * 32 + c4);
          *(GAS v2u*)(mix + (size_t)(b * T + t0 + row) * D + h * 128 + vq * 32 + c4) = (v2u){pk2(o.x, o.y), pk2(o.z, o.w)}; }
    }
}
struct MlChunkRegs { v4u q, k, v0, v1, o0, o1; float li, lf; };
DI void ml_load(MlChunkRegs& R, const bf16* proj, const float* gate, int b, int h, int tc, int tid) {
    const int row = tid >> 3, seg = tid & 7; const size_t hb = (size_t)(b * 4 + h) * T + tc + row;
    R.q = *(const GAS v4u*)(proj + hb * 64 + 8 * seg); R.k = *(const GAS v4u*)(proj + (size_t)M * 256 + hb * 64 + 8 * seg);
    const bf16* pv = proj + (size_t)M * 512 + hb * 128 + 16 * seg; R.v0 = *(const GAS v4u*)pv; R.v1 = *(const GAS v4u*)(pv + 8);
    const bf16* po = proj + (size_t)M * 1024 + hb * 128 + 16 * seg; R.o0 = *(const GAS v4u*)po; R.o1 = *(const GAS v4u*)(po + 8);
    R.li = 0.f; R.lf = 0.f;
    if (tid < 64) { const float* g = gate + ((size_t)b * T + tc + tid) * 16; R.li = g[h]; R.lf = g[4 + h]; }
}
DI unsigned scale_pk(unsigned u, float s) { return pk2(bflo(u) * s, bfhi(u) * s); }
DI void mlstm_chunked(Frame& F, const bf16* proj, const float* gate, const float* hgain, bf16* mix, int c) {
    constexpr int LD = 72, HLD = 132;
    const int b = c >> 2, h = c & 3;
    const int tid = F.tid, lane = F.lane, w = F.wave, r = lane & 15, quad = lane >> 4, row = tid >> 3, seg = tid & 7;
    LAS bf16* qs = (LAS bf16*)F.lds; LAS bf16* qw = qs + 64 * LD; LAS bf16* ks = qw + 64 * LD; LAS bf16* kTs = ks + 64 * LD; LAS bf16* Sd = kTs + 64 * LD;
    LAS bf16* vT = Sd + 64 * LD; LAS bf16* Cb = vT + 128 * LD;
    LAS float* hbuf = (LAS float*)(Cb + 128 * LD);
    LAS float* sA = hbuf + 64 * HLD; LAS float* sM = sA + 64; LAS float* sWi = sM + 64; LAS float* sWs = sWi + 64; LAS float* sEm = sWs + 64; LAS float* sN = sEm + 64  ; LAS float* sMisc = sN + 128;
    lds_barrier();
    for (int i = tid; i < 128 * LD / 2; i += NTHR) ((LAS unsigned*)Cb)[i] = 0u;
    if (tid < 128) sN[tid] = 0.f;
    f32x4 accC[4];
#pragma unroll
    for (int i = 0; i < 4; ++i) accC[i] = (f32x4){0.f, 0.f, 0.f, 0.f};
    float nreg = 0.f, mprev = 0.f;
    float gn[16];
#pragma unroll
    for (int i = 0; i < 16; ++i) gn[i] = hgain[h * 128 + 16 * seg + i];
    const size_t rb = (size_t)b * T;
    MlChunkRegs cur, nxt; ml_load(cur, proj, gate, b, h, 0, tid); nxt = cur;
    for (int ch = 0; ch < T / 64; ++ch) {
        const size_t r0 = rb + (size_t)ch * 64;
        if (ch + 1 < T / 64) ml_load(nxt, proj, gate, b, h, (ch + 1) * 64, tid);
        STG_T0();
        lds_barrier();
        STG(0);
        *(LAS v4u*)(qs + row * LD + 8 * seg) = cur.q;
        { v4u kk; kk.x = scale_pk(cur.k.x, 0.125f); kk.y = scale_pk(cur.k.y, 0.125f); kk.z = scale_pk(cur.k.z, 0.125f); kk.w = scale_pk(cur.k.w, 0.125f); cur.k = kk; *(LAS v4u*)(ks + row * LD + 8 * seg) = kk; }
        { const unsigned vv[8] = {cur.v0.x, cur.v0.y, cur.v0.z, cur.v0.w, cur.v1.x, cur.v1.y, cur.v1.z, cur.v1.w};
#pragma unroll
          for (int i = 0; i < 8; ++i) { vT[(16 * seg + 2 * i) * LD + row] = (bf16)(vv[i] & 0xffffu); vT[(16 * seg + 2 * i + 1) * LD + row] = (bf16)(vv[i] >> 16); } }
        if (w == 0) {
            float bb = cur.lf;
#pragma unroll
            for (int o = 1; o < 64; o <<= 1) { const float t = __shfl_up(bb, o); if (lane >= o) bb += t; }
            const float a = cur.li - bb; float cm = a;
#pragma unroll
            for (int o = 1; o < 64; o <<= 1) { const float t = __shfl_up(cm, o); if (lane >= o) cm = fmaxf(cm, t); }
            const float Mx = fmaxf(mprev, cm);
            const float b63 = __shfl(bb, 63), Mx63 = __shfl(Mx, 63);
            sA[lane] = a; sM[lane] = Mx; sWi[lane] = __expf(mprev - Mx); sWs[lane] = __expf(a - Mx63); sEm[lane] = __expf(-(bb + Mx));
            if (lane == 0) sMisc[0] = __expf(mprev - Mx63);
            mprev = b63 + Mx63;
        }
        STG(1);
        lds_barrier();
        STG(2);
        { const float wi = sWi[row], wsr = sWs[row];
          v4u t; t.x = scale_pk(cur.q.x, wi); t.y = scale_pk(cur.q.y, wi); t.z = scale_pk(cur.q.z, wi); t.w = scale_pk(cur.q.w, wi); *(LAS v4u*)(qw + row * LD + 8 * seg) = t;
          const unsigned kk[4] = {cur.k.x, cur.k.y, cur.k.z, cur.k.w};
#pragma unroll
          for (int i = 0; i < 4; ++i) { kTs[(8 * seg + 2 * i) * LD + row] = (bf16)f2bf(bflo(kk[i]) * wsr); kTs[(8 * seg + 2 * i + 1) * LD + row] = (bf16)f2bf(bfhi(kk[i]) * wsr); } }
        { const int mt = w >> 1;
          const bf16x8 a0 = *(const LAS bf16x8*)(qs + (16 * mt + r) * LD + 8 * quad), a1 = *(const LAS bf16x8*)(qs + (16 * mt + r) * LD + 32 + 8 * quad);
#pragma unroll
          for (int tt = 0; tt < 2; ++tt) { const int nt = 2 * (w & 1) + tt; f32x4 acc = (f32x4){0.f, 0.f, 0.f, 0.f};
              if (nt <= mt) { const bf16x8 b0 = *(const LAS bf16x8*)(ks + (16 * nt + r) * LD + 8 * quad), b1 = *(const LAS bf16x8*)(ks + (16 * nt + r) * LD + 32 + 8 * quad);
                  acc = mfma16(a0, b0, acc); acc = mfma16(a1, b1, acc); }
              const int s = 16 * nt + r; const float as = sA[s];
#pragma unroll
              for (int j = 0; j < 4; ++j) { const int t = 16 * mt + 4 * quad + j; const float v = (s <= t) ? acc[j] * __expf(as - sM[t]) : 0.f; Sd[t * LD + s] = (bf16)f2bf(v); } } }
        STG(3);
        lds_barrier();
        STG(4);
        const bf16x8 vf0 = *(const LAS bf16x8*)(vT + (16 * w + r) * LD + 8 * quad), vf1 = *(const LAS bf16x8*)(vT + (16 * w + r) * LD + 32 + 8 * quad);
        { const bf16x8 cf0 = *(const LAS bf16x8*)(Cb + (16 * w + r) * LD + 8 * quad), cf1 = *(const LAS bf16x8*)(Cb + (16 * w + r) * LD + 32 + 8 * quad);
#pragma unroll
          for (int mt = 0; mt < 4; ++mt) { f32x4 acc = (f32x4){0.f, 0.f, 0.f, 0.f};
              acc = mfma16(*(const LAS bf16x8*)(Sd + (16 * mt + r) * LD + 8 * quad), vf0, acc); acc = mfma16(*(const LAS bf16x8*)(Sd + (16 * mt + r) * LD + 32 + 8 * quad), vf1, acc);
              acc = mfma16(*(const LAS bf16x8*)(qw + (16 * mt + r) * LD + 8 * quad), cf0, acc); acc = mfma16(*(const LAS bf16x8*)(qw + (16 * mt + r) * LD + 32 + 8 * quad), cf1, acc);
#pragma unroll
              for (int j = 0; j < 4; ++j) hbuf[(16 * mt + 4 * quad + j) * HLD + 16 * w + r] = acc[j]; } }
        STG(5);
        lds_barrier();
        STG(6);
        { const float wold = sMisc[0];
#pragma unroll
          for (int nt = 0; nt < 4; ++nt) { f32x4 acc = accC[nt] * wold;
              acc = mfma16(vf0, *(const LAS bf16x8*)(kTs + (16 * nt + r) * LD + 8 * quad), acc); acc = mfma16(vf1, *(const LAS bf16x8*)(kTs + (16 * nt + r) * LD + 32 + 8 * quad), acc);
              accC[nt] = acc;
#pragma unroll
              for (int j = 0; j < 4; ++j) Cb[(16 * w + 4 * quad + j) * LD + 16 * nt + r] = (bf16)f2bf(acc[j]); }
          if (w == 0) { float sum = 0.f;
#pragma unroll
              for (int q8 = 0; q8 < 8; ++q8) { const v4u t = *(const LAS v4u*)(kTs + lane * LD + 8 * q8); sum += (bflo(t.x) + bfhi(t.x)) + (bflo(t.y) + bfhi(t.y)) + (bflo(t.z) + bfhi(t.z)) + (bflo(t.w) + bfhi(t.w)); }
              nreg = wold * nreg + sum; sN[((ch + 1) & 1) * 64 + lane] = nreg; } }
        { const LAS float* nv = sN + (ch & 1) * 64 + 8 * seg;
          const v4u sd = *(const LAS v4u*)(Sd + row * LD + 8 * seg);
          float p = (bflo(sd.x) + bfhi(sd.x)) + (bflo(sd.y) + bfhi(sd.y)) + (bflo(sd.z) + bfhi(sd.z)) + (bflo(sd.w) + bfhi(sd.w));
          const float qn = (bflo(cur.q.x) * nv[0] + bfhi(cur.q.x) * nv[1]) + (bflo(cur.q.y) * nv[2] + bfhi(cur.q.y) * nv[3]) + (bflo(cur.q.z) * nv[4] + bfhi(cur.q.z) * nv[5]) + (bflo(cur.q.w) * nv[6] + bfhi(cur.q.w) * nv[7]);
          p += sWi[row] * qn;
          p += __shfl_xor(p, 1); p += __shfl_xor(p, 2); p += __shfl_xor(p, 4);
          const float dinv = rcp_(fmaxf(fabsf(p), sEm[row]));
          float hv[16]; float ss = 0.f;
#pragma unroll
          for (int q4 = 0; q4 < 4; ++q4) { const f32x4 t = *(const LAS f32x4*)(hbuf + row * HLD + 16 * seg + 4 * q4); hv[4 * q4] = t.x * dinv; hv[4 * q4 + 1] = t.y * dinv; hv[4 * q4 + 2] = t.z * dinv; hv[4 * q4 + 3] = t.w * dinv; }
#pragma unroll
          for (int i = 0; i < 16; ++i) ss += hv[i] * hv[i];
          ss += __shfl_xor(ss, 1); ss += __shfl_xor(ss, 2); ss += __shfl_xor(ss, 4);
          const float rstd = rsq_(ss * (1.f / 128.f) + EPS);
          const unsigned og[8] = {cur.o0.x, cur.o0.y, cur.o0.z, cur.o0.w, cur.o1.x, cur.o1.y, cur.o1.z, cur.o1.w}; unsigned ow[8];
#pragma unroll
          for (int i = 0; i < 8; ++i) ow[i] = pk2(hv[2 * i] * rstd * gn[2 * i] * sigmoidf_(bflo(og[i])), hv[2 * i + 1] * rstd * gn[2 * i + 1] * sigmoidf_(bfhi(og[i])));
          bf16* op = mix + (r0 + row) * D + h * 128 + 16 * seg;
          *(GAS v4u*)op = (v4u){ow[0], ow[1], ow[2], ow[3]}; *(GAS v4u*)(op + 8) = (v4u){ow[4], ow[5], ow[6], ow[7]}; }
        STG(7);
        cur = nxt;
    }
}
constexpr size_t MIX_AT = 0, MIX_HALO = 64 * MiB, MIX_GL = 96 * MiB;
struct G1Raw { v2u raw[3][7]; };
struct G1Cw { float w[3][4][4]; };
DI void g1_load_raw(G1Raw& R, const bf16* big, const bf16* halo, int U, int tid) {
    const int ch = U & 127, h = (U >> 7) & 7, b = U >> 10, cg = tid & 31, rs = tid >> 5;
    const size_t hb0 = (size_t)(b * 8 + h) * T + (size_t)ch * 64;
#pragma unroll
    for (int which = 0; which < 3; ++which)
#pragma unroll
        for (int i = 0; i < 7; ++i) { const int rr = 4 * rs - 3 + i; v2u t = (v2u){0u, 0u};
            if (rr >= 0) t = *(const GAS v2u*)(big + (size_t)M * 1024 * which + (hb0 + rr) * 128 + 4 * cg);
            else if (ch > 0) t = *(const GAS v2u*)(halo + ((size_t)(b * 128 + ch - 1) * 3 + (3 + rr)) * 3072 + which * 1024 + h * 128 + 4 * cg);
            R.raw[which][i] = t; }
}
DI void g1_load_cw(G1Cw& C, const float* convw, int h, int tid) {
    const int cg = tid & 31;
#pragma unroll
    for (int which = 0; which < 3; ++which)
#pragma unroll
        for (int j = 0; j < 4; ++j) { const f32x4 t = *(const GAS f32x4*)(convw + j * 3072 + which * 1024 + h * 128 + 4 * cg); C.w[which][j][0] = t.x; C.w[which][j][1] = t.y; C.w[which][j][2] = t.z; C.w[which][j][3] = t.w; }
}
DI void gdn_g1_unit(Frame& F, bf16* big, const bf16* halo, const float* gate, G1Raw& RW, const float* convw, bf16* Hb, bf16* At, float* GL, int U, int Uend, bool st) {
    constexpr int LQ = 136, LX = 72, LR = 264;
    const int ch = U & 127, h = (U >> 7) & 7, b = U >> 10;
    const size_t r0 = (size_t)b * T + (size_t)ch * 64, hb0 = (size_t)(b * 8 + h) * T + (size_t)ch * 64;
    int tid_ = F.tid; asm volatile("" : "+v"(tid_));
    const int tid = tid_, lane = tid & 63, w = F.wave, r = lane & 15, quad = lane >> 4, row = tid >> 3, seg = tid & 7;
    const size_t hb = hb0 + row;
    LAS bf16* qn = (LAS bf16*)F.lds; LAS bf16* kn = qn + 64 * LQ; LAS bf16* vn = kn + 64 * LQ; LAS bf16* knT = vn + 64 * LQ;
    LAS bf16* Lb = knT + 128 * LX; LAS float* Lf = (LAS float*)(Lb + 64 * LX);
    LAS bf16* Db = (LAS bf16*)(Lf + 4 * 16 * 17); LAS bf16* Xt = Db + 4 * 16 * 20;
    LAS bf16* Xr = qn;
    LAS bf16* Ats = Xt;
    LAS float* sG = (LAS float*)(Xt + 256 * LX); LAS float* sBeta = sG + 64; LAS float* sEg = sBeta + 64;
    STG_T0();
    lds_barrier();
    STG(10);
    {
        const int cg = tid & 31, rs = tid >> 5;
#pragma unroll
        for (int which = 0; which < 3; ++which) {
            __builtin_amdgcn_sched_barrier(0);
            f32x4 cw[4];
#pragma unroll
            for (int j = 0; j < 4; ++j) cw[j] = *(const GAS f32x4*)(convw + j * 3072 + which * 1024 + h * 128 + 4 * cg);
            float x[7][4];
#pragma unroll
            for (int i = 0; i < 7; ++i) { const v2u t = RW.raw[which][i]; x[i][0] = bflo(t.x); x[i][1] = bfhi(t.x); x[i][2] = bflo(t.y); x[i][3] = bfhi(t.y); }
            float o[4][4]; float ss[4];
#pragma unroll
            for (int rr = 0; rr < 4; ++rr) { ss[rr] = 0.f;
#pragma unroll
                for (int c = 0; c < 4; ++c) { float a = cw[0][c] * x[rr][c]; a += cw[1][c] * x[rr + 1][c]; a += cw[2][c] * x[rr + 2][c]; a += cw[3][c] * x[rr + 3][c];
                    a = a * sigmoidf_(a); o[rr][c] = a; ss[rr] += a * a; } }
            if (which < 2) {
#pragma unroll
                for (int rr = 0; rr < 4; ++rr) { float t = ss[rr]; t += __shfl_xor(t, 1); t += __shfl_xor(t, 2); t += __shfl_xor(t, 4); t += __shfl_xor(t, 8); t += __shfl_xor(t, 16);
                    const float sc = rsq_(t + EPS) * (which == 0 ? 0.08838834764831845f : 1.0f);
#pragma unroll
                    for (int c = 0; c < 4; ++c) o[rr][c] *= sc; } }
            LAS bf16* dst = (which == 0 ? qn : (which == 1 ? kn : vn));
#pragma unroll
            for (int rr = 0; rr < 4; ++rr) *(LAS v2u*)(dst + (4 * rs + rr) * LQ + 4 * cg) = (v2u){pk2(o[rr][0], o[rr][1]), pk2(o[rr][2], o[rr][3])};
            if (which == 1) {
#pragma unroll
                for (int c = 0; c < 4; ++c) *(LAS v2u*)(knT + (4 * cg + c) * LX + ((4 * rs) ^ (8 * (cg & 7)))) = (v2u){pk2(o[0][c], o[1][c]), pk2(o[2][c], o[3][c])}; }
        }
    }
    if (U + 1 < Uend) g1_load_raw(RW, big, halo, U + 1, tid);
    if (w == 0) { const float* g = gate + (r0 + lane) * 16; float gg = g[8 + h]; const float be = g[h];
#pragma unroll
        for (int o = 1; o < 64; o <<= 1) { const float t = __shfl_up(gg, o); if (lane >= o) gg += t; }
        sG[lane] = gg; sBeta[lane] = be; sEg[lane] = __expf(gg); }
    STG(11);
    lds_barrier();
    STG(12);
    { const int mt = w >> 1;
#pragma unroll
      for (int tt = 0; tt < 2; ++tt) { const int nt = 2 * (w & 1) + tt; f32x4 ak = (f32x4){0.f, 0.f, 0.f, 0.f}, aq = ak;
          if (nt <= mt) {
#pragma unroll
              for (int kk = 0; kk < 4; ++kk) { const bf16x8 bk = *(const LAS bf16x8*)(kn + (16 * nt + r) * LQ + 32 * kk + 8 * quad);
                  ak = mfma16(*(const LAS bf16x8*)(kn + (16 * mt + r) * LQ + 32 * kk + 8 * quad), bk, ak); aq = mfma16(*(const LAS bf16x8*)(qn + (16 * mt + r) * LQ + 32 * kk + 8 * quad), bk, aq); } }
          const int s = 16 * nt + r; const float gs = sG[s];
#pragma unroll
          for (int j = 0; j < 4; ++j) { const int t = 16 * mt + 4 * quad + j; const float dec = (s <= t) ? __expf(sG[t] - gs) : 0.f;
              const float lv = (s < t) ? sBeta[t] * ak[j] * dec : 0.f;
              if (nt <= mt) { Lb[t * LX + s] = (bf16)f2bf(lv); if (nt == mt) Lf[(mt * 16 + 4 * quad + j) * 17 + r] = lv; }
              Ats[t * LX + s] = (bf16)f2bf(aq[j] * dec); } } }
    float R[4][2][4];
#pragma unroll
    for (int i = 0; i < 4; ++i)
#pragma unroll
        for (int ct = 0; ct < 2; ++ct)
#pragma unroll
            for (int j = 0; j < 4; ++j) { const int t = 16 * i + 4 * quad + j, cc = 32 * (w & 3) + 16 * ct + r;
                R[i][ct][j] = (w < 4) ? sBeta[t] * bf2f(vn[t * LQ + cc]) : sBeta[t] * sEg[t] * bf2f(kn[t * LQ + cc]); }
    STG(13);
    lds_barrier();
    STG(14);
    if (w == 0) { const int i = lane >> 4, cI = lane & 15; const LAS float* N = Lf + i * 16 * 17; float x[16];
#pragma unroll
        for (int rr = 0; rr < 16; ++rr) { float v = (rr == cI) ? 1.f : 0.f;
#pragma unroll
            for (int m = 0; m < rr; ++m) v -= N[rr * 17 + m] * x[m];
            x[rr] = v; Db[(i * 16 + rr) * 20 + cI] = (bf16)f2bf(v); }
    } else { const float gl = sG[63];
        if (st) for (int idx = tid - 64; idx < 2560; idx += NTHR - 64) {
            if (idx < 1024) { const int t = idx >> 4, c8 = (idx & 15) * 8; const v4u v = *(const LAS v4u*)(qn + t * LQ + c8); const float e = sEg[t];
                *(GAS v4u*)(big + (size_t)M * 2048 + (hb0 + t) * 128 + c8) = (v4u){scale_pk(v.x, e), scale_pk(v.y, e), scale_pk(v.z, e), scale_pk(v.w, e)}; }
            else if (idx >= 2048) { const int i3 = idx - 2048, t = i3 >> 3, s8 = (i3 & 7) * 8; *(GAS v4u*)(At + (size_t)U * 4096 + t * 64 + s8) = *(const LAS v4u*)(Ats + t * LX + s8); }
            else { const int i2 = idx - 1024, d = i2 >> 3, s8 = (i2 & 7) * 8; const v4u v = *(const LAS v4u*)(knT + d * LX + (s8 ^ (8 * ((d >> 2) & 7)))); float e[8];
#pragma unroll
                for (int q = 0; q < 8; ++q) e[q] = __expf(gl - sG[s8 + q]);
                *(GAS v4u*)(big + (size_t)M * 1024 + hb0 * 128 + d * 64 + s8) = (v4u){pk2(bflo(v.x) * e[0], bfhi(v.x) * e[1]), pk2(bflo(v.y) * e[2], bfhi(v.y) * e[3]), pk2(bflo(v.z) * e[4], bfhi(v.z) * e[5]), pk2(bflo(v.w) * e[6], bfhi(v.w) * e[7])}; } }
        if (st && tid == 64) GL[U] = __expf(gl); }
    STG(15);
    lds_barrier();
    STG(16);
#pragma unroll
    for (int i = 0; i < 4; ++i) {
#pragma unroll
        for (int ct = 0; ct < 2; ++ct) { const int col = 32 * w + 16 * ct + r; f32x4 acc = (f32x4){0.f, 0.f, 0.f, 0.f};
            if (i > 0) {
#pragma unroll
                for (int kk = 0; kk < 2; ++kk) if (32 * kk < 16 * i) {
                    bf16x8 af = *(const LAS bf16x8*)(Lb + (16 * i + r) * LX + 32 * kk + 8 * quad);
                    if (32 * kk + 8 * quad >= 16 * i) af = (bf16x8){0, 0, 0, 0, 0, 0, 0, 0};
                    acc = mfma16(af, *(const LAS bf16x8*)(Xt + col * LX + 32 * kk + 8 * quad), acc); } }
            const v2u bp = (v2u){pk2(R[i][ct][0] - acc[0], R[i][ct][1] - acc[1]), pk2(R[i][ct][2] - acc[2], R[i][ct][3] - acc[3])};
            const v2u ap = *(const LAS v2u*)(Db + (i * 16 + r) * 20 + 4 * quad);
            const f32x4 y = mfma16(__builtin_bit_cast(bf16x8, (v4u){ap.x, ap.y, 0u, 0u}), __builtin_bit_cast(bf16x8, (v4u){bp.x, bp.y, 0u, 0u}), (f32x4){0.f, 0.f, 0.f, 0.f});
            *(LAS v2u*)(Xt + col * LX + 16 * i + 4 * quad) = (v2u){pk2(y[0], y[1]), pk2(y[2], y[3])};
#pragma unroll
            for (int j = 0; j < 4; ++j) Xr[(16 * i + 4 * quad + j) * LR + col] = (bf16)f2bf(y[j]); }
        asm volatile("s_waitcnt lgkmcnt(0)" ::: "memory");
    }
    lds_barrier();
    STG(17);
    if (st) { const v4u u0 = *(const LAS v4u*)(Xr + row * LR + 16 * seg), u1 = *(const LAS v4u*)(Xr + row * LR + 16 * seg + 8), w0 = *(const LAS v4u*)(Xr + row * LR + 128 + 16 * seg), w1 = *(const LAS v4u*)(Xr + row * LR + 128 + 16 * seg + 8);
      bf16* up = Hb + hb * 128 + 16 * seg; *(GAS v4u*)up = u0; *(GAS v4u*)(up + 8) = u1;
      bf16* wp = big + hb * 128 + 16 * seg; *(GAS v4u*)wp = w0; *(GAS v4u*)(wp + 8) = w1; }
    STG(18);
}
DI void gdn_g1_phase(Frame& F, bf16* big, const bf16* halo, const float* gate, const float* convw, bf16* Hb, bf16* At, float* GL, bool st) {
    LAS unsigned* xt = (LAS unsigned*)(F.lds + (3 * 64 * 136 + 128 * 72 + 64 * 72) * 2 + 4 * 16 * 17 * 4 + 4 * 16 * 20 * 2);
    lds_barrier();
    for (int i = F.tid; i < 256 * 72 / 2; i += NTHR) xt[i] = 0u;
    const int per = (8192 + F.G - 1) / F.G, u0 = F.wg * per, u1 = (u0 + per < 8192) ? u0 + per : 8192;
    if (u0 >= u1) return;
    G1Raw RW;
    g1_load_raw(RW, big, halo, u0, F.tid);
    for (int U = u0; U < u1; ++U) gdn_g1_unit(F, big, halo, gate, RW, convw, Hb, At, GL, U, u1, st);
}
struct G2Regs { bf16x8 wf[4], qf[4], af[2], kf[2]; unsigned u[4]; float gl; };
DI void g2_load(G2Regs& R, const bf16* big, const bf16* Hb, const bf16* At, const float* GL, int b, int h, int vq, int ch, int w, int r, int quad) {
    const size_t hb0 = (size_t)(b * 8 + h) * T + (size_t)ch * 64; const int U = (b * 8 + h) * 128 + ch; const int mt = w >> 1, nt = w & 1;
    const bf16* pw = big + (hb0 + 16 * mt + r) * 128 + 8 * quad;
#pragma unroll
    for (int kk = 0; kk < 4; ++kk) { R.wf[kk] = *(const GAS bf16x8*)(pw + 32 * kk); R.qf[kk] = *(const GAS bf16x8*)(pw + (size_t)M * 2048 + 32 * kk); }
    const bf16* pa = At + (size_t)U * 4096 + (16 * mt + r) * 64 + 8 * quad;
    R.af[0] = *(const GAS bf16x8*)pa; R.af[1] = *(const GAS bf16x8*)(pa + 32);
    const int d = 16 * w + r; const bf16* pk = big + (size_t)M * 1024 + hb0 * 128 + d * 64 + 8 * quad;
    R.kf[0] = *(const GAS bf16x8*)pk; R.kf[1] = *(const GAS bf16x8*)(pk + 32);
    const bf16* pu = Hb + (hb0 + 16 * mt + 4 * quad) * 128 + vq * 32 + 16 * nt + r;
#pragma unroll
    for (int j = 0; j < 4; ++j) R.u[j] = pu[(size_t)j * 128];
    R.gl = GL[U];
}
DI void gdn_g2_chain(Frame& F, const bf16* big, bf16* Hb, const bf16* At, const float* GL, int c, bool st) {
    constexpr int LS = 136, LV = 72;
    const int b = c >> 5, h = (c >> 2) & 7, vq = c & 3;
    const int tid = F.tid, lane = F.lane, w = F.wave, r = lane & 15, quad = lane >> 4, mt = w >> 1, nt = w & 1;
    LAS bf16* St = (LAS bf16*)F.lds;
    LAS bf16* vnT = St + 32 * LS;
    lds_barrier();
    for (int i = tid; i < 32 * LS / 2; i += NTHR) ((LAS unsigned*)St)[i] = 0u;
    f32x4 accS[2]; accS[0] = (f32x4){0.f, 0.f, 0.f, 0.f}; accS[1] = accS[0];
    G2Regs cur, nxt; g2_load(cur, big, Hb, At, GL, b, h, vq, 0, w, r, quad); nxt = cur;
    lds_barrier();
    unsigned short opend[4] = {0, 0, 0, 0};
    for (int ch = 0; ch < T / 64; ++ch) {
        if (ch > 0 && st) { const size_t hbp = (size_t)(b * 8 + h) * T + (size_t)(ch - 1) * 64; bf16* po = Hb + (hbp + 16 * mt + 4 * quad) * 128 + vq * 32 + 16 * nt + r;
#pragma unroll
            for (int j = 0; j < 4; ++j) po[(size_t)j * 128] = opend[j]; }
        if (ch + 1 < T / 64) g2_load(nxt, big, Hb, At, GL, b, h, vq, ch + 1, w, r, quad);
        STG_T0();
        f32x4 av = (f32x4){0.f, 0.f, 0.f, 0.f}, ao = av;
#pragma unroll
        for (int kk = 0; kk < 4; ++kk) { const bf16x8 sf = *(const LAS bf16x8*)(St + (16 * nt + r) * LS + 32 * kk + 8 * quad); av = mfma16(cur.wf[kk], sf, av); ao = mfma16(cur.qf[kk], sf, ao); }
        *(LAS v2u*)(vnT + (16 * nt + r) * LV + 16 * mt + 4 * quad) = (v2u){pk2(bflo(cur.u[0]) - av[0], bflo(cur.u[1]) - av[1]), pk2(bflo(cur.u[2]) - av[2], bflo(cur.u[3]) - av[3])};
        STG(20);
        lds_barrier();
        STG(21);
#pragma unroll
        for (int kk = 0; kk < 2; ++kk) ao = mfma16(cur.af[kk], *(const LAS bf16x8*)(vnT + (16 * nt + r) * LV + 32 * kk + 8 * quad), ao);
#pragma unroll
        for (int j = 0; j < 4; ++j) opend[j] = (unsigned short)f2bf(ao[j]);
#pragma unroll
        for (int n2 = 0; n2 < 2; ++n2) { f32x4 a = accS[n2] * cur.gl;
#pragma unroll
            for (int kk = 0; kk < 2; ++kk) a = mfma16(cur.kf[kk], *(const LAS bf16x8*)(vnT + (16 * n2 + r) * LV + 32 * kk + 8 * quad), a);
            accS[n2] = a; *(LAS v2u*)(St + (16 * n2 + r) * LS + 16 * w + 4 * quad) = (v2u){pk2(a[0], a[1]), pk2(a[2], a[3])}; }
        STG(22);
        lds_barrier();
        STG(23);
        cur = nxt;
    }
    if (st) { const size_t hbp = (size_t)(b * 8 + h) * T + (size_t)(T / 64 - 1) * 64; bf16* po = Hb + (hbp + 16 * mt + 4 * quad) * 128 + vq * 32 + 16 * nt + r;
#pragma unroll
        for (int j = 0; j < 4; ++j) po[(size_t)j * 128] = opend[j]; }
}
DI void sb_unit(Frame& F, const bf16* proj, bf16* mix, int u) {
    constexpr int LDV = 72;
    const int qt = u & 63, h = (u >> 6) & 3, b = u >> 8;
    LAS bf16* Vt = (LAS bf16*)F.lds;
    volatile LAS unsigned* flag = (volatile LAS unsigned*)(F.lds + MISC_OFF + 64);
    const int w = F.wave, lane = F.lane, r = lane & 15, quad = lane >> 4;
    const int t0 = qt * 128, qpos = t0 + 16 * w + r;
    const size_t rb = (size_t)b * T;
    bf16x8 qf[4];
#pragma unroll
    for (int kk = 0; kk < 4; ++kk) qf[kk] = *(const GAS bf16x8*)(proj + (size_t)M * 1536 + ((size_t)(b * 4 + h) * T + qpos) * 128 + 32 * kk + 8 * quad);
    f32x4 o[8];
#pragma unroll
    for (int i = 0; i < 8; ++i) o[i] = (f32x4){0.f, 0.f, 0.f, 0.f};
    float carry = 0.f;
    const float scale = 0.08838834764831845f;
    for (int kb = 2 * qt + 1; kb >= 0; --kb) {
        const int k0 = kb * 64;
        lds_barrier();
        { const int key = F.tid >> 3, ds = (F.tid & 7) * 16; const bf16* src = proj + (size_t)M * 2560 + ((size_t)(b * 4 + h) * T + k0 + key) * 128 + ds;
          const v4u a = *(const GAS v4u*)src, c = *(const GAS v4u*)(src + 8);
          const unsigned ww[8] = {a.x, a.y, a.z, a.w, c.x, c.y, c.z, c.w};
#pragma unroll
          for (int i = 0; i < 8; ++i) { Vt[(ds + 2 * i) * LDV + key] = (bf16)(ww[i] & 0xffffu); Vt[(ds + 2 * i + 1) * LDV + key] = (bf16)(ww[i] >> 16); } }
        if (F.tid == 0) flag[0] = 0u;
        lds_barrier();
        if (k0 < t0 + 16 * w + 15) {
            f32x4 s[4];
#pragma unroll
            for (int mt = 0; mt < 4; ++mt) { s[mt] = (f32x4){0.f, 0.f, 0.f, 0.f};
                const bf16* kp = proj + (size_t)M * 2048 + ((size_t)(b * 4 + h) * T + k0 + 16 * mt + r) * 128 + 8 * quad;
#pragma unroll
                for (int kk = 0; kk < 4; ++kk) s[mt] = mfma16(*(const GAS bf16x8*)(kp + 32 * kk), qf[kk], s[mt]); }
            float l1[4][4], tot[4];
#pragma unroll
            for (int mt = 0; mt < 4; ++mt) { tot[mt] = 0.f;
#pragma unroll
                for (int j = 0; j < 4; ++j) { const float z = s[mt][j] * scale; const bool valid = (k0 + 16 * mt + 4 * quad + j) < qpos;
                    const float tl = __logf(1.0f + __expf(-fabsf(z)));
                    l1[mt][j] = valid ? (fminf(-z, 0.f) - tl) : 0.f; s[mt][j] = valid ? (fminf(z, 0.f) - tl) : -1e30f; tot[mt] += l1[mt][j]; } }
            float run = carry;
#pragma unroll
            for (int mt = 3; mt >= 0; --mt) {
                const float t1 = __shfl_xor(tot[mt], 16), t2 = __shfl_xor(tot[mt], 32), t3 = __shfl_xor(t1, 32);
                float hi = 0.f;
                hi += ((quad ^ 1) > quad) ? t1 : 0.f; hi += ((quad ^ 2) > quad) ? t2 : 0.f; hi += ((quad ^ 3) > quad) ? t3 : 0.f;
                float acc = run + hi;
#pragma unroll
                for (int j = 3; j >= 0; --j) { const float e = s[mt][j] + acc; s[mt][j] = __expf(e); acc += l1[mt][j]; }
                run += (tot[mt] + t1) + (t2 + t3);
            }
            carry = run;
#pragma unroll
            for (int s2 = 0; s2 < 2; ++s2) {
                v4u pw; pw.x = pk2(s[2 * s2][0], s[2 * s2][1]); pw.y = pk2(s[2 * s2][2], s[2 * s2][3]); pw.z = pk2(s[2 * s2 + 1][0], s[2 * s2 + 1][1]); pw.w = pk2(s[2 * s2 + 1][2], s[2 * s2 + 1][3]);
                const bf16x8 pf = __builtin_bit_cast(bf16x8, pw);
#pragma unroll
                for (int dt = 0; dt < 8; ++dt) { const LAS bf16* vp = Vt + (16 * dt + r) * LDV + 32 * s2 + 4 * quad;
                    const s16x4 lo = *(const LAS s16x4*)vp, hi4 = *(const LAS s16x4*)(vp + 16);
                    o[dt] = mfma16(__builtin_shufflevector(lo, hi4, 0, 1, 2, 3, 4, 5, 6, 7), pf, o[dt]); }
            }
        }
        if (!(carry < -SB_THR)) flag[0] = 1u;
        lds_barrier();
        if (flag[0] == 0u) break;
    }
    bf16* op = mix + (rb + qpos) * D + 512 + h * 128 + 4 * quad;
#pragma unroll
    for (int dt = 0; dt < 8; ++dt) *(GAS v2u*)(op + 16 * dt) = (v2u){pk2(o[dt][0], o[dt][1]), pk2(o[dt][2], o[dt][3])};
}
DI void xattn_phase(Frame& F, const bf16* Q, const bf16* KV, int l, bf16* O) {
    constexpr int LDV = 264;
    LAS bf16* Vt = (LAS bf16*)F.lds;
    const int per = (2048 + F.G - 1) / F.G, u0 = F.wg * per, u1 = (u0 + per < 2048) ? u0 + per : 2048;
    const int w = F.wave, lane = F.lane, r = lane & 15, quad = lane >> 4;
    int cur = -1;
    for (int u = u0; u < u1; ++u) {
        const int bh = u >> 6, qt = u & 63, b = bh >> 2, h = bh & 3;
        if (bh != cur) {
            lds_barrier();
#pragma unroll 4
            for (int it = 0; it < 16; ++it) { const int idx = F.tid + NTHR * it, key = idx >> 5, ds = (idx & 31) * 8;
                const v4u a = *(const GAS v4u*)(KV + (size_t)(b * MEMLEN + key) * 8192 + 2048 * l + 1024 + h * 256 + ds);
                const unsigned ww[4] = {a.x, a.y, a.z, a.w};
#pragma unroll
                for (int i = 0; i < 4; ++i) { Vt[(ds + 2 * i) * LDV + key] = (bf16)(ww[i] & 0xffffu); Vt[(ds + 2 * i + 1) * LDV + key] = (bf16)(ww[i] >> 16); } }
            lds_barrier(); cur = bh;
        }
        const size_t row = (size_t)b * T + qt * 128 + 16 * w + r;
        bf16x8 qf[8];
#pragma unroll
        for (int kk = 0; kk < 8; ++kk) qf[kk] = *(const GAS bf16x8*)(Q + row * D + h * 256 + 32 * kk + 8 * quad);
        f32x4 s[16];
#pragma unroll
        for (int mt = 0; mt < 16; ++mt) { s[mt] = (f32x4){0.f, 0.f, 0.f, 0.f};
            const bf16* kp = KV + (size_t)(b * MEMLEN + 16 * mt + r) * 8192 + 2048 * l + h * 256 + 8 * quad;
#pragma unroll
            for (int kk = 0; kk < 8; ++kk) s[mt] = mfma16(*(const GAS bf16x8*)(kp + 32 * kk), qf[kk], s[mt]); }
        float mx = -1e30f;
#pragma unroll
        for (int mt = 0; mt < 16; ++mt) mx = fmaxf(fmaxf(fmaxf(s[mt][0], s[mt][1]), fmaxf(s[mt][2], s[mt][3])), mx);
        mx = fmaxf(mx, __shfl_xor(mx, 16)); mx = fmaxf(mx, __shfl_xor(mx, 32));
        float sum = 0.f;
#pragma unroll
        for (int mt = 0; mt < 16; ++mt)
#pragma unroll
            for (int j = 0; j < 4; ++j) { const float p = __expf((s[mt][j] - mx) * 0.0625f); s[mt][j] = p; sum += p; }
        sum += __shfl_xor(sum, 16); sum += __shfl_xor(sum, 32);
        const float inv = 1.0f / sum;
        f32x4 o[16];
#pragma unroll
        for (int i = 0; i < 16; ++i) o[i] = (f32x4){0.f, 0.f, 0.f, 0.f};
#pragma unroll
        for (int s2 = 0; s2 < 8; ++s2) {
            v4u pw; pw.x = pk2(s[2 * s2][0], s[2 * s2][1]); pw.y = pk2(s[2 * s2][2], s[2 * s2][3]); pw.z = pk2(s[2 * s2 + 1][0], s[2 * s2 + 1][1]); pw.w = pk2(s[2 * s2 + 1][2], s[2 * s2 + 1][3]);
            const bf16x8 pf = __builtin_bit_cast(bf16x8, pw);
#pragma unroll
            for (int dt = 0; dt < 16; ++dt) { const LAS bf16* vp = Vt + (16 * dt + r) * LDV + 32 * s2 + 4 * quad;
                const s16x4 lo = *(const LAS s16x4*)vp, hi4 = *(const LAS s16x4*)(vp + 16);
                o[dt] = mfma16(__builtin_shufflevector(lo, hi4, 0, 1, 2, 3, 4, 5, 6, 7), pf, o[dt]); }
        }
        bf16* op = O + row * D + h * 256 + 4 * quad;
#pragma unroll
        for (int dt = 0; dt < 16; ++dt) *(GAS v2u*)(op + 16 * dt) = (v2u){pk2(o[dt][0] * inv, o[dt][1] * inv), pk2(o[dt][2] * inv, o[dt][3] * inv)};
    }
}
template <class Epi> DI void run_gemm(Frame& F, const bf16* A, const bf16* Bt, int M_, int N_, int K_, const Epi& E) {
    pg8::Gemm g{A, Bt, M_, N_, K_}; pg8::StaticOrder S; S.init(M_, N_, F.G, F.wg);
    pg8::gemm_phase<Epi, pg8::StaticOrder, PG8_ALIGN, PG8_SP2>(F.lds, g, S, E, F.tid);
}
constexpr int NPHASE = 43, PH_FINAL = 42, PPL = 10;
struct Args { In in; float* out; unsigned char* ws; int ph_lo, ph_hi, region, pad; };
__global__ void __launch_bounds__(NTHR, 2) fwd(Args a) {
    extern __shared__ __attribute__((aligned(16))) unsigned char lds_raw[];
    Frame F;
    F.lds = (LAS unsigned char*)lds_raw;
    F.tid = threadIdx.x; F.lane = F.tid & 63; F.wave = __builtin_amdgcn_readfirstlane(F.tid >> 6);
    F.G = gridDim.x; F.wg = blockIdx.x; F.gw = F.wg * NWAVES + F.wave; F.NGW = F.G * NWAVES;
    volatile LAS unsigned* MISC = (volatile LAS unsigned*)(F.lds + MISC_OFF);
    if (F.tid < 32) MISC[F.tid] = 0u;
    __syncthreads();
    const int lo = a.ph_lo, hi = a.ph_hi;
    unsigned char* ws = a.ws; const In& I = a.in;
    XcdBarrier bar; bar.bar = (unsigned*)(ws + WS_CTL) + CW_BAR + a.region * XCD_BAR_WORDS; bar.x = 0; bar.st = MISC + 8;
    if (hi - lo > 1) bar = xcd_barrier_post(bar.bar, MISC + 8);
#define IN(k) (lo <= (k) && (k) < hi)
#ifndef PROBE_DOUBLE
#define PROBE_DOUBLE -1
#endif
#ifndef PROBE_PAR
#define PROBE_PAR -1
#endif
#define PHASE(k) asm volatile("" : "+v"(F.tid)); F.lane = F.tid & 63; if (IN(k))
#define DUPQ(c) ((c) == PROBE_DOUBLE && (PROBE_PAR < 0 || (l & 1) == PROBE_PAR))
#ifndef PROBE_SEL
#define PROBE_SEL -1
#endif
    F.tacc = 0ull;
    unsigned long long tacc = 0ull, tlast = (PROBE_SEL >= 0) ? __builtin_amdgcn_s_memrealtime() : 0ull;
#define SELQ(k) ((PROBE_SEL >= 0 && PROBE_SEL <= 12) ? ((k) >= 2 && (k) < PH_FINAL && ((k) - 2) % PPL == PROBE_SEL && (PROBE_PAR < 0 || ((((k) - 2) / PPL) & 1) == PROBE_PAR)) : (PROBE_SEL == 101 ? (k) == 0 : (PROBE_SEL == 102 ? (k) == 1 : (PROBE_SEL == 103 ? (k) == PH_FINAL : false))))
#define SEAM(k) do { if (IN(k) && IN((k) + 1)) { \
        if (PROBE_SEL >= 0) { const unsigned long long tn_ = __builtin_amdgcn_s_memrealtime(); if (SELQ(k)) tacc += tn_ - tlast; tlast = tn_; } \
        xcd_barrier(bar); \
        if (PROBE_SEL >= 0) { const unsigned long long tn_ = __builtin_amdgcn_s_memrealtime(); if (PROBE_SEL == 100 || (PROBE_SEL >= 200 && (k) >= 2 && (k) < PH_FINAL && ((k) - 2) % PPL == PROBE_SEL - 200 && (PROBE_PAR < 0 || ((((k) - 2) / PPL) & 1) == PROBE_PAR))) tacc += tn_ - tlast; tlast = tn_; } } } while (0)
    bf16* H = (bf16*)(ws + WS_H); bf16* MIX = (bf16*)(ws + WS_MIX); bf16* BIG = (bf16*)(ws + WS_BIG); bf16* KVX = (bf16*)(ws + WS_KVX);
    float* GATE = (float*)(ws + WS_GATE); const bf16* WG = (const bf16*)(ws + WS_WG);

    PHASE(0) { p0_prologue(F, I, ws);
#ifdef PROBE_P0
        p0_prologue(F, I, ws);
#endif
    }
    SEAM(0);
    PHASE(1) run_gemm(F, (const bf16*)(ws + WS_MEMN), (const bf16*)(ws + WS_WKV), BATCH * MEMLEN, 8192, D, pg8::EpiBf16<0>{KVX, 8192, nullptr});
    SEAM(1);
    pg8::rs_t* RSA = (pg8::rs_t*)(ws + WS_RS);
#define RS_R(p) (RSA + (size_t)((p) & 1) * M)
#define RS_ZERO(p) do { pg8::rs_t* z_ = RSA + (size_t)(((p) + 1) & 1) * M; for (int i_ = F.wg * NTHR + F.tid; i_ < M; i_ += F.G * NTHR) __hip_atomic_store(z_ + i_, (pg8::rs_t)0, __ATOMIC_RELAXED, __HIP_MEMORY_SCOPE_AGENT); } while (0)
    for (int l = 0; l < DEPTH; ++l) {
        asm volatile("" : "+v"(F.tid)); F.lane = F.tid & 63;
        const int pb = 2 + PPL * l, j = l >> 1; const bool odd = (l & 1) != 0;
        unsigned char* wl = ws + WS_W + (size_t)l * W_LAYER;
        const float* xcur = (l == 0) ? I.p[0] : a.out;
        PHASE(pb + 0) { const int n = odd ? C_N : AB_N;
            run_gemm(F, H, (const bf16*)(wl + WO_WIN), M, n, D, pg8::EpiBlk{BIG, odd ? (bf16*)(ws + WS_MIX + MIX_HALO) : nullptr, odd ? 2 : 1, RS_R(3 * l)});
            if (DUPQ(0)) { run_gemm(F, H, (const bf16*)(wl + WO_WIN), M, n, D, pg8::EpiBlk{BIG, odd ? (bf16*)(ws + WS_MIX + MIX_HALO) : nullptr, odd ? 2 : 1, RS_R(3 * l)}); }
            if (!odd) gates_phase<1>(F, H, RS_R(3 * l), WG + l * 16384, GATE, I.p[4] + j * 4, I.p[5] + j * 4);
            else gates_phase<2>(F, H, RS_R(3 * l), WG + l * 16384, GATE, I.p[10] + j * 8, I.p[11] + j * 8);
        }
        SEAM(pb + 0);
        PHASE(pb + 1) {
            if (!odd) {
                const int gh = F.G >= 64 ? 32 : F.G / 2;
                if (F.wg < gh) { for (int c = F.wg; c < 32; c += gh) mlstm_chunked(F, BIG, GATE, I.p[6] + j * 512, MIX, c); }
                else { for (int u = F.wg - gh; u < 2048; u += F.G - gh) sb_unit(F, BIG, MIX, u); }
            } else {
                gdn_g1_phase(F, BIG, (const bf16*)(ws + WS_MIX + MIX_HALO), GATE, I.p[9] + (size_t)j * 4 * 3072, H, (bf16*)(ws + WS_MIX + MIX_AT), (float*)(ws + WS_MIX + MIX_GL), true);
            }
        }
        SEAM(pb + 1);
        PHASE(pb + 2) { if (odd) { for (int c = F.wg; c < 256; c += F.G) gdn_g2_chain(F, BIG, H, (const bf16*)(ws + WS_MIX + MIX_AT), (const float*)(ws + WS_MIX + MIX_GL), c, true); } }
        if (odd) SEAM(pb + 2);
        PHASE(pb + 3) { if (odd) headnorm_phase<true>(F, H, MIX, BIG, I.p[12] + j * 128); }
        if (odd) SEAM(pb + 3);
        PHASE(pb + 4) { RS_ZERO(3 * l + 1); run_gemm(F, MIX, (const bf16*)(wl + WO_WOUT), M, D, D, pg8::EpiResidN{xcur, a.out, H, RS_R(3 * l + 1)}); }
        SEAM(pb + 4);
        PHASE(pb + 5) { run_gemm(F, H, (const bf16*)(wl + WO_WQ), M, D, D, pg8::EpiBf16<0>{BIG, D, RS_R(3 * l + 1)}); if (DUPQ(5)) { run_gemm(F, H, (const bf16*)(wl + WO_WQ), M, D, D, pg8::EpiBf16<0>{BIG, D, RS_R(3 * l + 1)}); } }
        SEAM(pb + 5);
        PHASE(pb + 6) { xattn_phase(F, BIG, KVX, l, MIX); if (DUPQ(6)) { xattn_phase(F, BIG, KVX, l, MIX); } }
        SEAM(pb + 6);
        PHASE(pb + 7) { RS_ZERO(3 * l + 2); run_gemm(F, MIX, (const bf16*)(wl + WO_WO), M, D, D, pg8::EpiResidN{a.out, a.out, H, RS_R(3 * l + 2)}); }
        SEAM(pb + 7);
        PHASE(pb + 8) { run_gemm(F, H, (const bf16*)(wl + WO_W1), M, FF, D, pg8::EpiBf16<2>{BIG, FF, RS_R(3 * l + 2)}); if (DUPQ(8)) { run_gemm(F, H, (const bf16*)(wl + WO_W1), M, FF, D, pg8::EpiBf16<2>{BIG, FF, RS_R(3 * l + 2)}); } }
        SEAM(pb + 8);
        PHASE(pb + 9) { RS_ZERO(3 * l + 3); run_gemm(F, BIG, (const bf16*)(wl + WO_W2), M, D, FF, pg8::EpiResidN{a.out, a.out, H, RS_R(3 * l + 3)}); }
        SEAM(pb + 9);
    }
    PHASE(PH_FINAL) final_norm_phase(F, a.out, I.p[23]);
    if (PROBE_SEL >= 0) { const unsigned long long te = __builtin_amdgcn_s_memrealtime(); if (SELQ(PH_FINAL)) tacc += te - tlast;

#ifdef PROBE_WGLO
        if (!(F.wg >= PROBE_WGLO && F.wg < PROBE_WGHI)) tacc = 0ull;
#endif
        if (PROBE_STG >= 0) tacc = F.tacc;
        while (__builtin_amdgcn_s_memrealtime() - te < tacc) __builtin_amdgcn_s_sleep(16); }
#undef IN
#undef PHASE
#undef SEAM
}

#ifndef MK_SPLIT
#define MK_SPLIT 0
#endif
extern "C" void kernel_launch(void* const* d_in, const int* in_sizes, int n_in, void* d_out, int out_size, void* d_ws, size_t ws_size, hipStream_t stream) {
    static int grid = 0;
    if (grid == 0) {
        if (n_in != 24 || in_sizes[0] != M * D || out_size != M * D || ws_size < WS_END) { fprintf(stderr, "kernel_launch: unexpected shapes (n_in %d, in0 %d, out %d, ws %zu)\n", n_in, n_in > 0 ? in_sizes[0] : -1, out_size, ws_size); grid = -1; return; }
        int dev = 0, cus = 0;
        if (hipGetDevice(&dev) != hipSuccess || hipDeviceGetAttribute(&cus, hipDeviceAttributeMultiprocessorCount, dev) != hipSuccess) { grid = -1; return; }
        if (hipFuncSetAttribute((const void*)fwd, hipFuncAttributeMaxDynamicSharedMemorySize, LDS_BYTES) != hipSuccess) { fprintf(stderr, "kernel_launch: hipFuncSetAttribute failed\n"); grid = -1; return; }
        (void)hipGetLastError();
        grid = cus;
    }
    if (grid < 0) return;
    (void)hipMemsetAsync((char*)d_ws + WS_CTL, 0, CTL_ZERO_BYTES, stream);
    Args a{};
    for (int i = 0; i < 24; ++i) a.in.p[i] = (const float*)d_in[i];
    a.out = (float*)d_out; a.ws = (unsigned char*)d_ws; a.region = 0; a.pad = 0;
#if MK_SPLIT
    for (int p = 0; p < NPHASE; ++p) { a.ph_lo = p; a.ph_hi = p + 1; hipLaunchKernelGGL(fwd, dim3(grid), dim3(NTHR), LDS_BYTES, stream, a); }
#else
    a.ph_lo = 0; a.ph_hi = NPHASE; hipLaunchKernelGGL(fwd, dim3(grid), dim3(NTHR), LDS_BYTES, stream, a);
#endif
}
```

```cpp
#include <hip/hip_runtime.h>
#include <cstdio>
#include <cstdint>
namespace pg8 {
#define PG8_LAS __attribute__((address_space(3)))
typedef unsigned short bf16_t;
typedef short bf16x8 __attribute__((ext_vector_type(8)));
typedef float f32x4 __attribute__((ext_vector_type(4)));
typedef unsigned u32x4 __attribute__((ext_vector_type(4)));
constexpr int BM = 256, BK = 64, HALF = 128, HTB = HALF * BK * 2  , STAGE_BYTES = 8 * HTB, NXCD = 8, WGM = 8;

__host__ __device__ __forceinline__ int lds_byte(int r, int c) { const int st = (r >> 4) * 2 + (c >> 5), rr = r & 15, cc = c & 31, ob = rr * 64 + cc * 2; return st * 1024 + (ob ^ (((ob >> 9) & 1) << 5)); }
__host__ __device__ __forceinline__ void stage_rc(int b, int& R, int& C) { const int st = b / 1024, sb = b % 1024, swz = sb ^ (((sb >> 9) & 1) << 5); R = (st >> 1) * 16 + swz / 64; C = (st & 1) * 32 + (swz % 64) / 2; }
__host__ __device__ __forceinline__ int perm32(int rho) { const int n = rho >> 4, i = rho & 15; return 8 * (i >> 2) + 4 * n + (i & 3); }

struct Unit { int pm, pn; };
struct Gemm { const bf16_t* A; const bf16_t* Bt; int M, N, K; };

struct StaticOrder {
    int nM, nN, nwg, G, c;
    __host__ __device__ void init(int M, int N, int G_, int c_) { nM = M / BM; nN = N / BM; nwg = nM * nN; G = G_; c = c_; }
    __host__ __device__ bool next(int i, Unit& u) const {
        const long L = (long)i * G + c; if (L >= nwg) return false;
        int wgid = (int)L; { const int q = nwg / NXCD, r = nwg % NXCD, xcd = wgid % NXCD, off = wgid / NXCD; wgid = (xcd < r ? xcd * (q + 1) : r * (q + 1) + (xcd - r) * q) + off; }
        const int nig = WGM * nN, gid = wgid / nig, fm = gid * WGM, gsz = (nM - fm) < WGM ? (nM - fm) : WGM;
        u.pm = fm + ((wgid % nig) % gsz); u.pn = (wgid % nig) / gsz; return true;
    }
    __device__ __forceinline__ void a_ready(const Unit&) const {}
    __device__ __forceinline__ void done(const Unit&) const {}
};

__device__ __forceinline__ unsigned cvt_pk_bf16(float lo, float hi) { unsigned r; asm volatile("v_cvt_pk_bf16_f32 %0, %1, %2" : "=v"(r) : "v"(lo), "v"(hi)); return r; }
typedef unsigned long long rs_t;
__device__ __forceinline__ rs_t rs_fix(float ss) { return (rs_t)(ss * 16777216.0f + 0.5f); }
__device__ __forceinline__ float row_rstd(const rs_t* rs, int row) { return __builtin_amdgcn_rsqf((float)__hip_atomic_load(rs + row, __ATOMIC_RELAXED, __HIP_MEMORY_SCOPE_AGENT) * (1.0f / (16777216.0f * 1024.0f)) + 1e-6f); }
template <int ACT> struct EpiBf16 {
    static constexpr bool PERM = true, AFTER_DRAIN = false;
    bf16_t* O; int ldc; const rs_t* rs;
    __device__ __forceinline__ void operator()(const f32x4 (&acc)[2][2][4][2], const Unit& u, int wr, int wc, int fr, int fq) const {
        const int row0 = u.pm * BM + wr * 64 + fr; const int col0 = u.pn * BM + wc * 32 + 8 * fq;
#pragma unroll
        for (int ai = 0; ai < 2; ++ai)
#pragma unroll
            for (int m = 0; m < 4; ++m) { bf16_t* rowp = O + (size_t)(row0 + ai * HALF + m * 16) * ldc + col0;
                const float sc = rs ? row_rstd(rs, row0 + ai * HALF + m * 16) : 1.0f;
#pragma unroll
                for (int bj = 0; bj < 2; ++bj) { f32x4 v0 = acc[ai][bj][m][0] * sc, v1 = acc[ai][bj][m][1] * sc;
                    if (ACT == 2) {
#pragma unroll
                        for (int j = 0; j < 4; ++j) { const float a = fmaxf(v0[j], 0.f), b = fmaxf(v1[j], 0.f); v0[j] = a * a; v1[j] = b * b; } }
                    u32x4 w; w.x = cvt_pk_bf16(v0[0], v0[1]); w.y = cvt_pk_bf16(v0[2], v0[3]); w.z = cvt_pk_bf16(v1[0], v1[1]); w.w = cvt_pk_bf16(v1[2], v1[3]);
                    *(u32x4*)(rowp + bj * HALF) = w; }
                if (m & 1) asm volatile("" ::: "memory"); }
    }
};

struct EpiBlk {
    static constexpr bool PERM = true, AFTER_DRAIN = false;
    bf16_t* O; bf16_t* halo; int LAYOUT; const rs_t* rs;
    __device__ __forceinline__ void operator()(const f32x4 (&acc)[2][2][4][2], const Unit& u, int wr, int wc, int fr, int fq) const {
        constexpr int TT = 8192; constexpr size_t MTOT = 65536;
        const int row0 = u.pm * BM + wr * 64 + fr; const int b = row0 >> 13, t0 = row0 & (TT - 1);
        const int col0 = u.pn * BM + wc * 32 + 8 * fq;
        const bool dohalo = (LAYOUT == 2) && (halo != nullptr) && (fr >= 13) && (u.pn < 12);
        size_t base[2]; int wv[2];
#pragma unroll
        for (int bj = 0; bj < 2; ++bj) {
            const int cb = u.pn * BM + bj * HALF + wc * 32;
            if (LAYOUT == 2) { const int c0 = cb & ~1023, h = (cb >> 7) & 7; wv[bj] = 128; base[bj] = MTOT * c0 + (size_t)((b * 8 + h) * TT) * 128 + (cb & 127) + 8 * fq; }
            else if (cb < 512) { const int c0 = cb & ~255, h = (cb >> 6) & 3; wv[bj] = 64; base[bj] = MTOT * c0 + (size_t)((b * 4 + h) * TT) * 64 + (cb & 63) + 8 * fq; }
            else { const int c0 = 512 + ((cb - 512) & ~511), h = ((cb - 512) >> 7) & 3; wv[bj] = 128; base[bj] = MTOT * c0 + (size_t)((b * 4 + h) * TT) * 128 + (cb & 127) + 8 * fq; }
        }
#pragma unroll
        for (int ai = 0; ai < 2; ++ai)
#pragma unroll
            for (int m = 0; m < 4; ++m) { const int t = t0 + ai * HALF + m * 16; const float sc = row_rstd(rs, row0 + ai * HALF + m * 16);
#pragma unroll
                for (int bj = 0; bj < 2; ++bj) {
                    const f32x4 v0 = acc[ai][bj][m][0] * sc, v1 = acc[ai][bj][m][1] * sc;
                    u32x4 ww; ww.x = cvt_pk_bf16(v0[0], v0[1]); ww.y = cvt_pk_bf16(v0[2], v0[3]); ww.z = cvt_pk_bf16(v1[0], v1[1]); ww.w = cvt_pk_bf16(v1[2], v1[3]);
                    *(u32x4*)(O + base[bj] + (size_t)t * wv[bj]) = ww;
                    if (m == 3 && dohalo) *(u32x4*)(halo + ((size_t)((row0 + ai * HALF + 48) >> 6) * 3 + (fr - 13)) * 3072 + col0 + bj * HALF) = ww; }
                if (m & 1) asm volatile("" ::: "memory"); }
    }
};
struct EpiResidN {
    static constexpr bool PERM = false, AFTER_DRAIN = false;
    const float* base; float* out; bf16_t* xb; rs_t* rs;
    __device__ __forceinline__ void operator()(const f32x4 (&acc)[2][2][4][2], const Unit& u, int wr, int wc, int fr, int fq) const {
        const int row0 = u.pm * BM + wr * 64 + fr, col0 = u.pn * BM + wc * 32 + 4 * fq;
#pragma unroll
        for (int ai = 0; ai < 2; ++ai)
#pragma unroll
            for (int m = 0; m < 4; ++m) { const int row = row0 + ai * HALF + m * 16; const size_t off = (size_t)row * 1024 + col0; float ss = 0.f;
#pragma unroll
                for (int bj = 0; bj < 2; ++bj)
#pragma unroll
                    for (int n = 0; n < 2; ++n) { const f32x4 bs = *(const f32x4*)(base + off + bj * HALF + n * 16); const f32x4 o = bs + acc[ai][bj][m][n];
                        *(f32x4*)(out + off + bj * HALF + n * 16) = o; ss += (o[0] * o[0] + o[1] * o[1]) + (o[2] * o[2] + o[3] * o[3]);
                        typedef unsigned u32x2_ __attribute__((ext_vector_type(2))); u32x2_ w; w.x = cvt_pk_bf16(o[0], o[1]); w.y = cvt_pk_bf16(o[2], o[3]);
                        *(u32x2_*)(xb + off + bj * HALF + n * 16) = w; }
                ss += __shfl_xor(ss, 16); ss += __shfl_xor(ss, 32);
                if (fq == 0) __hip_atomic_fetch_add(rs + row, rs_fix(ss), __ATOMIC_RELAXED, __HIP_MEMORY_SCOPE_AGENT);
                if (m & 1) asm volatile("" ::: "memory"); }
    }
};
struct EpiResidB {
    static constexpr bool PERM = false, AFTER_DRAIN = false;
    bf16_t* xs; rs_t* rs;
    __device__ __forceinline__ void operator()(const f32x4 (&acc)[2][2][4][2], const Unit& u, int wr, int wc, int fr, int fq) const {
        typedef unsigned u32x2_ __attribute__((ext_vector_type(2)));
        const int row0 = u.pm * BM + wr * 64 + fr, col0 = u.pn * BM + wc * 32 + 4 * fq;
#pragma unroll
        for (int ai = 0; ai < 2; ++ai)
#pragma unroll
            for (int m = 0; m < 4; ++m) { const int row = row0 + ai * HALF + m * 16; bf16_t* p = xs + (size_t)row * 1024 + col0; float ss = 0.f;
                u32x2_ old[2][2];
#pragma unroll
                for (int bj = 0; bj < 2; ++bj)
#pragma unroll
                    for (int n = 0; n < 2; ++n) old[bj][n] = *(const u32x2_*)(p + bj * HALF + n * 16);
#pragma unroll
                for (int bj = 0; bj < 2; ++bj)
#pragma unroll
                    for (int n = 0; n < 2; ++n) { const u32x2_ b = old[bj][n]; const f32x4 a = acc[ai][bj][m][n];
                        u32x2_ w; w.x = cvt_pk_bf16(__uint_as_float(b.x << 16) + a[0], __uint_as_float(b.x & 0xffff0000u) + a[1]); w.y = cvt_pk_bf16(__uint_as_float(b.y << 16) + a[2], __uint_as_float(b.y & 0xffff0000u) + a[3]);
                        *(u32x2_*)(p + bj * HALF + n * 16) = w;
                        const float r0 = __uint_as_float(w.x << 16), r1 = __uint_as_float(w.x & 0xffff0000u), r2 = __uint_as_float(w.y << 16), r3 = __uint_as_float(w.y & 0xffff0000u);
                        ss += (r0 * r0 + r1 * r1) + (r2 * r2 + r3 * r3); }
                ss += __shfl_xor(ss, 16); ss += __shfl_xor(ss, 32);
                if (fq == 0) __hip_atomic_fetch_add(rs + row, rs_fix(ss), __ATOMIC_RELAXED, __HIP_MEMORY_SCOPE_AGENT);
                if (m & 1) asm volatile("" ::: "memory"); }
    }
};
struct EpiResid {
    static constexpr bool PERM = false, AFTER_DRAIN = false;
    const float* base; float* out; int ldc;
    __device__ __forceinline__ void operator()(const f32x4 (&acc)[2][2][4][2], const Unit& u, int wr, int wc, int fr, int fq) const {
        const int row0 = u.pm * BM + wr * 64 + fr, col0 = u.pn * BM + wc * 32 + 4 * fq;
#pragma unroll
        for (int ai = 0; ai < 2; ++ai)
#pragma unroll
            for (int m = 0; m < 4; ++m) { const size_t off = (size_t)(row0 + ai * HALF + m * 16) * ldc + col0;
#pragma unroll
                for (int bj = 0; bj < 2; ++bj)
#pragma unroll
                    for (int n = 0; n < 2; ++n) { const f32x4 bs = *(const f32x4*)(base + off + bj * HALF + n * 16); *(f32x4*)(out + off + bj * HALF + n * 16) = bs + acc[ai][bj][m][n]; }
                if (m & 1) asm volatile("" ::: "memory"); }
    }
};
template <class Epi, class Sched, bool ALIGN_EPI = false, bool SP2 = false>
__device__ __forceinline__ void gemm_phase(PG8_LAS unsigned char* lds, const Gemm g, const Sched& S, const Epi& E, int tid_in) {
    int tid_ = tid_in; asm volatile("" : "+v"(tid_)); const int tid = tid_, wid = __builtin_amdgcn_readfirstlane(tid >> 6), lane = tid & 63, wr = wid >> 2, wc = wid & 3, fr = lane & 15, fq = lane >> 4;
    const int K = g.K, nt = K / BK;
    unsigned voffA[2], voffB[2];
#pragma unroll
    for (int i = 0; i < 2; ++i) { int R, C; stage_rc(tid * 16 + i * 8192, R, C); const int Rb = Epi::PERM ? ((R & ~31) + perm32(R & 31)) : R;
        voffA[i] = (unsigned)(R * K + C) * 2u; voffB[i] = (unsigned)(Rb * K + C) * 2u; }
    const size_t kstep = (size_t)(BK * 2);
    const size_t hstep = (size_t)HALF * K * 2;
    const size_t tstep = 2 * hstep;
    const unsigned ldsw = (unsigned)wid * 1024u;
    const int aoff = lds_byte(wr * 64 + fr, fq * 8), boff = lds_byte(wc * 32 + fr, fq * 8);
#define PG8_SA(b, h) (((b) * 2 + (h)) * HTB)
#define PG8_SB(b, h) ((4 + (b) * 2 + (h)) * HTB)
#define PG8_STAGE(bufoff, gbase, voff) do { _Pragma("unroll") for (int _i = 0; _i < 2; ++_i) \
        __builtin_amdgcn_global_load_lds((const unsigned*)((const char*)(gbase) + (voff)[_i]), (PG8_LAS unsigned*)(lds + (bufoff) + ldsw + _i * 8192), 16, 0, 0); } while (0)
#define PG8_LDA(dst, b, h) do { _Pragma("unroll") for (int m = 0; m < 4; ++m) _Pragma("unroll") for (int k = 0; k < 2; ++k) dst[m][k] = *(const PG8_LAS bf16x8*)(lds + PG8_SA(b, h) + aoff + m * 2048 + k * 1024); } while (0)
#define PG8_LDB(dst, b, h) do { _Pragma("unroll") for (int n = 0; n < 2; ++n) _Pragma("unroll") for (int k = 0; k < 2; ++k) dst[n][k] = *(const PG8_LAS bf16x8*)(lds + PG8_SB(b, h) + boff + n * 2048 + k * 1024); } while (0)
#define PG8_MMA(ai, bj, At, Bt) do { __builtin_amdgcn_s_setprio(1); _Pragma("unroll") for (int m = 0; m < 4; ++m) _Pragma("unroll") for (int n = 0; n < 2; ++n) _Pragma("unroll") for (int k = 0; k < 2; ++k) \
        acc[ai][bj][m][n] = __builtin_amdgcn_mfma_f32_16x16x32_bf16(Bt[n][k], At[m][k], acc[ai][bj][m][n], 0, 0, 0); __builtin_amdgcn_s_setprio(0); } while (0)
#define PG8_WAIT_V(n) asm volatile("s_waitcnt vmcnt(" #n ")" ::: "memory")
#define PG8_WAIT_L(n) asm volatile("s_waitcnt lgkmcnt(" #n ")" ::: "memory")
#define PG8_BAR __builtin_amdgcn_s_barrier()
#define PG8_SCHED __builtin_amdgcn_sched_barrier(0)
    Unit cur, nxt; int ui = 0;
    if (!S.next(0, cur)) return;
    f32x4 acc[2][2][4][2];
#pragma unroll
    for (int a = 0; a < 2; ++a)
#pragma unroll
        for (int b = 0; b < 2; ++b)
#pragma unroll
            for (int m = 0; m < 4; ++m)
#pragma unroll
                for (int n = 0; n < 2; ++n) acc[a][b][m][n] = (f32x4){0.f, 0.f, 0.f, 0.f};
    bf16x8 At[4][2], B0[2][2], B1[2][2];
    const char* cA = (const char*)g.A + (size_t)cur.pm * tstep; const char* cB = (const char*)g.Bt + (size_t)cur.pn * tstep;
    S.a_ready(cur);
    if constexpr (SP2) {
        PG8_STAGE(PG8_SB(0, 0), cB, voffB); PG8_STAGE(PG8_SB(0, 1), cB + hstep, voffB); PG8_STAGE(PG8_SA(0, 0), cA, voffA); PG8_STAGE(PG8_SA(0, 1), cA + hstep, voffA);
        if (wr == 1) PG8_BAR;
        PG8_WAIT_V(2); PG8_BAR;
        PG8_STAGE(PG8_SB(1, 0), cB + kstep, voffB); PG8_STAGE(PG8_SA(1, 0), cA + kstep, voffA); PG8_STAGE(PG8_SB(1, 1), cB + hstep + kstep, voffB);
        PG8_WAIT_V(6); PG8_BAR;
    } else {
        PG8_STAGE(PG8_SB(0, 0), cB, voffB); PG8_STAGE(PG8_SA(0, 0), cA, voffA); PG8_STAGE(PG8_SB(0, 1), cB + hstep, voffB); PG8_STAGE(PG8_SA(0, 1), cA + hstep, voffA);
        if (wr == 1) PG8_BAR;
        PG8_WAIT_V(4); PG8_BAR;
        PG8_STAGE(PG8_SB(1, 0), cB + kstep, voffB); PG8_STAGE(PG8_SA(1, 0), cA + kstep, voffA); PG8_STAGE(PG8_SB(1, 1), cB + hstep + kstep, voffB);
        PG8_WAIT_V(6); PG8_BAR;
    }
    for (;;) {
        const bool has_next = S.next(ui + 1, nxt);
        const char* nA = has_next ? (const char*)g.A + (size_t)nxt.pm * tstep : cA; const char* nB = has_next ? (const char*)g.Bt + (size_t)nxt.pn * tstep : cB;
        for (int t = 0; t < nt; t += 2) {
            const bool last = (t == nt - 2);
            const char* a1 = cA + (size_t)(t + 1) * kstep;
            const char* a2 = last ? nA : cA + (size_t)(t + 2) * kstep; const char* b2 = last ? nB : cB + (size_t)(t + 2) * kstep;
            const char* a3 = a2 + kstep; const char* b3 = b2 + kstep;
            if (last && has_next) S.a_ready(nxt);
            if constexpr (SP2) {
            PG8_LDB(B0, 0, 0); PG8_LDB(B1, 0, 1); PG8_SCHED; PG8_LDA(At, 0, 0); PG8_STAGE(PG8_SA(1, 1), a1 + hstep, voffA);
            PG8_WAIT_V(8); PG8_WAIT_L(0); PG8_BAR; PG8_MMA(0, 0, At, B0); PG8_MMA(0, 1, At, B1); PG8_BAR; PG8_SCHED;
            PG8_LDA(At, 0, 1); PG8_STAGE(PG8_SB(0, 0), b2, voffB); PG8_STAGE(PG8_SB(0, 1), b2 + hstep, voffB); PG8_STAGE(PG8_SA(0, 0), a2, voffA);
            PG8_WAIT_V(8); PG8_WAIT_L(0); PG8_BAR; PG8_MMA(1, 0, At, B0); PG8_MMA(1, 1, At, B1); PG8_BAR; PG8_SCHED;
            PG8_LDB(B0, 1, 0); PG8_LDB(B1, 1, 1); PG8_SCHED; PG8_LDA(At, 1, 0); PG8_STAGE(PG8_SA(0, 1), a2 + hstep, voffA);
            PG8_WAIT_V(8); PG8_WAIT_L(0); PG8_BAR; PG8_MMA(0, 0, At, B0); PG8_MMA(0, 1, At, B1); PG8_BAR; PG8_SCHED;
            PG8_LDA(At, 1, 1); PG8_STAGE(PG8_SB(1, 0), b3, voffB); PG8_STAGE(PG8_SB(1, 1), b3 + hstep, voffB); PG8_STAGE(PG8_SA(1, 0), a3, voffA);
            PG8_WAIT_V(8); PG8_WAIT_L(0); PG8_BAR; PG8_MMA(1, 0, At, B0); PG8_MMA(1, 1, At, B1); PG8_BAR; PG8_SCHED;
            } else {
            PG8_LDB(B0, 0, 0); PG8_SCHED; PG8_LDA(At, 0, 0); PG8_STAGE(PG8_SA(1, 1), a1 + hstep, voffA);
            PG8_WAIT_L(8); PG8_BAR; PG8_WAIT_L(0); PG8_MMA(0, 0, At, B0); PG8_BAR; PG8_SCHED;
            PG8_LDB(B1, 0, 1); PG8_STAGE(PG8_SB(0, 0), b2, voffB);
            PG8_BAR; PG8_WAIT_L(0); PG8_MMA(0, 1, At, B1); PG8_BAR;
            PG8_LDA(At, 0, 1); PG8_STAGE(PG8_SA(0, 0), a2, voffA);
            PG8_BAR; PG8_WAIT_L(0); PG8_MMA(1, 0, At, B0); PG8_BAR; PG8_SCHED;
            PG8_STAGE(PG8_SB(0, 1), b2 + hstep, voffB);
            PG8_WAIT_V(6); PG8_BAR; PG8_MMA(1, 1, At, B1); PG8_BAR;
            PG8_LDB(B0, 1, 0); PG8_SCHED; PG8_LDA(At, 1, 0); PG8_STAGE(PG8_SA(0, 1), a2 + hstep, voffA);
            PG8_WAIT_L(8); PG8_BAR; PG8_WAIT_L(0); PG8_MMA(0, 0, At, B0); PG8_BAR; PG8_SCHED;
            PG8_LDB(B1, 1, 1); PG8_STAGE(PG8_SB(1, 0), b3, voffB);
            PG8_BAR; PG8_WAIT_L(0); PG8_MMA(0, 1, At, B1); PG8_BAR;
            PG8_LDA(At, 1, 1); PG8_STAGE(PG8_SA(1, 0), a3, voffA);
            PG8_BAR; PG8_WAIT_L(0); PG8_MMA(1, 0, At, B0); PG8_BAR; PG8_SCHED;
            PG8_STAGE(PG8_SB(1, 1), b3 + hstep, voffB);
            PG8_WAIT_V(6); PG8_BAR; PG8_MMA(1, 1, At, B1); PG8_BAR;
            }
        }
        if constexpr (ALIGN_EPI) { if (wr == 0) PG8_BAR; }
        if constexpr (!Epi::AFTER_DRAIN) { E(acc, cur, wr, wc, fr, fq); S.done(cur); }
        if (!has_next) break;
#pragma unroll
        for (int a = 0; a < 2; ++a)
#pragma unroll
            for (int b = 0; b < 2; ++b)
#pragma unroll
                for (int m = 0; m < 4; ++m)
#pragma unroll
                    for (int n = 0; n < 2; ++n) acc[a][b][m][n] = (f32x4){0.f, 0.f, 0.f, 0.f};
        cur = nxt; cA = nA; cB = nB; ++ui;
        if constexpr (ALIGN_EPI) { if (wr == 1) PG8_BAR; }
    }
    PG8_WAIT_V(0);
    if constexpr (!ALIGN_EPI) { if (wr == 0) PG8_BAR; }
    PG8_BAR;
    if constexpr (Epi::AFTER_DRAIN) { E.fused(acc, cur, wr, wc, fr, fq, lds, wid, lane); S.done(cur); }
#undef PG8_SA
#undef PG8_SB
#undef PG8_STAGE
#undef PG8_LDA
#undef PG8_LDB
#undef PG8_MMA
#undef PG8_WAIT_V
#undef PG8_WAIT_L
#undef PG8_BAR
#undef PG8_SCHED
}
}
#ifndef PG8_SP2
#define PG8_SP2 true
#endif
#ifndef PG8_ALIGN
#define PG8_ALIGN true
#endif
constexpr int NWAVES = 8, NTHR = 512;
constexpr int BATCH = 8, T = 8192, D = 1024, DEPTH = 4, MEMLEN = 256, FF = 4096;
constexpr int M = BATCH * T;
constexpr int AB_IN = 3080, AB_N = 3072, C_IN = 4112, C_N = 4096;
constexpr float EPS = 1e-6f;
constexpr float SB_THR = 40.0f;

constexpr size_t MiB = 1u << 20;
constexpr size_t WS_CTL = 0, CTL_ZERO_BYTES = 1 * MiB;
constexpr size_t WS_WG = 1 * MiB;
constexpr size_t WS_MEMN = 2 * MiB;
constexpr size_t WS_WKV = 6 * MiB;
constexpr size_t WS_W = 22 * MiB, W_LAYER = 30 * MiB;
constexpr size_t WO_WIN = 0, WO_WOUT = 8 * MiB, WO_WQ = 10 * MiB, WO_WO = 12 * MiB, WO_W1 = 14 * MiB, WO_W2 = 22 * MiB;
constexpr size_t WS_KVX = 142 * MiB;
constexpr size_t WS_GATE = 174 * MiB;
constexpr size_t WS_H = 178 * MiB;
constexpr size_t WS_MIX = 306 * MiB;
constexpr size_t WS_BIG = 434 * MiB;
constexpr size_t WS_RS = 946 * MiB;
constexpr size_t WS_MLS = 950 * MiB;
constexpr size_t WS_END = 956 * MiB;
constexpr int CW_TMO = 0, CW_BAR = 4096;

constexpr int LDS_BYTES = 147456;
constexpr int MISC_OFF = 140 * 1024;

#define GAS __attribute__((address_space(1)))
#define LAS __attribute__((address_space(3)))
#define DI __device__ __forceinline__
typedef unsigned short bf16;
typedef unsigned v4u __attribute__((ext_vector_type(4)));
typedef unsigned v2u __attribute__((ext_vector_type(2)));
typedef float f32x4 __attribute__((ext_vector_type(4)));
typedef short bf16x8 __attribute__((ext_vector_type(8)));
typedef short s16x4 __attribute__((ext_vector_type(4)));
#define LDS_WAIT() asm volatile("s_waitcnt lgkmcnt(0)" ::: "memory")
typedef float f32x2_ __attribute__((ext_vector_type(2)));
typedef __bf16 bf16x2_ __attribute__((ext_vector_type(2)));
DI unsigned pk2(float lo, float hi) { const f32x2_ v = {lo, hi}; return __builtin_bit_cast(unsigned, __builtin_convertvector(v, bf16x2_)); }
DI unsigned f2bf(float f) { return pk2(f, f) & 0xffffu; }
DI float bf2f(unsigned short b) { return __builtin_bit_cast(float, ((unsigned)b) << 16); }
DI float bflo(unsigned u) { return __builtin_bit_cast(float, u << 16); }
DI float bfhi(unsigned u) { return __builtin_bit_cast(float, u & 0xffff0000u); }
DI float wave_sum(float v) {
#pragma unroll
    for (int o = 1; o < 64; o <<= 1) v += __shfl_xor(v, o);
    return v;
}
DI float rcp_(float x) { return __builtin_amdgcn_rcpf(x); }
DI float rsq_(float x) { return __builtin_amdgcn_rsqf(x); }
DI float sigmoidf_(float x) { return rcp_(1.0f + __expf(-x)); }
DI void lds_barrier() { asm volatile("s_waitcnt lgkmcnt(0)" ::: "memory"); __builtin_amdgcn_s_barrier(); asm volatile("" ::: "memory"); }
#ifndef PROBE_STG
#define PROBE_STG -1
#endif
#define STG_T0() unsigned long long stg_t_ = (PROBE_STG >= 0) ? __builtin_amdgcn_s_memrealtime() : 0ull
#define STG(n) do { if (PROBE_STG >= 0) { const unsigned long long t_ = __builtin_amdgcn_s_memrealtime(); if (PROBE_STG == (n)) F.tacc += t_ - stg_t_; stg_t_ = t_; } } while (0)
DI f32x4 mfma16(bf16x8 a, bf16x8 b, f32x4 c) { return __builtin_amdgcn_mfma_f32_16x16x32_bf16(a, b, c, 0, 0, 0); }
#define XB_TMO      128
#define XB_XCNT(j)  (256  + 64 * (j))
#define XB_XSUB(j)  (1280 + 64 * (j))
#define XB_XGEN(j)  (2304 + 64 * (j))
#define XB_TOP      3328
#define XB_TOPGEN   3392
#define XCD_BAR_WORDS 3456
#define XB_SPIN_CAP (1u << 22)

__device__ __forceinline__ unsigned xb_ld(unsigned* p)              { return __hip_atomic_load(p, __ATOMIC_RELAXED, __HIP_MEMORY_SCOPE_AGENT); }
__device__ __forceinline__ unsigned xb_add(unsigned* p, unsigned v) { return __hip_atomic_fetch_add(p, v, __ATOMIC_RELAXED, __HIP_MEMORY_SCOPE_AGENT); }
__device__ __forceinline__ unsigned xb_xcc_id() { return (unsigned)__builtin_amdgcn_s_getreg((3 << 11) | 20) & 0xFu; }
#define XB_SPIN(cond, bar) do { unsigned _sp = 0; while (cond) { __builtin_amdgcn_s_sleep(1); \
    if ((++_sp & 255u) == 0u) { if (xb_ld(&(bar)[XB_TMO])) break; if (_sp > XB_SPIN_CAP) { atomicAdd(&(bar)[XB_TMO], 1u); break; } } } } while (0)

struct XcdBarrier {
    unsigned* bar; unsigned x;
    volatile LAS unsigned* st;
};

__device__ __forceinline__ XcdBarrier xcd_barrier_post(unsigned* bar, volatile LAS unsigned* st) {
    XcdBarrier b; b.bar = bar; b.x = xb_xcc_id(); b.st = st;
    if (threadIdx.x == 0) (void)xb_add(&bar[XB_XCNT(b.x)], 1u);
    return b;
}
__device__ __forceinline__ void xcd_barrier_complete(unsigned* bar, unsigned x, unsigned& nloc, unsigned& nx) {
    const unsigned G = gridDim.x * gridDim.y * gridDim.z;
    unsigned sum, cnt, mine, sp = 0u;
    for (;;) {
        sum = 0u; cnt = 0u; mine = 0u;
#pragma unroll
        for (unsigned j = 0; j < 16; ++j) { const unsigned c = xb_ld(&bar[XB_XCNT(j)]); sum += c; cnt += (c > 0u) ? 1u : 0u; mine = (j == x) ? c : mine; }
        if (sum == G) break;
        __builtin_amdgcn_s_sleep(1);
        if ((++sp & 255u) == 0u) { if (xb_ld(&bar[XB_TMO])) break; if (sp > XB_SPIN_CAP) { atomicAdd(&bar[XB_TMO], 1u); break; } }
    }
    nloc = mine > 0u ? mine : 1u; nx = cnt > 0u ? cnt : 1u;
}

__device__ __forceinline__ void xcd_barrier(const XcdBarrier& b) {
    asm volatile("s_waitcnt vmcnt(0)" ::: "memory");
    __syncthreads();
    if (threadIdx.x == 0) {
        unsigned* bar = b.bar;
        __builtin_amdgcn_s_waitcnt(0);
        unsigned nloc = b.st[0], nx = b.st[1];
        if (nloc == 0u) { xcd_barrier_complete(bar, b.x, nloc, nx); b.st[0] = nloc; b.st[1] = nx; }
        const unsigned old = xb_add(&bar[XB_XSUB(b.x)], 1u);
        const unsigned gen = old / nloc;
        if (old + 1u == (gen + 1u) * nloc) {
            __builtin_amdgcn_fence(__ATOMIC_RELEASE, "agent");
            asm volatile("s_waitcnt vmcnt(0)" ::: "memory");
            const unsigned og = xb_add(&bar[XB_TOP], 1u);
            const unsigned tg = og / nx;
            if (og + 1u == (tg + 1u) * nx) xb_add(&bar[XB_TOPGEN], 1u);
            else XB_SPIN(xb_ld(&bar[XB_TOPGEN]) == tg, bar);
            __builtin_amdgcn_fence(__ATOMIC_ACQUIRE, "agent");
            xb_add(&bar[XB_XGEN(b.x)], 1u);
            asm volatile("s_waitcnt vmcnt(0)" ::: "memory");
        } else {
            XB_SPIN(xb_ld(&bar[XB_XGEN(b.x)]) == gen, bar);
            __builtin_amdgcn_fence(__ATOMIC_ACQUIRE, "agent");
            asm volatile("s_waitcnt vmcnt(0)" ::: "memory");
        }
    }
    __syncthreads();
}
struct Frame {
    LAS unsigned char* lds;
    int tid, lane, wave;
    int G, wg, gw, NGW;
    unsigned long long tacc;
};

DI void transpose_item(const float* W, int ldsrc, int coloff, bf16* WT, int K, int row_off, int nblk, LAS float* scr, int item, int lane, const float* gain) {
    const int kb = item / nblk, nb = item % nblk, k0 = 64 * kb, n0 = 32 * nb;
#pragma unroll 8
    for (int i = 0; i < 32; ++i) { const int kk = 2 * i + (lane >> 5); scr[kk * 33 + (lane & 31)] = W[(size_t)(k0 + kk) * ldsrc + coloff + n0 + (lane & 31)] * (gain ? gain[k0 + kk] : 1.0f); }
    LDS_WAIT(); asm volatile("" ::: "memory");
    const int c = lane & 7;
#pragma unroll
    for (int j = 0; j < 4; ++j) { const int n = (lane >> 3) + 8 * j; const LAS float* s = scr + (8 * c) * 33 + n;
        v4u o; o.x = pk2(s[0 * 33], s[1 * 33]); o.y = pk2(s[2 * 33], s[3 * 33]); o.z = pk2(s[4 * 33], s[5 * 33]); o.w = pk2(s[6 * 33], s[7 * 33]);
        *(GAS v4u*)(WT + (size_t)(row_off + n0 + n) * K + k0 + 8 * c) = o; }
    LDS_WAIT(); asm volatile("" ::: "memory");
}
DI void transpose_matrix(Frame& F, const float* W, int ldsrc, int coloff, int ncols, int K, bf16* WT, int row_off, unsigned& base, const float* gain = nullptr) {
    LAS float* scr = (LAS float*)(F.lds + F.wave * 16384);
    const int nblk = ncols / 32, nitems = (K / 64) * nblk;
    int it = (int)(((unsigned)F.gw + (unsigned)F.NGW - (base % (unsigned)F.NGW)) % (unsigned)F.NGW);
    for (; it < nitems; it += F.NGW) transpose_item(W, ldsrc, coloff, WT, K, row_off, nblk, scr, it, F.lane, gain);
    base += (unsigned)nitems;
}
DI void rms_row(const float* xrow, const f32x4 (&g4)[4], f32x4 (&v)[4], int lane) {
    const GAS f32x4* xr = (const GAS f32x4*)xrow + lane; float s = 0.f;
#pragma unroll
    for (int j = 0; j < 4; ++j) { v[j] = xr[64 * j]; s += (v[j].x * v[j].x + v[j].y * v[j].y) + (v[j].z * v[j].z + v[j].w * v[j].w); }
    const float rstd = rsq_(wave_sum(s) * (1.f / 1024.f) + EPS);
#pragma unroll
    for (int j = 0; j < 4; ++j) v[j] = v[j] * rstd * g4[j];
}
DI void store_row_bf16(bf16* orow, const f32x4 (&v)[4], int lane) {
    GAS unsigned long long* o8 = (GAS unsigned long long*)orow + lane;
#pragma unroll
    for (int j = 0; j < 4; ++j) o8[64 * j] = (unsigned long long)pk2(v[j].x, v[j].y) | ((unsigned long long)pk2(v[j].z, v[j].w) << 32);
}
struct In { const float* p[24]; };
DI void p0_prologue(Frame& F, const In& I, unsigned char* ws) {
    unsigned base = 0;
    for (int l = 0; l < DEPTH; ++l) {
        const int j = l >> 1; unsigned char* wl = ws + WS_W + (size_t)l * W_LAYER;
        if ((l & 1) == 0) {
            transpose_matrix(F, I.p[3] + (size_t)j * D * AB_IN, AB_IN, 0, 1536, D, (bf16*)(wl + WO_WIN), 0, base, I.p[2] + l * D);
            transpose_matrix(F, I.p[3] + (size_t)j * D * AB_IN, AB_IN, 1544, 1536, D, (bf16*)(wl + WO_WIN), 1536, base, I.p[2] + l * D);
            transpose_matrix(F, I.p[7] + (size_t)j * D * D, D, 0, D, D, (bf16*)(wl + WO_WOUT), 0, base);
        } else {
            transpose_matrix(F, I.p[8] + (size_t)j * D * C_IN, C_IN, 0, 4096, D, (bf16*)(wl + WO_WIN), 0, base, I.p[2] + l * D);
            transpose_matrix(F, I.p[13] + (size_t)j * D * D, D, 0, D, D, (bf16*)(wl + WO_WOUT), 0, base);
        }
        transpose_matrix(F, I.p[16] + (size_t)l * D * D, D, 0, D, D, (bf16*)(wl + WO_WQ), 0, base, I.p[14] + l * D);
        transpose_matrix(F, I.p[19] + (size_t)l * D * D, D, 0, D, D, (bf16*)(wl + WO_WO), 0, base);
        transpose_matrix(F, I.p[17] + (size_t)l * D * D, D, 0, D, D, (bf16*)(ws + WS_WKV), 2048 * l, base);
        transpose_matrix(F, I.p[18] + (size_t)l * D * D, D, 0, D, D, (bf16*)(ws + WS_WKV), 2048 * l + 1024, base);
        transpose_matrix(F, I.p[21] + (size_t)l * D * FF, FF, 0, FF, D, (bf16*)(wl + WO_W1), 0, base, I.p[20] + l * D);
        transpose_matrix(F, I.p[22] + (size_t)l * FF * D, D, 0, D, FF, (bf16*)(wl + WO_W2), 0, base);
    }
    for (int idx = F.wg * NTHR + F.tid; idx < DEPTH * 16 * 1024; idx += F.G * NTHR) {
        const int l = idx >> 14, g = (idx >> 10) & 15, k = idx & 1023, j = l >> 1; float v = 0.f;
        if ((l & 1) == 0) { if (g < 8) v = I.p[3][(size_t)j * D * AB_IN + (size_t)k * AB_IN + 1536 + g]; }
        else v = I.p[8][(size_t)j * D * C_IN + (size_t)k * C_IN + 4096 + g];
        ((bf16*)(ws + WS_WG))[idx] = (bf16)f2bf(v * I.p[2][l * D + k]);
    }
    { f32x4 g4[4];
#pragma unroll
      for (int j = 0; j < 4; ++j) g4[j] = ((const GAS f32x4*)I.p[15])[F.lane + 64 * j];
      for (int r = F.gw; r < BATCH * MEMLEN; r += F.NGW) { f32x4 v[4]; rms_row(I.p[1] + (size_t)r * D, g4, v, F.lane); store_row_bf16((bf16*)(ws + WS_MEMN) + (size_t)r * D, v, F.lane); } }
    for (int r = F.gw; r < M; r += F.NGW) { const GAS f32x4* xr = (const GAS f32x4*)(I.p[0] + (size_t)r * D) + F.lane; f32x4 v[4]; float s = 0.f;
#pragma unroll
        for (int j = 0; j < 4; ++j) { v[j] = xr[64 * j]; const unsigned a = pk2(v[j].x, v[j].y), b = pk2(v[j].z, v[j].w); const float r0 = bflo(a), r1 = bfhi(a), r2 = bflo(b), r3 = bfhi(b); s += (r0 * r0 + r1 * r1) + (r2 * r2 + r3 * r3); }
        s = wave_sum(s); store_row_bf16((bf16*)(ws + WS_H) + (size_t)r * D, v, F.lane);
        if (F.lane == 0) { __hip_atomic_store((pg8::rs_t*)(ws + WS_RS) + r, pg8::rs_fix(s), __ATOMIC_RELAXED, __HIP_MEMORY_SCOPE_AGENT); __hip_atomic_store((pg8::rs_t*)(ws + WS_RS) + M + r, (pg8::rs_t)0, __ATOMIC_RELAXED, __HIP_MEMORY_SCOPE_AGENT); } }
}
template <int MODE> DI void gates_phase(Frame& F, const bf16* xb, const pg8::rs_t* rs, const bf16* WgB, float* gate, const float* p0, const float* p1) {
    constexpr int LW = 1032;
    LAS bf16* wl = (LAS bf16*)F.lds;
    const int r = F.lane & 15, quad = F.lane >> 4;
    lds_barrier();
    for (int i = F.tid; i < 2048; i += NTHR) { const int g = i >> 7, c8 = (i & 127) * 8; *(LAS v4u*)(wl + g * LW + c8) = *(const GAS v4u*)(WgB + g * 1024 + c8); }
    float par = 0.f, par2 = 0.f;
    if (MODE == 1) { if (r < 4) par = p0[r]; else if (r < 8) par = p1[r - 4]; }
    if (MODE == 2) { if (r >= 8) { par = p0[r - 8]; par2 = p1[r - 8]; } }
    lds_barrier();
    for (int g = F.gw; g < M / 16; g += F.NGW) {
        const bf16* xa = xb + (size_t)(16 * g + r) * D + 8 * quad; f32x4 acc = (f32x4){0.f, 0.f, 0.f, 0.f};
#pragma unroll 8
        for (int kk = 0; kk < 32; ++kk) acc = mfma16(*(const GAS bf16x8*)(xa + 32 * kk), *(const LAS bf16x8*)(wl + r * LW + 32 * kk + 8 * quad), acc);
#pragma unroll
        for (int j = 0; j < 4; ++j) { const int row = 16 * g + 4 * quad + j; const float keep = acc[j] * pg8::row_rstd(rs, row); float o = 0.f;
            if (MODE == 1) { const float v = keep + par; o = (r < 4) ? 15.0f * tanhf(v * (1.0f / 15.0f)) : (fminf(v, 0.f) - log1pf(expf(-fabsf(v)))); }
            if (MODE == 2) { if (r < 8) o = 1.0f / (1.0f + expf(-keep)); else { const float z = keep + par2; o = -expf(par) * (fmaxf(z, 0.f) + log1pf(expf(-fabsf(z)))); } }
            if (MODE == 2 || r < 8) gate[(size_t)row * 16 + r] = o; }
    }
    lds_barrier();
}
DI void final_norm_phase(Frame& F, const bf16* xs, float* out, const float* gain) {
    f32x4 g4[4];
#pragma unroll
    for (int j = 0; j < 4; ++j) g4[j] = ((const GAS f32x4*)gain)[F.lane + 64 * j];
    for (int r = F.gw; r < M; r += F.NGW) { const GAS v2u* xr = (const GAS v2u*)(xs + (size_t)r * D) + F.lane; f32x4 v[4]; float s = 0.f;
#pragma unroll
        for (int j = 0; j < 4; ++j) { const v2u t = xr[64 * j]; v[j] = (f32x4){bflo(t.x), bfhi(t.x), bflo(t.y), bfhi(t.y)}; s += (v[j].x * v[j].x + v[j].y * v[j].y) + (v[j].z * v[j].z + v[j].w * v[j].w); }
        const float rstd = rsq_(wave_sum(s) * (1.f / 1024.f) + EPS); GAS f32x4* o = (GAS f32x4*)(out + (size_t)r * D) + F.lane;
#pragma unroll
        for (int j = 0; j < 4; ++j) o[64 * j] = v[j] * rstd * g4[j]; }
}
template <bool ODD> DI void headnorm_phase(Frame& F, const bf16* src, bf16* mix, const bf16* proj, const float* hg) {
    constexpr int NC = ODD ? 16 : 8;
    for (int r = F.gw; r < M; r += F.NGW) {
        const int c0 = NC * F.lane;
        float x[NC], gt[NC];
#pragma unroll
        for (int q = 0; q < NC / 8; ++q) {
            const size_t hoff = ((size_t)((r >> 13) * 8 + ((c0 + 8 * q) >> 7)) * T + (r & (T - 1))) * 128 + ((c0 + 8 * q) & 127);
            const v4u raw = ODD ? *(const GAS v4u*)(src + hoff) : *(const GAS v4u*)(src + (size_t)r * D + c0 + 8 * q);
            const v4u gr = ODD ? *(const GAS v4u*)(proj + (size_t)M * 3072 + hoff) : *(const GAS v4u*)(proj + (size_t)r * AB_N + 1024 + c0 + 8 * q);
            x[8 * q + 0] = bflo(raw.x); x[8 * q + 1] = bfhi(raw.x); x[8 * q + 2] = bflo(raw.y); x[8 * q + 3] = bfhi(raw.y); x[8 * q + 4] = bflo(raw.z); x[8 * q + 5] = bfhi(raw.z); x[8 * q + 6] = bflo(raw.w); x[8 * q + 7] = bfhi(raw.w);
            gt[8 * q + 0] = bflo(gr.x); gt[8 * q + 1] = bfhi(gr.x); gt[8 * q + 2] = bflo(gr.y); gt[8 * q + 3] = bfhi(gr.y); gt[8 * q + 4] = bflo(gr.z); gt[8 * q + 5] = bfhi(gr.z); gt[8 * q + 6] = bflo(gr.w); gt[8 * q + 7] = bfhi(gr.w);
        }
        float ss = 0.f;
#pragma unroll
        for (int i = 0; i < NC; ++i) ss += x[i] * x[i];
        ss += __shfl_xor(ss, 1); ss += __shfl_xor(ss, 2); ss += __shfl_xor(ss, 4); if (!ODD) ss += __shfl_xor(ss, 8);
        const float rstd = rsq_(ss * (1.f / 128.f) + EPS);
#pragma unroll
        for (int i = 0; i < NC; ++i) { const float g = ODD ? hg[(c0 + i) & 127] : hg[c0 + i]; const float s = sigmoidf_(gt[i]); x[i] = x[i] * rstd * g * (ODD ? gt[i] * s : s); }
#pragma unroll
        for (int q = 0; q < NC / 8; ++q) { v4u o; o.x = pk2(x[8 * q], x[8 * q + 1]); o.y = pk2(x[8 * q + 2], x[8 * q + 3]); o.z = pk2(x[8 * q + 4], x[8 * q + 5]); o.w = pk2(x[8 * q + 6], x[8 * q + 7]);
            *(GAS v4u*)(mix + (size_t)r * D + c0 + 8 * q) = o; }
    }
}
DI void mlstm_chain(Frame& F, const bf16* proj, const float* gate, bf16* mix, int c) {
    const int b = c >> 4, h = (c >> 2) & 3, vq = c & 3, vl = F.tid >> 4, dg = F.tid & 15;
    float C0 = 0.f, C1 = 0.f, C2 = 0.f, C3 = 0.f, n0 = 0.f, n1 = 0.f, n2 = 0.f, n3 = 0.f, m = 0.f;
    const bf16* pq = proj + (size_t)b * T * AB_N + h * 64 + 4 * dg;
    const bf16* pk = pq + 256;
    const bf16* pv = proj + (size_t)b * T * AB_N + 512 + h * 128 + vq * 32 + vl;
    const float* pg = gate + (size_t)b * T * 16 + h;
    bf16* po = mix + (size_t)b * T * D + h * 128 + vq * 32 + vl;
    for (int t0 = 0; t0 < T; t0 += 8) {
        v2u qr[8], kr[8]; unsigned short vr[8]; float li[8], lf[8];
#pragma unroll
        for (int i = 0; i < 8; ++i) { qr[i] = *(const GAS v2u*)(pq + (size_t)(t0 + i) * AB_N); kr[i] = *(const GAS v2u*)(pk + (size_t)(t0 + i) * AB_N); vr[i] = pv[(size_t)(t0 + i) * AB_N];
            li[i] = pg[(size_t)(t0 + i) * 16]; lf[i] = pg[(size_t)(t0 + i) * 16 + 4]; }
#pragma unroll
        for (int i = 0; i < 8; ++i) {
            const float q0 = bflo(qr[i].x), q1 = bfhi(qr[i].x), q2 = bflo(qr[i].y), q3 = bfhi(qr[i].y);
            const float k0 = bflo(kr[i].x) * 0.125f, k1 = bfhi(kr[i].x) * 0.125f, k2 = bflo(kr[i].y) * 0.125f, k3 = bfhi(kr[i].y) * 0.125f;
            const float vv = bf2f(vr[i]);
            const float mn = fmaxf(lf[i] + m, li[i]); const float fp = __expf(lf[i] + m - mn), ip = __expf(li[i] - mn); m = mn;
            const float iv = ip * vv;
            C0 = fp * C0 + iv * k0; C1 = fp * C1 + iv * k1; C2 = fp * C2 + iv * k2; C3 = fp * C3 + iv * k3;
            n0 = fp * n0 + ip * k0; n1 = fp * n1 + ip * k1; n2 = fp * n2 + ip * k2; n3 = fp * n3 + ip * k3;
            float pn = (C0 * q0 + C1 * q1) + (C2 * q2 + C3 * q3), pd = (n0 * q0 + n1 * q1) + (n2 * q2 + n3 * q3);
#pragma unroll
            for (int o = 1; o < 16; o <<= 1) { pn += __shfl_xor(pn, o); pd += __shfl_xor(pd, o); }
            const float hv = pn / fmaxf(fabsf(pd), __expf(-mn));
            if (dg == 0) po[(size_t)(t0 + i) * D] = (bf16)f2bf(hv);
        }
    }
}
DI void gdn_chain(Frame& F, const bf16* proj, const float* gate, const float* convw, bf16* mix, int c) {
    const int b = c >> 5, h = (c >> 2) & 7, vq = c & 3, cc = F.tid >> 4, dg = F.tid & 15;
    LAS float* qs = (LAS float*)F.lds; LAS float* ks = qs + 64 * 128; LAS float* vs = ks + 64 * 128; LAS float* os = vs + 64 * 32; LAS float* bet = os + 64 * 32; LAS float* alp = bet + 64;
    float S[8];
#pragma unroll
    for (int j = 0; j < 8; ++j) S[j] = 0.f;
    for (int t0 = 0; t0 < T; t0 += 64) {
        __syncthreads();
        { const int row = F.tid >> 3, seg = F.tid & 7, t = t0 + row;
#pragma unroll
          for (int which = 0; which < 2; ++which) {
              const int colg = which * 1024 + h * 128 + seg * 16; float a[16];
#pragma unroll
              for (int i = 0; i < 16; ++i) a[i] = 0.f;
#pragma unroll
              for (int j = 0; j < 4; ++j) { const int tt = t - 3 + j;
                  if (tt >= 0) { const bf16* src = proj + (size_t)(b * T + tt) * C_N + colg; const float* w = convw + j * 3072 + colg;
#pragma unroll
                      for (int q = 0; q < 2; ++q) { const v4u raw = *(const GAS v4u*)(src + 8 * q); const f32x4 w0 = *(const GAS f32x4*)(w + 8 * q), w1 = *(const GAS f32x4*)(w + 8 * q + 4);
                          a[8 * q + 0] += bflo(raw.x) * w0.x; a[8 * q + 1] += bfhi(raw.x) * w0.y; a[8 * q + 2] += bflo(raw.y) * w0.z; a[8 * q + 3] += bfhi(raw.y) * w0.w;
                          a[8 * q + 4] += bflo(raw.z) * w1.x; a[8 * q + 5] += bfhi(raw.z) * w1.y; a[8 * q + 6] += bflo(raw.w) * w1.z; a[8 * q + 7] += bfhi(raw.w) * w1.w; } } }
              float ss = 0.f;
#pragma unroll
              for (int i = 0; i < 16; ++i) { a[i] = a[i] * sigmoidf_(a[i]); ss += a[i] * a[i]; }
              ss += __shfl_xor(ss, 1); ss += __shfl_xor(ss, 2); ss += __shfl_xor(ss, 4);
              const float sc = rsq_(ss + EPS) * (which == 0 ? 0.08838834764831845f : 1.0f);
              LAS float* dst = (which == 0 ? qs : ks) + row * 128 + seg * 16;
#pragma unroll
              for (int q = 0; q < 4; ++q) *(LAS f32x4*)(dst + 4 * q) = (f32x4){a[4 * q] * sc, a[4 * q + 1] * sc, a[4 * q + 2] * sc, a[4 * q + 3] * sc};
          } }
        if (F.tid < 256) { const int row = F.tid >> 2, seg = F.tid & 3, t = t0 + row; const int colg = 2048 + h * 128 + vq * 32 + seg * 8; float a[8];
#pragma unroll
            for (int i = 0; i < 8; ++i) a[i] = 0.f;
#pragma unroll
            for (int j = 0; j < 4; ++j) { const int tt = t - 3 + j;
                if (tt >= 0) { const v4u raw = *(const GAS v4u*)(proj + (size_t)(b * T + tt) * C_N + colg); const float* w = convw + j * 3072 + colg; const f32x4 w0 = *(const GAS f32x4*)w, w1 = *(const GAS f32x4*)(w + 4);
                    a[0] += bflo(raw.x) * w0.x; a[1] += bfhi(raw.x) * w0.y; a[2] += bflo(raw.y) * w0.z; a[3] += bfhi(raw.y) * w0.w; a[4] += bflo(raw.z) * w1.x; a[5] += bfhi(raw.z) * w1.y; a[6] += bflo(raw.w) * w1.z; a[7] += bfhi(raw.w) * w1.w; } }
#pragma unroll
            for (int i = 0; i < 8; ++i) a[i] = a[i] * sigmoidf_(a[i]);
            *(LAS f32x4*)(vs + row * 32 + seg * 8) = (f32x4){a[0], a[1], a[2], a[3]}; *(LAS f32x4*)(vs + row * 32 + seg * 8 + 4) = (f32x4){a[4], a[5], a[6], a[7]}; }
        if (F.tid < 64) { const float* g = gate + (size_t)(b * T + t0 + F.tid) * 16; bet[F.tid] = g[h]; alp[F.tid] = __expf(g[8 + h]); }
        __syncthreads();
        for (int s = 0; s < 64; ++s) {
            const f32x4 ka = *(const LAS f32x4*)(ks + s * 128 + 8 * dg), kb = *(const LAS f32x4*)(ks + s * 128 + 8 * dg + 4);
            const f32x4 qa = *(const LAS f32x4*)(qs + s * 128 + 8 * dg), qb = *(const LAS f32x4*)(qs + s * 128 + 8 * dg + 4);
            const float vv = vs[s * 32 + cc], be = bet[s], al = alp[s];
            float p = (ka.x * S[0] + ka.y * S[1]) + (ka.z * S[2] + ka.w * S[3]) + (kb.x * S[4] + kb.y * S[5]) + (kb.z * S[6] + kb.w * S[7]);
#pragma unroll
            for (int o = 1; o < 16; o <<= 1) p += __shfl_xor(p, o);
            const float dl = be * (vv - al * p);
            S[0] = al * S[0] + ka.x * dl; S[1] = al * S[1] + ka.y * dl; S[2] = al * S[2] + ka.z * dl; S[3] = al * S[3] + ka.w * dl;
            S[4] = al * S[4] + kb.x * dl; S[5] = al * S[5] + kb.y * dl; S[6] = al * S[6] + kb.z * dl; S[7] = al * S[7] + kb.w * dl;
            float po = (qa.x * S[0] + qa.y * S[1]) + (qa.z * S[2] + qa.w * S[3]) + (qb.x * S[4] + qb.y * S[5]) + (qb.z * S[6] + qb.w * S[7]);
#pragma unroll
            for (int o = 1; o < 16; o <<= 1) po += __shfl_xor(po, o);
            if (dg == 0) os[s * 32 + cc] = po;
        }
        __syncthreads();
        { const int row = F.tid >> 3, c4 = (F.tid & 7) * 4; const f32x4 o = *(const LAS f32x4*)(os + row * 32 + c4);
          *(GAS v2u*)(mix + (size_t)(b * T + t0 + row) * D + h * 128 + vq * 32 + c4) = (v2u){pk2(o.x, o.y), pk2(o.z, o.w)}; }
    }
}
struct MlChunkRegs { v4u q, k, v0, v1, o0, o1; float li, lf; };
DI void ml_load(MlChunkRegs& R, const bf16* proj, const float* gate, int b, int h, int tc, int tid) {
    const int row = tid >> 3, seg = tid & 7; const size_t hb = (size_t)(b * 4 + h) * T + tc + row;
    R.q = *(const GAS v4u*)(proj + hb * 64 + 8 * seg); R.k = *(const GAS v4u*)(proj + (size_t)M * 256 + hb * 64 + 8 * seg);
    const bf16* pv = proj + (size_t)M * 512 + hb * 128 + 16 * seg; R.v0 = *(const GAS v4u*)pv; R.v1 = *(const GAS v4u*)(pv + 8);
    const bf16* po = proj + (size_t)M * 1024 + hb * 128 + 16 * seg; R.o0 = *(const GAS v4u*)po; R.o1 = *(const GAS v4u*)(po + 8);
    R.li = 0.f; R.lf = 0.f;
    if (tid < 64) { const float* g = gate + ((size_t)b * T + tc + tid) * 16; R.li = g[h]; R.lf = g[4 + h]; }
}
DI unsigned scale_pk(unsigned u, float s) { return pk2(bflo(u) * s, bfhi(u) * s); }
DI void mlstm_chunked(Frame& F, const bf16* proj, const float* gate, const float* hgain, bf16* mix, int c) {
    constexpr int LD = 72, HLD = 132;
    const int b = c >> 2, h = c & 3;
    const int tid = F.tid, lane = F.lane, w = F.wave, r = lane & 15, quad = lane >> 4, row = tid >> 3, seg = tid & 7;
    LAS bf16* qs = (LAS bf16*)F.lds; LAS bf16* qw = qs + 64 * LD; LAS bf16* ks = qw + 64 * LD; LAS bf16* kTs = ks + 64 * LD; LAS bf16* Sd = kTs + 64 * LD;
    LAS bf16* vT = Sd + 64 * LD; LAS bf16* Cb = vT + 128 * LD;
    LAS float* hbuf = (LAS float*)(Cb + 128 * LD);
    LAS float* sA = hbuf + 64 * HLD; LAS float* sM = sA + 64; LAS float* sWi = sM + 64; LAS float* sWs = sWi + 64; LAS float* sEm = sWs + 64; LAS float* sN = sEm + 64  ; LAS float* sMisc = sN + 128;
    lds_barrier();
    for (int i = tid; i < 128 * LD / 2; i += NTHR) ((LAS unsigned*)Cb)[i] = 0u;
    if (tid < 128) sN[tid] = 0.f;
    f32x4 accC[4];
#pragma unroll
    for (int i = 0; i < 4; ++i) accC[i] = (f32x4){0.f, 0.f, 0.f, 0.f};
    float nreg = 0.f, mprev = 0.f;
    float gn[16];
#pragma unroll
    for (int i = 0; i < 16; ++i) gn[i] = hgain[h * 128 + 16 * seg + i];
    const size_t rb = (size_t)b * T;
    MlChunkRegs cur, nxt; ml_load(cur, proj, gate, b, h, 0, tid); nxt = cur;
    for (int ch = 0; ch < T / 64; ++ch) {
        const size_t r0 = rb + (size_t)ch * 64;
        if (ch + 1 < T / 64) ml_load(nxt, proj, gate, b, h, (ch + 1) * 64, tid);
        STG_T0();
        lds_barrier();
        STG(0);
        *(LAS v4u*)(qs + row * LD + 8 * seg) = cur.q;
        { v4u kk; kk.x = scale_pk(cur.k.x, 0.125f); kk.y = scale_pk(cur.k.y, 0.125f); kk.z = scale_pk(cur.k.z, 0.125f); kk.w = scale_pk(cur.k.w, 0.125f); cur.k = kk; *(LAS v4u*)(ks + row * LD + 8 * seg) = kk; }
        { const unsigned vv[8] = {cur.v0.x, cur.v0.y, cur.v0.z, cur.v0.w, cur.v1.x, cur.v1.y, cur.v1.z, cur.v1.w};
#pragma unroll
          for (int i = 0; i < 8; ++i) { vT[(16 * seg + 2 * i) * LD + row] = (bf16)(vv[i] & 0xffffu); vT[(16 * seg + 2 * i + 1) * LD + row] = (bf16)(vv[i] >> 16); } }
        if (w == 0) {
            float bb = cur.lf;
#pragma unroll
            for (int o = 1; o < 64; o <<= 1) { const float t = __shfl_up(bb, o); if (lane >= o) bb += t; }
            const float a = cur.li - bb; float cm = a;
#pragma unroll
            for (int o = 1; o < 64; o <<= 1) { const float t = __shfl_up(cm, o); if (lane >= o) cm = fmaxf(cm, t); }
            const float Mx = fmaxf(mprev, cm);
            const float b63 = __shfl(bb, 63), Mx63 = __shfl(Mx, 63);
            sA[lane] = a; sM[lane] = Mx; sWi[lane] = __expf(mprev - Mx); sWs[lane] = __expf(a - Mx63); sEm[lane] = __expf(-(bb + Mx));
            if (lane == 0) sMisc[0] = __expf(mprev - Mx63);
            mprev = b63 + Mx63;
        }
        STG(1);
        lds_barrier();
        STG(2);
        { const float wi = sWi[row], wsr = sWs[row];
          v4u t; t.x = scale_pk(cur.q.x, wi); t.y = scale_pk(cur.q.y, wi); t.z = scale_pk(cur.q.z, wi); t.w = scale_pk(cur.q.w, wi); *(LAS v4u*)(qw + row * LD + 8 * seg) = t;
          const unsigned kk[4] = {cur.k.x, cur.k.y, cur.k.z, cur.k.w};
#pragma unroll
          for (int i = 0; i < 4; ++i) { kTs[(8 * seg + 2 * i) * LD + row] = (bf16)f2bf(bflo(kk[i]) * wsr); kTs[(8 * seg + 2 * i + 1) * LD + row] = (bf16)f2bf(bfhi(kk[i]) * wsr); } }
        { const int mt = w >> 1;
          const bf16x8 a0 = *(const LAS bf16x8*)(qs + (16 * mt + r) * LD + 8 * quad), a1 = *(const LAS bf16x8*)(qs + (16 * mt + r) * LD + 32 + 8 * quad);
#pragma unroll
          for (int tt = 0; tt < 2; ++tt) { const int nt = 2 * (w & 1) + tt; f32x4 acc = (f32x4){0.f, 0.f, 0.f, 0.f};
              if (nt <= mt) { const bf16x8 b0 = *(const LAS bf16x8*)(ks + (16 * nt + r) * LD + 8 * quad), b1 = *(const LAS bf16x8*)(ks + (16 * nt + r) * LD + 32 + 8 * quad);
                  acc = mfma16(a0, b0, acc); acc = mfma16(a1, b1, acc); }
              const int s = 16 * nt + r; const float as = sA[s];
#pragma unroll
              for (int j = 0; j < 4; ++j) { const int t = 16 * mt + 4 * quad + j; const float v = (s <= t) ? acc[j] * __expf(as - sM[t]) : 0.f; Sd[t * LD + s] = (bf16)f2bf(v); } } }
        STG(3);
        lds_barrier();
        STG(4);
        const bf16x8 vf0 = *(const LAS bf16x8*)(vT + (16 * w + r) * LD + 8 * quad), vf1 = *(const LAS bf16x8*)(vT + (16 * w + r) * LD + 32 + 8 * quad);
        { const bf16x8 cf0 = *(const LAS bf16x8*)(Cb + (16 * w + r) * LD + 8 * quad), cf1 = *(const LAS bf16x8*)(Cb + (16 * w + r) * LD + 32 + 8 * quad);
#pragma unroll
          for (int mt = 0; mt < 4; ++mt) { f32x4 acc = (f32x4){0.f, 0.f, 0.f, 0.f};
              acc = mfma16(*(const LAS bf16x8*)(Sd + (16 * mt + r) * LD + 8 * quad), vf0, acc); acc = mfma16(*(const LAS bf16x8*)(Sd + (16 * mt + r) * LD + 32 + 8 * quad), vf1, acc);
              acc = mfma16(*(const LAS bf16x8*)(qw + (16 * mt + r) * LD + 8 * quad), cf0, acc); acc = mfma16(*(const LAS bf16x8*)(qw + (16 * mt + r) * LD + 32 + 8 * quad), cf1, acc);
#pragma unroll
              for (int j = 0; j < 4; ++j) hbuf[(16 * mt + 4 * quad + j) * HLD + 16 * w + r] = acc[j]; } }
        STG(5);
        lds_barrier();
        STG(6);
        { const float wold = sMisc[0];
#pragma unroll
          for (int nt = 0; nt < 4; ++nt) { f32x4 acc = accC[nt] * wold;
              acc = mfma16(vf0, *(const LAS bf16x8*)(kTs + (16 * nt + r) * LD + 8 * quad), acc); acc = mfma16(vf1, *(const LAS bf16x8*)(kTs + (16 * nt + r) * LD + 32 + 8 * quad), acc);
              accC[nt] = acc;
#pragma unroll
              for (int j = 0; j < 4; ++j) Cb[(16 * w + 4 * quad + j) * LD + 16 * nt + r] = (bf16)f2bf(acc[j]); }
          if (w == 0) { float sum = 0.f;
#pragma unroll
              for (int q8 = 0; q8 < 8; ++q8) { const v4u t = *(const LAS v4u*)(kTs + lane * LD + 8 * q8); sum += (bflo(t.x) + bfhi(t.x)) + (bflo(t.y) + bfhi(t.y)) + (bflo(t.z) + bfhi(t.z)) + (bflo(t.w) + bfhi(t.w)); }
              nreg = wold * nreg + sum; sN[((ch + 1) & 1) * 64 + lane] = nreg; } }
        { const LAS float* nv = sN + (ch & 1) * 64 + 8 * seg;
          const v4u sd = *(const LAS v4u*)(Sd + row * LD + 8 * seg);
          float p = (bflo(sd.x) + bfhi(sd.x)) + (bflo(sd.y) + bfhi(sd.y)) + (bflo(sd.z) + bfhi(sd.z)) + (bflo(sd.w) + bfhi(sd.w));
          const float qn = (bflo(cur.q.x) * nv[0] + bfhi(cur.q.x) * nv[1]) + (bflo(cur.q.y) * nv[2] + bfhi(cur.q.y) * nv[3]) + (bflo(cur.q.z) * nv[4] + bfhi(cur.q.z) * nv[5]) + (bflo(cur.q.w) * nv[6] + bfhi(cur.q.w) * nv[7]);
          p += sWi[row] * qn;
          p += __shfl_xor(p, 1); p += __shfl_xor(p, 2); p += __shfl_xor(p, 4);
          const float dinv = rcp_(fmaxf(fabsf(p), sEm[row]));
          float hv[16]; float ss = 0.f;
#pragma unroll
          for (int q4 = 0; q4 < 4; ++q4) { const f32x4 t = *(const LAS f32x4*)(hbuf + row * HLD + 16 * seg + 4 * q4); hv[4 * q4] = t.x * dinv; hv[4 * q4 + 1] = t.y * dinv; hv[4 * q4 + 2] = t.z * dinv; hv[4 * q4 + 3] = t.w * dinv; }
#pragma unroll
          for (int i = 0; i < 16; ++i) ss += hv[i] * hv[i];
          ss += __shfl_xor(ss, 1); ss += __shfl_xor(ss, 2); ss += __shfl_xor(ss, 4);
          const float rstd = rsq_(ss * (1.f / 128.f) + EPS);
          const unsigned og[8] = {cur.o0.x, cur.o0.y, cur.o0.z, cur.o0.w, cur.o1.x, cur.o1.y, cur.o1.z, cur.o1.w}; unsigned ow[8];
#pragma unroll
          for (int i = 0; i < 8; ++i) ow[i] = pk2(hv[2 * i] * rstd * gn[2 * i] * sigmoidf_(bflo(og[i])), hv[2 * i + 1] * rstd * gn[2 * i + 1] * sigmoidf_(bfhi(og[i])));
          bf16* op = mix + (r0 + row) * D + h * 128 + 16 * seg;
          *(GAS v4u*)op = (v4u){ow[0], ow[1], ow[2], ow[3]}; *(GAS v4u*)(op + 8) = (v4u){ow[4], ow[5], ow[6], ow[7]}; }
        STG(7);
        cur = nxt;
    }
}
constexpr size_t H_NUML = 0, H_DC = 64 * MiB;
constexpr int MLS_STRIDE = 320;
struct MlaRegs { v4u q, k, v0, v1; float li, lf; };
DI void mla_load(MlaRegs& R, const bf16* proj, const float* gate, int unit, int tid) {
    const int ch = unit & 127, bh = unit >> 7, b = bh >> 2, h = bh & 3, s = tid & 63, dseg = tid >> 6;
    const size_t hb = (size_t)bh * T + ch * 64 + s;
    R.q = *(const GAS v4u*)(proj + hb * 64 + 8 * dseg); R.k = *(const GAS v4u*)(proj + (size_t)M * 256 + hb * 64 + 8 * dseg);
    const bf16* pv = proj + (size_t)M * 512 + hb * 128 + 16 * dseg; R.v0 = *(const GAS v4u*)pv; R.v1 = *(const GAS v4u*)(pv + 8);
    const float* g = gate + ((size_t)b * T + ch * 64 + s) * 16; R.li = g[h]; R.lf = g[4 + h];
}
DI void mlstm_a_unit(Frame& F, MlaRegs& R, const bf16* proj, const float* gate, bf16* numl, bf16* dc, float* scal, int unit, int unit_end) {
    constexpr int LD = 72, LN = 136;
    int tid_ = F.tid; asm volatile("" : "+v"(tid_));
    const int tid = tid_, lane = tid & 63, w = F.wave, r = lane & 15, quad = lane >> 4, dseg = tid >> 6;
    LAS bf16* qs = (LAS bf16*)F.lds; LAS bf16* ks = qs + 64 * LD; LAS bf16* ksT = ks + 64 * LD; LAS bf16* vT = ksT + 64 * LD; LAS bf16* Sd = vT + 128 * LD; LAS bf16* Cst = Sd + 64 * LD; LAS bf16* numS = Cst + 128 * LD;
    LAS float* sCm = (LAS float*)(numS + 64 * LN); LAS float* sDen = sCm + 64; LAS float* sDn = sDen + 64;
    float bb = R.lf;
#pragma unroll
    for (int o = 1; o < 64; o <<= 1) { const float t = __shfl_up(bb, o); if (lane >= o) bb += t; }
    const float a = R.li - bb; float cm = a;
#pragma unroll
    for (int o = 1; o < 64; o <<= 1) { const float t = __shfl_up(cm, o); if (lane >= o) cm = fmaxf(cm, t); }
    const float Astar = __shfl(cm, 63), b63 = __shfl(bb, 63);
    const float ksc = 0.125f * __expf(a - Astar);
    lds_barrier();
    *(LAS v4u*)(qs + lane * LD + 8 * dseg) = R.q;
    { v4u kk; kk.x = scale_pk(R.k.x, ksc); kk.y = scale_pk(R.k.y, ksc); kk.z = scale_pk(R.k.z, ksc); kk.w = scale_pk(R.k.w, ksc); *(LAS v4u*)(ks + lane * LD + 8 * dseg) = kk;
      const unsigned kw[4] = {kk.x, kk.y, kk.z, kk.w};
#pragma unroll
      for (int i = 0; i < 4; ++i) { ksT[(8 * dseg + 2 * i) * LD + lane] = (bf16)(kw[i] & 0xffffu); ksT[(8 * dseg + 2 * i + 1) * LD + lane] = (bf16)(kw[i] >> 16); }
      const unsigned vv[8] = {R.v0.x, R.v0.y, R.v0.z, R.v0.w, R.v1.x, R.v1.y, R.v1.z, R.v1.w};
#pragma unroll
      for (int i = 0; i < 8; ++i) { vT[(16 * dseg + 2 * i) * LD + lane] = (bf16)(vv[i] & 0xffffu); vT[(16 * dseg + 2 * i + 1) * LD + lane] = (bf16)(vv[i] >> 16); } }
    if (w == 0) sCm[lane] = cm;
    if (unit + 1 < unit_end) mla_load(R, proj, gate, unit + 1, tid);
    lds_barrier();
    { const int mt = w >> 1;
      const bf16x8 a0 = *(const LAS bf16x8*)(qs + (16 * mt + r) * LD + 8 * quad), a1 = *(const LAS bf16x8*)(qs + (16 * mt + r) * LD + 32 + 8 * quad);
#pragma unroll
      for (int tt = 0; tt < 2; ++tt) { const int nt = 2 * (w & 1) + tt; f32x4 acc = (f32x4){0.f, 0.f, 0.f, 0.f};
          if (nt <= mt) { acc = mfma16(a0, *(const LAS bf16x8*)(ks + (16 * nt + r) * LD + 8 * quad), acc); acc = mfma16(a1, *(const LAS bf16x8*)(ks + (16 * nt + r) * LD + 32 + 8 * quad), acc); }
          const int s = 16 * nt + r;
#pragma unroll
          for (int j = 0; j < 4; ++j) { const int t = 16 * mt + 4 * quad + j; const float v = (s <= t) ? acc[j] * __expf(Astar - sCm[t]) : 0.f; Sd[t * LD + s] = (bf16)f2bf(v); } } }
    const bf16x8 vf0 = *(const LAS bf16x8*)(vT + (16 * w + r) * LD + 8 * quad), vf1 = *(const LAS bf16x8*)(vT + (16 * w + r) * LD + 32 + 8 * quad);
#pragma unroll
    for (int nt = 0; nt < 4; ++nt) { f32x4 acc = (f32x4){0.f, 0.f, 0.f, 0.f};
        acc = mfma16(vf0, *(const LAS bf16x8*)(ksT + (16 * nt + r) * LD + 8 * quad), acc); acc = mfma16(vf1, *(const LAS bf16x8*)(ksT + (16 * nt + r) * LD + 32 + 8 * quad), acc);
#pragma unroll
        for (int j = 0; j < 4; ++j) Cst[(16 * w + 4 * quad + j) * LD + 16 * nt + r] = (bf16)f2bf(acc[j]); }
    if (w == 0) { float sum = 0.f;
#pragma unroll
        for (int q8 = 0; q8 < 8; ++q8) { const v4u t = *(const LAS v4u*)(ksT + lane * LD + 8 * q8); sum += (bflo(t.x) + bfhi(t.x)) + (bflo(t.y) + bfhi(t.y)) + (bflo(t.z) + bfhi(t.z)) + (bflo(t.w) + bfhi(t.w)); }
        sDn[lane] = sum; }
    lds_barrier();
#pragma unroll
    for (int mt = 0; mt < 4; ++mt) { f32x4 acc = (f32x4){0.f, 0.f, 0.f, 0.f};
        acc = mfma16(*(const LAS bf16x8*)(Sd + (16 * mt + r) * LD + 8 * quad), vf0, acc); acc = mfma16(*(const LAS bf16x8*)(Sd + (16 * mt + r) * LD + 32 + 8 * quad), vf1, acc);
#pragma unroll
        for (int j = 0; j < 4; ++j) numS[(16 * mt + 4 * quad + j) * LN + 16 * w + r] = (bf16)f2bf(acc[j]); }
    { const int row = tid >> 3, seg = tid & 7; const v4u sd = *(const LAS v4u*)(Sd + row * LD + 8 * seg);
      float p = (bflo(sd.x) + bfhi(sd.x)) + (bflo(sd.y) + bfhi(sd.y)) + (bflo(sd.z) + bfhi(sd.z)) + (bflo(sd.w) + bfhi(sd.w));
      p += __shfl_xor(p, 1); p += __shfl_xor(p, 2); p += __shfl_xor(p, 4); if (seg == 0) sDen[row] = p; }
    lds_barrier();
    { const int row = tid >> 3, c16 = (tid & 7) * 16; bf16* g = numl + (size_t)unit * 8192 + row * 128 + c16;
      *(GAS v4u*)g = *(const LAS v4u*)(numS + row * LN + c16); *(GAS v4u*)(g + 8) = *(const LAS v4u*)(numS + row * LN + c16 + 8);
      const int dv = tid >> 2, d16 = (tid & 3) * 16; bf16* gc = dc + (size_t)unit * 8192 + dv * 64 + d16;
      *(GAS v4u*)gc = *(const LAS v4u*)(Cst + dv * LD + d16); *(GAS v4u*)(gc + 8) = *(const LAS v4u*)(Cst + dv * LD + d16 + 8);
      float* sc = scal + (size_t)unit * MLS_STRIDE;
      if (w == 0) { sc[lane] = sDen[lane]; sc[64 + lane] = cm; sc[128 + lane] = bb; sc[192 + lane] = sDn[lane]; if (lane == 0) { sc[256] = Astar; sc[257] = b63; } } }
}
DI void mlstm_a_phase(Frame& F, const bf16* proj, const float* gate, bf16* numl, bf16* dc, float* scal) {
    const int per = (4096 + F.G - 1) / F.G, u0 = F.wg * per, u1 = (u0 + per < 4096) ? u0 + per : 4096;
    if (u0 >= u1) return;
    MlaRegs R; mla_load(R, proj, gate, u0, F.tid);
    for (int u = u0; u < u1; ++u) mlstm_a_unit(F, R, proj, gate, numl, dc, scal, u, u1);
}
DI void mlstm_b_phase(Frame& F, bf16* dc, float* scal) {
    for (int c = F.wg; c < 256; c += F.G) {
        const int bh = c >> 3, part = c & 7, e = part * 1024 + 2 * F.tid; const bool nth = (part == 0) && (F.tid < 64);
        float c0 = 0.f, c1 = 0.f, nn = 0.f, m = 0.f;
        for (int cb = 0; cb < 128; cb += 8) {
            unsigned dv[8]; float As[8], bs[8], dn[8];
#pragma unroll
            for (int i = 0; i < 8; ++i) { const size_t un = (size_t)bh * 128 + cb + i; dv[i] = *(const GAS unsigned*)(dc + un * 8192 + e); const float* sc = scal + un * MLS_STRIDE; As[i] = sc[256]; bs[i] = sc[257]; dn[i] = nth ? sc[192 + F.tid] : 0.f; }
#pragma unroll
            for (int i = 0; i < 8; ++i) { const size_t un = (size_t)bh * 128 + cb + i; float* sc = scal + un * MLS_STRIDE;
                const float Mx = fmaxf(m, As[i]), wo = __expf(m - Mx), wd = __expf(As[i] - Mx);
                *(GAS unsigned*)(dc + un * 8192 + e) = pk2(c0, c1);
                if (nth) sc[192 + F.tid] = nn;
                if (part == 0 && F.tid == 64) sc[258] = m;
                c0 = wo * c0 + wd * bflo(dv[i]); c1 = wo * c1 + wd * bfhi(dv[i]); nn = wo * nn + wd * dn[i]; m = bs[i] + Mx; }
        }
    }
}
struct MlcRegs { bf16x8 qa[4][2], cb[2]; v4u nl0, nl1, o0, o1, qr; f32x4 n0, n1; float denL, cm, bb, mprev; };
DI void mlc_load(MlcRegs& R, const bf16* proj, const bf16* numl, const bf16* dc, const float* scal, int unit, int tid, int w) {
    const int ch = unit & 127, bh = unit >> 7, lane = tid & 63, r = lane & 15, quad = lane >> 4, row = tid >> 3, seg = tid & 7;
    const size_t hb0 = (size_t)bh * T + ch * 64;
#pragma unroll
    for (int mt = 0; mt < 4; ++mt) { const bf16* p = proj + (hb0 + 16 * mt + r) * 64 + 8 * quad; R.qa[mt][0] = *(const GAS bf16x8*)p; R.qa[mt][1] = *(const GAS bf16x8*)(p + 32); }
    { const bf16* p = dc + (size_t)unit * 8192 + (16 * w + r) * 64 + 8 * quad; R.cb[0] = *(const GAS bf16x8*)p; R.cb[1] = *(const GAS bf16x8*)(p + 32); }
    { const bf16* p = numl + (size_t)unit * 8192 + row * 128 + 16 * seg; R.nl0 = *(const GAS v4u*)p; R.nl1 = *(const GAS v4u*)(p + 8); }
    { const bf16* p = proj + (size_t)M * 1024 + (hb0 + row) * 128 + 16 * seg; R.o0 = *(const GAS v4u*)p; R.o1 = *(const GAS v4u*)(p + 8); }
    R.qr = *(const GAS v4u*)(proj + (hb0 + row) * 64 + 8 * seg);
    const float* sc = scal + (size_t)unit * MLS_STRIDE;
    R.n0 = *(const GAS f32x4*)(sc + 192 + 8 * seg); R.n1 = *(const GAS f32x4*)(sc + 192 + 8 * seg + 4);
    R.denL = sc[row]; R.cm = sc[64 + row]; R.bb = sc[128 + row]; R.mprev = sc[258];
}
DI void mlstm_c_phase(Frame& F, const bf16* proj, const bf16* numl, const bf16* dc, const float* scal, const float* hgain, bf16* mix) {
    constexpr int HLD = 132;
    const int per = (4096 + F.G - 1) / F.G, u0 = F.wg * per, u1 = (u0 + per < 4096) ? u0 + per : 4096;
    if (u0 >= u1) return;
    LAS float* hbuf = (LAS float*)F.lds;
    MlcRegs R; mlc_load(R, proj, numl, dc, scal, u0, F.tid, F.wave);
    for (int u = u0; u < u1; ++u) {
        int tid_ = F.tid; asm volatile("" : "+v"(tid_));
        const int tid = tid_, lane = tid & 63, w = F.wave, r = lane & 15, quad = lane >> 4, row = tid >> 3, seg = tid & 7;
        const int ch = u & 127, bh = u >> 7, b = bh >> 2, h = bh & 3;
        lds_barrier();
#pragma unroll
        for (int mt = 0; mt < 4; ++mt) { f32x4 acc = (f32x4){0.f, 0.f, 0.f, 0.f}; acc = mfma16(R.qa[mt][0], R.cb[0], acc); acc = mfma16(R.qa[mt][1], R.cb[1], acc);
#pragma unroll
            for (int j = 0; j < 4; ++j) hbuf[(16 * mt + 4 * quad + j) * HLD + 16 * w + r] = acc[j]; }
        const v4u nl0 = R.nl0, nl1 = R.nl1, o0 = R.o0, o1 = R.o1, qr = R.qr; const f32x4 n0 = R.n0, n1 = R.n1; const float denL = R.denL, cm = R.cm, bb = R.bb, mprev = R.mprev;
        if (u + 1 < u1) mlc_load(R, proj, numl, dc, scal, u + 1, tid, w);
        lds_barrier();
        { const float Mx = fmaxf(mprev, cm), e1 = __expf(cm - Mx), wi = __expf(mprev - Mx);
          float qn = (bflo(qr.x) * n0[0] + bfhi(qr.x) * n0[1]) + (bflo(qr.y) * n0[2] + bfhi(qr.y) * n0[3]) + (bflo(qr.z) * n1[0] + bfhi(qr.z) * n1[1]) + (bflo(qr.w) * n1[2] + bfhi(qr.w) * n1[3]);
          qn += __shfl_xor(qn, 1); qn += __shfl_xor(qn, 2); qn += __shfl_xor(qn, 4);
          const float den = e1 * denL + wi * qn; const float dinv = rcp_(fmaxf(fabsf(den), __expf(-(bb + Mx))));
          const unsigned nw[8] = {nl0.x, nl0.y, nl0.z, nl0.w, nl1.x, nl1.y, nl1.z, nl1.w};
          float hv[16]; float ss = 0.f;
#pragma unroll
          for (int q4 = 0; q4 < 4; ++q4) { const f32x4 t = *(const LAS f32x4*)(hbuf + row * HLD + 16 * seg + 4 * q4);
              hv[4 * q4] = (e1 * bflo(nw[2 * q4]) + wi * t.x) * dinv; hv[4 * q4 + 1] = (e1 * bfhi(nw[2 * q4]) + wi * t.y) * dinv; hv[4 * q4 + 2] = (e1 * bflo(nw[2 * q4 + 1]) + wi * t.z) * dinv; hv[4 * q4 + 3] = (e1 * bfhi(nw[2 * q4 + 1]) + wi * t.w) * dinv; }
#pragma unroll
          for (int i = 0; i < 16; ++i) ss += hv[i] * hv[i];
          ss += __shfl_xor(ss, 1); ss += __shfl_xor(ss, 2); ss += __shfl_xor(ss, 4);
          const float rstd = rsq_(ss * (1.f / 128.f) + EPS);
          const unsigned og[8] = {o0.x, o0.y, o0.z, o0.w, o1.x, o1.y, o1.z, o1.w}; unsigned ow[8];
          const float* gp = hgain + h * 128 + 16 * seg;
#pragma unroll
          for (int i = 0; i < 8; ++i) ow[i] = pk2(hv[2 * i] * rstd * gp[2 * i] * sigmoidf_(bflo(og[i])), hv[2 * i + 1] * rstd * gp[2 * i + 1] * sigmoidf_(bfhi(og[i])));
          bf16* op = mix + ((size_t)b * T + ch * 64 + row) * D + h * 128 + 16 * seg;
          *(GAS v4u*)op = (v4u){ow[0], ow[1], ow[2], ow[3]}; *(GAS v4u*)(op + 8) = (v4u){ow[4], ow[5], ow[6], ow[7]}; }
    }
}
constexpr size_t MIX_AT = 0, MIX_HALO = 64 * MiB, MIX_GL = 96 * MiB;
struct G1Raw { v2u raw[3][7]; };
struct G1Cw { float w[3][4][4]; };
DI void g1_load_raw(G1Raw& R, const bf16* big, const bf16* halo, int U, int tid) {
    const int ch = U & 127, h = (U >> 7) & 7, b = U >> 10, cg = tid & 31, rs = tid >> 5;
    const size_t hb0 = (size_t)(b * 8 + h) * T + (size_t)ch * 64;
#pragma unroll
    for (int which = 0; which < 3; ++which)
#pragma unroll
        for (int i = 0; i < 7; ++i) { const int rr = 4 * rs - 3 + i; v2u t = (v2u){0u, 0u};
            if (rr >= 0) t = *(const GAS v2u*)(big + (size_t)M * 1024 * which + (hb0 + rr) * 128 + 4 * cg);
            else if (ch > 0) t = *(const GAS v2u*)(halo + ((size_t)(b * 128 + ch - 1) * 3 + (3 + rr)) * 3072 + which * 1024 + h * 128 + 4 * cg);
            R.raw[which][i] = t; }
}
DI void g1_load_cw(G1Cw& C, const float* convw, int h, int tid) {
    const int cg = tid & 31;
#pragma unroll
    for (int which = 0; which < 3; ++which)
#pragma unroll
        for (int j = 0; j < 4; ++j) { const f32x4 t = *(const GAS f32x4*)(convw + j * 3072 + which * 1024 + h * 128 + 4 * cg); C.w[which][j][0] = t.x; C.w[which][j][1] = t.y; C.w[which][j][2] = t.z; C.w[which][j][3] = t.w; }
}
DI void gdn_g1_unit(Frame& F, bf16* big, const bf16* halo, const float* gate, G1Raw& RW, const float* convw, bf16* Hb, bf16* At, float* GL, int U, int Uend, bool st) {
    constexpr int LQ = 136, LX = 72, LR = 264;
    const int ch = U & 127, h = (U >> 7) & 7, b = U >> 10;
    const size_t r0 = (size_t)b * T + (size_t)ch * 64, hb0 = (size_t)(b * 8 + h) * T + (size_t)ch * 64;
    int tid_ = F.tid; asm volatile("" : "+v"(tid_));
    const int tid = tid_, lane = tid & 63, w = F.wave, r = lane & 15, quad = lane >> 4, row = tid >> 3, seg = tid & 7;
    const size_t hb = hb0 + row;
    LAS bf16* qn = (LAS bf16*)F.lds; LAS bf16* kn = qn + 64 * LQ; LAS bf16* vn = kn + 64 * LQ; LAS bf16* knT = vn + 64 * LQ;
    LAS bf16* Lb = knT + 128 * LX; LAS float* Lf = (LAS float*)(Lb + 64 * LX);
    LAS bf16* Db = (LAS bf16*)(Lf + 4 * 16 * 17); LAS bf16* Xt = Db + 4 * 16 * 20;
    LAS bf16* Xr = qn;
    LAS bf16* Ats = Xt;
    LAS float* sG = (LAS float*)(Xt + 256 * LX); LAS float* sBeta = sG + 64; LAS float* sEg = sBeta + 64;
    STG_T0();
    lds_barrier();
    STG(10);
    {
        const int cg = tid & 31, rs = tid >> 5;
#pragma unroll
        for (int which = 0; which < 3; ++which) {
            __builtin_amdgcn_sched_barrier(0);
            f32x4 cw[4];
#pragma unroll
            for (int j = 0; j < 4; ++j) cw[j] = *(const GAS f32x4*)(convw + j * 3072 + which * 1024 + h * 128 + 4 * cg);
            float x[7][4];
#pragma unroll
            for (int i = 0; i < 7; ++i) { const v2u t = RW.raw[which][i]; x[i][0] = bflo(t.x); x[i][1] = bfhi(t.x); x[i][2] = bflo(t.y); x[i][3] = bfhi(t.y); }
            float o[4][4]; float ss[4];
#pragma unroll
            for (int rr = 0; rr < 4; ++rr) { ss[rr] = 0.f;
#pragma unroll
                for (int c = 0; c < 4; ++c) { float a = cw[0][c] * x[rr][c]; a += cw[1][c] * x[rr + 1][c]; a += cw[2][c] * x[rr + 2][c]; a += cw[3][c] * x[rr + 3][c];
                    a = a * sigmoidf_(a); o[rr][c] = a; ss[rr] += a * a; } }
            if (which < 2) {
#pragma unroll
                for (int rr = 0; rr < 4; ++rr) { float t = ss[rr]; t += __shfl_xor(t, 1); t += __shfl_xor(t, 2); t += __shfl_xor(t, 4); t += __shfl_xor(t, 8); t += __shfl_xor(t, 16);
                    const float sc = rsq_(t + EPS) * (which == 0 ? 0.08838834764831845f : 1.0f);
#pragma unroll
                    for (int c = 0; c < 4; ++c) o[rr][c] *= sc; } }
            LAS bf16* dst = (which == 0 ? qn : (which == 1 ? kn : vn));
#pragma unroll
            for (int rr = 0; rr < 4; ++rr) *(LAS v2u*)(dst + (4 * rs + rr) * LQ + 4 * cg) = (v2u){pk2(o[rr][0], o[rr][1]), pk2(o[rr][2], o[rr][3])};
            if (which == 1) {
#pragma unroll
                for (int c = 0; c < 4; ++c) *(LAS v2u*)(knT + (4 * cg + c) * LX + ((4 * rs) ^ (8 * (cg & 7)))) = (v2u){pk2(o[0][c], o[1][c]), pk2(o[2][c], o[3][c])}; }
        }
    }
    if (U + 1 < Uend) g1_load_raw(RW, big, halo, U + 1, tid);
    if (w == 0) { const float* g = gate + (r0 + lane) * 16; float gg = g[8 + h]; const float be = g[h];
#pragma unroll
        for (int o = 1; o < 64; o <<= 1) { const float t = __shfl_up(gg, o); if (lane >= o) gg += t; }
        sG[lane] = gg; sBeta[lane] = be; sEg[lane] = __expf(gg); }
    STG(11);
    lds_barrier();
    STG(12);
    { const int mt = w >> 1;
#pragma unroll
      for (int tt = 0; tt < 2; ++tt) { const int nt = 2 * (w & 1) + tt; f32x4 ak = (f32x4){0.f, 0.f, 0.f, 0.f}, aq = ak;
          if (nt <= mt) {
#pragma unroll
              for (int kk = 0; kk < 4; ++kk) { const bf16x8 bk = *(const LAS bf16x8*)(kn + (16 * nt + r) * LQ + 32 * kk + 8 * quad);
                  ak = mfma16(*(const LAS bf16x8*)(kn + (16 * mt + r) * LQ + 32 * kk + 8 * quad), bk, ak); aq = mfma16(*(const LAS bf16x8*)(qn + (16 * mt + r) * LQ + 32 * kk + 8 * quad), bk, aq); } }
          const int s = 16 * nt + r; const float gs = sG[s];
#pragma unroll
          for (int j = 0; j < 4; ++j) { const int t = 16 * mt + 4 * quad + j; const float dec = (s <= t) ? __expf(sG[t] - gs) : 0.f;
              const float lv = (s < t) ? sBeta[t] * ak[j] * dec : 0.f;
              if (nt <= mt) { Lb[t * LX + s] = (bf16)f2bf(lv); if (nt == mt) Lf[(mt * 16 + 4 * quad + j) * 17 + r] = lv; }
              Ats[t * LX + s] = (bf16)f2bf(aq[j] * dec); } } }
    float R[4][2][4];
#pragma unroll
    for (int i = 0; i < 4; ++i)
#pragma unroll
        for (int ct = 0; ct < 2; ++ct)
#pragma unroll
            for (int j = 0; j < 4; ++j) { const int t = 16 * i + 4 * quad + j, cc = 32 * (w & 3) + 16 * ct + r;
                R[i][ct][j] = (w < 4) ? sBeta[t] * bf2f(vn[t * LQ + cc]) : sBeta[t] * sEg[t] * bf2f(kn[t * LQ + cc]); }
    STG(13);
    lds_barrier();
    STG(14);
    if (w == 0) { const int i = lane >> 4, cI = lane & 15; const LAS float* N = Lf + i * 16 * 17; float x[16];
#pragma unroll
        for (int rr = 0; rr < 16; ++rr) { float v = (rr == cI) ? 1.f : 0.f;
#pragma unroll
            for (int m = 0; m < rr; ++m) v -= N[rr * 17 + m] * x[m];
            x[rr] = v; Db[(i * 16 + rr) * 20 + cI] = (bf16)f2bf(v); }
    } else { const float gl = sG[63];
        if (st) for (int idx = tid - 64; idx < 2560; idx += NTHR - 64) {
            if (idx < 1024) { const int t = idx >> 4, c8 = (idx & 15) * 8; const v4u v = *(const LAS v4u*)(qn + t * LQ + c8); const float e = sEg[t];
                *(GAS v4u*)(big + (size_t)M * 2048 + (hb0 + t) * 128 + c8) = (v4u){scale_pk(v.x, e), scale_pk(v.y, e), scale_pk(v.z, e), scale_pk(v.w, e)}; }
            else if (idx >= 2048) { const int i3 = idx - 2048, t = i3 >> 3, s8 = (i3 & 7) * 8; *(GAS v4u*)(At + (size_t)U * 4096 + t * 64 + s8) = *(const LAS v4u*)(Ats + t * LX + s8); }
            else { const int i2 = idx - 1024, d = i2 >> 3, s8 = (i2 & 7) * 8; const v4u v = *(const LAS v4u*)(knT + d * LX + (s8 ^ (8 * ((d >> 2) & 7)))); float e[8];
#pragma unroll
                for (int q = 0; q < 8; ++q) e[q] = __expf(gl - sG[s8 + q]);
                *(GAS v4u*)(big + (size_t)M * 1024 + hb0 * 128 + d * 64 + s8) = (v4u){pk2(bflo(v.x) * e[0], bfhi(v.x) * e[1]), pk2(bflo(v.y) * e[2], bfhi(v.y) * e[3]), pk2(bflo(v.z) * e[4], bfhi(v.z) * e[5]), pk2(bflo(v.w) * e[6], bfhi(v.w) * e[7])}; } }
        if (st && tid == 64) GL[U] = __expf(gl); }
    STG(15);
    lds_barrier();
    STG(16);
#pragma unroll
    for (int i = 0; i < 4; ++i) {
#pragma unroll
        for (int ct = 0; ct < 2; ++ct) { const int col = 32 * w + 16 * ct + r; f32x4 acc = (f32x4){0.f, 0.f, 0.f, 0.f};
            if (i > 0) {
#pragma unroll
                for (int kk = 0; kk < 2; ++kk) if (32 * kk < 16 * i) {
                    bf16x8 af = *(const LAS bf16x8*)(Lb + (16 * i + r) * LX + 32 * kk + 8 * quad);
                    if (32 * kk + 8 * quad >= 16 * i) af = (bf16x8){0, 0, 0, 0, 0, 0, 0, 0};
                    acc = mfma16(af, *(const LAS bf16x8*)(Xt + col * LX + 32 * kk + 8 * quad), acc); } }
            const v2u bp = (v2u){pk2(R[i][ct][0] - acc[0], R[i][ct][1] - acc[1]), pk2(R[i][ct][2] - acc[2], R[i][ct][3] - acc[3])};
            const v2u ap = *(const LAS v2u*)(Db + (i * 16 + r) * 20 + 4 * quad);
            const f32x4 y = mfma16(__builtin_bit_cast(bf16x8, (v4u){ap.x, ap.y, 0u, 0u}), __builtin_bit_cast(bf16x8, (v4u){bp.x, bp.y, 0u, 0u}), (f32x4){0.f, 0.f, 0.f, 0.f});
            *(LAS v2u*)(Xt + col * LX + 16 * i + 4 * quad) = (v2u){pk2(y[0], y[1]), pk2(y[2], y[3])};
#pragma unroll
            for (int j = 0; j < 4; ++j) Xr[(16 * i + 4 * quad + j) * LR + col] = (bf16)f2bf(y[j]); }
        asm volatile("s_waitcnt lgkmcnt(0)" ::: "memory");
    }
    lds_barrier();
    STG(17);
    if (st) { const v4u u0 = *(const LAS v4u*)(Xr + row * LR + 16 * seg), u1 = *(const LAS v4u*)(Xr + row * LR + 16 * seg + 8), w0 = *(const LAS v4u*)(Xr + row * LR + 128 + 16 * seg), w1 = *(const LAS v4u*)(Xr + row * LR + 128 + 16 * seg + 8);
      bf16* up = Hb + hb * 128 + 16 * seg; *(GAS v4u*)up = u0; *(GAS v4u*)(up + 8) = u1;
      bf16* wp = big + hb * 128 + 16 * seg; *(GAS v4u*)wp = w0; *(GAS v4u*)(wp + 8) = w1; }
    STG(18);
}
DI void gdn_g1_phase(Frame& F, bf16* big, const bf16* halo, const float* gate, const float* convw, bf16* Hb, bf16* At, float* GL, bool st) {
    LAS unsigned* xt = (LAS unsigned*)(F.lds + (3 * 64 * 136 + 128 * 72 + 64 * 72) * 2 + 4 * 16 * 17 * 4 + 4 * 16 * 20 * 2);
    lds_barrier();
    for (int i = F.tid; i < 256 * 72 / 2; i += NTHR) xt[i] = 0u;
    const int per = (8192 + F.G - 1) / F.G, u0 = F.wg * per, u1 = (u0 + per < 8192) ? u0 + per : 8192;
    if (u0 >= u1) return;
    G1Raw RW;
    g1_load_raw(RW, big, halo, u0, F.tid);
    for (int U = u0; U < u1; ++U) gdn_g1_unit(F, big, halo, gate, RW, convw, Hb, At, GL, U, u1, st);
}
struct G2Regs { bf16x8 wf[4], qf[4], af[2], kf[2]; unsigned u[4]; float gl; };
DI void g2_load(G2Regs& R, const bf16* big, const bf16* Hb, const bf16* At, const float* GL, int b, int h, int vq, int ch, int w, int r, int quad) {
    const size_t hb0 = (size_t)(b * 8 + h) * T + (size_t)ch * 64; const int U = (b * 8 + h) * 128 + ch; const int mt = w >> 1, nt = w & 1;
    const bf16* pw = big + (hb0 + 16 * mt + r) * 128 + 8 * quad;
#pragma unroll
    for (int kk = 0; kk < 4; ++kk) { R.wf[kk] = *(const GAS bf16x8*)(pw + 32 * kk); R.qf[kk] = *(const GAS bf16x8*)(pw + (size_t)M * 2048 + 32 * kk); }
    const bf16* pa = At + (size_t)U * 4096 + (16 * mt + r) * 64 + 8 * quad;
    R.af[0] = *(const GAS bf16x8*)pa; R.af[1] = *(const GAS bf16x8*)(pa + 32);
    const int d = 16 * w + r; const bf16* pk = big + (size_t)M * 1024 + hb0 * 128 + d * 64 + 8 * quad;
    R.kf[0] = *(const GAS bf16x8*)pk; R.kf[1] = *(const GAS bf16x8*)(pk + 32);
    const bf16* pu = Hb + (hb0 + 16 * mt + 4 * quad) * 128 + vq * 32 + 16 * nt + r;
#pragma unroll
    for (int j = 0; j < 4; ++j) R.u[j] = pu[(size_t)j * 128];
    R.gl = GL[U];
}
DI void gdn_g2_chain(Frame& F, const bf16* big, bf16* Hb, const bf16* At, const float* GL, int c, bool st) {
    constexpr int LS = 136, LV = 72;
    const int b = c >> 5, h = (c >> 2) & 7, vq = c & 3;
    const int tid = F.tid, lane = F.lane, w = F.wave, r = lane & 15, quad = lane >> 4, mt = w >> 1, nt = w & 1;
    LAS bf16* St = (LAS bf16*)F.lds;
    LAS bf16* vnT = St + 32 * LS;
    lds_barrier();
    for (int i = tid; i < 32 * LS / 2; i += NTHR) ((LAS unsigned*)St)[i] = 0u;
    f32x4 accS[2]; accS[0] = (f32x4){0.f, 0.f, 0.f, 0.f}; accS[1] = accS[0];
    G2Regs cur, nxt; g2_load(cur, big, Hb, At, GL, b, h, vq, 0, w, r, quad); nxt = cur;
    lds_barrier();
    unsigned short opend[4] = {0, 0, 0, 0};
    for (int ch = 0; ch < T / 64; ++ch) {
        if (ch > 0 && st) { const size_t hbp = (size_t)(b * 8 + h) * T + (size_t)(ch - 1) * 64; bf16* po = Hb + (hbp + 16 * mt + 4 * quad) * 128 + vq * 32 + 16 * nt + r;
#pragma unroll
            for (int j = 0; j < 4; ++j) po[(size_t)j * 128] = opend[j]; }
        if (ch + 1 < T / 64) g2_load(nxt, big, Hb, At, GL, b, h, vq, ch + 1, w, r, quad);
        STG_T0();
        f32x4 av = (f32x4){0.f, 0.f, 0.f, 0.f}, ao = av;
#pragma unroll
        for (int kk = 0; kk < 4; ++kk) { const bf16x8 sf = *(const LAS bf16x8*)(St + (16 * nt + r) * LS + 32 * kk + 8 * quad); av = mfma16(cur.wf[kk], sf, av); ao = mfma16(cur.qf[kk], sf, ao); }
        *(LAS v2u*)(vnT + (16 * nt + r) * LV + 16 * mt + 4 * quad) = (v2u){pk2(bflo(cur.u[0]) - av[0], bflo(cur.u[1]) - av[1]), pk2(bflo(cur.u[2]) - av[2], bflo(cur.u[3]) - av[3])};
        STG(20);
        lds_barrier();
        STG(21);
#pragma unroll
        for (int kk = 0; kk < 2; ++kk) ao = mfma16(cur.af[kk], *(const LAS bf16x8*)(vnT + (16 * nt + r) * LV + 32 * kk + 8 * quad), ao);
#pragma unroll
        for (int j = 0; j < 4; ++j) opend[j] = (unsigned short)f2bf(ao[j]);
#pragma unroll
        for (int n2 = 0; n2 < 2; ++n2) { f32x4 a = accS[n2] * cur.gl;
#pragma unroll
            for (int kk = 0; kk < 2; ++kk) a = mfma16(cur.kf[kk], *(const LAS bf16x8*)(vnT + (16 * n2 + r) * LV + 32 * kk + 8 * quad), a);
            accS[n2] = a; *(LAS v2u*)(St + (16 * n2 + r) * LS + 16 * w + 4 * quad) = (v2u){pk2(a[0], a[1]), pk2(a[2], a[3])}; }
        STG(22);
        lds_barrier();
        STG(23);
        cur = nxt;
    }
    if (st) { const size_t hbp = (size_t)(b * 8 + h) * T + (size_t)(T / 64 - 1) * 64; bf16* po = Hb + (hbp + 16 * mt + 4 * quad) * 128 + vq * 32 + 16 * nt + r;
#pragma unroll
        for (int j = 0; j < 4; ++j) po[(size_t)j * 128] = opend[j]; }
}
struct SbRegs { v4u k0, k1, v0, v1; };
DI void sb_load(SbRegs& R, const bf16* proj, int b, int h, int k0, int tid) {
    const size_t hb = (size_t)(b * 4 + h) * T + k0;
    const bf16* pk = proj + (size_t)M * 2048 + (hb + (tid >> 3)) * 128 + (tid & 7) * 16;
    R.k0 = *(const GAS v4u*)pk; R.k1 = *(const GAS v4u*)(pk + 8);
    const bf16* pv = proj + (size_t)M * 2560 + (hb + (tid & 63)) * 128 + (tid >> 6) * 16;
    R.v0 = *(const GAS v4u*)pv; R.v1 = *(const GAS v4u*)(pv + 8);
}
DI void sb_unit(Frame& F, const bf16* proj, bf16* mix, int u) {
    constexpr int LDV = 72, LDK = 136;
    const int qt = u & 63, h = (u >> 6) & 3, b = u >> 8;
    LAS bf16* Vt = (LAS bf16*)F.lds;
    LAS bf16* Ks = Vt + 128 * LDV;
    volatile LAS unsigned* flag = (volatile LAS unsigned*)(F.lds + MISC_OFF + 64);
    const int w = F.wave, lane = F.lane, r = lane & 15, quad = lane >> 4;
    const int t0 = qt * 128, qpos = t0 + 16 * w + r;
    const size_t rb = (size_t)b * T;
    bf16x8 qf[4];
#pragma unroll
    for (int kk = 0; kk < 4; ++kk) qf[kk] = *(const GAS bf16x8*)(proj + (size_t)M * 1536 + ((size_t)(b * 4 + h) * T + qpos) * 128 + 32 * kk + 8 * quad);
    f32x4 o[8];
#pragma unroll
    for (int i = 0; i < 8; ++i) o[i] = (f32x4){0.f, 0.f, 0.f, 0.f};
    float carry = 0.f;
    const float scale = 0.08838834764831845f;
    SbRegs R; sb_load(R, proj, b, h, (2 * qt + 1) * 64, F.tid);
    for (int kb = 2 * qt + 1; kb >= 0; --kb) {
        const int k0 = kb * 64;
        lds_barrier();
        { LAS bf16* kd = Ks + (F.tid >> 3) * LDK + (F.tid & 7) * 16; *(LAS v4u*)kd = R.k0; *(LAS v4u*)(kd + 8) = R.k1;
          const unsigned ww[8] = {R.v0.x, R.v0.y, R.v0.z, R.v0.w, R.v1.x, R.v1.y, R.v1.z, R.v1.w}; const int key = F.tid & 63, ds = (F.tid >> 6) * 16;
#pragma unroll
          for (int i = 0; i < 8; ++i) { Vt[(ds + 2 * i) * LDV + key] = (bf16)(ww[i] & 0xffffu); Vt[(ds + 2 * i + 1) * LDV + key] = (bf16)(ww[i] >> 16); } }
        if (F.tid == 0) flag[0] = 0u;
        if (kb > 0) sb_load(R, proj, b, h, k0 - 64, F.tid);
        lds_barrier();
        if (k0 < t0 + 16 * w + 15) {
            f32x4 s[4];
#pragma unroll
            for (int mt = 0; mt < 4; ++mt) { s[mt] = (f32x4){0.f, 0.f, 0.f, 0.f};
                const LAS bf16* kp = Ks + (16 * mt + r) * LDK + 8 * quad;
#pragma unroll
                for (int kk = 0; kk < 4; ++kk) s[mt] = mfma16(*(const LAS bf16x8*)(kp + 32 * kk), qf[kk], s[mt]); }
            float l1[4][4], tot[4];
#pragma unroll
            for (int mt = 0; mt < 4; ++mt) { tot[mt] = 0.f;
#pragma unroll
                for (int j = 0; j < 4; ++j) { const float z = s[mt][j] * scale; const bool valid = (k0 + 16 * mt + 4 * quad + j) < qpos;
                    const float tl = __logf(1.0f + __expf(-fabsf(z)));
                    l1[mt][j] = valid ? (fminf(-z, 0.f) - tl) : 0.f; s[mt][j] = valid ? (fminf(z, 0.f) - tl) : -1e30f; tot[mt] += l1[mt][j]; } }
            float run = carry;
#pragma unroll
            for (int mt = 3; mt >= 0; --mt) {
                const float t1 = __shfl_xor(tot[mt], 16), t2 = __shfl_xor(tot[mt], 32), t3 = __shfl_xor(t1, 32);
                float hi = 0.f;
                hi += ((quad ^ 1) > quad) ? t1 : 0.f; hi += ((quad ^ 2) > quad) ? t2 : 0.f; hi += ((quad ^ 3) > quad) ? t3 : 0.f;
                float acc = run + hi;
#pragma unroll
                for (int j = 3; j >= 0; --j) { const float e = s[mt][j] + acc; s[mt][j] = __expf(e); acc += l1[mt][j]; }
                run += (tot[mt] + t1) + (t2 + t3);
            }
            carry = run;
#pragma unroll
            for (int s2 = 0; s2 < 2; ++s2) {
                v4u pw; pw.x = pk2(s[2 * s2][0], s[2 * s2][1]); pw.y = pk2(s[2 * s2][2], s[2 * s2][3]); pw.z = pk2(s[2 * s2 + 1][0], s[2 * s2 + 1][1]); pw.w = pk2(s[2 * s2 + 1][2], s[2 * s2 + 1][3]);
                const bf16x8 pf = __builtin_bit_cast(bf16x8, pw);
#pragma unroll
                for (int dt = 0; dt < 8; ++dt) { const LAS bf16* vp = Vt + (16 * dt + r) * LDV + 32 * s2 + 4 * quad;
                    const s16x4 lo = *(const LAS s16x4*)vp, hi4 = *(const LAS s16x4*)(vp + 16);
                    o[dt] = mfma16(__builtin_shufflevector(lo, hi4, 0, 1, 2, 3, 4, 5, 6, 7), pf, o[dt]); }
            }
        }
        if (!(carry < -SB_THR)) flag[0] = 1u;
        lds_barrier();
        if (flag[0] == 0u) break;
    }
    bf16* op = mix + (rb + qpos) * D + 512 + h * 128 + 4 * quad;
#pragma unroll
    for (int dt = 0; dt < 8; ++dt) *(GAS v2u*)(op + 16 * dt) = (v2u){pk2(o[dt][0], o[dt][1]), pk2(o[dt][2], o[dt][3])};
}
struct XaRegs { v4u k[4], v[4]; };
DI void xa_load(XaRegs& R, const bf16* KV, int l, int b, int h, int c, int tid) {
    const bf16* pk = KV + (size_t)(b * MEMLEN + 64 * c + (tid >> 3)) * 8192 + 2048 * l + h * 256 + (tid & 7) * 32;
    const bf16* pv = KV + (size_t)(b * MEMLEN + 64 * c + (tid & 63)) * 8192 + 2048 * l + 1024 + h * 256 + (tid >> 6) * 32;
#pragma unroll
    for (int i = 0; i < 4; ++i) { R.k[i] = *(const GAS v4u*)(pk + 8 * i); R.v[i] = *(const GAS v4u*)(pv + 8 * i); }
}
DI void xattn_phase(Frame& F, const bf16* Q, const bf16* KV, int l, bf16* O) {
    constexpr int LDK = 264, LDV = 72, BUF = 64 * LDK + 256 * LDV;
    LAS bf16* lds = (LAS bf16*)F.lds;
    const int per = (2048 + F.G - 1) / F.G, u0 = F.wg * per, u1 = (u0 + per < 2048) ? u0 + per : 2048;
    if (u0 >= u1) return;
    const int w = F.wave, lane = F.lane, r = lane & 15, quad = lane >> 4, tid = F.tid;
    XaRegs R; xa_load(R, KV, l, (u0 >> 6) >> 2, (u0 >> 6) & 3, 0, tid);
    int step = 0;
    for (int u = u0; u < u1; ++u) {
        const int bh = u >> 6, qt = u & 63, b = bh >> 2, h = bh & 3;
        const size_t row = (size_t)b * T + qt * 128 + 16 * w + r;
        bf16x8 qf[8];
#pragma unroll
        for (int kk = 0; kk < 8; ++kk) qf[kk] = *(const GAS bf16x8*)(Q + row * D + h * 256 + 32 * kk + 8 * quad);
        f32x4 o[16];
#pragma unroll
        for (int i = 0; i < 16; ++i) o[i] = (f32x4){0.f, 0.f, 0.f, 0.f};
        float mrun = -1e30f, lsum = 0.f;
        for (int c = 0; c < 4; ++c, ++step) {
            LAS bf16* Kc = lds + (step & 1) * BUF; LAS bf16* Vt = Kc + 64 * LDK;
            { LAS bf16* kd = Kc + (tid >> 3) * LDK + (tid & 7) * 32;
#pragma unroll
              for (int i = 0; i < 4; ++i) *(LAS v4u*)(kd + 8 * i) = R.k[i];
              const int key = tid & 63, ds = (tid >> 6) * 32;
#pragma unroll
              for (int i = 0; i < 4; ++i) { const unsigned ww[4] = {R.v[i].x, R.v[i].y, R.v[i].z, R.v[i].w};
#pragma unroll
                  for (int e = 0; e < 4; ++e) { Vt[(ds + 8 * i + 2 * e) * LDV + key] = (bf16)(ww[e] & 0xffffu); Vt[(ds + 8 * i + 2 * e + 1) * LDV + key] = (bf16)(ww[e] >> 16); } } }
            lds_barrier();
            { const int un = (c == 3) ? u + 1 : u;
              if (un < u1) xa_load(R, KV, l, (un >> 6) >> 2, (un >> 6) & 3, (c + 1) & 3, tid); }
            f32x4 s[4];
#pragma unroll
            for (int mt = 0; mt < 4; ++mt) { s[mt] = (f32x4){0.f, 0.f, 0.f, 0.f};
                const LAS bf16* kp = Kc + (16 * mt + r) * LDK + 8 * quad;
#pragma unroll
                for (int kk = 0; kk < 8; ++kk) s[mt] = mfma16(*(const LAS bf16x8*)(kp + 32 * kk), qf[kk], s[mt]); }
            float mx = -1e30f;
#pragma unroll
            for (int mt = 0; mt < 4; ++mt) mx = fmaxf(fmaxf(fmaxf(s[mt][0], s[mt][1]), fmaxf(s[mt][2], s[mt][3])), mx);
            mx = fmaxf(mx, __shfl_xor(mx, 16)); mx = fmaxf(mx, __shfl_xor(mx, 32));
            const float mnew = fmaxf(mrun, mx), alpha = __expf((mrun - mnew) * 0.0625f); mrun = mnew;
            float ps = 0.f;
#pragma unroll
            for (int mt = 0; mt < 4; ++mt)
#pragma unroll
                for (int j = 0; j < 4; ++j) { const float p = __expf((s[mt][j] - mnew) * 0.0625f); s[mt][j] = p; ps += p; }
            lsum = lsum * alpha + ps;
#pragma unroll
            for (int i = 0; i < 16; ++i) o[i] = o[i] * alpha;
#pragma unroll
            for (int s2 = 0; s2 < 2; ++s2) {
                v4u pw; pw.x = pk2(s[2 * s2][0], s[2 * s2][1]); pw.y = pk2(s[2 * s2][2], s[2 * s2][3]); pw.z = pk2(s[2 * s2 + 1][0], s[2 * s2 + 1][1]); pw.w = pk2(s[2 * s2 + 1][2], s[2 * s2 + 1][3]);
                const bf16x8 pf = __builtin_bit_cast(bf16x8, pw);
#pragma unroll
                for (int dt = 0; dt < 16; ++dt) { const LAS bf16* vp = Vt + (16 * dt + r) * LDV + 32 * s2 + 4 * quad;
                    const s16x4 lo = *(const LAS s16x4*)vp, hi4 = *(const LAS s16x4*)(vp + 16);
                    o[dt] = mfma16(__builtin_shufflevector(lo, hi4, 0, 1, 2, 3, 4, 5, 6, 7), pf, o[dt]); }
            }
        }
        lsum += __shfl_xor(lsum, 16); lsum += __shfl_xor(lsum, 32);
        const float inv = rcp_(lsum);
        bf16* op = O + row * D + h * 256 + 4 * quad;
#pragma unroll
        for (int dt = 0; dt < 16; ++dt) *(GAS v2u*)(op + 16 * dt) = (v2u){pk2(o[dt][0] * inv, o[dt][1] * inv), pk2(o[dt][2] * inv, o[dt][3] * inv)};
    }
    lds_barrier();
}
template <class Epi> DI void run_gemm(Frame& F, const bf16* A, const bf16* Bt, int M_, int N_, int K_, const Epi& E) {
    pg8::Gemm g{A, Bt, M_, N_, K_}; pg8::StaticOrder S; S.init(M_, N_, F.G, F.wg);
    pg8::gemm_phase<Epi, pg8::StaticOrder, PG8_ALIGN, PG8_SP2>(F.lds, g, S, E, F.tid);
}
constexpr int NPHASE = 43, PH_FINAL = 42, PPL = 10;
constexpr int SB_N1 = 512, SB_N2 = 1280;
struct Args { In in; float* out; unsigned char* ws; int ph_lo, ph_hi, region, pad; };
__global__ void __launch_bounds__(NTHR, 2) fwd(Args a) {
    extern __shared__ __attribute__((aligned(16))) unsigned char lds_raw[];
    Frame F;
    F.lds = (LAS unsigned char*)lds_raw;
    F.tid = threadIdx.x; F.lane = F.tid & 63; F.wave = __builtin_amdgcn_readfirstlane(F.tid >> 6);
    F.G = gridDim.x; F.wg = blockIdx.x; F.gw = F.wg * NWAVES + F.wave; F.NGW = F.G * NWAVES;
    volatile LAS unsigned* MISC = (volatile LAS unsigned*)(F.lds + MISC_OFF);
    if (F.tid < 32) MISC[F.tid] = 0u;
    __syncthreads();
    const int lo = a.ph_lo, hi = a.ph_hi;
    unsigned char* ws = a.ws; const In& I = a.in;
    XcdBarrier bar; bar.bar = (unsigned*)(ws + WS_CTL) + CW_BAR + a.region * XCD_BAR_WORDS; bar.x = 0; bar.st = MISC + 8;
    if (hi - lo > 1) bar = xcd_barrier_post(bar.bar, MISC + 8);
#define IN(k) (lo <= (k) && (k) < hi)
#ifndef PROBE_DOUBLE
#define PROBE_DOUBLE -1
#endif
#ifndef PROBE_PAR
#define PROBE_PAR -1
#endif
#define PHASE(k) asm volatile("" : "+v"(F.tid)); F.lane = F.tid & 63; if (IN(k))
#define DUPQ(c) ((c) == PROBE_DOUBLE && (PROBE_PAR < 0 || (l & 1) == PROBE_PAR))
#ifndef PROBE_SEL
#define PROBE_SEL -1
#endif
    F.tacc = 0ull;
    unsigned long long tacc = 0ull, tlast = (PROBE_SEL >= 0) ? __builtin_amdgcn_s_memrealtime() : 0ull;
#define SELQ(k) ((PROBE_SEL >= 0 && PROBE_SEL <= 12) ? ((k) >= 2 && (k) < PH_FINAL && ((k) - 2) % PPL == PROBE_SEL && (PROBE_PAR < 0 || ((((k) - 2) / PPL) & 1) == PROBE_PAR)) : (PROBE_SEL == 101 ? (k) == 0 : (PROBE_SEL == 102 ? (k) == 1 : (PROBE_SEL == 103 ? (k) == PH_FINAL : false))))
#define SEAM(k) do { if (IN(k) && IN((k) + 1)) { \
        if (PROBE_SEL >= 0) { const unsigned long long tn_ = __builtin_amdgcn_s_memrealtime(); if (SELQ(k)) tacc += tn_ - tlast; tlast = tn_; } \
        xcd_barrier(bar); \
        if (PROBE_SEL >= 0) { const unsigned long long tn_ = __builtin_amdgcn_s_memrealtime(); if (PROBE_SEL == 100 || (PROBE_SEL >= 200 && (k) >= 2 && (k) < PH_FINAL && ((k) - 2) % PPL == PROBE_SEL - 200 && (PROBE_PAR < 0 || ((((k) - 2) / PPL) & 1) == PROBE_PAR))) tacc += tn_ - tlast; tlast = tn_; } } } while (0)
    bf16* XS = (bf16*)(ws + WS_H); unsigned char* mixb = (unsigned char*)a.out; bf16* MIX = (bf16*)mixb; unsigned char* scrb = mixb + 128 * MiB; bf16* SCR = (bf16*)scrb;
    bf16* BIG = (bf16*)(ws + WS_BIG); bf16* KVX = (bf16*)(ws + WS_KVX);
    float* GATE = (float*)(ws + WS_GATE); const bf16* WG = (const bf16*)(ws + WS_WG);

    PHASE(0) { p0_prologue(F, I, ws);
#ifdef PROBE_P0
        p0_prologue(F, I, ws);
#endif
    }
    SEAM(0);
    PHASE(1) run_gemm(F, (const bf16*)(ws + WS_MEMN), (const bf16*)(ws + WS_WKV), BATCH * MEMLEN, 8192, D, pg8::EpiBf16<0>{KVX, 8192, nullptr});
    SEAM(1);
    pg8::rs_t* RSA = (pg8::rs_t*)(ws + WS_RS);
#define RS_R(p) (RSA + (size_t)((p) & 1) * M)
#define RS_ZERO(p) do { pg8::rs_t* z_ = RSA + (size_t)(((p) + 1) & 1) * M; for (int i_ = F.wg * NTHR + F.tid; i_ < M; i_ += F.G * NTHR) __hip_atomic_store(z_ + i_, (pg8::rs_t)0, __ATOMIC_RELAXED, __HIP_MEMORY_SCOPE_AGENT); } while (0)
    for (int l = 0; l < DEPTH; ++l) {
        asm volatile("" : "+v"(F.tid)); F.lane = F.tid & 63;
        const int pb = 2 + PPL * l, j = l >> 1; const bool odd = (l & 1) != 0;
        unsigned char* wl = ws + WS_W + (size_t)l * W_LAYER;
        PHASE(pb + 0) { const int n = odd ? C_N : AB_N;
            run_gemm(F, XS, (const bf16*)(wl + WO_WIN), M, n, D, pg8::EpiBlk{BIG, odd ? (bf16*)(mixb + MIX_HALO) : nullptr, odd ? 2 : 1, RS_R(3 * l)});
            if (DUPQ(0)) { run_gemm(F, XS, (const bf16*)(wl + WO_WIN), M, n, D, pg8::EpiBlk{BIG, odd ? (bf16*)(mixb + MIX_HALO) : nullptr, odd ? 2 : 1, RS_R(3 * l)}); }
            if (!odd) gates_phase<1>(F, XS, RS_R(3 * l), WG + l * 16384, GATE, I.p[4] + j * 4, I.p[5] + j * 4);
            else gates_phase<2>(F, XS, RS_R(3 * l), WG + l * 16384, GATE, I.p[10] + j * 8, I.p[11] + j * 8);
        }
        SEAM(pb + 0);
        PHASE(pb + 1) {
            if (!odd) {
                mlstm_a_phase(F, BIG, GATE, (bf16*)(scrb + H_NUML), (bf16*)(scrb + H_DC), (float*)(ws + WS_MLS));
                for (int u = F.wg; u < SB_N1; u += F.G) sb_unit(F, BIG, MIX, u);
            } else {
                gdn_g1_phase(F, BIG, (const bf16*)(mixb + MIX_HALO), GATE, I.p[9] + (size_t)j * 4 * 3072, SCR, (bf16*)(mixb + MIX_AT), (float*)(mixb + MIX_GL), true);
            }
        }
        SEAM(pb + 1);
        PHASE(pb + 2) {
            if (odd) { for (int c = F.wg; c < 256; c += F.G) gdn_g2_chain(F, BIG, SCR, (const bf16*)(mixb + MIX_AT), (const float*)(mixb + MIX_GL), c, true); }
            else { mlstm_b_phase(F, (bf16*)(scrb + H_DC), (float*)(ws + WS_MLS)); for (int u = SB_N1 + F.wg; u < SB_N2; u += F.G) sb_unit(F, BIG, MIX, u); }
        }
        SEAM(pb + 2);
        PHASE(pb + 3) {
            if (odd) headnorm_phase<true>(F, SCR, MIX, BIG, I.p[12] + j * 128);
            else { mlstm_c_phase(F, BIG, (const bf16*)(scrb + H_NUML), (const bf16*)(scrb + H_DC), (const float*)(ws + WS_MLS), I.p[6] + j * 512, MIX); for (int u = SB_N2 + F.wg; u < 2048; u += F.G) sb_unit(F, BIG, MIX, u); }
        }
        SEAM(pb + 3);
        PHASE(pb + 4) { RS_ZERO(3 * l + 1); run_gemm(F, MIX, (const bf16*)(wl + WO_WOUT), M, D, D, pg8::EpiResidB{XS, RS_R(3 * l + 1)}); }
        SEAM(pb + 4);
        PHASE(pb + 5) { run_gemm(F, XS, (const bf16*)(wl + WO_WQ), M, D, D, pg8::EpiBf16<0>{BIG, D, RS_R(3 * l + 1)}); if (DUPQ(5)) { run_gemm(F, XS, (const bf16*)(wl + WO_WQ), M, D, D, pg8::EpiBf16<0>{BIG, D, RS_R(3 * l + 1)}); } }
        SEAM(pb + 5);
        PHASE(pb + 6) { xattn_phase(F, BIG, KVX, l, MIX); if (DUPQ(6)) { xattn_phase(F, BIG, KVX, l, MIX); } }
        SEAM(pb + 6);
        PHASE(pb + 7) { RS_ZERO(3 * l + 2); run_gemm(F, MIX, (const bf16*)(wl + WO_WO), M, D, D, pg8::EpiResidB{XS, RS_R(3 * l + 2)}); }
        SEAM(pb + 7);
        PHASE(pb + 8) { run_gemm(F, XS, (const bf16*)(wl + WO_W1), M, FF, D, pg8::EpiBf16<2>{BIG, FF, RS_R(3 * l + 2)}); if (DUPQ(8)) { run_gemm(F, XS, (const bf16*)(wl + WO_W1), M, FF, D, pg8::EpiBf16<2>{BIG, FF, RS_R(3 * l + 2)}); } }
        SEAM(pb + 8);
        PHASE(pb + 9) { RS_ZERO(3 * l + 3); run_gemm(F, BIG, (const bf16*)(wl + WO_W2), M, D, FF, pg8::EpiResidB{XS, RS_R(3 * l + 3)}); }
        SEAM(pb + 9);
    }
    PHASE(PH_FINAL) final_norm_phase(F, XS, a.out, I.p[23]);
    if (PROBE_SEL >= 0) { const unsigned long long te = __builtin_amdgcn_s_memrealtime(); if (SELQ(PH_FINAL)) tacc += te - tlast;

#ifdef PROBE_WGLO
        if (!(F.wg >= PROBE_WGLO && F.wg < PROBE_WGHI)) tacc = 0ull;
#endif
        if (PROBE_STG >= 0) tacc = F.tacc;
        while (__builtin_amdgcn_s_memrealtime() - te < tacc) __builtin_amdgcn_s_sleep(16); }
#undef IN
#undef PHASE
#undef SEAM
}

#ifndef MK_SPLIT
#define MK_SPLIT 0
#endif
extern "C" void kernel_launch(void* const* d_in, const int* in_sizes, int n_in, void* d_out, int out_size, void* d_ws, size_t ws_size, hipStream_t stream) {
    static int grid = 0;
    if (grid == 0) {
        if (n_in != 24 || in_sizes[0] != M * D || out_size != M * D || ws_size < WS_END) { fprintf(stderr, "kernel_launch: unexpected shapes (n_in %d, in0 %d, out %d, ws %zu)\n", n_in, n_in > 0 ? in_sizes[0] : -1, out_size, ws_size); grid = -1; return; }
        int dev = 0, cus = 0;
        if (hipGetDevice(&dev) != hipSuccess || hipDeviceGetAttribute(&cus, hipDeviceAttributeMultiprocessorCount, dev) != hipSuccess) { grid = -1; return; }
        if (hipFuncSetAttribute((const void*)fwd, hipFuncAttributeMaxDynamicSharedMemorySize, LDS_BYTES) != hipSuccess) { fprintf(stderr, "kernel_launch: hipFuncSetAttribute failed\n"); grid = -1; return; }
        (void)hipGetLastError();
        grid = cus;
    }
    if (grid < 0) return;
    (void)hipMemsetAsync((char*)d_ws + WS_CTL, 0, CTL_ZERO_BYTES, stream);
    Args a{};
    for (int i = 0; i < 24; ++i) a.in.p[i] = (const float*)d_in[i];
    a.out = (float*)d_out; a.ws = (unsigned char*)d_ws; a.region = 0; a.pad = 0;
#if MK_SPLIT
    for (int p = 0; p < NPHASE; ++p) { a.ph_lo = p; a.ph_hi = p + 1; hipLaunchKernelGGL(fwd, dim3(grid), dim3(NTHR), LDS_BYTES, stream, a); }
#else
    a.ph_lo = 0; a.ph_hi = NPHASE; hipLaunchKernelGGL(fwd, dim3(grid), dim3(NTHR), LDS_BYTES, stream, a);
#endif
}
```

```cpp
#include <hip/hip_runtime.h>
#include <cstdio>
#include <cstdint>
namespace pg8 {
#define PG8_LAS __attribute__((address_space(3)))
typedef unsigned short bf16_t;
typedef short bf16x8 __attribute__((ext_vector_type(8)));
typedef float f32x4 __attribute__((ext_vector_type(4)));
typedef unsigned u32x4 __attribute__((ext_vector_type(4)));
constexpr int BM = 256, BK = 64, HALF = 128, HTB = HALF * BK * 2  , STAGE_BYTES = 8 * HTB, NXCD = 8, WGM = 8;

__host__ __device__ __forceinline__ int lds_byte(int r, int c) { const int st = (r >> 4) * 2 + (c >> 5), rr = r & 15, cc = c & 31, ob = rr * 64 + cc * 2; return st * 1024 + (ob ^ (((ob >> 9) & 1) << 5)); }
__host__ __device__ __forceinline__ void stage_rc(int b, int& R, int& C) { const int st = b / 1024, sb = b % 1024, swz = sb ^ (((sb >> 9) & 1) << 5); R = (st >> 1) * 16 + swz / 64; C = (st & 1) * 32 + (swz % 64) / 2; }
__host__ __device__ __forceinline__ int perm32(int rho) { const int n = rho >> 4, i = rho & 15; return 8 * (i >> 2) + 4 * n + (i & 3); }

struct Unit { int pm, pn; };
struct Gemm { const bf16_t* A; const bf16_t* Bt; int M, N, K; };

struct StaticOrder {
    int nM, nN, nwg, G, c;
    __host__ __device__ void init(int M, int N, int G_, int c_) { nM = M / BM; nN = N / BM; nwg = nM * nN; G = G_; c = c_; }
    __host__ __device__ bool next(int i, Unit& u) const {
        const long L = (long)i * G + c; if (L >= nwg) return false;
        int wgid = (int)L; { const int q = nwg / NXCD, r = nwg % NXCD, xcd = wgid % NXCD, off = wgid / NXCD; wgid = (xcd < r ? xcd * (q + 1) : r * (q + 1) + (xcd - r) * q) + off; }
        const int nig = WGM * nN, gid = wgid / nig, fm = gid * WGM, gsz = (nM - fm) < WGM ? (nM - fm) : WGM;
        u.pm = fm + ((wgid % nig) % gsz); u.pn = (wgid % nig) / gsz; return true;
    }
    __device__ __forceinline__ void a_ready(const Unit&) const {}
    __device__ __forceinline__ void done(const Unit&) const {}
};

__device__ __forceinline__ unsigned cvt_pk_bf16(float lo, float hi) { unsigned r; asm volatile("v_cvt_pk_bf16_f32 %0, %1, %2" : "=v"(r) : "v"(lo), "v"(hi)); return r; }
typedef unsigned long long rs_t;
__device__ __forceinline__ rs_t rs_fix(float ss) { return (rs_t)(ss * 16777216.0f + 0.5f); }
__device__ __forceinline__ float row_rstd(const rs_t* rs, int row) { return __builtin_amdgcn_rsqf((float)__hip_atomic_load(rs + row, __ATOMIC_RELAXED, __HIP_MEMORY_SCOPE_AGENT) * (1.0f / (16777216.0f * 1024.0f)) + 1e-6f); }
template <int ACT> struct EpiBf16 {
    static constexpr bool PERM = true, AFTER_DRAIN = false;
    bf16_t* O; int ldc; const rs_t* rs;
    __device__ __forceinline__ void operator()(const f32x4 (&acc)[2][2][4][2], const Unit& u, int wr, int wc, int fr, int fq) const {
        const int row0 = u.pm * BM + wr * 64 + fr; const int col0 = u.pn * BM + wc * 32 + 8 * fq;
#pragma unroll
        for (int ai = 0; ai < 2; ++ai)
#pragma unroll
            for (int m = 0; m < 4; ++m) { bf16_t* rowp = O + (size_t)(row0 + ai * HALF + m * 16) * ldc + col0;
                const float sc = rs ? row_rstd(rs, row0 + ai * HALF + m * 16) : 1.0f;
#pragma unroll
                for (int bj = 0; bj < 2; ++bj) { f32x4 v0 = acc[ai][bj][m][0] * sc, v1 = acc[ai][bj][m][1] * sc;
                    if (ACT == 2) {
#pragma unroll
                        for (int j = 0; j < 4; ++j) { const float a = fmaxf(v0[j], 0.f), b = fmaxf(v1[j], 0.f); v0[j] = a * a; v1[j] = b * b; } }
                    u32x4 w; w.x = cvt_pk_bf16(v0[0], v0[1]); w.y = cvt_pk_bf16(v0[2], v0[3]); w.z = cvt_pk_bf16(v1[0], v1[1]); w.w = cvt_pk_bf16(v1[2], v1[3]);
                    *(u32x4*)(rowp + bj * HALF) = w; }
                if (m & 1) asm volatile("" ::: "memory"); }
    }
};

struct EpiBlk {
    static constexpr bool PERM = true, AFTER_DRAIN = false;
    bf16_t* O; bf16_t* halo; int LAYOUT; const rs_t* rs;
    __device__ __forceinline__ void operator()(const f32x4 (&acc)[2][2][4][2], const Unit& u, int wr, int wc, int fr, int fq) const {
        constexpr int TT = 8192; constexpr size_t MTOT = 65536;
        const int row0 = u.pm * BM + wr * 64 + fr; const int b = row0 >> 13, t0 = row0 & (TT - 1);
        const int col0 = u.pn * BM + wc * 32 + 8 * fq;
        const bool dohalo = (LAYOUT == 2) && (halo != nullptr) && (fr >= 13) && (u.pn < 12);
        size_t base[2]; int wv[2];
#pragma unroll
        for (int bj = 0; bj < 2; ++bj) {
            const int cb = u.pn * BM + bj * HALF + wc * 32;
            if (LAYOUT == 2) { const int c0 = cb & ~1023, h = (cb >> 7) & 7; wv[bj] = 128; base[bj] = MTOT * c0 + (size_t)((b * 8 + h) * TT) * 128 + (cb & 127) + 8 * fq; }
            else if (cb < 512) { const int c0 = cb & ~255, h = (cb >> 6) & 3; wv[bj] = 64; base[bj] = MTOT * c0 + (size_t)((b * 4 + h) * TT) * 64 + (cb & 63) + 8 * fq; }
            else { const int c0 = 512 + ((cb - 512) & ~511), h = ((cb - 512) >> 7) & 3; wv[bj] = 128; base[bj] = MTOT * c0 + (size_t)((b * 4 + h) * TT) * 128 + (cb & 127) + 8 * fq; }
        }
#pragma unroll
        for (int ai = 0; ai < 2; ++ai)
#pragma unroll
            for (int m = 0; m < 4; ++m) { const int t = t0 + ai * HALF + m * 16; const float sc = row_rstd(rs, row0 + ai * HALF + m * 16);
#pragma unroll
                for (int bj = 0; bj < 2; ++bj) {
                    const f32x4 v0 = acc[ai][bj][m][0] * sc, v1 = acc[ai][bj][m][1] * sc;
                    u32x4 ww; ww.x = cvt_pk_bf16(v0[0], v0[1]); ww.y = cvt_pk_bf16(v0[2], v0[3]); ww.z = cvt_pk_bf16(v1[0], v1[1]); ww.w = cvt_pk_bf16(v1[2], v1[3]);
                    *(u32x4*)(O + base[bj] + (size_t)t * wv[bj]) = ww;
                    if (m == 3 && dohalo) *(u32x4*)(halo + ((size_t)((row0 + ai * HALF + 48) >> 6) * 3 + (fr - 13)) * 3072 + col0 + bj * HALF) = ww; }
                if (m & 1) asm volatile("" ::: "memory"); }
    }
};
struct EpiResidN {
    static constexpr bool PERM = false, AFTER_DRAIN = false;
    const float* base; float* out; bf16_t* xb; rs_t* rs;
    __device__ __forceinline__ void operator()(const f32x4 (&acc)[2][2][4][2], const Unit& u, int wr, int wc, int fr, int fq) const {
        const int row0 = u.pm * BM + wr * 64 + fr, col0 = u.pn * BM + wc * 32 + 4 * fq;
#pragma unroll
        for (int ai = 0; ai < 2; ++ai)
#pragma unroll
            for (int m = 0; m < 4; ++m) { const int row = row0 + ai * HALF + m * 16; const size_t off = (size_t)row * 1024 + col0; float ss = 0.f;
#pragma unroll
                for (int bj = 0; bj < 2; ++bj)
#pragma unroll
                    for (int n = 0; n < 2; ++n) { const f32x4 bs = *(const f32x4*)(base + off + bj * HALF + n * 16); const f32x4 o = bs + acc[ai][bj][m][n];
                        *(f32x4*)(out + off + bj * HALF + n * 16) = o; ss += (o[0] * o[0] + o[1] * o[1]) + (o[2] * o[2] + o[3] * o[3]);
                        typedef unsigned u32x2_ __attribute__((ext_vector_type(2))); u32x2_ w; w.x = cvt_pk_bf16(o[0], o[1]); w.y = cvt_pk_bf16(o[2], o[3]);
                        *(u32x2_*)(xb + off + bj * HALF + n * 16) = w; }
                ss += __shfl_xor(ss, 16); ss += __shfl_xor(ss, 32);
                if (fq == 0) __hip_atomic_fetch_add(rs + row, rs_fix(ss), __ATOMIC_RELAXED, __HIP_MEMORY_SCOPE_AGENT);
                if (m & 1) asm volatile("" ::: "memory"); }
    }
};
struct EpiResidB {
    static constexpr bool PERM = false, AFTER_DRAIN = false;
    bf16_t* xs; rs_t* rs;
    __device__ __forceinline__ void operator()(const f32x4 (&acc)[2][2][4][2], const Unit& u, int wr, int wc, int fr, int fq) const {
        typedef unsigned u32x2_ __attribute__((ext_vector_type(2)));
        const int row0 = u.pm * BM + wr * 64 + fr, col0 = u.pn * BM + wc * 32 + 4 * fq;
#pragma unroll
        for (int ai = 0; ai < 2; ++ai)
#pragma unroll
            for (int m = 0; m < 4; ++m) { const int row = row0 + ai * HALF + m * 16; bf16_t* p = xs + (size_t)row * 1024 + col0; float ss = 0.f;
                u32x2_ old[2][2];
#pragma unroll
                for (int bj = 0; bj < 2; ++bj)
#pragma unroll
                    for (int n = 0; n < 2; ++n) old[bj][n] = *(const u32x2_*)(p + bj * HALF + n * 16);
#pragma unroll
                for (int bj = 0; bj < 2; ++bj)
#pragma unroll
                    for (int n = 0; n < 2; ++n) { const u32x2_ b = old[bj][n]; const f32x4 a = acc[ai][bj][m][n];
                        u32x2_ w; w.x = cvt_pk_bf16(__uint_as_float(b.x << 16) + a[0], __uint_as_float(b.x & 0xffff0000u) + a[1]); w.y = cvt_pk_bf16(__uint_as_float(b.y << 16) + a[2], __uint_as_float(b.y & 0xffff0000u) + a[3]);
                        *(u32x2_*)(p + bj * HALF + n * 16) = w;
                        const float r0 = __uint_as_float(w.x << 16), r1 = __uint_as_float(w.x & 0xffff0000u), r2 = __uint_as_float(w.y << 16), r3 = __uint_as_float(w.y & 0xffff0000u);
                        ss += (r0 * r0 + r1 * r1) + (r2 * r2 + r3 * r3); }
                ss += __shfl_xor(ss, 16); ss += __shfl_xor(ss, 32);
                if (fq == 0) __hip_atomic_fetch_add(rs + row, rs_fix(ss), __ATOMIC_RELAXED, __HIP_MEMORY_SCOPE_AGENT);
                if (m & 1) asm volatile("" ::: "memory"); }
    }
};
struct EpiResid {
    static constexpr bool PERM = false, AFTER_DRAIN = false;
    const float* base; float* out; int ldc;
    __device__ __forceinline__ void operator()(const f32x4 (&acc)[2][2][4][2], const Unit& u, int wr, int wc, int fr, int fq) const {
        const int row0 = u.pm * BM + wr * 64 + fr, col0 = u.pn * BM + wc * 32 + 4 * fq;
#pragma unroll
        for (int ai = 0; ai < 2; ++ai)
#pragma unroll
            for (int m = 0; m < 4; ++m) { const size_t off = (size_t)(row0 + ai * HALF + m * 16) * ldc + col0;
#pragma unroll
                for (int bj = 0; bj < 2; ++bj)
#pragma unroll
                    for (int n = 0; n < 2; ++n) { const f32x4 bs = *(const f32x4*)(base + off + bj * HALF + n * 16); *(f32x4*)(out + off + bj * HALF + n * 16) = bs + acc[ai][bj][m][n]; }
                if (m & 1) asm volatile("" ::: "memory"); }
    }
};
template <class Epi, class Sched, bool ALIGN_EPI = false, bool SP2 = false>
__device__ __forceinline__ void gemm_phase(PG8_LAS unsigned char* lds, const Gemm g, const Sched& S, const Epi& E, int tid_in) {
    int tid_ = tid_in; asm volatile("" : "+v"(tid_)); const int tid = tid_, wid = __builtin_amdgcn_readfirstlane(tid >> 6), lane = tid & 63, wr = wid >> 2, wc = wid & 3, fr = lane & 15, fq = lane >> 4;
    const int K = g.K, nt = K / BK;
    unsigned voffA[2], voffB[2];
#pragma unroll
    for (int i = 0; i < 2; ++i) { int R, C; stage_rc(tid * 16 + i * 8192, R, C); const int Rb = Epi::PERM ? ((R & ~31) + perm32(R & 31)) : R;
        voffA[i] = (unsigned)(R * K + C) * 2u; voffB[i] = (unsigned)(Rb * K + C) * 2u; }
    const size_t kstep = (size_t)(BK * 2);
    const size_t hstep = (size_t)HALF * K * 2;
    const size_t tstep = 2 * hstep;
    const unsigned ldsw = (unsigned)wid * 1024u;
    const int aoff = lds_byte(wr * 64 + fr, fq * 8), boff = lds_byte(wc * 32 + fr, fq * 8);
#define PG8_SA(b, h) (((b) * 2 + (h)) * HTB)
#define PG8_SB(b, h) ((4 + (b) * 2 + (h)) * HTB)
#define PG8_STAGE(bufoff, gbase, voff) do { _Pragma("unroll") for (int _i = 0; _i < 2; ++_i) \
        __builtin_amdgcn_global_load_lds((const unsigned*)((const char*)(gbase) + (voff)[_i]), (PG8_LAS unsigned*)(lds + (bufoff) + ldsw + _i * 8192), 16, 0, 0); } while (0)
#define PG8_LDA(dst, b, h) do { _Pragma("unroll") for (int m = 0; m < 4; ++m) _Pragma("unroll") for (int k = 0; k < 2; ++k) dst[m][k] = *(const PG8_LAS bf16x8*)(lds + PG8_SA(b, h) + aoff + m * 2048 + k * 1024); } while (0)
#define PG8_LDB(dst, b, h) do { _Pragma("unroll") for (int n = 0; n < 2; ++n) _Pragma("unroll") for (int k = 0; k < 2; ++k) dst[n][k] = *(const PG8_LAS bf16x8*)(lds + PG8_SB(b, h) + boff + n * 2048 + k * 1024); } while (0)
#define PG8_MMA(ai, bj, At, Bt) do { __builtin_amdgcn_s_setprio(1); _Pragma("unroll") for (int m = 0; m < 4; ++m) _Pragma("unroll") for (int n = 0; n < 2; ++n) _Pragma("unroll") for (int k = 0; k < 2; ++k) \
        acc[ai][bj][m][n] = __builtin_amdgcn_mfma_f32_16x16x32_bf16(Bt[n][k], At[m][k], acc[ai][bj][m][n], 0, 0, 0); __builtin_amdgcn_s_setprio(0); } while (0)
#define PG8_WAIT_V(n) asm volatile("s_waitcnt vmcnt(" #n ")" ::: "memory")
#define PG8_WAIT_L(n) asm volatile("s_waitcnt lgkmcnt(" #n ")" ::: "memory")
#define PG8_BAR __builtin_amdgcn_s_barrier()
#define PG8_SCHED __builtin_amdgcn_sched_barrier(0)
    Unit cur, nxt; int ui = 0;
    if (!S.next(0, cur)) return;
    f32x4 acc[2][2][4][2];
#pragma unroll
    for (int a = 0; a < 2; ++a)
#pragma unroll
        for (int b = 0; b < 2; ++b)
#pragma unroll
            for (int m = 0; m < 4; ++m)
#pragma unroll
                for (int n = 0; n < 2; ++n) acc[a][b][m][n] = (f32x4){0.f, 0.f, 0.f, 0.f};
    bf16x8 At[4][2], B0[2][2], B1[2][2];
    const char* cA = (const char*)g.A + (size_t)cur.pm * tstep; const char* cB = (const char*)g.Bt + (size_t)cur.pn * tstep;
    S.a_ready(cur);
    if constexpr (SP2) {
        PG8_STAGE(PG8_SB(0, 0), cB, voffB); PG8_STAGE(PG8_SB(0, 1), cB + hstep, voffB); PG8_STAGE(PG8_SA(0, 0), cA, voffA); PG8_STAGE(PG8_SA(0, 1), cA + hstep, voffA);
        if (wr == 1) PG8_BAR;
        PG8_WAIT_V(2); PG8_BAR;
        PG8_STAGE(PG8_SB(1, 0), cB + kstep, voffB); PG8_STAGE(PG8_SA(1, 0), cA + kstep, voffA); PG8_STAGE(PG8_SB(1, 1), cB + hstep + kstep, voffB);
        PG8_WAIT_V(6); PG8_BAR;
    } else {
        PG8_STAGE(PG8_SB(0, 0), cB, voffB); PG8_STAGE(PG8_SA(0, 0), cA, voffA); PG8_STAGE(PG8_SB(0, 1), cB + hstep, voffB); PG8_STAGE(PG8_SA(0, 1), cA + hstep, voffA);
        if (wr == 1) PG8_BAR;
        PG8_WAIT_V(4); PG8_BAR;
        PG8_STAGE(PG8_SB(1, 0), cB + kstep, voffB); PG8_STAGE(PG8_SA(1, 0), cA + kstep, voffA); PG8_STAGE(PG8_SB(1, 1), cB + hstep + kstep, voffB);
        PG8_WAIT_V(6); PG8_BAR;
    }
    for (;;) {
        const bool has_next = S.next(ui + 1, nxt);
        const char* nA = has_next ? (const char*)g.A + (size_t)nxt.pm * tstep : cA; const char* nB = has_next ? (const char*)g.Bt + (size_t)nxt.pn * tstep : cB;
        for (int t = 0; t < nt; t += 2) {
            const bool last = (t == nt - 2);
            const char* a1 = cA + (size_t)(t + 1) * kstep;
            const char* a2 = last ? nA : cA + (size_t)(t + 2) * kstep; const char* b2 = last ? nB : cB + (size_t)(t + 2) * kstep;
            const char* a3 = a2 + kstep; const char* b3 = b2 + kstep;
            if (last && has_next) S.a_ready(nxt);
            if constexpr (SP2) {
            PG8_LDB(B0, 0, 0); PG8_LDB(B1, 0, 1); PG8_SCHED; PG8_LDA(At, 0, 0); PG8_STAGE(PG8_SA(1, 1), a1 + hstep, voffA);
            PG8_WAIT_V(8); PG8_WAIT_L(0); PG8_BAR; PG8_MMA(0, 0, At, B0); PG8_MMA(0, 1, At, B1); PG8_BAR; PG8_SCHED;
            PG8_LDA(At, 0, 1); PG8_STAGE(PG8_SB(0, 0), b2, voffB); PG8_STAGE(PG8_SB(0, 1), b2 + hstep, voffB); PG8_STAGE(PG8_SA(0, 0), a2, voffA);
            PG8_WAIT_V(8); PG8_WAIT_L(0); PG8_BAR; PG8_MMA(1, 0, At, B0); PG8_MMA(1, 1, At, B1); PG8_BAR; PG8_SCHED;
            PG8_LDB(B0, 1, 0); PG8_LDB(B1, 1, 1); PG8_SCHED; PG8_LDA(At, 1, 0); PG8_STAGE(PG8_SA(0, 1), a2 + hstep, voffA);
            PG8_WAIT_V(8); PG8_WAIT_L(0); PG8_BAR; PG8_MMA(0, 0, At, B0); PG8_MMA(0, 1, At, B1); PG8_BAR; PG8_SCHED;
            PG8_LDA(At, 1, 1); PG8_STAGE(PG8_SB(1, 0), b3, voffB); PG8_STAGE(PG8_SB(1, 1), b3 + hstep, voffB); PG8_STAGE(PG8_SA(1, 0), a3, voffA);
            PG8_WAIT_V(8); PG8_WAIT_L(0); PG8_BAR; PG8_MMA(1, 0, At, B0); PG8_MMA(1, 1, At, B1); PG8_BAR; PG8_SCHED;
            } else {
            PG8_LDB(B0, 0, 0); PG8_SCHED; PG8_LDA(At, 0, 0); PG8_STAGE(PG8_SA(1, 1), a1 + hstep, voffA);
            PG8_WAIT_L(8); PG8_BAR; PG8_WAIT_L(0); PG8_MMA(0, 0, At, B0); PG8_BAR; PG8_SCHED;
            PG8_LDB(B1, 0, 1); PG8_STAGE(PG8_SB(0, 0), b2, voffB);
            PG8_BAR; PG8_WAIT_L(0); PG8_MMA(0, 1, At, B1); PG8_BAR;
            PG8_LDA(At, 0, 1); PG8_STAGE(PG8_SA(0, 0), a2, voffA);
            PG8_BAR; PG8_WAIT_L(0); PG8_MMA(1, 0, At, B0); PG8_BAR; PG8_SCHED;
            PG8_STAGE(PG8_SB(0, 1), b2 + hstep, voffB);
            PG8_WAIT_V(6); PG8_BAR; PG8_MMA(1, 1, At, B1); PG8_BAR;
            PG8_LDB(B0, 1, 0); PG8_SCHED; PG8_LDA(At, 1, 0); PG8_STAGE(PG8_SA(0, 1), a2 + hstep, voffA);
            PG8_WAIT_L(8); PG8_BAR; PG8_WAIT_L(0); PG8_MMA(0, 0, At, B0); PG8_BAR; PG8_SCHED;
            PG8_LDB(B1, 1, 1); PG8_STAGE(PG8_SB(1, 0), b3, voffB);
            PG8_BAR; PG8_WAIT_L(0); PG8_MMA(0, 1, At, B1); PG8_BAR;
            PG8_LDA(At, 1, 1); PG8_STAGE(PG8_SA(1, 0), a3, voffA);
            PG8_BAR; PG8_WAIT_L(0); PG8_MMA(1, 0, At, B0); PG8_BAR; PG8_SCHED;
            PG8_STAGE(PG8_SB(1, 1), b3 + hstep, voffB);
            PG8_WAIT_V(6); PG8_BAR; PG8_MMA(1, 1, At, B1); PG8_BAR;
            }
        }
        if constexpr (ALIGN_EPI) { if (wr == 0) PG8_BAR; }
        if constexpr (!Epi::AFTER_DRAIN) { E(acc, cur, wr, wc, fr, fq); S.done(cur); }
        if (!has_next) break;
#pragma unroll
        for (int a = 0; a < 2; ++a)
#pragma unroll
            for (int b = 0; b < 2; ++b)
#pragma unroll
                for (int m = 0; m < 4; ++m)
#pragma unroll
                    for (int n = 0; n < 2; ++n) acc[a][b][m][n] = (f32x4){0.f, 0.f, 0.f, 0.f};
        cur = nxt; cA = nA; cB = nB; ++ui;
        if constexpr (ALIGN_EPI) { if (wr == 1) PG8_BAR; }
    }
    PG8_WAIT_V(0);
    if constexpr (!ALIGN_EPI) { if (wr == 0) PG8_BAR; }
    PG8_BAR;
    if constexpr (Epi::AFTER_DRAIN) { E.fused(acc, cur, wr, wc, fr, fq, lds, wid, lane); S.done(cur); }
#undef PG8_SA
#undef PG8_SB
#undef PG8_STAGE
#undef PG8_LDA
#undef PG8_LDB
#undef PG8_MMA
#undef PG8_WAIT_V
#undef PG8_WAIT_L
#undef PG8_BAR
#undef PG8_SCHED
}
}
#ifndef PG8_SP2
#define PG8_SP2 true
#endif
#ifndef PG8_ALIGN
#define PG8_ALIGN true
#endif
constexpr int NWAVES = 8, NTHR = 512;
constexpr int BATCH = 8, T = 8192, D = 1024, DEPTH = 4, MEMLEN = 256, FF = 4096;
constexpr int M = BATCH * T;
constexpr int AB_IN = 3080, AB_N = 3072, C_IN = 4112, C_N = 4096;
constexpr float EPS = 1e-6f;
constexpr float SB_THR = 40.0f;

constexpr size_t MiB = 1u << 20;
constexpr size_t WS_CTL = 0, CTL_ZERO_BYTES = 1 * MiB;
constexpr size_t WS_WG = 1 * MiB;
constexpr size_t WS_MEMN = 2 * MiB;
constexpr size_t WS_WKV = 6 * MiB;
constexpr size_t WS_W = 22 * MiB, W_LAYER = 30 * MiB;
constexpr size_t WO_WIN = 0, WO_WOUT = 8 * MiB, WO_WQ = 10 * MiB, WO_WO = 12 * MiB, WO_W1 = 14 * MiB, WO_W2 = 22 * MiB;
constexpr size_t WS_KVX = 142 * MiB;
constexpr size_t WS_GATE = 174 * MiB;
constexpr size_t WS_H = 178 * MiB;
constexpr size_t WS_MIX = 306 * MiB;
constexpr size_t WS_BIG = 434 * MiB;
constexpr size_t WS_RS = 946 * MiB;
constexpr size_t WS_MLS = 950 * MiB;
constexpr size_t WS_END = 956 * MiB;
constexpr int CW_TMO = 0, CW_BAR = 4096;

constexpr int LDS_BYTES = 147456;
constexpr int MISC_OFF = 140 * 1024;

#define GAS __attribute__((address_space(1)))
#define LAS __attribute__((address_space(3)))
#define DI __device__ __forceinline__
typedef unsigned short bf16;
typedef unsigned v4u __attribute__((ext_vector_type(4)));
typedef unsigned v2u __attribute__((ext_vector_type(2)));
typedef float f32x4 __attribute__((ext_vector_type(4)));
typedef short bf16x8 __attribute__((ext_vector_type(8)));
typedef short s16x4 __attribute__((ext_vector_type(4)));
#define LDS_WAIT() asm volatile("s_waitcnt lgkmcnt(0)" ::: "memory")
typedef float f32x2_ __attribute__((ext_vector_type(2)));
typedef __bf16 bf16x2_ __attribute__((ext_vector_type(2)));
DI unsigned pk2(float lo, float hi) { const f32x2_ v = {lo, hi}; return __builtin_bit_cast(unsigned, __builtin_convertvector(v, bf16x2_)); }
DI unsigned f2bf(float f) { return pk2(f, f) & 0xffffu; }
DI float bf2f(unsigned short b) { return __builtin_bit_cast(float, ((unsigned)b) << 16); }
DI float bflo(unsigned u) { return __builtin_bit_cast(float, u << 16); }
DI float bfhi(unsigned u) { return __builtin_bit_cast(float, u & 0xffff0000u); }
template <int CTRL> DI float dppf(float v) { return __builtin_bit_cast(float, __builtin_amdgcn_update_dpp(0, __builtin_bit_cast(int, v), CTRL, 0xF, 0xF, true)); }
DI float red4(float v) { v += dppf<0xB1>(v); v += dppf<0x4E>(v); return v; }
DI float red8(float v) { v = red4(v); v += dppf<0x141>(v); return v; }
DI float red16(float v) { v = red8(v); v += dppf<0x140>(v); return v; }
DI float wave_sum(float v) { v = red16(v); v += __shfl_xor(v, 16); v += __shfl_xor(v, 32); return v; }
DI float rcp_(float x) { return __builtin_amdgcn_rcpf(x); }
DI float rsq_(float x) { return __builtin_amdgcn_rsqf(x); }
DI float sigmoidf_(float x) { return rcp_(1.0f + __expf(-x)); }
DI void lds_barrier() { asm volatile("s_waitcnt lgkmcnt(0)" ::: "memory"); __builtin_amdgcn_s_barrier(); asm volatile("" ::: "memory"); }
#ifndef PROBE_STG
#define PROBE_STG -1
#endif
#define STG_T0() unsigned long long stg_t_ = (PROBE_STG >= 0) ? __builtin_amdgcn_s_memrealtime() : 0ull
#define STG(n) do { if (PROBE_STG >= 0) { const unsigned long long t_ = __builtin_amdgcn_s_memrealtime(); if (PROBE_STG == (n)) F.tacc += t_ - stg_t_; stg_t_ = t_; } } while (0)
DI f32x4 mfma16(bf16x8 a, bf16x8 b, f32x4 c) { return __builtin_amdgcn_mfma_f32_16x16x32_bf16(a, b, c, 0, 0, 0); }
#define XB_TMO      128
#define XB_XCNT(j)  (256  + 64 * (j))
#define XB_XSUB(j)  (1280 + 64 * (j))
#define XB_XGEN(j)  (2304 + 64 * (j))
#define XB_TOP      3328
#define XB_TOPGEN   3392
#define XCD_BAR_WORDS 3456
#define XB_SPIN_CAP (1u << 22)

__device__ __forceinline__ unsigned xb_ld(unsigned* p)              { return __hip_atomic_load(p, __ATOMIC_RELAXED, __HIP_MEMORY_SCOPE_AGENT); }
__device__ __forceinline__ unsigned xb_add(unsigned* p, unsigned v) { return __hip_atomic_fetch_add(p, v, __ATOMIC_RELAXED, __HIP_MEMORY_SCOPE_AGENT); }
__device__ __forceinline__ unsigned xb_xcc_id() { return (unsigned)__builtin_amdgcn_s_getreg((3 << 11) | 20) & 0xFu; }
#define XB_SPIN(cond, bar) do { unsigned _sp = 0; while (cond) { __builtin_amdgcn_s_sleep(1); \
    if ((++_sp & 255u) == 0u) { if (xb_ld(&(bar)[XB_TMO])) break; if (_sp > XB_SPIN_CAP) { atomicAdd(&(bar)[XB_TMO], 1u); break; } } } } while (0)

struct XcdBarrier {
    unsigned* bar; unsigned x;
    volatile LAS unsigned* st;
};

__device__ __forceinline__ XcdBarrier xcd_barrier_post(unsigned* bar, volatile LAS unsigned* st) {
    XcdBarrier b; b.bar = bar; b.x = xb_xcc_id(); b.st = st;
    if (threadIdx.x == 0) (void)xb_add(&bar[XB_XCNT(b.x)], 1u);
    return b;
}
__device__ __forceinline__ void xcd_barrier_complete(unsigned* bar, unsigned x, unsigned& nloc, unsigned& nx) {
    const unsigned G = gridDim.x * gridDim.y * gridDim.z;
    unsigned sum, cnt, mine, sp = 0u;
    for (;;) {
        sum = 0u; cnt = 0u; mine = 0u;
#pragma unroll
        for (unsigned j = 0; j < 16; ++j) { const unsigned c = xb_ld(&bar[XB_XCNT(j)]); sum += c; cnt += (c > 0u) ? 1u : 0u; mine = (j == x) ? c : mine; }
        if (sum == G) break;
        __builtin_amdgcn_s_sleep(1);
        if ((++sp & 255u) == 0u) { if (xb_ld(&bar[XB_TMO])) break; if (sp > XB_SPIN_CAP) { atomicAdd(&bar[XB_TMO], 1u); break; } }
    }
    nloc = mine > 0u ? mine : 1u; nx = cnt > 0u ? cnt : 1u;
}

__device__ __forceinline__ void xcd_barrier(const XcdBarrier& b) {
    asm volatile("s_waitcnt vmcnt(0)" ::: "memory");
    __syncthreads();
    if (threadIdx.x == 0) {
        unsigned* bar = b.bar;
        __builtin_amdgcn_s_waitcnt(0);
        unsigned nloc = b.st[0], nx = b.st[1];
        if (nloc == 0u) { xcd_barrier_complete(bar, b.x, nloc, nx); b.st[0] = nloc; b.st[1] = nx; }
        const unsigned old = xb_add(&bar[XB_XSUB(b.x)], 1u);
        const unsigned gen = old / nloc;
        if (old + 1u == (gen + 1u) * nloc) {
            __builtin_amdgcn_fence(__ATOMIC_RELEASE, "agent");
            asm volatile("s_waitcnt vmcnt(0)" ::: "memory");
            const unsigned og = xb_add(&bar[XB_TOP], 1u);
            const unsigned tg = og / nx;
            if (og + 1u == (tg + 1u) * nx) xb_add(&bar[XB_TOPGEN], 1u);
            else XB_SPIN(xb_ld(&bar[XB_TOPGEN]) == tg, bar);
            __builtin_amdgcn_fence(__ATOMIC_ACQUIRE, "agent");
            xb_add(&bar[XB_XGEN(b.x)], 1u);
            asm volatile("s_waitcnt vmcnt(0)" ::: "memory");
        } else {
            XB_SPIN(xb_ld(&bar[XB_XGEN(b.x)]) == gen, bar);
            __builtin_amdgcn_fence(__ATOMIC_ACQUIRE, "agent");
            asm volatile("s_waitcnt vmcnt(0)" ::: "memory");
        }
    }
    __syncthreads();
}
struct Frame {
    LAS unsigned char* lds;
    int tid, lane, wave;
    int G, wg, gw, NGW;
    unsigned long long tacc;
};

DI void transpose_item(const float* W, int ldsrc, int coloff, bf16* WT, int K, int row_off, int nblk, LAS float* scr, int item, int lane, const float* gain) {
    const int kb = item / nblk, nb = item % nblk, k0 = 64 * kb, n0 = 32 * nb;
    const bool al16 = (((ldsrc | (coloff + n0)) & 3) == 0);
    if (al16) { const int kr = lane >> 3, c4 = (lane & 7) * 4;
#pragma unroll
        for (int i = 0; i < 8; ++i) { const int kk = 8 * i + kr; const f32x4 v = *(const GAS f32x4*)(W + (size_t)(k0 + kk) * ldsrc + coloff + n0 + c4); const float g = gain ? gain[k0 + kk] : 1.0f;
            scr[kk * 33 + c4] = v.x * g; scr[kk * 33 + c4 + 1] = v.y * g; scr[kk * 33 + c4 + 2] = v.z * g; scr[kk * 33 + c4 + 3] = v.w * g; }
    } else {
#pragma unroll 8
        for (int i = 0; i < 32; ++i) { const int kk = 2 * i + (lane >> 5); scr[kk * 33 + (lane & 31)] = W[(size_t)(k0 + kk) * ldsrc + coloff + n0 + (lane & 31)] * (gain ? gain[k0 + kk] : 1.0f); }
    }
    LDS_WAIT(); asm volatile("" ::: "memory");
    const int c = lane & 7;
#pragma unroll
    for (int j = 0; j < 4; ++j) { const int n = (lane >> 3) + 8 * j; const LAS float* s = scr + (8 * c) * 33 + n;
        v4u o; o.x = pk2(s[0 * 33], s[1 * 33]); o.y = pk2(s[2 * 33], s[3 * 33]); o.z = pk2(s[4 * 33], s[5 * 33]); o.w = pk2(s[6 * 33], s[7 * 33]);
        *(GAS v4u*)(WT + (size_t)(row_off + n0 + n) * K + k0 + 8 * c) = o; }
    LDS_WAIT(); asm volatile("" ::: "memory");
}
DI void transpose_matrix(Frame& F, const float* W, int ldsrc, int coloff, int ncols, int K, bf16* WT, int row_off, unsigned& base, const float* gain = nullptr) {
    LAS float* scr = (LAS float*)(F.lds + F.wave * 16384);
    const int nblk = ncols / 32, nitems = (K / 64) * nblk;
    int it = (int)(((unsigned)F.gw + (unsigned)F.NGW - (base % (unsigned)F.NGW)) % (unsigned)F.NGW);
    for (; it < nitems; it += F.NGW) transpose_item(W, ldsrc, coloff, WT, K, row_off, nblk, scr, it, F.lane, gain);
    base += (unsigned)nitems;
}
DI void rms_row(const float* xrow, const f32x4 (&g4)[4], f32x4 (&v)[4], int lane) {
    const GAS f32x4* xr = (const GAS f32x4*)xrow + lane; float s = 0.f;
#pragma unroll
    for (int j = 0; j < 4; ++j) { v[j] = xr[64 * j]; s += (v[j].x * v[j].x + v[j].y * v[j].y) + (v[j].z * v[j].z + v[j].w * v[j].w); }
    const float rstd = rsq_(wave_sum(s) * (1.f / 1024.f) + EPS);
#pragma unroll
    for (int j = 0; j < 4; ++j) v[j] = v[j] * rstd * g4[j];
}
DI void store_row_bf16(bf16* orow, const f32x4 (&v)[4], int lane) {
    GAS unsigned long long* o8 = (GAS unsigned long long*)orow + lane;
#pragma unroll
    for (int j = 0; j < 4; ++j) o8[64 * j] = (unsigned long long)pk2(v[j].x, v[j].y) | ((unsigned long long)pk2(v[j].z, v[j].w) << 32);
}
struct In { const float* p[24]; };
DI void p0_prologue(Frame& F, const In& I, unsigned char* ws) {
    unsigned base = 0;
    for (int l = 0; l < DEPTH; ++l) {
        const int j = l >> 1; unsigned char* wl = ws + WS_W + (size_t)l * W_LAYER;
        if ((l & 1) == 0) {
            transpose_matrix(F, I.p[3] + (size_t)j * D * AB_IN, AB_IN, 0, 1536, D, (bf16*)(wl + WO_WIN), 0, base, I.p[2] + l * D);
            transpose_matrix(F, I.p[3] + (size_t)j * D * AB_IN, AB_IN, 1544, 1536, D, (bf16*)(wl + WO_WIN), 1536, base, I.p[2] + l * D);
            transpose_matrix(F, I.p[7] + (size_t)j * D * D, D, 0, D, D, (bf16*)(wl + WO_WOUT), 0, base);
        } else {
            transpose_matrix(F, I.p[8] + (size_t)j * D * C_IN, C_IN, 0, 4096, D, (bf16*)(wl + WO_WIN), 0, base, I.p[2] + l * D);
            transpose_matrix(F, I.p[13] + (size_t)j * D * D, D, 0, D, D, (bf16*)(wl + WO_WOUT), 0, base);
        }
        transpose_matrix(F, I.p[16] + (size_t)l * D * D, D, 0, D, D, (bf16*)(wl + WO_WQ), 0, base, I.p[14] + l * D);
        transpose_matrix(F, I.p[19] + (size_t)l * D * D, D, 0, D, D, (bf16*)(wl + WO_WO), 0, base);
        transpose_matrix(F, I.p[17] + (size_t)l * D * D, D, 0, D, D, (bf16*)(ws + WS_WKV), 2048 * l, base);
        transpose_matrix(F, I.p[18] + (size_t)l * D * D, D, 0, D, D, (bf16*)(ws + WS_WKV), 2048 * l + 1024, base);
        transpose_matrix(F, I.p[21] + (size_t)l * D * FF, FF, 0, FF, D, (bf16*)(wl + WO_W1), 0, base, I.p[20] + l * D);
        transpose_matrix(F, I.p[22] + (size_t)l * FF * D, D, 0, D, FF, (bf16*)(wl + WO_W2), 0, base);
    }
    for (int idx = F.wg * NTHR + F.tid; idx < DEPTH * 16 * 1024; idx += F.G * NTHR) {
        const int l = idx >> 14, g = (idx >> 10) & 15, k = idx & 1023, j = l >> 1; float v = 0.f;
        if ((l & 1) == 0) { if (g < 8) v = I.p[3][(size_t)j * D * AB_IN + (size_t)k * AB_IN + 1536 + g]; }
        else v = I.p[8][(size_t)j * D * C_IN + (size_t)k * C_IN + 4096 + g];
        ((bf16*)(ws + WS_WG))[idx] = (bf16)f2bf(v * I.p[2][l * D + k]);
    }
    { f32x4 g4[4];
#pragma unroll
      for (int j = 0; j < 4; ++j) g4[j] = ((const GAS f32x4*)I.p[15])[F.lane + 64 * j];
      for (int r = F.gw; r < BATCH * MEMLEN; r += F.NGW) { f32x4 v[4]; rms_row(I.p[1] + (size_t)r * D, g4, v, F.lane); store_row_bf16((bf16*)(ws + WS_MEMN) + (size_t)r * D, v, F.lane); } }
    for (int r = F.gw; r < M; r += F.NGW) { const GAS f32x4* xr = (const GAS f32x4*)(I.p[0] + (size_t)r * D) + F.lane; f32x4 v[4]; float s = 0.f;
#pragma unroll
        for (int j = 0; j < 4; ++j) { v[j] = xr[64 * j]; const unsigned a = pk2(v[j].x, v[j].y), b = pk2(v[j].z, v[j].w); const float r0 = bflo(a), r1 = bfhi(a), r2 = bflo(b), r3 = bfhi(b); s += (r0 * r0 + r1 * r1) + (r2 * r2 + r3 * r3); }
        s = wave_sum(s); store_row_bf16((bf16*)(ws + WS_H) + (size_t)r * D, v, F.lane);
        if (F.lane == 0) { __hip_atomic_store((pg8::rs_t*)(ws + WS_RS) + r, pg8::rs_fix(s), __ATOMIC_RELAXED, __HIP_MEMORY_SCOPE_AGENT); __hip_atomic_store((pg8::rs_t*)(ws + WS_RS) + M + r, (pg8::rs_t)0, __ATOMIC_RELAXED, __HIP_MEMORY_SCOPE_AGENT); } }
}
template <int MODE> DI void gates_phase(Frame& F, const bf16* xb, const pg8::rs_t* rs, const bf16* WgB, float* gate, const float* p0, const float* p1) {
    constexpr int LW = 1032;
    LAS bf16* wl = (LAS bf16*)F.lds;
    const int r = F.lane & 15, quad = F.lane >> 4;
    lds_barrier();
    for (int i = F.tid; i < 2048; i += NTHR) { const int g = i >> 7, c8 = (i & 127) * 8; *(LAS v4u*)(wl + g * LW + c8) = *(const GAS v4u*)(WgB + g * 1024 + c8); }
    float par = 0.f, par2 = 0.f;
    if (MODE == 1) { if (r < 4) par = p0[r]; else if (r < 8) par = p1[r - 4]; }
    if (MODE == 2) { if (r >= 8) { par = p0[r - 8]; par2 = p1[r - 8]; } }
    lds_barrier();
    for (int g = F.gw; g < M / 16; g += F.NGW) {
        const bf16* xa = xb + (size_t)(16 * g + r) * D + 8 * quad; f32x4 acc = (f32x4){0.f, 0.f, 0.f, 0.f};
#pragma unroll 8
        for (int kk = 0; kk < 32; ++kk) acc = mfma16(*(const GAS bf16x8*)(xa + 32 * kk), *(const LAS bf16x8*)(wl + r * LW + 32 * kk + 8 * quad), acc);
#pragma unroll
        for (int j = 0; j < 4; ++j) { const int row = 16 * g + 4 * quad + j; const float keep = acc[j] * pg8::row_rstd(rs, row); float o = 0.f;
            if (MODE == 1) { const float v = keep + par; o = (r < 4) ? 15.0f * tanhf(v * (1.0f / 15.0f)) : (fminf(v, 0.f) - log1pf(expf(-fabsf(v)))); }
            if (MODE == 2) { if (r < 8) o = 1.0f / (1.0f + expf(-keep)); else { const float z = keep + par2; o = -expf(par) * (fmaxf(z, 0.f) + log1pf(expf(-fabsf(z)))); } }
            if (MODE == 2 || r < 8) gate[(size_t)row * 16 + r] = o; }
    }
    lds_barrier();
}
DI void final_norm_phase(Frame& F, const bf16* xs, float* out, const float* gain) {
    f32x4 g4[4];
#pragma unroll
    for (int j = 0; j < 4; ++j) g4[j] = ((const GAS f32x4*)gain)[F.lane + 64 * j];
    for (int r = F.gw; r < M; r += F.NGW) { const GAS v2u* xr = (const GAS v2u*)(xs + (size_t)r * D) + F.lane; f32x4 v[4]; float s = 0.f;
#pragma unroll
        for (int j = 0; j < 4; ++j) { const v2u t = xr[64 * j]; v[j] = (f32x4){bflo(t.x), bfhi(t.x), bflo(t.y), bfhi(t.y)}; s += (v[j].x * v[j].x + v[j].y * v[j].y) + (v[j].z * v[j].z + v[j].w * v[j].w); }
        const float rstd = rsq_(wave_sum(s) * (1.f / 1024.f) + EPS); GAS f32x4* o = (GAS f32x4*)(out + (size_t)r * D) + F.lane;
#pragma unroll
        for (int j = 0; j < 4; ++j) o[64 * j] = v[j] * rstd * g4[j]; }
}
template <bool ODD> DI void headnorm_phase(Frame& F, const bf16* src, bf16* mix, const bf16* proj, const float* hg) {
    constexpr int NC = ODD ? 16 : 8;
    for (int r = F.gw; r < M; r += F.NGW) {
        const int c0 = NC * F.lane;
        float x[NC], gt[NC];
#pragma unroll
        for (int q = 0; q < NC / 8; ++q) {
            const size_t hoff = ((size_t)((r >> 13) * 8 + ((c0 + 8 * q) >> 7)) * T + (r & (T - 1))) * 128 + ((c0 + 8 * q) & 127);
            const v4u raw = ODD ? *(const GAS v4u*)(src + hoff) : *(const GAS v4u*)(src + (size_t)r * D + c0 + 8 * q);
            const v4u gr = ODD ? *(const GAS v4u*)(proj + (size_t)M * 3072 + hoff) : *(const GAS v4u*)(proj + (size_t)r * AB_N + 1024 + c0 + 8 * q);
            x[8 * q + 0] = bflo(raw.x); x[8 * q + 1] = bfhi(raw.x); x[8 * q + 2] = bflo(raw.y); x[8 * q + 3] = bfhi(raw.y); x[8 * q + 4] = bflo(raw.z); x[8 * q + 5] = bfhi(raw.z); x[8 * q + 6] = bflo(raw.w); x[8 * q + 7] = bfhi(raw.w);
            gt[8 * q + 0] = bflo(gr.x); gt[8 * q + 1] = bfhi(gr.x); gt[8 * q + 2] = bflo(gr.y); gt[8 * q + 3] = bfhi(gr.y); gt[8 * q + 4] = bflo(gr.z); gt[8 * q + 5] = bfhi(gr.z); gt[8 * q + 6] = bflo(gr.w); gt[8 * q + 7] = bfhi(gr.w);
        }
        float ss = 0.f;
#pragma unroll
        for (int i = 0; i < NC; ++i) ss += x[i] * x[i];
        ss = ODD ? red8(ss) : red16(ss);
        const float rstd = rsq_(ss * (1.f / 128.f) + EPS);
#pragma unroll
        for (int i = 0; i < NC; ++i) { const float g = ODD ? hg[(c0 + i) & 127] : hg[c0 + i]; const float s = sigmoidf_(gt[i]); x[i] = x[i] * rstd * g * (ODD ? gt[i] * s : s); }
#pragma unroll
        for (int q = 0; q < NC / 8; ++q) { v4u o; o.x = pk2(x[8 * q], x[8 * q + 1]); o.y = pk2(x[8 * q + 2], x[8 * q + 3]); o.z = pk2(x[8 * q + 4], x[8 * q + 5]); o.w = pk2(x[8 * q + 6], x[8 * q + 7]);
            *(GAS v4u*)(mix + (size_t)r * D + c0 + 8 * q) = o; }
    }
}
DI void mlstm_chain(Frame& F, const bf16* proj, const float* gate, bf16* mix, int c) {
    const int b = c >> 4, h = (c >> 2) & 3, vq = c & 3, vl = F.tid >> 4, dg = F.tid & 15;
    float C0 = 0.f, C1 = 0.f, C2 = 0.f, C3 = 0.f, n0 = 0.f, n1 = 0.f, n2 = 0.f, n3 = 0.f, m = 0.f;
    const bf16* pq = proj + (size_t)b * T * AB_N + h * 64 + 4 * dg;
    const bf16* pk = pq + 256;
    const bf16* pv = proj + (size_t)b * T * AB_N + 512 + h * 128 + vq * 32 + vl;
    const float* pg = gate + (size_t)b * T * 16 + h;
    bf16* po = mix + (size_t)b * T * D + h * 128 + vq * 32 + vl;
    for (int t0 = 0; t0 < T; t0 += 8) {
        v2u qr[8], kr[8]; unsigned short vr[8]; float li[8], lf[8];
#pragma unroll
        for (int i = 0; i < 8; ++i) { qr[i] = *(const GAS v2u*)(pq + (size_t)(t0 + i) * AB_N); kr[i] = *(const GAS v2u*)(pk + (size_t)(t0 + i) * AB_N); vr[i] = pv[(size_t)(t0 + i) * AB_N];
            li[i] = pg[(size_t)(t0 + i) * 16]; lf[i] = pg[(size_t)(t0 + i) * 16 + 4]; }
#pragma unroll
        for (int i = 0; i < 8; ++i) {
            const float q0 = bflo(qr[i].x), q1 = bfhi(qr[i].x), q2 = bflo(qr[i].y), q3 = bfhi(qr[i].y);
            const float k0 = bflo(kr[i].x) * 0.125f, k1 = bfhi(kr[i].x) * 0.125f, k2 = bflo(kr[i].y) * 0.125f, k3 = bfhi(kr[i].y) * 0.125f;
            const float vv = bf2f(vr[i]);
            const float mn = fmaxf(lf[i] + m, li[i]); const float fp = __expf(lf[i] + m - mn), ip = __expf(li[i] - mn); m = mn;
            const float iv = ip * vv;
            C0 = fp * C0 + iv * k0; C1 = fp * C1 + iv * k1; C2 = fp * C2 + iv * k2; C3 = fp * C3 + iv * k3;
            n0 = fp * n0 + ip * k0; n1 = fp * n1 + ip * k1; n2 = fp * n2 + ip * k2; n3 = fp * n3 + ip * k3;
            float pn = (C0 * q0 + C1 * q1) + (C2 * q2 + C3 * q3), pd = (n0 * q0 + n1 * q1) + (n2 * q2 + n3 * q3);
#pragma unroll
            for (int o = 1; o < 16; o <<= 1) { pn += __shfl_xor(pn, o); pd += __shfl_xor(pd, o); }
            const float hv = pn / fmaxf(fabsf(pd), __expf(-mn));
            if (dg == 0) po[(size_t)(t0 + i) * D] = (bf16)f2bf(hv);
        }
    }
}
DI void gdn_chain(Frame& F, const bf16* proj, const float* gate, const float* convw, bf16* mix, int c) {
    const int b = c >> 5, h = (c >> 2) & 7, vq = c & 3, cc = F.tid >> 4, dg = F.tid & 15;
    LAS float* qs = (LAS float*)F.lds; LAS float* ks = qs + 64 * 128; LAS float* vs = ks + 64 * 128; LAS float* os = vs + 64 * 32; LAS float* bet = os + 64 * 32; LAS float* alp = bet + 64;
    float S[8];
#pragma unroll
    for (int j = 0; j < 8; ++j) S[j] = 0.f;
    for (int t0 = 0; t0 < T; t0 += 64) {
        __syncthreads();
        { const int row = F.tid >> 3, seg = F.tid & 7, t = t0 + row;
#pragma unroll
          for (int which = 0; which < 2; ++which) {
              const int colg = which * 1024 + h * 128 + seg * 16; float a[16];
#pragma unroll
              for (int i = 0; i < 16; ++i) a[i] = 0.f;
#pragma unroll
              for (int j = 0; j < 4; ++j) { const int tt = t - 3 + j;
                  if (tt >= 0) { const bf16* src = proj + (size_t)(b * T + tt) * C_N + colg; const float* w = convw + j * 3072 + colg;
#pragma unroll
                      for (int q = 0; q < 2; ++q) { const v4u raw = *(const GAS v4u*)(src + 8 * q); const f32x4 w0 = *(const GAS f32x4*)(w + 8 * q), w1 = *(const GAS f32x4*)(w + 8 * q + 4);
                          a[8 * q + 0] += bflo(raw.x) * w0.x; a[8 * q + 1] += bfhi(raw.x) * w0.y; a[8 * q + 2] += bflo(raw.y) * w0.z; a[8 * q + 3] += bfhi(raw.y) * w0.w;
                          a[8 * q + 4] += bflo(raw.z) * w1.x; a[8 * q + 5] += bfhi(raw.z) * w1.y; a[8 * q + 6] += bflo(raw.w) * w1.z; a[8 * q + 7] += bfhi(raw.w) * w1.w; } } }
              float ss = 0.f;
#pragma unroll
              for (int i = 0; i < 16; ++i) { a[i] = a[i] * sigmoidf_(a[i]); ss += a[i] * a[i]; }
              ss = red8(ss);
              const float sc = rsq_(ss + EPS) * (which == 0 ? 0.08838834764831845f : 1.0f);
              LAS float* dst = (which == 0 ? qs : ks) + row * 128 + seg * 16;
#pragma unroll
              for (int q = 0; q < 4; ++q) *(LAS f32x4*)(dst + 4 * q) = (f32x4){a[4 * q] * sc, a[4 * q + 1] * sc, a[4 * q + 2] * sc, a[4 * q + 3] * sc};
          } }
        if (F.tid < 256) { const int row = F.tid >> 2, seg = F.tid & 3, t = t0 + row; const int colg = 2048 + h * 128 + vq * 32 + seg * 8; float a[8];
#pragma unroll
            for (int i = 0; i < 8; ++i) a[i] = 0.f;
#pragma unroll
            for (int j = 0; j < 4; ++j) { const int tt = t - 3 + j;
                if (tt >= 0) { const v4u raw = *(const GAS v4u*)(proj + (size_t)(b * T + tt) * C_N + colg); const float* w = convw + j * 3072 + colg; const f32x4 w0 = *(const GAS f32x4*)w, w1 = *(const GAS f32x4*)(w + 4);
                    a[0] += bflo(raw.x) * w0.x; a[1] += bfhi(raw.x) * w0.y; a[2] += bflo(raw.y) * w0.z; a[3] += bfhi(raw.y) * w0.w; a[4] += bflo(raw.z) * w1.x; a[5] += bfhi(raw.z) * w1.y; a[6] += bflo(raw.w) * w1.z; a[7] += bfhi(raw.w) * w1.w; } }
#pragma unroll
            for (int i = 0; i < 8; ++i) a[i] = a[i] * sigmoidf_(a[i]);
            *(LAS f32x4*)(vs + row * 32 + seg * 8) = (f32x4){a[0], a[1], a[2], a[3]}; *(LAS f32x4*)(vs + row * 32 + seg * 8 + 4) = (f32x4){a[4], a[5], a[6], a[7]}; }
        if (F.tid < 64) { const float* g = gate + (size_t)(b * T + t0 + F.tid) * 16; bet[F.tid] = g[h]; alp[F.tid] = __expf(g[8 + h]); }
        __syncthreads();
        for (int s = 0; s < 64; ++s) {
            const f32x4 ka = *(const LAS f32x4*)(ks + s * 128 + 8 * dg), kb = *(const LAS f32x4*)(ks + s * 128 + 8 * dg + 4);
            const f32x4 qa = *(const LAS f32x4*)(qs + s * 128 + 8 * dg), qb = *(const LAS f32x4*)(qs + s * 128 + 8 * dg + 4);
            const float vv = vs[s * 32 + cc], be = bet[s], al = alp[s];
            float p = (ka.x * S[0] + ka.y * S[1]) + (ka.z * S[2] + ka.w * S[3]) + (kb.x * S[4] + kb.y * S[5]) + (kb.z * S[6] + kb.w * S[7]);
#pragma unroll
            for (int o = 1; o < 16; o <<= 1) p += __shfl_xor(p, o);
            const float dl = be * (vv - al * p);
            S[0] = al * S[0] + ka.x * dl; S[1] = al * S[1] + ka.y * dl; S[2] = al * S[2] + ka.z * dl; S[3] = al * S[3] + ka.w * dl;
            S[4] = al * S[4] + kb.x * dl; S[5] = al * S[5] + kb.y * dl; S[6] = al * S[6] + kb.z * dl; S[7] = al * S[7] + kb.w * dl;
            float po = (qa.x * S[0] + qa.y * S[1]) + (qa.z * S[2] + qa.w * S[3]) + (qb.x * S[4] + qb.y * S[5]) + (qb.z * S[6] + qb.w * S[7]);
#pragma unroll
            for (int o = 1; o < 16; o <<= 1) po += __shfl_xor(po, o);
            if (dg == 0) os[s * 32 + cc] = po;
        }
        __syncthreads();
        { const int row = F.tid >> 3, c4 = (F.tid & 7) * 4; const f32x4 o = *(const LAS f32x4*)(os + row * 32 + c4);
          *(GAS v2u*)(mix + (size_t)(b * T + t0 + row) * D + h * 128 + vq * 32 + c4) = (v2u){pk2(o.x, o.y), pk2(o.z, o.w)}; }
    }
}
struct MlChunkRegs { v4u q, k, v0, v1, o0, o1; float li, lf; };
DI void ml_load(MlChunkRegs& R, const bf16* proj, const float* gate, int b, int h, int tc, int tid) {
    const int row = tid >> 3, seg = tid & 7; const size_t hb = (size_t)(b * 4 + h) * T + tc + row;
    R.q = *(const GAS v4u*)(proj + hb * 64 + 8 * seg); R.k = *(const GAS v4u*)(proj + (size_t)M * 256 + hb * 64 + 8 * seg);
    const bf16* pv = proj + (size_t)M * 512 + hb * 128 + 16 * seg; R.v0 = *(const GAS v4u*)pv; R.v1 = *(const GAS v4u*)(pv + 8);
    const bf16* po = proj + (size_t)M * 1024 + hb * 128 + 16 * seg; R.o0 = *(const GAS v4u*)po; R.o1 = *(const GAS v4u*)(po + 8);
    R.li = 0.f; R.lf = 0.f;
    if (tid < 64) { const float* g = gate + ((size_t)b * T + tc + tid) * 16; R.li = g[h]; R.lf = g[4 + h]; }
}
DI unsigned scale_pk(unsigned u, float s) { return pk2(bflo(u) * s, bfhi(u) * s); }
DI void mlstm_chunked(Frame& F, const bf16* proj, const float* gate, const float* hgain, bf16* mix, int c) {
    constexpr int LD = 72, HLD = 132;
    const int b = c >> 2, h = c & 3;
    const int tid = F.tid, lane = F.lane, w = F.wave, r = lane & 15, quad = lane >> 4, row = tid >> 3, seg = tid & 7;
    LAS bf16* qs = (LAS bf16*)F.lds; LAS bf16* qw = qs + 64 * LD; LAS bf16* ks = qw + 64 * LD; LAS bf16* kTs = ks + 64 * LD; LAS bf16* Sd = kTs + 64 * LD;
    LAS bf16* vT = Sd + 64 * LD; LAS bf16* Cb = vT + 128 * LD;
    LAS float* hbuf = (LAS float*)(Cb + 128 * LD);
    LAS float* sA = hbuf + 64 * HLD; LAS float* sM = sA + 64; LAS float* sWi = sM + 64; LAS float* sWs = sWi + 64; LAS float* sEm = sWs + 64; LAS float* sN = sEm + 64  ; LAS float* sMisc = sN + 128;
    lds_barrier();
    for (int i = tid; i < 128 * LD / 2; i += NTHR) ((LAS unsigned*)Cb)[i] = 0u;
    if (tid < 128) sN[tid] = 0.f;
    f32x4 accC[4];
#pragma unroll
    for (int i = 0; i < 4; ++i) accC[i] = (f32x4){0.f, 0.f, 0.f, 0.f};
    float nreg = 0.f, mprev = 0.f;
    float gn[16];
#pragma unroll
    for (int i = 0; i < 16; ++i) gn[i] = hgain[h * 128 + 16 * seg + i];
    const size_t rb = (size_t)b * T;
    MlChunkRegs cur, nxt; ml_load(cur, proj, gate, b, h, 0, tid); nxt = cur;
    for (int ch = 0; ch < T / 64; ++ch) {
        const size_t r0 = rb + (size_t)ch * 64;
        if (ch + 1 < T / 64) ml_load(nxt, proj, gate, b, h, (ch + 1) * 64, tid);
        STG_T0();
        lds_barrier();
        STG(0);
        *(LAS v4u*)(qs + row * LD + 8 * seg) = cur.q;
        { v4u kk; kk.x = scale_pk(cur.k.x, 0.125f); kk.y = scale_pk(cur.k.y, 0.125f); kk.z = scale_pk(cur.k.z, 0.125f); kk.w = scale_pk(cur.k.w, 0.125f); cur.k = kk; *(LAS v4u*)(ks + row * LD + 8 * seg) = kk; }
        { const unsigned vv[8] = {cur.v0.x, cur.v0.y, cur.v0.z, cur.v0.w, cur.v1.x, cur.v1.y, cur.v1.z, cur.v1.w};
#pragma unroll
          for (int i = 0; i < 8; ++i) { vT[(16 * seg + 2 * i) * LD + row] = (bf16)(vv[i] & 0xffffu); vT[(16 * seg + 2 * i + 1) * LD + row] = (bf16)(vv[i] >> 16); } }
        if (w == 0) {
            float bb = cur.lf;
#pragma unroll
            for (int o = 1; o < 64; o <<= 1) { const float t = __shfl_up(bb, o); if (lane >= o) bb += t; }
            const float a = cur.li - bb; float cm = a;
#pragma unroll
            for (int o = 1; o < 64; o <<= 1) { const float t = __shfl_up(cm, o); if (lane >= o) cm = fmaxf(cm, t); }
            const float Mx = fmaxf(mprev, cm);
            const float b63 = __shfl(bb, 63), Mx63 = __shfl(Mx, 63);
            sA[lane] = a; sM[lane] = Mx; sWi[lane] = __expf(mprev - Mx); sWs[lane] = __expf(a - Mx63); sEm[lane] = __expf(-(bb + Mx));
            if (lane == 0) sMisc[0] = __expf(mprev - Mx63);
            mprev = b63 + Mx63;
        }
        STG(1);
        lds_barrier();
        STG(2);
        { const float wi = sWi[row], wsr = sWs[row];
          v4u t; t.x = scale_pk(cur.q.x, wi); t.y = scale_pk(cur.q.y, wi); t.z = scale_pk(cur.q.z, wi); t.w = scale_pk(cur.q.w, wi); *(LAS v4u*)(qw + row * LD + 8 * seg) = t;
          const unsigned kk[4] = {cur.k.x, cur.k.y, cur.k.z, cur.k.w};
#pragma unroll
          for (int i = 0; i < 4; ++i) { kTs[(8 * seg + 2 * i) * LD + row] = (bf16)f2bf(bflo(kk[i]) * wsr); kTs[(8 * seg + 2 * i + 1) * LD + row] = (bf16)f2bf(bfhi(kk[i]) * wsr); } }
        { const int mt = w >> 1;
          const bf16x8 a0 = *(const LAS bf16x8*)(qs + (16 * mt + r) * LD + 8 * quad), a1 = *(const LAS bf16x8*)(qs + (16 * mt + r) * LD + 32 + 8 * quad);
#pragma unroll
          for (int tt = 0; tt < 2; ++tt) { const int nt = 2 * (w & 1) + tt; f32x4 acc = (f32x4){0.f, 0.f, 0.f, 0.f};
              if (nt <= mt) { const bf16x8 b0 = *(const LAS bf16x8*)(ks + (16 * nt + r) * LD + 8 * quad), b1 = *(const LAS bf16x8*)(ks + (16 * nt + r) * LD + 32 + 8 * quad);
                  acc = mfma16(a0, b0, acc); acc = mfma16(a1, b1, acc); }
              const int s = 16 * nt + r; const float as = sA[s];
#pragma unroll
              for (int j = 0; j < 4; ++j) { const int t = 16 * mt + 4 * quad + j; const float v = (s <= t) ? acc[j] * __expf(as - sM[t]) : 0.f; Sd[t * LD + s] = (bf16)f2bf(v); } } }
        STG(3);
        lds_barrier();
        STG(4);
        const bf16x8 vf0 = *(const LAS bf16x8*)(vT + (16 * w + r) * LD + 8 * quad), vf1 = *(const LAS bf16x8*)(vT + (16 * w + r) * LD + 32 + 8 * quad);
        { const bf16x8 cf0 = *(const LAS bf16x8*)(Cb + (16 * w + r) * LD + 8 * quad), cf1 = *(const LAS bf16x8*)(Cb + (16 * w + r) * LD + 32 + 8 * quad);
#pragma unroll
          for (int mt = 0; mt < 4; ++mt) { f32x4 acc = (f32x4){0.f, 0.f, 0.f, 0.f};
              acc = mfma16(*(const LAS bf16x8*)(Sd + (16 * mt + r) * LD + 8 * quad), vf0, acc); acc = mfma16(*(const LAS bf16x8*)(Sd + (16 * mt + r) * LD + 32 + 8 * quad), vf1, acc);
              acc = mfma16(*(const LAS bf16x8*)(qw + (16 * mt + r) * LD + 8 * quad), cf0, acc); acc = mfma16(*(const LAS bf16x8*)(qw + (16 * mt + r) * LD + 32 + 8 * quad), cf1, acc);
#pragma unroll
              for (int j = 0; j < 4; ++j) hbuf[(16 * mt + 4 * quad + j) * HLD + 16 * w + r] = acc[j]; } }
        STG(5);
        lds_barrier();
        STG(6);
        { const float wold = sMisc[0];
#pragma unroll
          for (int nt = 0; nt < 4; ++nt) { f32x4 acc = accC[nt] * wold;
              acc = mfma16(vf0, *(const LAS bf16x8*)(kTs + (16 * nt + r) * LD + 8 * quad), acc); acc = mfma16(vf1, *(const LAS bf16x8*)(kTs + (16 * nt + r) * LD + 32 + 8 * quad), acc);
              accC[nt] = acc;
#pragma unroll
              for (int j = 0; j < 4; ++j) Cb[(16 * w + 4 * quad + j) * LD + 16 * nt + r] = (bf16)f2bf(acc[j]); }
          if (w == 0) { float sum = 0.f;
#pragma unroll
              for (int q8 = 0; q8 < 8; ++q8) { const v4u t = *(const LAS v4u*)(kTs + lane * LD + 8 * q8); sum += (bflo(t.x) + bfhi(t.x)) + (bflo(t.y) + bfhi(t.y)) + (bflo(t.z) + bfhi(t.z)) + (bflo(t.w) + bfhi(t.w)); }
              nreg = wold * nreg + sum; sN[((ch + 1) & 1) * 64 + lane] = nreg; } }
        { const LAS float* nv = sN + (ch & 1) * 64 + 8 * seg;
          const v4u sd = *(const LAS v4u*)(Sd + row * LD + 8 * seg);
          float p = (bflo(sd.x) + bfhi(sd.x)) + (bflo(sd.y) + bfhi(sd.y)) + (bflo(sd.z) + bfhi(sd.z)) + (bflo(sd.w) + bfhi(sd.w));
          const float qn = (bflo(cur.q.x) * nv[0] + bfhi(cur.q.x) * nv[1]) + (bflo(cur.q.y) * nv[2] + bfhi(cur.q.y) * nv[3]) + (bflo(cur.q.z) * nv[4] + bfhi(cur.q.z) * nv[5]) + (bflo(cur.q.w) * nv[6] + bfhi(cur.q.w) * nv[7]);
          p += sWi[row] * qn;
          p = red8(p);
          const float dinv = rcp_(fmaxf(fabsf(p), sEm[row]));
          float hv[16]; float ss = 0.f;
#pragma unroll
          for (int q4 = 0; q4 < 4; ++q4) { const f32x4 t = *(const LAS f32x4*)(hbuf + row * HLD + 16 * seg + 4 * q4); hv[4 * q4] = t.x * dinv; hv[4 * q4 + 1] = t.y * dinv; hv[4 * q4 + 2] = t.z * dinv; hv[4 * q4 + 3] = t.w * dinv; }
#pragma unroll
          for (int i = 0; i < 16; ++i) ss += hv[i] * hv[i];
          ss = red8(ss);
          const float rstd = rsq_(ss * (1.f / 128.f) + EPS);
          const unsigned og[8] = {cur.o0.x, cur.o0.y, cur.o0.z, cur.o0.w, cur.o1.x, cur.o1.y, cur.o1.z, cur.o1.w}; unsigned ow[8];
#pragma unroll
          for (int i = 0; i < 8; ++i) ow[i] = pk2(hv[2 * i] * rstd * gn[2 * i] * sigmoidf_(bflo(og[i])), hv[2 * i + 1] * rstd * gn[2 * i + 1] * sigmoidf_(bfhi(og[i])));
          bf16* op = mix + (r0 + row) * D + h * 128 + 16 * seg;
          *(GAS v4u*)op = (v4u){ow[0], ow[1], ow[2], ow[3]}; *(GAS v4u*)(op + 8) = (v4u){ow[4], ow[5], ow[6], ow[7]}; }
        STG(7);
        cur = nxt;
    }
}
constexpr size_t H_NUML = 0, H_DC = 64 * MiB;
constexpr int MLS_STRIDE = 320;
struct MlaRegs { v4u q, k, v0, v1; float li, lf; };
DI void mla_load(MlaRegs& R, const bf16* proj, const float* gate, int unit, int tid) {
    const int ch = unit & 127, bh = unit >> 7, b = bh >> 2, h = bh & 3, s = tid & 63, dseg = tid >> 6;
    const size_t hb = (size_t)bh * T + ch * 64 + s;
    R.q = *(const GAS v4u*)(proj + hb * 64 + 8 * dseg); R.k = *(const GAS v4u*)(proj + (size_t)M * 256 + hb * 64 + 8 * dseg);
    const bf16* pv = proj + (size_t)M * 512 + hb * 128 + 16 * dseg; R.v0 = *(const GAS v4u*)pv; R.v1 = *(const GAS v4u*)(pv + 8);
    const float* g = gate + ((size_t)b * T + ch * 64 + s) * 16; R.li = g[h]; R.lf = g[4 + h];
}
DI void mlstm_a_unit(Frame& F, MlaRegs& R, const bf16* proj, const float* gate, bf16* numl, bf16* dc, float* scal, int unit, int unit_end) {
    constexpr int LD = 72, LN = 136;
    int tid_ = F.tid; asm volatile("" : "+v"(tid_));
    const int tid = tid_, lane = tid & 63, w = F.wave, r = lane & 15, quad = lane >> 4, dseg = tid >> 6;
    LAS bf16* qs = (LAS bf16*)F.lds; LAS bf16* ks = qs + 64 * LD; LAS bf16* ksT = ks + 64 * LD; LAS bf16* vT = ksT + 64 * LD; LAS bf16* Sd = vT + 128 * LD; LAS bf16* Cst = Sd + 64 * LD; LAS bf16* numS = Cst + 128 * LD;
    LAS float* sCm = (LAS float*)(numS + 64 * LN); LAS float* sDen = sCm + 64; LAS float* sDn = sDen + 64;
    float bb = R.lf;
#pragma unroll
    for (int o = 1; o < 64; o <<= 1) { const float t = __shfl_up(bb, o); if (lane >= o) bb += t; }
    const float a = R.li - bb; float cm = a;
#pragma unroll
    for (int o = 1; o < 64; o <<= 1) { const float t = __shfl_up(cm, o); if (lane >= o) cm = fmaxf(cm, t); }
    const float Astar = __shfl(cm, 63), b63 = __shfl(bb, 63);
    const float ksc = 0.125f * __expf(a - Astar);
    lds_barrier();
    *(LAS v4u*)(qs + lane * LD + 8 * dseg) = R.q;
    { v4u kk; kk.x = scale_pk(R.k.x, ksc); kk.y = scale_pk(R.k.y, ksc); kk.z = scale_pk(R.k.z, ksc); kk.w = scale_pk(R.k.w, ksc); *(LAS v4u*)(ks + lane * LD + 8 * dseg) = kk;
      const unsigned kw[4] = {kk.x, kk.y, kk.z, kk.w};
#pragma unroll
      for (int i = 0; i < 4; ++i) { ksT[(8 * dseg + 2 * i) * LD + lane] = (bf16)(kw[i] & 0xffffu); ksT[(8 * dseg + 2 * i + 1) * LD + lane] = (bf16)(kw[i] >> 16); }
      const unsigned vv[8] = {R.v0.x, R.v0.y, R.v0.z, R.v0.w, R.v1.x, R.v1.y, R.v1.z, R.v1.w};
#pragma unroll
      for (int i = 0; i < 8; ++i) { vT[(16 * dseg + 2 * i) * LD + lane] = (bf16)(vv[i] & 0xffffu); vT[(16 * dseg + 2 * i + 1) * LD + lane] = (bf16)(vv[i] >> 16); } }
    if (w == 0) sCm[lane] = cm;
    if (unit + 1 < unit_end) mla_load(R, proj, gate, unit + 1, tid);
    lds_barrier();
    { const int mt = w >> 1;
      const bf16x8 a0 = *(const LAS bf16x8*)(qs + (16 * mt + r) * LD + 8 * quad), a1 = *(const LAS bf16x8*)(qs + (16 * mt + r) * LD + 32 + 8 * quad);
#pragma unroll
      for (int tt = 0; tt < 2; ++tt) { const int nt = 2 * (w & 1) + tt; f32x4 acc = (f32x4){0.f, 0.f, 0.f, 0.f};
          if (nt <= mt) { acc = mfma16(a0, *(const LAS bf16x8*)(ks + (16 * nt + r) * LD + 8 * quad), acc); acc = mfma16(a1, *(const LAS bf16x8*)(ks + (16 * nt + r) * LD + 32 + 8 * quad), acc); }
          const int s = 16 * nt + r;
#pragma unroll
          for (int j = 0; j < 4; ++j) { const int t = 16 * mt + 4 * quad + j; const float v = (s <= t) ? acc[j] * __expf(Astar - sCm[t]) : 0.f; Sd[t * LD + s] = (bf16)f2bf(v); } } }
    const bf16x8 vf0 = *(const LAS bf16x8*)(vT + (16 * w + r) * LD + 8 * quad), vf1 = *(const LAS bf16x8*)(vT + (16 * w + r) * LD + 32 + 8 * quad);
#pragma unroll
    for (int nt = 0; nt < 4; ++nt) { f32x4 acc = (f32x4){0.f, 0.f, 0.f, 0.f};
        acc = mfma16(vf0, *(const LAS bf16x8*)(ksT + (16 * nt + r) * LD + 8 * quad), acc); acc = mfma16(vf1, *(const LAS bf16x8*)(ksT + (16 * nt + r) * LD + 32 + 8 * quad), acc);
#pragma unroll
        for (int j = 0; j < 4; ++j) Cst[(16 * w + 4 * quad + j) * LD + 16 * nt + r] = (bf16)f2bf(acc[j]); }
    if (w == 0) { float sum = 0.f;
#pragma unroll
        for (int q8 = 0; q8 < 8; ++q8) { const v4u t = *(const LAS v4u*)(ksT + lane * LD + 8 * q8); sum += (bflo(t.x) + bfhi(t.x)) + (bflo(t.y) + bfhi(t.y)) + (bflo(t.z) + bfhi(t.z)) + (bflo(t.w) + bfhi(t.w)); }
        sDn[lane] = sum; }
    lds_barrier();
#pragma unroll
    for (int mt = 0; mt < 4; ++mt) { f32x4 acc = (f32x4){0.f, 0.f, 0.f, 0.f};
        acc = mfma16(*(const LAS bf16x8*)(Sd + (16 * mt + r) * LD + 8 * quad), vf0, acc); acc = mfma16(*(const LAS bf16x8*)(Sd + (16 * mt + r) * LD + 32 + 8 * quad), vf1, acc);
#pragma unroll
        for (int j = 0; j < 4; ++j) numS[(16 * mt + 4 * quad + j) * LN + 16 * w + r] = (bf16)f2bf(acc[j]); }
    { const int row = tid >> 3, seg = tid & 7; const v4u sd = *(const LAS v4u*)(Sd + row * LD + 8 * seg);
      float p = (bflo(sd.x) + bfhi(sd.x)) + (bflo(sd.y) + bfhi(sd.y)) + (bflo(sd.z) + bfhi(sd.z)) + (bflo(sd.w) + bfhi(sd.w));
      p = red8(p); if (seg == 0) sDen[row] = p; }
    lds_barrier();
    { const int row = tid >> 3, c16 = (tid & 7) * 16; bf16* g = numl + (size_t)unit * 8192 + row * 128 + c16;
      *(GAS v4u*)g = *(const LAS v4u*)(numS + row * LN + c16); *(GAS v4u*)(g + 8) = *(const LAS v4u*)(numS + row * LN + c16 + 8);
      const int dv = tid >> 2, d16 = (tid & 3) * 16; bf16* gc = dc + (size_t)unit * 8192 + dv * 64 + d16;
      *(GAS v4u*)gc = *(const LAS v4u*)(Cst + dv * LD + d16); *(GAS v4u*)(gc + 8) = *(const LAS v4u*)(Cst + dv * LD + d16 + 8);
      float* sc = scal + (size_t)unit * MLS_STRIDE;
      if (w == 0) { sc[lane] = sDen[lane]; sc[64 + lane] = cm; sc[128 + lane] = bb; sc[192 + lane] = sDn[lane]; if (lane == 0) { sc[256] = Astar; sc[257] = b63; } } }
}
DI void mlstm_a_phase(Frame& F, const bf16* proj, const float* gate, bf16* numl, bf16* dc, float* scal) {
    const int per = (4096 + F.G - 1) / F.G, u0 = F.wg * per, u1 = (u0 + per < 4096) ? u0 + per : 4096;
    if (u0 >= u1) return;
    MlaRegs R; mla_load(R, proj, gate, u0, F.tid);
    for (int u = u0; u < u1; ++u) mlstm_a_unit(F, R, proj, gate, numl, dc, scal, u, u1);
}
DI void mlstm_b_phase(Frame& F, bf16* dc, float* scal) {
    for (int c = F.wg; c < 256; c += F.G) {
        const int bh = c >> 3, part = c & 7, e = part * 1024 + 2 * F.tid; const bool nth = (part == 0) && (F.tid < 64);
        float c0 = 0.f, c1 = 0.f, nn = 0.f, m = 0.f;
        for (int cb = 0; cb < 128; cb += 8) {
            unsigned dv[8]; float As[8], bs[8], dn[8];
#pragma unroll
            for (int i = 0; i < 8; ++i) { const size_t un = (size_t)bh * 128 + cb + i; dv[i] = *(const GAS unsigned*)(dc + un * 8192 + e); const float* sc = scal + un * MLS_STRIDE; As[i] = sc[256]; bs[i] = sc[257]; dn[i] = nth ? sc[192 + F.tid] : 0.f; }
#pragma unroll
            for (int i = 0; i < 8; ++i) { const size_t un = (size_t)bh * 128 + cb + i; float* sc = scal + un * MLS_STRIDE;
                const float Mx = fmaxf(m, As[i]), wo = __expf(m - Mx), wd = __expf(As[i] - Mx);
                *(GAS unsigned*)(dc + un * 8192 + e) = pk2(c0, c1);
                if (nth) sc[192 + F.tid] = nn;
                if (part == 0 && F.tid == 64) sc[258] = m;
                c0 = wo * c0 + wd * bflo(dv[i]); c1 = wo * c1 + wd * bfhi(dv[i]); nn = wo * nn + wd * dn[i]; m = bs[i] + Mx; }
        }
    }
}
struct MlcRegs { bf16x8 qa[4][2], cb[2]; v4u nl0, nl1, o0, o1, qr; f32x4 n0, n1; float denL, cm, bb, mprev; };
DI void mlc_load(MlcRegs& R, const bf16* proj, const bf16* numl, const bf16* dc, const float* scal, int unit, int tid, int w) {
    const int ch = unit & 127, bh = unit >> 7, lane = tid & 63, r = lane & 15, quad = lane >> 4, row = tid >> 3, seg = tid & 7;
    const size_t hb0 = (size_t)bh * T + ch * 64;
#pragma unroll
    for (int mt = 0; mt < 4; ++mt) { const bf16* p = proj + (hb0 + 16 * mt + r) * 64 + 8 * quad; R.qa[mt][0] = *(const GAS bf16x8*)p; R.qa[mt][1] = *(const GAS bf16x8*)(p + 32); }
    { const bf16* p = dc + (size_t)unit * 8192 + (16 * w + r) * 64 + 8 * quad; R.cb[0] = *(const GAS bf16x8*)p; R.cb[1] = *(const GAS bf16x8*)(p + 32); }
    { const bf16* p = numl + (size_t)unit * 8192 + row * 128 + 16 * seg; R.nl0 = *(const GAS v4u*)p; R.nl1 = *(const GAS v4u*)(p + 8); }
    { const bf16* p = proj + (size_t)M * 1024 + (hb0 + row) * 128 + 16 * seg; R.o0 = *(const GAS v4u*)p; R.o1 = *(const GAS v4u*)(p + 8); }
    R.qr = *(const GAS v4u*)(proj + (hb0 + row) * 64 + 8 * seg);
    const float* sc = scal + (size_t)unit * MLS_STRIDE;
    R.n0 = *(const GAS f32x4*)(sc + 192 + 8 * seg); R.n1 = *(const GAS f32x4*)(sc + 192 + 8 * seg + 4);
    R.denL = sc[row]; R.cm = sc[64 + row]; R.bb = sc[128 + row]; R.mprev = sc[258];
}
DI void mlstm_c_phase(Frame& F, const bf16* proj, const bf16* numl, const bf16* dc, const float* scal, const float* hgain, bf16* mix) {
    constexpr int HLD = 132;
    const int per = (4096 + F.G - 1) / F.G, u0 = F.wg * per, u1 = (u0 + per < 4096) ? u0 + per : 4096;
    if (u0 >= u1) return;
    LAS float* hbuf = (LAS float*)F.lds;
    MlcRegs R; mlc_load(R, proj, numl, dc, scal, u0, F.tid, F.wave);
    for (int u = u0; u < u1; ++u) {
        int tid_ = F.tid; asm volatile("" : "+v"(tid_));
        const int tid = tid_, lane = tid & 63, w = F.wave, r = lane & 15, quad = lane >> 4, row = tid >> 3, seg = tid & 7;
        const int ch = u & 127, bh = u >> 7, b = bh >> 2, h = bh & 3;
        lds_barrier();
#pragma unroll
        for (int mt = 0; mt < 4; ++mt) { f32x4 acc = (f32x4){0.f, 0.f, 0.f, 0.f}; acc = mfma16(R.qa[mt][0], R.cb[0], acc); acc = mfma16(R.qa[mt][1], R.cb[1], acc);
#pragma unroll
            for (int j = 0; j < 4; ++j) hbuf[(16 * mt + 4 * quad + j) * HLD + 16 * w + r] = acc[j]; }
        const v4u nl0 = R.nl0, nl1 = R.nl1, o0 = R.o0, o1 = R.o1, qr = R.qr; const f32x4 n0 = R.n0, n1 = R.n1; const float denL = R.denL, cm = R.cm, bb = R.bb, mprev = R.mprev;
        if (u + 1 < u1) mlc_load(R, proj, numl, dc, scal, u + 1, tid, w);
        lds_barrier();
        { const float Mx = fmaxf(mprev, cm), e1 = __expf(cm - Mx), wi = __expf(mprev - Mx);
          float qn = (bflo(qr.x) * n0[0] + bfhi(qr.x) * n0[1]) + (bflo(qr.y) * n0[2] + bfhi(qr.y) * n0[3]) + (bflo(qr.z) * n1[0] + bfhi(qr.z) * n1[1]) + (bflo(qr.w) * n1[2] + bfhi(qr.w) * n1[3]);
          qn = red8(qn);
          const float den = e1 * denL + wi * qn; const float dinv = rcp_(fmaxf(fabsf(den), __expf(-(bb + Mx))));
          const unsigned nw[8] = {nl0.x, nl0.y, nl0.z, nl0.w, nl1.x, nl1.y, nl1.z, nl1.w};
          float hv[16]; float ss = 0.f;
#pragma unroll
          for (int q4 = 0; q4 < 4; ++q4) { const f32x4 t = *(const LAS f32x4*)(hbuf + row * HLD + 16 * seg + 4 * q4);
              hv[4 * q4] = (e1 * bflo(nw[2 * q4]) + wi * t.x) * dinv; hv[4 * q4 + 1] = (e1 * bfhi(nw[2 * q4]) + wi * t.y) * dinv; hv[4 * q4 + 2] = (e1 * bflo(nw[2 * q4 + 1]) + wi * t.z) * dinv; hv[4 * q4 + 3] = (e1 * bfhi(nw[2 * q4 + 1]) + wi * t.w) * dinv; }
#pragma unroll
          for (int i = 0; i < 16; ++i) ss += hv[i] * hv[i];
          ss = red8(ss);
          const float rstd = rsq_(ss * (1.f / 128.f) + EPS);
          const unsigned og[8] = {o0.x, o0.y, o0.z, o0.w, o1.x, o1.y, o1.z, o1.w}; unsigned ow[8];
          const float* gp = hgain + h * 128 + 16 * seg;
#pragma unroll
          for (int i = 0; i < 8; ++i) ow[i] = pk2(hv[2 * i] * rstd * gp[2 * i] * sigmoidf_(bflo(og[i])), hv[2 * i + 1] * rstd * gp[2 * i + 1] * sigmoidf_(bfhi(og[i])));
          bf16* op = mix + ((size_t)b * T + ch * 64 + row) * D + h * 128 + 16 * seg;
          *(GAS v4u*)op = (v4u){ow[0], ow[1], ow[2], ow[3]}; *(GAS v4u*)(op + 8) = (v4u){ow[4], ow[5], ow[6], ow[7]}; }
    }
}
constexpr size_t MIX_AT = 0, MIX_HALO = 64 * MiB, MIX_GL = 96 * MiB;
struct G1Raw { v2u raw[3][7]; };
struct G1Cw { float w[3][4][4]; };
DI void g1_load_raw(G1Raw& R, const bf16* big, const bf16* halo, int U, int tid) {
    const int ch = U & 127, h = (U >> 7) & 7, b = U >> 10, cg = tid & 31, rs = tid >> 5;
    const size_t hb0 = (size_t)(b * 8 + h) * T + (size_t)ch * 64;
#pragma unroll
    for (int which = 0; which < 3; ++which)
#pragma unroll
        for (int i = 0; i < 7; ++i) { const int rr = 4 * rs - 3 + i; v2u t = (v2u){0u, 0u};
            if (rr >= 0) t = *(const GAS v2u*)(big + (size_t)M * 1024 * which + (hb0 + rr) * 128 + 4 * cg);
            else if (ch > 0) t = *(const GAS v2u*)(halo + ((size_t)(b * 128 + ch - 1) * 3 + (3 + rr)) * 3072 + which * 1024 + h * 128 + 4 * cg);
            R.raw[which][i] = t; }
}
DI void g1_load_cw(G1Cw& C, const float* convw, int h, int tid) {
    const int cg = tid & 31;
#pragma unroll
    for (int which = 0; which < 3; ++which)
#pragma unroll
        for (int j = 0; j < 4; ++j) { const f32x4 t = *(const GAS f32x4*)(convw + j * 3072 + which * 1024 + h * 128 + 4 * cg); C.w[which][j][0] = t.x; C.w[which][j][1] = t.y; C.w[which][j][2] = t.z; C.w[which][j][3] = t.w; }
}
DI void gdn_g1_unit(Frame& F, bf16* big, const bf16* halo, const float* gate, G1Raw& RW, const float* convw, bf16* Hb, bf16* At, float* GL, int U, int Uend, bool st) {
    constexpr int LQ = 136, LX = 72, LR = 264;
    const int ch = U & 127, h = (U >> 7) & 7, b = U >> 10;
    const size_t r0 = (size_t)b * T + (size_t)ch * 64, hb0 = (size_t)(b * 8 + h) * T + (size_t)ch * 64;
    int tid_ = F.tid; asm volatile("" : "+v"(tid_));
    const int tid = tid_, lane = tid & 63, w = F.wave, r = lane & 15, quad = lane >> 4, row = tid >> 3, seg = tid & 7;
    const size_t hb = hb0 + row;
    LAS bf16* qn = (LAS bf16*)F.lds; LAS bf16* kn = qn + 64 * LQ; LAS bf16* vn = kn + 64 * LQ; LAS bf16* knT = vn + 64 * LQ;
    LAS bf16* Lb = knT + 128 * LX; LAS float* Lf = (LAS float*)(Lb + 64 * LX);
    LAS bf16* Db = (LAS bf16*)(Lf + 4 * 16 * 17); LAS bf16* Xt = Db + 4 * 16 * 20;
    LAS bf16* Xr = qn;
    LAS bf16* Ats = Xt;
    LAS float* sG = (LAS float*)(Xt + 256 * LX); LAS float* sBeta = sG + 64; LAS float* sEg = sBeta + 64;
    f32x4 cwa[3][4];
#pragma unroll
    for (int which = 0; which < 3; ++which)
#pragma unroll
        for (int j = 0; j < 4; ++j) cwa[which][j] = *(const GAS f32x4*)(convw + j * 3072 + which * 1024 + h * 128 + 4 * (tid & 31));
    STG_T0();
    lds_barrier();
    STG(10);
    {
        const int cg = tid & 31, rs = tid >> 5;
#pragma unroll
        for (int which = 0; which < 3; ++which) {
            __builtin_amdgcn_sched_barrier(0);
            const f32x4 (&cw)[4] = cwa[which];
            float x[7][4];
#pragma unroll
            for (int i = 0; i < 7; ++i) { const v2u t = RW.raw[which][i]; x[i][0] = bflo(t.x); x[i][1] = bfhi(t.x); x[i][2] = bflo(t.y); x[i][3] = bfhi(t.y); }
            float o[4][4]; float ss[4];
#pragma unroll
            for (int rr = 0; rr < 4; ++rr) {
#pragma unroll
                for (int c = 0; c < 4; ++c) { float a = cw[0][c] * x[rr][c]; a += cw[1][c] * x[rr + 1][c]; a += cw[2][c] * x[rr + 2][c]; a += cw[3][c] * x[rr + 3][c]; o[rr][c] = a; } }
#pragma unroll
            for (int rr = 0; rr < 4; ++rr) { ss[rr] = 0.f;
#pragma unroll
                for (int c = 0; c < 4; ++c) { float a = o[rr][c]; a = a * sigmoidf_(a); o[rr][c] = a; ss[rr] += a * a; } }

            if (which < 2) {
#pragma unroll
                for (int rr = 0; rr < 4; ++rr) { float t = ss[rr]; t = red16(t); t += __shfl_xor(t, 16);
                    const float sc = rsq_(t + EPS) * (which == 0 ? 0.08838834764831845f : 1.0f);
#pragma unroll
                    for (int c = 0; c < 4; ++c) o[rr][c] *= sc; } }
            LAS bf16* dst = (which == 0 ? qn : (which == 1 ? kn : vn));
#pragma unroll
            for (int rr = 0; rr < 4; ++rr) *(LAS v2u*)(dst + (4 * rs + rr) * LQ + 4 * cg) = (v2u){pk2(o[rr][0], o[rr][1]), pk2(o[rr][2], o[rr][3])};
            if (which == 1) {
#pragma unroll
                for (int c = 0; c < 4; ++c) *(LAS v2u*)(knT + (4 * cg + c) * LX + ((4 * rs) ^ (8 * (cg & 7)))) = (v2u){pk2(o[0][c], o[1][c]), pk2(o[2][c], o[3][c])}; }
        }
    }
    if (U + 1 < Uend) g1_load_raw(RW, big, halo, U + 1, tid);
    if (w == 0) { const float* g = gate + (r0 + lane) * 16; float gg = g[8 + h]; const float be = g[h];
#pragma unroll
        for (int o = 1; o < 64; o <<= 1) { const float t = __shfl_up(gg, o); if (lane >= o) gg += t; }
        sG[lane] = gg; sBeta[lane] = be; sEg[lane] = __expf(gg); }
    STG(11);
    lds_barrier();
    STG(12);
    { const int mt = w >> 1;
#pragma unroll
      for (int tt = 0; tt < 2; ++tt) { const int nt = 2 * (w & 1) + tt; f32x4 ak = (f32x4){0.f, 0.f, 0.f, 0.f}, aq = ak;
          if (nt <= mt) {
#pragma unroll
              for (int kk = 0; kk < 4; ++kk) { const bf16x8 bk = *(const LAS bf16x8*)(kn + (16 * nt + r) * LQ + 32 * kk + 8 * quad);
                  ak = mfma16(*(const LAS bf16x8*)(kn + (16 * mt + r) * LQ + 32 * kk + 8 * quad), bk, ak); aq = mfma16(*(const LAS bf16x8*)(qn + (16 * mt + r) * LQ + 32 * kk + 8 * quad), bk, aq); } }
          const int s = 16 * nt + r; const float gs = sG[s];
#pragma unroll
          for (int j = 0; j < 4; ++j) { const int t = 16 * mt + 4 * quad + j; const float dec = (s <= t) ? __expf(sG[t] - gs) : 0.f;
              const float lv = (s < t) ? sBeta[t] * ak[j] * dec : 0.f;
              if (nt <= mt) { Lb[t * LX + s] = (bf16)f2bf(lv); if (nt == mt) Lf[(mt * 16 + 4 * quad + j) * 17 + r] = lv; }
              Ats[t * LX + s] = (bf16)f2bf(aq[j] * dec); } } }
    float R[4][2][4];
#pragma unroll
    for (int i = 0; i < 4; ++i)
#pragma unroll
        for (int ct = 0; ct < 2; ++ct)
#pragma unroll
            for (int j = 0; j < 4; ++j) { const int t = 16 * i + 4 * quad + j, cc = 32 * (w & 3) + 16 * ct + r;
                R[i][ct][j] = (w < 4) ? sBeta[t] * bf2f(vn[t * LQ + cc]) : sBeta[t] * sEg[t] * bf2f(kn[t * LQ + cc]); }
    STG(13);
    lds_barrier();
    STG(14);
    if (w == 0) { const int i = lane >> 4, cI = lane & 15; const LAS float* N = Lf + i * 16 * 17; float x[16];
#pragma unroll
        for (int rr = 0; rr < 16; ++rr) { float v = (rr == cI) ? 1.f : 0.f;
#pragma unroll
            for (int m = 0; m < rr; ++m) v -= N[rr * 17 + m] * x[m];
            x[rr] = v; Db[(i * 16 + rr) * 20 + cI] = (bf16)f2bf(v); }
    } else { const float gl = sG[63];
        if (st) for (int idx = tid - 64; idx < 2560; idx += NTHR - 64) {
            if (idx < 1024) { const int t = idx >> 4, c8 = (idx & 15) * 8; const v4u v = *(const LAS v4u*)(qn + t * LQ + c8); const float e = sEg[t];
                *(GAS v4u*)(big + (size_t)M * 2048 + (hb0 + t) * 128 + c8) = (v4u){scale_pk(v.x, e), scale_pk(v.y, e), scale_pk(v.z, e), scale_pk(v.w, e)}; }
            else if (idx >= 2048) { const int i3 = idx - 2048, t = i3 >> 3, s8 = (i3 & 7) * 8; *(GAS v4u*)(At + (size_t)U * 4096 + t * 64 + s8) = *(const LAS v4u*)(Ats + t * LX + s8); }
            else { const int i2 = idx - 1024, d = i2 >> 3, s8 = (i2 & 7) * 8; const v4u v = *(const LAS v4u*)(knT + d * LX + (s8 ^ (8 * ((d >> 2) & 7)))); float e[8];
#pragma unroll
                for (int q = 0; q < 8; ++q) e[q] = __expf(gl - sG[s8 + q]);
                *(GAS v4u*)(big + (size_t)M * 1024 + hb0 * 128 + d * 64 + s8) = (v4u){pk2(bflo(v.x) * e[0], bfhi(v.x) * e[1]), pk2(bflo(v.y) * e[2], bfhi(v.y) * e[3]), pk2(bflo(v.z) * e[4], bfhi(v.z) * e[5]), pk2(bflo(v.w) * e[6], bfhi(v.w) * e[7])}; } }
        if (st && tid == 64) GL[U] = __expf(gl); }
    STG(15);
    lds_barrier();
    STG(16);
#pragma unroll
    for (int i = 0; i < 4; ++i) {
#pragma unroll
        for (int ct = 0; ct < 2; ++ct) { const int col = 32 * w + 16 * ct + r; f32x4 acc = (f32x4){0.f, 0.f, 0.f, 0.f};
            if (i > 0) {
#pragma unroll
                for (int kk = 0; kk < 2; ++kk) if (32 * kk < 16 * i) {
                    bf16x8 af = *(const LAS bf16x8*)(Lb + (16 * i + r) * LX + 32 * kk + 8 * quad);
                    if (32 * kk + 8 * quad >= 16 * i) af = (bf16x8){0, 0, 0, 0, 0, 0, 0, 0};
                    acc = mfma16(af, *(const LAS bf16x8*)(Xt + col * LX + 32 * kk + 8 * quad), acc); } }
            const v2u bp = (v2u){pk2(R[i][ct][0] - acc[0], R[i][ct][1] - acc[1]), pk2(R[i][ct][2] - acc[2], R[i][ct][3] - acc[3])};
            const v2u ap = *(const LAS v2u*)(Db + (i * 16 + r) * 20 + 4 * quad);
            const f32x4 y = mfma16(__builtin_bit_cast(bf16x8, (v4u){ap.x, ap.y, 0u, 0u}), __builtin_bit_cast(bf16x8, (v4u){bp.x, bp.y, 0u, 0u}), (f32x4){0.f, 0.f, 0.f, 0.f});
            *(LAS v2u*)(Xt + col * LX + 16 * i + 4 * quad) = (v2u){pk2(y[0], y[1]), pk2(y[2], y[3])};
#pragma unroll
            for (int j = 0; j < 4; ++j) Xr[(16 * i + 4 * quad + j) * LR + col] = (bf16)f2bf(y[j]); }
        asm volatile("s_waitcnt lgkmcnt(0)" ::: "memory");
    }
    lds_barrier();
    STG(17);
    if (st) { const v4u u0 = *(const LAS v4u*)(Xr + row * LR + 16 * seg), u1 = *(const LAS v4u*)(Xr + row * LR + 16 * seg + 8), w0 = *(const LAS v4u*)(Xr + row * LR + 128 + 16 * seg), w1 = *(const LAS v4u*)(Xr + row * LR + 128 + 16 * seg + 8);
      bf16* up = Hb + hb * 128 + 16 * seg; *(GAS v4u*)up = u0; *(GAS v4u*)(up + 8) = u1;
      bf16* wp = big + hb * 128 + 16 * seg; *(GAS v4u*)wp = w0; *(GAS v4u*)(wp + 8) = w1; }
    STG(18);
}
DI void gdn_g1_phase(Frame& F, bf16* big, const bf16* halo, const float* gate, const float* convw, bf16* Hb, bf16* At, float* GL, bool st) {
    LAS unsigned* xt = (LAS unsigned*)(F.lds + (3 * 64 * 136 + 128 * 72 + 64 * 72) * 2 + 4 * 16 * 17 * 4 + 4 * 16 * 20 * 2);
    lds_barrier();
    for (int i = F.tid; i < 256 * 72 / 2; i += NTHR) xt[i] = 0u;
    const int per = (8192 + F.G - 1) / F.G, u0 = F.wg * per, u1 = (u0 + per < 8192) ? u0 + per : 8192;
    if (u0 >= u1) return;
    G1Raw RW;
    g1_load_raw(RW, big, halo, u0, F.tid);
    for (int U = u0; U < u1; ++U) gdn_g1_unit(F, big, halo, gate, RW, convw, Hb, At, GL, U, u1, st);
}
struct G2Regs { bf16x8 f[10]; unsigned u[8]; float gl; };
DI void g2_load(G2Regs& R, const bf16* big, const bf16* Hb, const bf16* At, const float* GL, int b, int h, int vq, int ch, int w, int r, int quad) {
    const size_t hb0 = (size_t)(b * 8 + h) * T + (size_t)ch * 64; const int U = (b * 8 + h) * 128 + ch;
    if (w < 4) { const int mt = w;
        const bf16* pw = big + (hb0 + 16 * mt + r) * 128 + 8 * quad;
#pragma unroll
        for (int kk = 0; kk < 4; ++kk) { R.f[kk] = *(const GAS bf16x8*)(pw + 32 * kk); R.f[4 + kk] = *(const GAS bf16x8*)(pw + (size_t)M * 2048 + 32 * kk); }
        const bf16* pa = At + (size_t)U * 4096 + (16 * mt + r) * 64 + 8 * quad;
        R.f[8] = *(const GAS bf16x8*)pa; R.f[9] = *(const GAS bf16x8*)(pa + 32);
        const bf16* pu = Hb + (hb0 + 16 * mt + 4 * quad) * 128 + vq * 32 + r;
#pragma unroll
        for (int nt = 0; nt < 2; ++nt)
#pragma unroll
            for (int j = 0; j < 4; ++j) R.u[nt * 4 + j] = pu[(size_t)j * 128 + 16 * nt];
    } else { const int dg = w - 4;
#pragma unroll
        for (int i = 0; i < 2; ++i) { const int d = 32 * dg + 16 * i + r; const bf16* pk = big + (size_t)M * 1024 + hb0 * 128 + d * 64 + 8 * quad;
            R.f[2 * i] = *(const GAS bf16x8*)pk; R.f[2 * i + 1] = *(const GAS bf16x8*)(pk + 32); }
        R.gl = GL[U];
    }
}
struct G2State { f32x4 accS[2][2]; unsigned opend[8]; };
DI void g2_store_o(const G2State& S, bf16* Hb, int b, int h, int vq, int ch, int w, int r, int quad) {
    if (w < 4) { const size_t hbp = (size_t)(b * 8 + h) * T + (size_t)ch * 64; bf16* po = Hb + (hbp + 16 * w + 4 * quad) * 128 + vq * 32 + r;
#pragma unroll
        for (int nt = 0; nt < 2; ++nt)
#pragma unroll
            for (int j = 0; j < 4; ++j) po[(size_t)j * 128 + 16 * nt] = (bf16)S.opend[nt * 4 + j]; }
}
DI void g2_step(Frame& F, const bf16* big, bf16* Hb, const bf16* At, const float* GL, int b, int h, int vq, int ch, const G2Regs& cur, G2Regs& ld, G2State& S, LAS bf16* St, LAS bf16* vnT, bool st) {
    constexpr int LS = 136, LV = 72;
    const int lane = F.lane, w = F.wave, r = lane & 15, quad = lane >> 4;
    if (ch > 0 && st) g2_store_o(S, Hb, b, h, vq, ch - 1, w, r, quad);
    if (ch + 1 < T / 64) g2_load(ld, big, Hb, At, GL, b, h, vq, ch + 1, w, r, quad);
    STG_T0();
    f32x4 ao[2];
    if (w < 4) { const int mt = w;
#pragma unroll
        for (int nt = 0; nt < 2; ++nt) { f32x4 av = (f32x4){0.f, 0.f, 0.f, 0.f}; ao[nt] = av;
#pragma unroll
            for (int kk = 0; kk < 4; ++kk) { const bf16x8 sf = *(const LAS bf16x8*)(St + (16 * nt + r) * LS + 32 * kk + 8 * quad); av = mfma16(cur.f[kk], sf, av); ao[nt] = mfma16(cur.f[4 + kk], sf, ao[nt]); }
            *(LAS v2u*)(vnT + (16 * nt + r) * LV + 16 * mt + 4 * quad) = (v2u){pk2(bflo(cur.u[nt * 4 + 0]) - av[0], bflo(cur.u[nt * 4 + 1]) - av[1]), pk2(bflo(cur.u[nt * 4 + 2]) - av[2], bflo(cur.u[nt * 4 + 3]) - av[3])}; }
    }
    STG(20);
    lds_barrier();
    STG(21);
    if (w < 4) {
#pragma unroll
        for (int nt = 0; nt < 2; ++nt) {
#pragma unroll
            for (int kk = 0; kk < 2; ++kk) ao[nt] = mfma16(cur.f[8 + kk], *(const LAS bf16x8*)(vnT + (16 * nt + r) * LV + 32 * kk + 8 * quad), ao[nt]);
#pragma unroll
            for (int j = 0; j < 4; ++j) S.opend[nt * 4 + j] = f2bf(ao[nt][j]); }
    } else { const int dg = w - 4;
#pragma unroll
        for (int i = 0; i < 2; ++i)
#pragma unroll
            for (int n2 = 0; n2 < 2; ++n2) { f32x4 a = S.accS[i][n2] * cur.gl;
#pragma unroll
                for (int kk = 0; kk < 2; ++kk) a = mfma16(cur.f[2 * i + kk], *(const LAS bf16x8*)(vnT + (16 * n2 + r) * LV + 32 * kk + 8 * quad), a);
                S.accS[i][n2] = a; *(LAS v2u*)(St + (16 * n2 + r) * LS + 32 * dg + 16 * i + 4 * quad) = (v2u){pk2(a[0], a[1]), pk2(a[2], a[3])}; }
    }
    STG(22);
    lds_barrier();
    STG(23);
    __builtin_amdgcn_sched_barrier(0);
}
DI void gdn_g2_chain(Frame& F, const bf16* big, bf16* Hb, const bf16* At, const float* GL, int c, bool st) {
    constexpr int LS = 136;
    const int b = c >> 5, h = (c >> 2) & 7, vq = c & 3;
    const int tid = F.tid, lane = F.lane, w = F.wave, r = lane & 15, quad = lane >> 4;
    LAS bf16* St = (LAS bf16*)F.lds;
    LAS bf16* vnT = St + 32 * LS;
    lds_barrier();
    for (int i = tid; i < 32 * LS / 2; i += NTHR) ((LAS unsigned*)St)[i] = 0u;
    G2State S;
#pragma unroll
    for (int i = 0; i < 2; ++i) { S.accS[i][0] = (f32x4){0.f, 0.f, 0.f, 0.f}; S.accS[i][1] = S.accS[i][0]; }
#pragma unroll
    for (int j = 0; j < 8; ++j) S.opend[j] = 0u;
    G2Regs R0, R1;
#pragma unroll
    for (int i = 0; i < 10; ++i) { R0.f[i] = (bf16x8){0, 0, 0, 0, 0, 0, 0, 0}; R1.f[i] = R0.f[i]; }
#pragma unroll
    for (int i = 0; i < 8; ++i) { R0.u[i] = 0u; R1.u[i] = 0u; }
    R0.gl = 0.f; R1.gl = 0.f;
    g2_load(R0, big, Hb, At, GL, b, h, vq, 0, w, r, quad);
    lds_barrier();
    for (int ch = 0; ch < T / 64; ch += 2) {
        g2_step(F, big, Hb, At, GL, b, h, vq, ch, R0, R1, S, St, vnT, st);
        g2_step(F, big, Hb, At, GL, b, h, vq, ch + 1, R1, R0, S, St, vnT, st);
    }
    if (st) g2_store_o(S, Hb, b, h, vq, T / 64 - 1, w, r, quad);
}
struct SbRegs { v4u k0, k1, v0, v1; };
DI void sb_load(SbRegs& R, const bf16* proj, int b, int h, int k0, int tid) {
    const size_t hb = (size_t)(b * 4 + h) * T + k0;
    const bf16* pk = proj + (size_t)M * 2048 + (hb + (tid >> 3)) * 128 + (tid & 7) * 16;
    R.k0 = *(const GAS v4u*)pk; R.k1 = *(const GAS v4u*)(pk + 8);
    const bf16* pv = proj + (size_t)M * 2560 + (hb + (tid & 63)) * 128 + (tid >> 6) * 16;
    R.v0 = *(const GAS v4u*)pv; R.v1 = *(const GAS v4u*)(pv + 8);
}
DI void sb_unit(Frame& F, const bf16* proj, bf16* mix, int u) {
    constexpr int LDV = 72, LDK = 136;
    const int qt = u & 63, h = (u >> 6) & 3, b = u >> 8;
    LAS bf16* Vt = (LAS bf16*)F.lds;
    LAS bf16* Ks = Vt + 128 * LDV;
    volatile LAS unsigned* flag = (volatile LAS unsigned*)(F.lds + MISC_OFF + 64);
    const int w = F.wave, lane = F.lane, r = lane & 15, quad = lane >> 4;
    const int t0 = qt * 128, qpos = t0 + 16 * w + r;
    const size_t rb = (size_t)b * T;
    bf16x8 qf[4];
#pragma unroll
    for (int kk = 0; kk < 4; ++kk) qf[kk] = *(const GAS bf16x8*)(proj + (size_t)M * 1536 + ((size_t)(b * 4 + h) * T + qpos) * 128 + 32 * kk + 8 * quad);
    f32x4 o[8];
#pragma unroll
    for (int i = 0; i < 8; ++i) o[i] = (f32x4){0.f, 0.f, 0.f, 0.f};
    float carry = 0.f;
    const float scale = 0.08838834764831845f;
    SbRegs R; sb_load(R, proj, b, h, (2 * qt + 1) * 64, F.tid);
    for (int kb = 2 * qt + 1; kb >= 0; --kb) {
        const int k0 = kb * 64;
        lds_barrier();
        { LAS bf16* kd = Ks + (F.tid >> 3) * LDK + (F.tid & 7) * 16; *(LAS v4u*)kd = R.k0; *(LAS v4u*)(kd + 8) = R.k1;
          const unsigned ww[8] = {R.v0.x, R.v0.y, R.v0.z, R.v0.w, R.v1.x, R.v1.y, R.v1.z, R.v1.w}; const int key = F.tid & 63, ds = (F.tid >> 6) * 16;
#pragma unroll
          for (int i = 0; i < 8; ++i) { Vt[(ds + 2 * i) * LDV + key] = (bf16)(ww[i] & 0xffffu); Vt[(ds + 2 * i + 1) * LDV + key] = (bf16)(ww[i] >> 16); } }
        if (F.tid == 0) flag[0] = 0u;
        if (kb > 0) sb_load(R, proj, b, h, k0 - 64, F.tid);
        lds_barrier();
        if (k0 < t0 + 16 * w + 15) {
            f32x4 s[4];
#pragma unroll
            for (int mt = 0; mt < 4; ++mt) { s[mt] = (f32x4){0.f, 0.f, 0.f, 0.f};
                const LAS bf16* kp = Ks + (16 * mt + r) * LDK + 8 * quad;
#pragma unroll
                for (int kk = 0; kk < 4; ++kk) s[mt] = mfma16(*(const LAS bf16x8*)(kp + 32 * kk), qf[kk], s[mt]); }
            float l1[4][4], tot[4];
#pragma unroll
            for (int mt = 0; mt < 4; ++mt) { tot[mt] = 0.f;
#pragma unroll
                for (int j = 0; j < 4; ++j) { const float z = s[mt][j] * scale; const bool valid = (k0 + 16 * mt + 4 * quad + j) < qpos;
                    const float tl = __logf(1.0f + __expf(-fabsf(z)));
                    l1[mt][j] = valid ? (fminf(-z, 0.f) - tl) : 0.f; s[mt][j] = valid ? (fminf(z, 0.f) - tl) : -1e30f; tot[mt] += l1[mt][j]; } }
            float run = carry;
#pragma unroll
            for (int mt = 3; mt >= 0; --mt) {
                const float t1 = __shfl_xor(tot[mt], 16), t2 = __shfl_xor(tot[mt], 32), t3 = __shfl_xor(t1, 32);
                float hi = 0.f;
                hi += ((quad ^ 1) > quad) ? t1 : 0.f; hi += ((quad ^ 2) > quad) ? t2 : 0.f; hi += ((quad ^ 3) > quad) ? t3 : 0.f;
                float acc = run + hi;
#pragma unroll
                for (int j = 3; j >= 0; --j) { const float e = s[mt][j] + acc; s[mt][j] = __expf(e); acc += l1[mt][j]; }
                run += (tot[mt] + t1) + (t2 + t3);
            }
            carry = run;
#pragma unroll
            for (int s2 = 0; s2 < 2; ++s2) {
                v4u pw; pw.x = pk2(s[2 * s2][0], s[2 * s2][1]); pw.y = pk2(s[2 * s2][2], s[2 * s2][3]); pw.z = pk2(s[2 * s2 + 1][0], s[2 * s2 + 1][1]); pw.w = pk2(s[2 * s2 + 1][2], s[2 * s2 + 1][3]);
                const bf16x8 pf = __builtin_bit_cast(bf16x8, pw);
#pragma unroll
                for (int dt = 0; dt < 8; ++dt) { const LAS bf16* vp = Vt + (16 * dt + r) * LDV + 32 * s2 + 4 * quad;
                    const s16x4 lo = *(const LAS s16x4*)vp, hi4 = *(const LAS s16x4*)(vp + 16);
                    o[dt] = mfma16(__builtin_shufflevector(lo, hi4, 0, 1, 2, 3, 4, 5, 6, 7), pf, o[dt]); }
            }
        }
        if (!(carry < -SB_THR)) flag[0] = 1u;
        lds_barrier();
        if (flag[0] == 0u) break;
    }
    bf16* op = mix + (rb + qpos) * D + 512 + h * 128 + 4 * quad;
#pragma unroll
    for (int dt = 0; dt < 8; ++dt) *(GAS v2u*)(op + 16 * dt) = (v2u){pk2(o[dt][0], o[dt][1]), pk2(o[dt][2], o[dt][3])};
}
struct XaRegs { v4u k[4], v[4]; };
DI void xa_load(XaRegs& R, const bf16* KV, int l, int b, int h, int c, int tid) {
    const bf16* pk = KV + (size_t)(b * MEMLEN + 64 * c + (tid >> 3)) * 8192 + 2048 * l + h * 256 + (tid & 7) * 32;
    const bf16* pv = KV + (size_t)(b * MEMLEN + 64 * c + (tid & 63)) * 8192 + 2048 * l + 1024 + h * 256 + (tid >> 6) * 32;
#pragma unroll
    for (int i = 0; i < 4; ++i) { R.k[i] = *(const GAS v4u*)(pk + 8 * i); R.v[i] = *(const GAS v4u*)(pv + 8 * i); }
}
DI void xattn_phase(Frame& F, const bf16* Q, const bf16* KV, int l, bf16* O) {
    constexpr int LDK = 264, LDV = 72, BUF = 64 * LDK + 256 * LDV;
    LAS bf16* lds = (LAS bf16*)F.lds;
    const int per = (2048 + F.G - 1) / F.G, u0 = F.wg * per, u1 = (u0 + per < 2048) ? u0 + per : 2048;
    if (u0 >= u1) return;
    const int w = F.wave, lane = F.lane, r = lane & 15, quad = lane >> 4, tid = F.tid;
    XaRegs R; xa_load(R, KV, l, (u0 >> 6) >> 2, (u0 >> 6) & 3, 0, tid);
    int step = 0;
    for (int u = u0; u < u1; ++u) {
        const int bh = u >> 6, qt = u & 63, b = bh >> 2, h = bh & 3;
        const size_t row = (size_t)b * T + qt * 128 + 16 * w + r;
        bf16x8 qf[8];
#pragma unroll
        for (int kk = 0; kk < 8; ++kk) qf[kk] = *(const GAS bf16x8*)(Q + row * D + h * 256 + 32 * kk + 8 * quad);
        f32x4 o[16];
#pragma unroll
        for (int i = 0; i < 16; ++i) o[i] = (f32x4){0.f, 0.f, 0.f, 0.f};
        float mrun = -1e30f, lsum = 0.f;
        for (int c = 0; c < 4; ++c, ++step) {
            LAS bf16* Kc = lds + (step & 1) * BUF; LAS bf16* Vt = Kc + 64 * LDK;
            { LAS bf16* kd = Kc + (tid >> 3) * LDK + (tid & 7) * 32;
#pragma unroll
              for (int i = 0; i < 4; ++i) *(LAS v4u*)(kd + 8 * i) = R.k[i];
              const int key = tid & 63, ds = (tid >> 6) * 32;
#pragma unroll
              for (int i = 0; i < 4; ++i) { const unsigned ww[4] = {R.v[i].x, R.v[i].y, R.v[i].z, R.v[i].w};
#pragma unroll
                  for (int e = 0; e < 4; ++e) { Vt[(ds + 8 * i + 2 * e) * LDV + key] = (bf16)(ww[e] & 0xffffu); Vt[(ds + 8 * i + 2 * e + 1) * LDV + key] = (bf16)(ww[e] >> 16); } } }
            lds_barrier();
            { const int un = (c == 3) ? u + 1 : u;
              if (un < u1) xa_load(R, KV, l, (un >> 6) >> 2, (un >> 6) & 3, (c + 1) & 3, tid); }
            f32x4 s[4];
#pragma unroll
            for (int mt = 0; mt < 4; ++mt) { s[mt] = (f32x4){0.f, 0.f, 0.f, 0.f};
                const LAS bf16* kp = Kc + (16 * mt + r) * LDK + 8 * quad;
#pragma unroll
                for (int kk = 0; kk < 8; ++kk) s[mt] = mfma16(*(const LAS bf16x8*)(kp + 32 * kk), qf[kk], s[mt]); }
            float mx = -1e30f;
#pragma unroll
            for (int mt = 0; mt < 4; ++mt) mx = fmaxf(fmaxf(fmaxf(s[mt][0], s[mt][1]), fmaxf(s[mt][2], s[mt][3])), mx);
            mx = fmaxf(mx, __shfl_xor(mx, 16)); mx = fmaxf(mx, __shfl_xor(mx, 32));
            const float mnew = fmaxf(mrun, mx), alpha = __expf((mrun - mnew) * 0.0625f); mrun = mnew;
            float ps = 0.f;
#pragma unroll
            for (int mt = 0; mt < 4; ++mt)
#pragma unroll
                for (int j = 0; j < 4; ++j) { const float p = __expf((s[mt][j] - mnew) * 0.0625f); s[mt][j] = p; ps += p; }
            lsum = lsum * alpha + ps;
#pragma unroll
            for (int i = 0; i < 16; ++i) o[i] = o[i] * alpha;
#pragma unroll
            for (int s2 = 0; s2 < 2; ++s2) {
                v4u pw; pw.x = pk2(s[2 * s2][0], s[2 * s2][1]); pw.y = pk2(s[2 * s2][2], s[2 * s2][3]); pw.z = pk2(s[2 * s2 + 1][0], s[2 * s2 + 1][1]); pw.w = pk2(s[2 * s2 + 1][2], s[2 * s2 + 1][3]);
                const bf16x8 pf = __builtin_bit_cast(bf16x8, pw);
#pragma unroll
                for (int dt = 0; dt < 16; ++dt) { const LAS bf16* vp = Vt + (16 * dt + r) * LDV + 32 * s2 + 4 * quad;
                    const s16x4 lo = *(const LAS s16x4*)vp, hi4 = *(const LAS s16x4*)(vp + 16);
                    o[dt] = mfma16(__builtin_shufflevector(lo, hi4, 0, 1, 2, 3, 4, 5, 6, 7), pf, o[dt]); }
            }
        }
        lsum += __shfl_xor(lsum, 16); lsum += __shfl_xor(lsum, 32);
        const float inv = rcp_(lsum);
        bf16* op = O + row * D + h * 256 + 4 * quad;
#pragma unroll
        for (int dt = 0; dt < 16; ++dt) *(GAS v2u*)(op + 16 * dt) = (v2u){pk2(o[dt][0] * inv, o[dt][1] * inv), pk2(o[dt][2] * inv, o[dt][3] * inv)};
    }
    lds_barrier();
}
template <class Epi> DI void run_gemm(Frame& F, const bf16* A, const bf16* Bt, int M_, int N_, int K_, const Epi& E) {
    pg8::Gemm g{A, Bt, M_, N_, K_}; pg8::StaticOrder S; S.init(M_, N_, F.G, F.wg);
    pg8::gemm_phase<Epi, pg8::StaticOrder, PG8_ALIGN, PG8_SP2>(F.lds, g, S, E, F.tid);
}
constexpr int NPHASE = 43, PH_FINAL = 42, PPL = 10;
constexpr int SB_N1 = 512, SB_N2 = 1280;
struct Args { In in; float* out; unsigned char* ws; int ph_lo, ph_hi, region, pad; };
__global__ void __launch_bounds__(NTHR, 2) fwd(Args a) {
    extern __shared__ __attribute__((aligned(16))) unsigned char lds_raw[];
    Frame F;
    F.lds = (LAS unsigned char*)lds_raw;
    F.tid = threadIdx.x; F.lane = F.tid & 63; F.wave = __builtin_amdgcn_readfirstlane(F.tid >> 6);
    F.G = gridDim.x; F.wg = blockIdx.x; F.gw = F.wg * NWAVES + F.wave; F.NGW = F.G * NWAVES;
    volatile LAS unsigned* MISC = (volatile LAS unsigned*)(F.lds + MISC_OFF);
    if (F.tid < 32) MISC[F.tid] = 0u;
    __syncthreads();
    const int lo = a.ph_lo, hi = a.ph_hi;
    unsigned char* ws = a.ws; const In& I = a.in;
    XcdBarrier bar; bar.bar = (unsigned*)(ws + WS_CTL) + CW_BAR + a.region * XCD_BAR_WORDS; bar.x = 0; bar.st = MISC + 8;
    if (hi - lo > 1) bar = xcd_barrier_post(bar.bar, MISC + 8);
#define IN(k) (lo <= (k) && (k) < hi)
#ifndef PROBE_DOUBLE
#define PROBE_DOUBLE -1
#endif
#ifndef PROBE_PAR
#define PROBE_PAR -1
#endif
#define PHASE(k) asm volatile("" : "+v"(F.tid)); F.lane = F.tid & 63; if (IN(k))
#define DUPQ(c) ((c) == PROBE_DOUBLE && (PROBE_PAR < 0 || (l & 1) == PROBE_PAR))
#ifndef PROBE_SEL
#define PROBE_SEL -1
#endif
    F.tacc = 0ull;
    unsigned long long tacc = 0ull, tlast = (PROBE_SEL >= 0) ? __builtin_amdgcn_s_memrealtime() : 0ull;
#define SELQ(k) ((PROBE_SEL >= 0 && PROBE_SEL <= 12) ? ((k) >= 2 && (k) < PH_FINAL && ((k) - 2) % PPL == PROBE_SEL && (PROBE_PAR < 0 || ((((k) - 2) / PPL) & 1) == PROBE_PAR)) : (PROBE_SEL == 101 ? (k) == 0 : (PROBE_SEL == 102 ? (k) == 1 : (PROBE_SEL == 103 ? (k) == PH_FINAL : false))))
#define SEAM(k) do { if (IN(k) && IN((k) + 1)) { \
        if (PROBE_SEL >= 0) { const unsigned long long tn_ = __builtin_amdgcn_s_memrealtime(); if (SELQ(k)) tacc += tn_ - tlast; tlast = tn_; } \
        xcd_barrier(bar); \
        if (PROBE_SEL >= 0) { const unsigned long long tn_ = __builtin_amdgcn_s_memrealtime(); if (PROBE_SEL == 100 || (PROBE_SEL >= 200 && (k) >= 2 && (k) < PH_FINAL && ((k) - 2) % PPL == PROBE_SEL - 200 && (PROBE_PAR < 0 || ((((k) - 2) / PPL) & 1) == PROBE_PAR))) tacc += tn_ - tlast; tlast = tn_; } } } while (0)
    bf16* XS = (bf16*)(ws + WS_H); unsigned char* mixb = (unsigned char*)a.out; bf16* MIX = (bf16*)mixb; unsigned char* scrb = mixb + 128 * MiB; bf16* SCR = (bf16*)scrb;
    bf16* BIG = (bf16*)(ws + WS_BIG); bf16* KVX = (bf16*)(ws + WS_KVX);
    float* GATE = (float*)(ws + WS_GATE); const bf16* WG = (const bf16*)(ws + WS_WG);

    PHASE(0) { p0_prologue(F, I, ws);
#ifdef PROBE_P0
        p0_prologue(F, I, ws);
#endif
    }
    SEAM(0);
    PHASE(1) run_gemm(F, (const bf16*)(ws + WS_MEMN), (const bf16*)(ws + WS_WKV), BATCH * MEMLEN, 8192, D, pg8::EpiBf16<0>{KVX, 8192, nullptr});
    SEAM(1);
    pg8::rs_t* RSA = (pg8::rs_t*)(ws + WS_RS);
#define RS_R(p) (RSA + (size_t)((p) & 1) * M)
#define RS_ZERO(p) do { pg8::rs_t* z_ = RSA + (size_t)(((p) + 1) & 1) * M; for (int i_ = F.wg * NTHR + F.tid; i_ < M; i_ += F.G * NTHR) __hip_atomic_store(z_ + i_, (pg8::rs_t)0, __ATOMIC_RELAXED, __HIP_MEMORY_SCOPE_AGENT); } while (0)
    for (int l = 0; l < DEPTH; ++l) {
        asm volatile("" : "+v"(F.tid)); F.lane = F.tid & 63;
        const int pb = 2 + PPL * l, j = l >> 1; const bool odd = (l & 1) != 0;
        unsigned char* wl = ws + WS_W + (size_t)l * W_LAYER;
        PHASE(pb + 0) { const int n = odd ? C_N : AB_N;
            run_gemm(F, XS, (const bf16*)(wl + WO_WIN), M, n, D, pg8::EpiBlk{BIG, odd ? (bf16*)(mixb + MIX_HALO) : nullptr, odd ? 2 : 1, RS_R(3 * l)});
            if (DUPQ(0)) { run_gemm(F, XS, (const bf16*)(wl + WO_WIN), M, n, D, pg8::EpiBlk{BIG, odd ? (bf16*)(mixb + MIX_HALO) : nullptr, odd ? 2 : 1, RS_R(3 * l)}); }
            if (!odd) gates_phase<1>(F, XS, RS_R(3 * l), WG + l * 16384, GATE, I.p[4] + j * 4, I.p[5] + j * 4);
            else gates_phase<2>(F, XS, RS_R(3 * l), WG + l * 16384, GATE, I.p[10] + j * 8, I.p[11] + j * 8);
        }
        SEAM(pb + 0);
        PHASE(pb + 1) {
            if (!odd) {
                mlstm_a_phase(F, BIG, GATE, (bf16*)(scrb + H_NUML), (bf16*)(scrb + H_DC), (float*)(ws + WS_MLS));
                for (int u = F.wg; u < SB_N1; u += F.G) sb_unit(F, BIG, MIX, u);
            } else {
                gdn_g1_phase(F, BIG, (const bf16*)(mixb + MIX_HALO), GATE, I.p[9] + (size_t)j * 4 * 3072, SCR, (bf16*)(mixb + MIX_AT), (float*)(mixb + MIX_GL), true);
            }
        }
        SEAM(pb + 1);
        PHASE(pb + 2) {
            if (odd) { for (int c = F.wg; c < 256; c += F.G) gdn_g2_chain(F, BIG, SCR, (const bf16*)(mixb + MIX_AT), (const float*)(mixb + MIX_GL), c, true); }
            else { mlstm_b_phase(F, (bf16*)(scrb + H_DC), (float*)(ws + WS_MLS)); for (int u = SB_N1 + F.wg; u < SB_N2; u += F.G) sb_unit(F, BIG, MIX, u); }
        }
        SEAM(pb + 2);
        PHASE(pb + 3) {
            if (odd) headnorm_phase<true>(F, SCR, MIX, BIG, I.p[12] + j * 128);
            else { mlstm_c_phase(F, BIG, (const bf16*)(scrb + H_NUML), (const bf16*)(scrb + H_DC), (const float*)(ws + WS_MLS), I.p[6] + j * 512, MIX); for (int u = SB_N2 + F.wg; u < 2048; u += F.G) sb_unit(F, BIG, MIX, u); }
        }
        SEAM(pb + 3);
        PHASE(pb + 4) { RS_ZERO(3 * l + 1); run_gemm(F, MIX, (const bf16*)(wl + WO_WOUT), M, D, D, pg8::EpiResidB{XS, RS_R(3 * l + 1)}); }
        SEAM(pb + 4);
        PHASE(pb + 5) { run_gemm(F, XS, (const bf16*)(wl + WO_WQ), M, D, D, pg8::EpiBf16<0>{BIG, D, RS_R(3 * l + 1)}); if (DUPQ(5)) { run_gemm(F, XS, (const bf16*)(wl + WO_WQ), M, D, D, pg8::EpiBf16<0>{BIG, D, RS_R(3 * l + 1)}); } }
        SEAM(pb + 5);
        PHASE(pb + 6) { xattn_phase(F, BIG, KVX, l, MIX); if (DUPQ(6)) { xattn_phase(F, BIG, KVX, l, MIX); } }
        SEAM(pb + 6);
        PHASE(pb + 7) { RS_ZERO(3 * l + 2); run_gemm(F, MIX, (const bf16*)(wl + WO_WO), M, D, D, pg8::EpiResidB{XS, RS_R(3 * l + 2)}); }
        SEAM(pb + 7);
        PHASE(pb + 8) { run_gemm(F, XS, (const bf16*)(wl + WO_W1), M, FF, D, pg8::EpiBf16<2>{BIG, FF, RS_R(3 * l + 2)}); if (DUPQ(8)) { run_gemm(F, XS, (const bf16*)(wl + WO_W1), M, FF, D, pg8::EpiBf16<2>{BIG, FF, RS_R(3 * l + 2)}); } }
        SEAM(pb + 8);
        PHASE(pb + 9) { RS_ZERO(3 * l + 3); run_gemm(F, BIG, (const bf16*)(wl + WO_W2), M, D, FF, pg8::EpiResidB{XS, RS_R(3 * l + 3)}); }
        SEAM(pb + 9);
    }
    PHASE(PH_FINAL) final_norm_phase(F, XS, a.out, I.p[23]);
    if (PROBE_SEL >= 0) { const unsigned long long te = __builtin_amdgcn_s_memrealtime(); if (SELQ(PH_FINAL)) tacc += te - tlast;

#ifdef PROBE_WGLO
        if (!(F.wg >= PROBE_WGLO && F.wg < PROBE_WGHI)) tacc = 0ull;
#endif
        if (PROBE_STG >= 0) tacc = F.tacc;
        while (__builtin_amdgcn_s_memrealtime() - te < tacc) __builtin_amdgcn_s_sleep(16); }
#undef IN
#undef PHASE
#undef SEAM
}

#ifndef MK_SPLIT
#define MK_SPLIT 0
#endif
extern "C" void kernel_launch(void* const* d_in, const int* in_sizes, int n_in, void* d_out, int out_size, void* d_ws, size_t ws_size, hipStream_t stream) {
    static int grid = 0;
    if (grid == 0) {
        if (n_in != 24 || in_sizes[0] != M * D || out_size != M * D || ws_size < WS_END) { fprintf(stderr, "kernel_launch: unexpected shapes (n_in %d, in0 %d, out %d, ws %zu)\n", n_in, n_in > 0 ? in_sizes[0] : -1, out_size, ws_size); grid = -1; return; }
        int dev = 0, cus = 0;
        if (hipGetDevice(&dev) != hipSuccess || hipDeviceGetAttribute(&cus, hipDeviceAttributeMultiprocessorCount, dev) != hipSuccess) { grid = -1; return; }
        if (hipFuncSetAttribute((const void*)fwd, hipFuncAttributeMaxDynamicSharedMemorySize, LDS_BYTES) != hipSuccess) { fprintf(stderr, "kernel_launch: hipFuncSetAttribute failed\n"); grid = -1; return; }
        (void)hipGetLastError();
        grid = cus;
    }
    if (grid < 0) return;
    (void)hipMemsetAsync((char*)d_ws + WS_CTL, 0, CTL_ZERO_BYTES, stream);
    Args a{};
    for (int i = 0; i < 24; ++i) a.in.p[i] = (const float*)d_in[i];
    a.out = (float*)d_out; a.ws = (unsigned char*)d_ws; a.region = 0; a.pad = 0;
#if MK_SPLIT
    for (int p = 0; p < NPHASE; ++p) { a.ph_lo = p; a.ph_hi = p + 1; hipLaunchKernelGGL(fwd, dim3(grid), dim3(NTHR), LDS_BYTES, stream, a); }
#else
    a.ph_lo = 0; a.ph_hi = NPHASE; hipLaunchKernelGGL(fwd, dim3(grid), dim3(NTHR), LDS_BYTES, stream, a);
#endif
}
```

```cpp
#include <hip/hip_runtime.h>
#include <cstdio>
#include <cstdint>
namespace pg8 {
#define PG8_LAS __attribute__((address_space(3)))
typedef unsigned short bf16_t;
typedef short bf16x8 __attribute__((ext_vector_type(8)));
typedef float f32x4 __attribute__((ext_vector_type(4)));
typedef unsigned u32x4 __attribute__((ext_vector_type(4)));
constexpr int BM = 256, BK = 64, HALF = 128, HTB = HALF * BK * 2  , STAGE_BYTES = 8 * HTB, NXCD = 8, WGM = 8;

__host__ __device__ __forceinline__ int lds_byte(int r, int c) { const int st = (r >> 4) * 2 + (c >> 5), rr = r & 15, cc = c & 31, ob = rr * 64 + cc * 2; return st * 1024 + (ob ^ (((ob >> 9) & 1) << 5)); }
__host__ __device__ __forceinline__ void stage_rc(int b, int& R, int& C) { const int st = b / 1024, sb = b % 1024, swz = sb ^ (((sb >> 9) & 1) << 5); R = (st >> 1) * 16 + swz / 64; C = (st & 1) * 32 + (swz % 64) / 2; }
__host__ __device__ __forceinline__ int perm32(int rho) { const int n = rho >> 4, i = rho & 15; return 8 * (i >> 2) + 4 * n + (i & 3); }

struct Unit { int pm, pn; };
struct Gemm { const bf16_t* A; const bf16_t* Bt; int M, N, K; };

struct StaticOrder {
    int nM, nN, nwg, G, c;
    __host__ __device__ void init(int M, int N, int G_, int c_) { nM = M / BM; nN = N / BM; nwg = nM * nN; G = G_; c = c_; }
    __host__ __device__ bool next(int i, Unit& u) const {
        const long L = (long)i * G + c; if (L >= nwg) return false;
        int wgid = (int)L; { const int q = nwg / NXCD, r = nwg % NXCD, xcd = wgid % NXCD, off = wgid / NXCD; wgid = (xcd < r ? xcd * (q + 1) : r * (q + 1) + (xcd - r) * q) + off; }
        const int nig = WGM * nN, gid = wgid / nig, fm = gid * WGM, gsz = (nM - fm) < WGM ? (nM - fm) : WGM;
        u.pm = fm + ((wgid % nig) % gsz); u.pn = (wgid % nig) / gsz; return true;
    }
    __device__ __forceinline__ void a_ready(const Unit&) const {}
    __device__ __forceinline__ void done(const Unit&) const {}
};

__device__ __forceinline__ unsigned cvt_pk_bf16(float lo, float hi) { unsigned r; asm volatile("v_cvt_pk_bf16_f32 %0, %1, %2" : "=v"(r) : "v"(lo), "v"(hi)); return r; }
typedef unsigned long long rs_t;
__device__ __forceinline__ rs_t rs_fix(float ss) { return (rs_t)(ss * 16777216.0f + 0.5f); }
__device__ __forceinline__ float row_rstd(const rs_t* rs, int row) { return __builtin_amdgcn_rsqf((float)__hip_atomic_load(rs + row, __ATOMIC_RELAXED, __HIP_MEMORY_SCOPE_AGENT) * (1.0f / (16777216.0f * 1024.0f)) + 1e-6f); }
template <int ACT> struct EpiBf16 {
    static constexpr bool PERM = true, AFTER_DRAIN = false;
    bf16_t* O; int ldc; const rs_t* rs;
    __device__ __forceinline__ void operator()(const f32x4 (&acc)[2][2][4][2], const Unit& u, int wr, int wc, int fr, int fq) const {
        const int row0 = u.pm * BM + wr * 64 + fr; const int col0 = u.pn * BM + wc * 32 + 8 * fq;
#pragma unroll
        for (int ai = 0; ai < 2; ++ai)
#pragma unroll
            for (int m = 0; m < 4; ++m) { bf16_t* rowp = O + (size_t)(row0 + ai * HALF + m * 16) * ldc + col0;
                const float sc = rs ? row_rstd(rs, row0 + ai * HALF + m * 16) : 1.0f;
#pragma unroll
                for (int bj = 0; bj < 2; ++bj) { f32x4 v0 = acc[ai][bj][m][0] * sc, v1 = acc[ai][bj][m][1] * sc;
                    if (ACT == 2) {
#pragma unroll
                        for (int j = 0; j < 4; ++j) { const float a = fmaxf(v0[j], 0.f), b = fmaxf(v1[j], 0.f); v0[j] = a * a; v1[j] = b * b; } }
                    u32x4 w; w.x = cvt_pk_bf16(v0[0], v0[1]); w.y = cvt_pk_bf16(v0[2], v0[3]); w.z = cvt_pk_bf16(v1[0], v1[1]); w.w = cvt_pk_bf16(v1[2], v1[3]);
                    *(u32x4*)(rowp + bj * HALF) = w; }
                if (m & 1) asm volatile("" ::: "memory"); }
    }
};

struct EpiBlk {
    static constexpr bool PERM = true, AFTER_DRAIN = false;
    bf16_t* O; bf16_t* halo; int LAYOUT; const rs_t* rs;
    __device__ __forceinline__ void operator()(const f32x4 (&acc)[2][2][4][2], const Unit& u, int wr, int wc, int fr, int fq) const {
        constexpr int TT = 8192; constexpr size_t MTOT = 65536;
        const int row0 = u.pm * BM + wr * 64 + fr; const int b = row0 >> 13, t0 = row0 & (TT - 1);
        const int col0 = u.pn * BM + wc * 32 + 8 * fq;
        const bool dohalo = (LAYOUT == 2) && (halo != nullptr) && (fr >= 13) && (u.pn < 12);
        size_t base[2]; int wv[2];
#pragma unroll
        for (int bj = 0; bj < 2; ++bj) {
            const int cb = u.pn * BM + bj * HALF + wc * 32;
            if (LAYOUT == 2) { const int c0 = cb & ~1023, h = (cb >> 7) & 7; wv[bj] = 128; base[bj] = MTOT * c0 + (size_t)((b * 8 + h) * TT) * 128 + (cb & 127) + 8 * fq; }
            else if (cb < 512) { const int c0 = cb & ~255, h = (cb >> 6) & 3; wv[bj] = 64; base[bj] = MTOT * c0 + (size_t)((b * 4 + h) * TT) * 64 + (cb & 63) + 8 * fq; }
            else { const int c0 = 512 + ((cb - 512) & ~511), h = ((cb - 512) >> 7) & 3; wv[bj] = 128; base[bj] = MTOT * c0 + (size_t)((b * 4 + h) * TT) * 128 + (cb & 127) + 8 * fq; }
        }
#pragma unroll
        for (int ai = 0; ai < 2; ++ai)
#pragma unroll
            for (int m = 0; m < 4; ++m) { const int t = t0 + ai * HALF + m * 16; const float sc = row_rstd(rs, row0 + ai * HALF + m * 16);
#pragma unroll
                for (int bj = 0; bj < 2; ++bj) {
                    const f32x4 v0 = acc[ai][bj][m][0] * sc, v1 = acc[ai][bj][m][1] * sc;
                    u32x4 ww; ww.x = cvt_pk_bf16(v0[0], v0[1]); ww.y = cvt_pk_bf16(v0[2], v0[3]); ww.z = cvt_pk_bf16(v1[0], v1[1]); ww.w = cvt_pk_bf16(v1[2], v1[3]);
                    *(u32x4*)(O + base[bj] + (size_t)t * wv[bj]) = ww;
                    if (m == 3 && dohalo) *(u32x4*)(halo + ((size_t)((row0 + ai * HALF + 48) >> 6) * 3 + (fr - 13)) * 3072 + col0 + bj * HALF) = ww; }
                if (m & 1) asm volatile("" ::: "memory"); }
    }
};
struct EpiResidB {
    static constexpr bool PERM = false, AFTER_DRAIN = false;
    bf16_t* xs; rs_t* rs;
    __device__ __forceinline__ void operator()(const f32x4 (&acc)[2][2][4][2], const Unit& u, int wr, int wc, int fr, int fq) const {
        typedef unsigned u32x2_ __attribute__((ext_vector_type(2)));
        const int row0 = u.pm * BM + wr * 64 + fr, col0 = u.pn * BM + wc * 32 + 4 * fq;
#pragma unroll
        for (int ai = 0; ai < 2; ++ai) {
            u32x2_ old[4][2][2];
#pragma unroll
            for (int m = 0; m < 4; ++m) { const bf16_t* p = xs + (size_t)(row0 + ai * HALF + m * 16) * 1024 + col0;
#pragma unroll
                for (int bj = 0; bj < 2; ++bj)
#pragma unroll
                    for (int n = 0; n < 2; ++n) old[m][bj][n] = *(const u32x2_*)(p + bj * HALF + n * 16); }
#pragma unroll
            for (int m = 0; m < 4; ++m) { const int row = row0 + ai * HALF + m * 16; bf16_t* p = xs + (size_t)row * 1024 + col0; float ss = 0.f;
#pragma unroll
                for (int bj = 0; bj < 2; ++bj)
#pragma unroll
                    for (int n = 0; n < 2; ++n) { const u32x2_ b = old[m][bj][n]; const f32x4 a = acc[ai][bj][m][n];
                        u32x2_ w; w.x = cvt_pk_bf16(__uint_as_float(b.x << 16) + a[0], __uint_as_float(b.x & 0xffff0000u) + a[1]); w.y = cvt_pk_bf16(__uint_as_float(b.y << 16) + a[2], __uint_as_float(b.y & 0xffff0000u) + a[3]);
                        *(u32x2_*)(p + bj * HALF + n * 16) = w;
                        const float r0 = __uint_as_float(w.x << 16), r1 = __uint_as_float(w.x & 0xffff0000u), r2 = __uint_as_float(w.y << 16), r3 = __uint_as_float(w.y & 0xffff0000u);
                        ss += (r0 * r0 + r1 * r1) + (r2 * r2 + r3 * r3); }
                ss += __shfl_xor(ss, 16); ss += __shfl_xor(ss, 32);
                if (fq == 0) __hip_atomic_fetch_add(rs + row, rs_fix(ss), __ATOMIC_RELAXED, __HIP_MEMORY_SCOPE_AGENT); }
            asm volatile("" ::: "memory");
        }
    }
};
template <class Epi, class Sched, bool ALIGN_EPI = false, bool SP2 = false>
__device__ __forceinline__ void gemm_phase(PG8_LAS unsigned char* lds, const Gemm g, const Sched& S, const Epi& E, int tid_in) {
    int tid_ = tid_in; asm volatile("" : "+v"(tid_)); const int tid = tid_, wid = __builtin_amdgcn_readfirstlane(tid >> 6), lane = tid & 63, wr = wid >> 2, wc = wid & 3, fr = lane & 15, fq = lane >> 4;
    const int K = g.K, nt = K / BK;
    unsigned voffA[2], voffB[2];
#pragma unroll
    for (int i = 0; i < 2; ++i) { int R, C; stage_rc(tid * 16 + i * 8192, R, C); const int Rb = Epi::PERM ? ((R & ~31) + perm32(R & 31)) : R;
        voffA[i] = (unsigned)(R * K + C) * 2u; voffB[i] = (unsigned)(Rb * K + C) * 2u; }
    const size_t kstep = (size_t)(BK * 2);
    const size_t hstep = (size_t)HALF * K * 2;
    const size_t tstep = 2 * hstep;
    const unsigned ldsw = (unsigned)wid * 1024u;
    const int aoff = lds_byte(wr * 64 + fr, fq * 8), boff = lds_byte(wc * 32 + fr, fq * 8);
#define PG8_SA(b, h) (((b) * 2 + (h)) * HTB)
#define PG8_SB(b, h) ((4 + (b) * 2 + (h)) * HTB)
#define PG8_STAGE(bufoff, gbase, voff) do { _Pragma("unroll") for (int _i = 0; _i < 2; ++_i) \
        __builtin_amdgcn_global_load_lds((const unsigned*)((const char*)(gbase) + (voff)[_i]), (PG8_LAS unsigned*)(lds + (bufoff) + ldsw + _i * 8192), 16, 0, 0); } while (0)
#define PG8_LDA(dst, b, h) do { _Pragma("unroll") for (int m = 0; m < 4; ++m) _Pragma("unroll") for (int k = 0; k < 2; ++k) dst[m][k] = *(const PG8_LAS bf16x8*)(lds + PG8_SA(b, h) + aoff + m * 2048 + k * 1024); } while (0)
#define PG8_LDB(dst, b, h) do { _Pragma("unroll") for (int n = 0; n < 2; ++n) _Pragma("unroll") for (int k = 0; k < 2; ++k) dst[n][k] = *(const PG8_LAS bf16x8*)(lds + PG8_SB(b, h) + boff + n * 2048 + k * 1024); } while (0)
#define PG8_MMA(ai, bj, At, Bt) do { __builtin_amdgcn_s_setprio(1); _Pragma("unroll") for (int m = 0; m < 4; ++m) _Pragma("unroll") for (int n = 0; n < 2; ++n) _Pragma("unroll") for (int k = 0; k < 2; ++k) \
        acc[ai][bj][m][n] = __builtin_amdgcn_mfma_f32_16x16x32_bf16(Bt[n][k], At[m][k], acc[ai][bj][m][n], 0, 0, 0); __builtin_amdgcn_s_setprio(0); } while (0)
#define PG8_WAIT_V(n) asm volatile("s_waitcnt vmcnt(" #n ")" ::: "memory")
#define PG8_WAIT_L(n) asm volatile("s_waitcnt lgkmcnt(" #n ")" ::: "memory")
#define PG8_BAR __builtin_amdgcn_s_barrier()
#define PG8_SCHED __builtin_amdgcn_sched_barrier(0)
    Unit cur, nxt; int ui = 0;
    if (!S.next(0, cur)) return;
    f32x4 acc[2][2][4][2];
#pragma unroll
    for (int a = 0; a < 2; ++a)
#pragma unroll
        for (int b = 0; b < 2; ++b)
#pragma unroll
            for (int m = 0; m < 4; ++m)
#pragma unroll
                for (int n = 0; n < 2; ++n) acc[a][b][m][n] = (f32x4){0.f, 0.f, 0.f, 0.f};
    bf16x8 At[4][2], B0[2][2], B1[2][2];
    const char* cA = (const char*)g.A + (size_t)cur.pm * tstep; const char* cB = (const char*)g.Bt + (size_t)cur.pn * tstep;
    S.a_ready(cur);
    if constexpr (SP2) {
        PG8_STAGE(PG8_SB(0, 0), cB, voffB); PG8_STAGE(PG8_SB(0, 1), cB + hstep, voffB); PG8_STAGE(PG8_SA(0, 0), cA, voffA); PG8_STAGE(PG8_SA(0, 1), cA + hstep, voffA);
        if (wr == 1) PG8_BAR;
        PG8_WAIT_V(2); PG8_BAR;
        PG8_STAGE(PG8_SB(1, 0), cB + kstep, voffB); PG8_STAGE(PG8_SA(1, 0), cA + kstep, voffA); PG8_STAGE(PG8_SB(1, 1), cB + hstep + kstep, voffB);
        PG8_WAIT_V(6); PG8_BAR;
    } else {
        PG8_STAGE(PG8_SB(0, 0), cB, voffB); PG8_STAGE(PG8_SA(0, 0), cA, voffA); PG8_STAGE(PG8_SB(0, 1), cB + hstep, voffB); PG8_STAGE(PG8_SA(0, 1), cA + hstep, voffA);
        if (wr == 1) PG8_BAR;
        PG8_WAIT_V(4); PG8_BAR;
        PG8_STAGE(PG8_SB(1, 0), cB + kstep, voffB); PG8_STAGE(PG8_SA(1, 0), cA + kstep, voffA); PG8_STAGE(PG8_SB(1, 1), cB + hstep + kstep, voffB);
        PG8_WAIT_V(6); PG8_BAR;
    }
    for (;;) {
        const bool has_next = S.next(ui + 1, nxt);
        const char* nA = has_next ? (const char*)g.A + (size_t)nxt.pm * tstep : cA; const char* nB = has_next ? (const char*)g.Bt + (size_t)nxt.pn * tstep : cB;
        for (int t = 0; t < nt; t += 2) {
            const bool last = (t == nt - 2);
            const char* a1 = cA + (size_t)(t + 1) * kstep;
            const char* a2 = last ? nA : cA + (size_t)(t + 2) * kstep; const char* b2 = last ? nB : cB + (size_t)(t + 2) * kstep;
            const char* a3 = a2 + kstep; const char* b3 = b2 + kstep;
            if (last && has_next) S.a_ready(nxt);
            if constexpr (SP2) {
            PG8_LDB(B0, 0, 0); PG8_LDB(B1, 0, 1); PG8_SCHED; PG8_LDA(At, 0, 0); PG8_STAGE(PG8_SA(1, 1), a1 + hstep, voffA);
            PG8_WAIT_V(8); PG8_WAIT_L(0); PG8_BAR; PG8_MMA(0, 0, At, B0); PG8_MMA(0, 1, At, B1); PG8_BAR; PG8_SCHED;
            PG8_LDA(At, 0, 1); PG8_STAGE(PG8_SB(0, 0), b2, voffB); PG8_STAGE(PG8_SB(0, 1), b2 + hstep, voffB); PG8_STAGE(PG8_SA(0, 0), a2, voffA);
            PG8_WAIT_V(8); PG8_WAIT_L(0); PG8_BAR; PG8_MMA(1, 0, At, B0); PG8_MMA(1, 1, At, B1); PG8_BAR; PG8_SCHED;
            PG8_LDB(B0, 1, 0); PG8_LDB(B1, 1, 1); PG8_SCHED; PG8_LDA(At, 1, 0); PG8_STAGE(PG8_SA(0, 1), a2 + hstep, voffA);
            PG8_WAIT_V(8); PG8_WAIT_L(0); PG8_BAR; PG8_MMA(0, 0, At, B0); PG8_MMA(0, 1, At, B1); PG8_BAR; PG8_SCHED;
            PG8_LDA(At, 1, 1); PG8_STAGE(PG8_SB(1, 0), b3, voffB); PG8_STAGE(PG8_SB(1, 1), b3 + hstep, voffB); PG8_STAGE(PG8_SA(1, 0), a3, voffA);
            PG8_WAIT_V(8); PG8_WAIT_L(0); PG8_BAR; PG8_MMA(1, 0, At, B0); PG8_MMA(1, 1, At, B1); PG8_BAR; PG8_SCHED;
            } else {
            PG8_LDB(B0, 0, 0); PG8_SCHED; PG8_LDA(At, 0, 0); PG8_STAGE(PG8_SA(1, 1), a1 + hstep, voffA);
            PG8_WAIT_L(8); PG8_BAR; PG8_WAIT_L(0); PG8_MMA(0, 0, At, B0); PG8_BAR; PG8_SCHED;
            PG8_LDB(B1, 0, 1); PG8_STAGE(PG8_SB(0, 0), b2, voffB);
            PG8_BAR; PG8_WAIT_L(0); PG8_MMA(0, 1, At, B1); PG8_BAR;
            PG8_LDA(At, 0, 1); PG8_STAGE(PG8_SA(0, 0), a2, voffA);
            PG8_BAR; PG8_WAIT_L(0); PG8_MMA(1, 0, At, B0); PG8_BAR; PG8_SCHED;
            PG8_STAGE(PG8_SB(0, 1), b2 + hstep, voffB);
            PG8_WAIT_V(6); PG8_BAR; PG8_MMA(1, 1, At, B1); PG8_BAR;
            PG8_LDB(B0, 1, 0); PG8_SCHED; PG8_LDA(At, 1, 0); PG8_STAGE(PG8_SA(0, 1), a2 + hstep, voffA);
            PG8_WAIT_L(8); PG8_BAR; PG8_WAIT_L(0); PG8_MMA(0, 0, At, B0); PG8_BAR; PG8_SCHED;
            PG8_LDB(B1, 1, 1); PG8_STAGE(PG8_SB(1, 0), b3, voffB);
            PG8_BAR; PG8_WAIT_L(0); PG8_MMA(0, 1, At, B1); PG8_BAR;
            PG8_LDA(At, 1, 1); PG8_STAGE(PG8_SA(1, 0), a3, voffA);
            PG8_BAR; PG8_WAIT_L(0); PG8_MMA(1, 0, At, B0); PG8_BAR; PG8_SCHED;
            PG8_STAGE(PG8_SB(1, 1), b3 + hstep, voffB);
            PG8_WAIT_V(6); PG8_BAR; PG8_MMA(1, 1, At, B1); PG8_BAR;
            }
        }
        if constexpr (ALIGN_EPI) { if (wr == 0) PG8_BAR; }
        if constexpr (!Epi::AFTER_DRAIN) { E(acc, cur, wr, wc, fr, fq); S.done(cur); }
        if (!has_next) break;
#pragma unroll
        for (int a = 0; a < 2; ++a)
#pragma unroll
            for (int b = 0; b < 2; ++b)
#pragma unroll
                for (int m = 0; m < 4; ++m)
#pragma unroll
                    for (int n = 0; n < 2; ++n) acc[a][b][m][n] = (f32x4){0.f, 0.f, 0.f, 0.f};
        cur = nxt; cA = nA; cB = nB; ++ui;
        if constexpr (ALIGN_EPI) { if (wr == 1) PG8_BAR; }
    }
    PG8_WAIT_V(0);
    if constexpr (!ALIGN_EPI) { if (wr == 0) PG8_BAR; }
    PG8_BAR;
    if constexpr (Epi::AFTER_DRAIN) { E.fused(acc, cur, wr, wc, fr, fq, lds, wid, lane); S.done(cur); }
#undef PG8_SA
#undef PG8_SB
#undef PG8_STAGE
#undef PG8_LDA
#undef PG8_LDB
#undef PG8_MMA
#undef PG8_WAIT_V
#undef PG8_WAIT_L
#undef PG8_BAR
#undef PG8_SCHED
}
}
#ifndef PG8_SP2
#define PG8_SP2 true
#endif
#ifndef PG8_ALIGN
#define PG8_ALIGN true
#endif
constexpr int NWAVES = 8, NTHR = 512;
constexpr int BATCH = 8, T = 8192, D = 1024, DEPTH = 4, MEMLEN = 256, FF = 4096;
constexpr int M = BATCH * T;
constexpr int AB_IN = 3080, AB_N = 3072, C_IN = 4112, C_N = 4096;
constexpr float EPS = 1e-6f;
constexpr float SB_THR = 40.0f;

constexpr size_t MiB = 1u << 20;
constexpr size_t WS_CTL = 0, CTL_ZERO_BYTES = 1 * MiB;
constexpr size_t WS_WG = 1 * MiB;
constexpr size_t WS_MEMN = 2 * MiB;
constexpr size_t WS_WKV = 6 * MiB;
constexpr size_t WS_W = 22 * MiB, W_LAYER = 30 * MiB;
constexpr size_t WO_WIN = 0, WO_WOUT = 8 * MiB, WO_WQ = 10 * MiB, WO_WO = 12 * MiB, WO_W1 = 14 * MiB, WO_W2 = 22 * MiB;
constexpr size_t WS_KVX = 142 * MiB;
constexpr size_t WS_GATE = 174 * MiB;
constexpr size_t WS_H = 178 * MiB;
constexpr size_t WS_MIX = 306 * MiB;
constexpr size_t WS_BIG = 434 * MiB;
constexpr size_t WS_RS = 946 * MiB;
constexpr size_t WS_MLS = 950 * MiB;
constexpr size_t WS_END = 956 * MiB;
constexpr int CW_TMO = 0, CW_BAR = 4096;

constexpr int LDS_BYTES = 147456;
constexpr int MISC_OFF = 140 * 1024;

#define GAS __attribute__((address_space(1)))
#define LAS __attribute__((address_space(3)))
#define DI __device__ __forceinline__
typedef unsigned short bf16;
typedef unsigned v4u __attribute__((ext_vector_type(4)));
typedef unsigned v2u __attribute__((ext_vector_type(2)));
typedef float f32x4 __attribute__((ext_vector_type(4)));
typedef short bf16x8 __attribute__((ext_vector_type(8)));
typedef short s16x4 __attribute__((ext_vector_type(4)));
#define LDS_WAIT() asm volatile("s_waitcnt lgkmcnt(0)" ::: "memory")
typedef float f32x2_ __attribute__((ext_vector_type(2)));
typedef __bf16 bf16x2_ __attribute__((ext_vector_type(2)));
DI unsigned pk2(float lo, float hi) { const f32x2_ v = {lo, hi}; return __builtin_bit_cast(unsigned, __builtin_convertvector(v, bf16x2_)); }
DI unsigned f2bf(float f) { return pk2(f, f) & 0xffffu; }
DI float bf2f(unsigned short b) { return __builtin_bit_cast(float, ((unsigned)b) << 16); }
DI float bflo(unsigned u) { return __builtin_bit_cast(float, u << 16); }
DI float bfhi(unsigned u) { return __builtin_bit_cast(float, u & 0xffff0000u); }
template <int CTRL> DI float dppf(float v) { return __builtin_bit_cast(float, __builtin_amdgcn_update_dpp(0, __builtin_bit_cast(int, v), CTRL, 0xF, 0xF, true)); }
DI float red4(float v) { v += dppf<0xB1>(v); v += dppf<0x4E>(v); return v; }
DI float red8(float v) { v = red4(v); v += dppf<0x141>(v); return v; }
DI float red16(float v) { v = red8(v); v += dppf<0x140>(v); return v; }
DI float wave_sum(float v) { v = red16(v); v += __shfl_xor(v, 16); v += __shfl_xor(v, 32); return v; }
DI float rcp_(float x) { return __builtin_amdgcn_rcpf(x); }
DI float rsq_(float x) { return __builtin_amdgcn_rsqf(x); }
DI float sigmoidf_(float x) { return rcp_(1.0f + __expf(-x)); }
DI void lds_barrier() { asm volatile("s_waitcnt lgkmcnt(0)" ::: "memory"); __builtin_amdgcn_s_barrier(); asm volatile("" ::: "memory"); }
#ifndef PROBE_STG
#define PROBE_STG -1
#endif
#define STG_T0() unsigned long long stg_t_ = (PROBE_STG >= 0) ? __builtin_amdgcn_s_memrealtime() : 0ull
#define STG(n) do { if (PROBE_STG >= 0) { const unsigned long long t_ = __builtin_amdgcn_s_memrealtime(); if (PROBE_STG == (n)) F.tacc += t_ - stg_t_; stg_t_ = t_; } } while (0)
DI f32x4 mfma16(bf16x8 a, bf16x8 b, f32x4 c) { return __builtin_amdgcn_mfma_f32_16x16x32_bf16(a, b, c, 0, 0, 0); }
#define XB_TMO      128
#define XB_XCNT(j)  (256  + 64 * (j))
#define XB_XSUB(j)  (1280 + 64 * (j))
#define XB_XGEN(j)  (2304 + 64 * (j))
#define XB_TOP      3328
#define XB_TOPGEN   3392
#define XCD_BAR_WORDS 3456
#define XB_SPIN_CAP (1u << 22)

__device__ __forceinline__ unsigned xb_ld(unsigned* p)              { return __hip_atomic_load(p, __ATOMIC_RELAXED, __HIP_MEMORY_SCOPE_AGENT); }
__device__ __forceinline__ unsigned xb_add(unsigned* p, unsigned v) { return __hip_atomic_fetch_add(p, v, __ATOMIC_RELAXED, __HIP_MEMORY_SCOPE_AGENT); }
__device__ __forceinline__ unsigned xb_xcc_id() { return (unsigned)__builtin_amdgcn_s_getreg((3 << 11) | 20) & 0xFu; }
#define XB_SPIN(cond, bar) do { unsigned _sp = 0; while (cond) { __builtin_amdgcn_s_sleep(1); \
    if ((++_sp & 255u) == 0u) { if (xb_ld(&(bar)[XB_TMO])) break; if (_sp > XB_SPIN_CAP) { atomicAdd(&(bar)[XB_TMO], 1u); break; } } } } while (0)

struct XcdBarrier {
    unsigned* bar; unsigned x;
    volatile LAS unsigned* st;
};

__device__ __forceinline__ XcdBarrier xcd_barrier_post(unsigned* bar, volatile LAS unsigned* st) {
    XcdBarrier b; b.bar = bar; b.x = xb_xcc_id(); b.st = st;
    if (threadIdx.x == 0) (void)xb_add(&bar[XB_XCNT(b.x)], 1u);
    return b;
}
__device__ __forceinline__ void xcd_barrier_complete(unsigned* bar, unsigned x, unsigned& nloc, unsigned& nx) {
    const unsigned G = gridDim.x * gridDim.y * gridDim.z;
    unsigned sum, cnt, mine, sp = 0u;
    for (;;) {
        sum = 0u; cnt = 0u; mine = 0u;
#pragma unroll
        for (unsigned j = 0; j < 16; ++j) { const unsigned c = xb_ld(&bar[XB_XCNT(j)]); sum += c; cnt += (c > 0u) ? 1u : 0u; mine = (j == x) ? c : mine; }
        if (sum == G) break;
        __builtin_amdgcn_s_sleep(1);
        if ((++sp & 255u) == 0u) { if (xb_ld(&bar[XB_TMO])) break; if (sp > XB_SPIN_CAP) { atomicAdd(&bar[XB_TMO], 1u); break; } }
    }
    nloc = mine > 0u ? mine : 1u; nx = cnt > 0u ? cnt : 1u;
}

__device__ __forceinline__ void xcd_barrier(const XcdBarrier& b) {
    asm volatile("s_waitcnt vmcnt(0)" ::: "memory");
    __syncthreads();
    if (threadIdx.x == 0) {
        unsigned* bar = b.bar;
        __builtin_amdgcn_s_waitcnt(0);
        unsigned nloc = b.st[0], nx = b.st[1];
        if (nloc == 0u) { xcd_barrier_complete(bar, b.x, nloc, nx); b.st[0] = nloc; b.st[1] = nx; }
        const unsigned old = xb_add(&bar[XB_XSUB(b.x)], 1u);
        const unsigned gen = old / nloc;
        if (old + 1u == (gen + 1u) * nloc) {
            __builtin_amdgcn_fence(__ATOMIC_RELEASE, "agent");
            asm volatile("s_waitcnt vmcnt(0)" ::: "memory");
            const unsigned og = xb_add(&bar[XB_TOP], 1u);
            const unsigned tg = og / nx;
            if (og + 1u == (tg + 1u) * nx) xb_add(&bar[XB_TOPGEN], 1u);
            else XB_SPIN(xb_ld(&bar[XB_TOPGEN]) == tg, bar);
            __builtin_amdgcn_fence(__ATOMIC_ACQUIRE, "agent");
            xb_add(&bar[XB_XGEN(b.x)], 1u);
            asm volatile("s_waitcnt vmcnt(0)" ::: "memory");
        } else {
            XB_SPIN(xb_ld(&bar[XB_XGEN(b.x)]) == gen, bar);
            __builtin_amdgcn_fence(__ATOMIC_ACQUIRE, "agent");
            asm volatile("s_waitcnt vmcnt(0)" ::: "memory");
        }
    }
    __syncthreads();
}
struct Frame {
    LAS unsigned char* lds;
    int tid, lane, wave;
    int G, wg, gw, NGW;
    unsigned long long tacc;
};

DI void transpose_item(const float* W, int ldsrc, int coloff, bf16* WT, int K, int row_off, int nblk, LAS float* scr, int item, int lane, const float* gain) {
    const int kb = item / nblk, nb = item % nblk, k0 = 64 * kb, n0 = 32 * nb;
    const bool al16 = (((ldsrc | (coloff + n0)) & 3) == 0);
    if (al16) { const int kr = lane >> 3, c4 = (lane & 7) * 4;
#pragma unroll
        for (int i = 0; i < 8; ++i) { const int kk = 8 * i + kr; const f32x4 v = *(const GAS f32x4*)(W + (size_t)(k0 + kk) * ldsrc + coloff + n0 + c4); const float g = gain ? gain[k0 + kk] : 1.0f;
            scr[kk * 33 + c4] = v.x * g; scr[kk * 33 + c4 + 1] = v.y * g; scr[kk * 33 + c4 + 2] = v.z * g; scr[kk * 33 + c4 + 3] = v.w * g; }
    } else {
#pragma unroll 8
        for (int i = 0; i < 32; ++i) { const int kk = 2 * i + (lane >> 5); scr[kk * 33 + (lane & 31)] = W[(size_t)(k0 + kk) * ldsrc + coloff + n0 + (lane & 31)] * (gain ? gain[k0 + kk] : 1.0f); }
    }
    LDS_WAIT(); asm volatile("" ::: "memory");
    const int c = lane & 7;
#pragma unroll
    for (int j = 0; j < 4; ++j) { const int n = (lane >> 3) + 8 * j; const LAS float* s = scr + (8 * c) * 33 + n;
        v4u o; o.x = pk2(s[0 * 33], s[1 * 33]); o.y = pk2(s[2 * 33], s[3 * 33]); o.z = pk2(s[4 * 33], s[5 * 33]); o.w = pk2(s[6 * 33], s[7 * 33]);
        *(GAS v4u*)(WT + (size_t)(row_off + n0 + n) * K + k0 + 8 * c) = o; }
    LDS_WAIT(); asm volatile("" ::: "memory");
}
DI void transpose_matrix(Frame& F, const float* W, int ldsrc, int coloff, int ncols, int K, bf16* WT, int row_off, unsigned& base, const float* gain = nullptr) {
    LAS float* scr = (LAS float*)(F.lds + F.wave * 16384);
    const int nblk = ncols / 32, nitems = (K / 64) * nblk;
    int it = (int)(((unsigned)F.gw + (unsigned)F.NGW - (base % (unsigned)F.NGW)) % (unsigned)F.NGW);
    for (; it < nitems; it += F.NGW) transpose_item(W, ldsrc, coloff, WT, K, row_off, nblk, scr, it, F.lane, gain);
    base += (unsigned)nitems;
}
DI void rms_row(const float* xrow, const f32x4 (&g4)[4], f32x4 (&v)[4], int lane) {
    const GAS f32x4* xr = (const GAS f32x4*)xrow + lane; float s = 0.f;
#pragma unroll
    for (int j = 0; j < 4; ++j) { v[j] = xr[64 * j]; s += (v[j].x * v[j].x + v[j].y * v[j].y) + (v[j].z * v[j].z + v[j].w * v[j].w); }
    const float rstd = rsq_(wave_sum(s) * (1.f / 1024.f) + EPS);
#pragma unroll
    for (int j = 0; j < 4; ++j) v[j] = v[j] * rstd * g4[j];
}
DI void store_row_bf16(bf16* orow, const f32x4 (&v)[4], int lane) {
    GAS unsigned long long* o8 = (GAS unsigned long long*)orow + lane;
#pragma unroll
    for (int j = 0; j < 4; ++j) o8[64 * j] = (unsigned long long)pk2(v[j].x, v[j].y) | ((unsigned long long)pk2(v[j].z, v[j].w) << 32);
}
struct In { const float* p[24]; };
DI void p0_prologue(Frame& F, const In& I, unsigned char* ws) {
    unsigned base = 0;
    for (int l = 0; l < DEPTH; ++l) {
        const int j = l >> 1; unsigned char* wl = ws + WS_W + (size_t)l * W_LAYER;
        if ((l & 1) == 0) {
            transpose_matrix(F, I.p[3] + (size_t)j * D * AB_IN, AB_IN, 0, 1536, D, (bf16*)(wl + WO_WIN), 0, base, I.p[2] + l * D);
            transpose_matrix(F, I.p[3] + (size_t)j * D * AB_IN, AB_IN, 1544, 1536, D, (bf16*)(wl + WO_WIN), 1536, base, I.p[2] + l * D);
            transpose_matrix(F, I.p[7] + (size_t)j * D * D, D, 0, D, D, (bf16*)(wl + WO_WOUT), 0, base);
        } else {
            transpose_matrix(F, I.p[8] + (size_t)j * D * C_IN, C_IN, 0, 4096, D, (bf16*)(wl + WO_WIN), 0, base, I.p[2] + l * D);
            transpose_matrix(F, I.p[13] + (size_t)j * D * D, D, 0, D, D, (bf16*)(wl + WO_WOUT), 0, base);
        }
        transpose_matrix(F, I.p[16] + (size_t)l * D * D, D, 0, D, D, (bf16*)(wl + WO_WQ), 0, base, I.p[14] + l * D);
        transpose_matrix(F, I.p[19] + (size_t)l * D * D, D, 0, D, D, (bf16*)(wl + WO_WO), 0, base);
        transpose_matrix(F, I.p[17] + (size_t)l * D * D, D, 0, D, D, (bf16*)(ws + WS_WKV), 2048 * l, base);
        transpose_matrix(F, I.p[18] + (size_t)l * D * D, D, 0, D, D, (bf16*)(ws + WS_WKV), 2048 * l + 1024, base);
        transpose_matrix(F, I.p[21] + (size_t)l * D * FF, FF, 0, FF, D, (bf16*)(wl + WO_W1), 0, base, I.p[20] + l * D);
        transpose_matrix(F, I.p[22] + (size_t)l * FF * D, D, 0, D, FF, (bf16*)(wl + WO_W2), 0, base);
    }
    for (int idx = F.wg * NTHR + F.tid; idx < DEPTH * 16 * 1024; idx += F.G * NTHR) {
        const int l = idx >> 14, g = (idx >> 10) & 15, k = idx & 1023, j = l >> 1; float v = 0.f;
        if ((l & 1) == 0) { if (g < 8) v = I.p[3][(size_t)j * D * AB_IN + (size_t)k * AB_IN + 1536 + g]; }
        else v = I.p[8][(size_t)j * D * C_IN + (size_t)k * C_IN + 4096 + g];
        ((bf16*)(ws + WS_WG))[idx] = (bf16)f2bf(v * I.p[2][l * D + k]);
    }
    { f32x4 g4[4];
#pragma unroll
      for (int j = 0; j < 4; ++j) g4[j] = ((const GAS f32x4*)I.p[15])[F.lane + 64 * j];
      for (int r = F.gw; r < BATCH * MEMLEN; r += F.NGW) { f32x4 v[4]; rms_row(I.p[1] + (size_t)r * D, g4, v, F.lane); store_row_bf16((bf16*)(ws + WS_MEMN) + (size_t)r * D, v, F.lane); } }
    for (int r = F.gw; r < M; r += F.NGW) { const GAS f32x4* xr = (const GAS f32x4*)(I.p[0] + (size_t)r * D) + F.lane; f32x4 v[4]; float s = 0.f;
#pragma unroll
        for (int j = 0; j < 4; ++j) { v[j] = xr[64 * j]; const unsigned a = pk2(v[j].x, v[j].y), b = pk2(v[j].z, v[j].w); const float r0 = bflo(a), r1 = bfhi(a), r2 = bflo(b), r3 = bfhi(b); s += (r0 * r0 + r1 * r1) + (r2 * r2 + r3 * r3); }
        s = wave_sum(s); store_row_bf16((bf16*)(ws + WS_H) + (size_t)r * D, v, F.lane);
        if (F.lane == 0) { __hip_atomic_store((pg8::rs_t*)(ws + WS_RS) + r, pg8::rs_fix(s), __ATOMIC_RELAXED, __HIP_MEMORY_SCOPE_AGENT); __hip_atomic_store((pg8::rs_t*)(ws + WS_RS) + M + r, (pg8::rs_t)0, __ATOMIC_RELAXED, __HIP_MEMORY_SCOPE_AGENT); } }
}
template <int MODE> DI void gates_phase(Frame& F, const bf16* xb, const pg8::rs_t* rs, const bf16* WgB, float* gate, const float* p0, const float* p1) {
    constexpr int LW = 1032;
    LAS bf16* wl = (LAS bf16*)F.lds;
    const int r = F.lane & 15, quad = F.lane >> 4;
    lds_barrier();
    for (int i = F.tid; i < 2048; i += NTHR) { const int g = i >> 7, c8 = (i & 127) * 8; *(LAS v4u*)(wl + g * LW + c8) = *(const GAS v4u*)(WgB + g * 1024 + c8); }
    float par = 0.f, par2 = 0.f;
    if (MODE == 1) { if (r < 4) par = p0[r]; else if (r < 8) par = p1[r - 4]; }
    if (MODE == 2) { if (r >= 8) { par = p0[r - 8]; par2 = p1[r - 8]; } }
    lds_barrier();
    for (int g = F.gw; g < M / 16; g += F.NGW) {
        const bf16* xa = xb + (size_t)(16 * g + r) * D + 8 * quad; f32x4 acc = (f32x4){0.f, 0.f, 0.f, 0.f};
#pragma unroll 8
        for (int kk = 0; kk < 32; ++kk) acc = mfma16(*(const GAS bf16x8*)(xa + 32 * kk), *(const LAS bf16x8*)(wl + r * LW + 32 * kk + 8 * quad), acc);
#pragma unroll
        for (int j = 0; j < 4; ++j) { const int row = 16 * g + 4 * quad + j; const float keep = acc[j] * pg8::row_rstd(rs, row); float o = 0.f;
            if (MODE == 1) { const float v = keep + par; o = (r < 4) ? 15.0f * tanhf(v * (1.0f / 15.0f)) : (fminf(v, 0.f) - log1pf(expf(-fabsf(v)))); }
            if (MODE == 2) { if (r < 8) o = 1.0f / (1.0f + expf(-keep)); else { const float z = keep + par2; o = -expf(par) * (fmaxf(z, 0.f) + log1pf(expf(-fabsf(z)))); } }
            if (MODE == 2 || r < 8) gate[(size_t)row * 16 + r] = o; }
    }
    lds_barrier();
}
DI void final_norm_phase(Frame& F, const bf16* xs, float* out, const float* gain) {
    f32x4 g4[4];
#pragma unroll
    for (int j = 0; j < 4; ++j) g4[j] = ((const GAS f32x4*)gain)[F.lane + 64 * j];
    for (int r = F.gw; r < M; r += F.NGW) { const GAS v2u* xr = (const GAS v2u*)(xs + (size_t)r * D) + F.lane; f32x4 v[4]; float s = 0.f;
#pragma unroll
        for (int j = 0; j < 4; ++j) { const v2u t = xr[64 * j]; v[j] = (f32x4){bflo(t.x), bfhi(t.x), bflo(t.y), bfhi(t.y)}; s += (v[j].x * v[j].x + v[j].y * v[j].y) + (v[j].z * v[j].z + v[j].w * v[j].w); }
        const float rstd = rsq_(wave_sum(s) * (1.f / 1024.f) + EPS); GAS f32x4* o = (GAS f32x4*)(out + (size_t)r * D) + F.lane;
#pragma unroll
        for (int j = 0; j < 4; ++j) o[64 * j] = v[j] * rstd * g4[j]; }
}
template <bool ODD> DI void headnorm_phase(Frame& F, const bf16* src, bf16* mix, const bf16* proj, const float* hg) {
    constexpr int NC = ODD ? 16 : 8;
    for (int r = F.gw; r < M; r += F.NGW) {
        const int c0 = NC * F.lane;
        float x[NC], gt[NC];
#pragma unroll
        for (int q = 0; q < NC / 8; ++q) {
            const size_t hoff = ((size_t)((r >> 13) * 8 + ((c0 + 8 * q) >> 7)) * T + (r & (T - 1))) * 128 + ((c0 + 8 * q) & 127);
            const v4u raw = ODD ? *(const GAS v4u*)(src + hoff) : *(const GAS v4u*)(src + (size_t)r * D + c0 + 8 * q);
            const v4u gr = ODD ? *(const GAS v4u*)(proj + (size_t)M * 3072 + hoff) : *(const GAS v4u*)(proj + (size_t)r * AB_N + 1024 + c0 + 8 * q);
            x[8 * q + 0] = bflo(raw.x); x[8 * q + 1] = bfhi(raw.x); x[8 * q + 2] = bflo(raw.y); x[8 * q + 3] = bfhi(raw.y); x[8 * q + 4] = bflo(raw.z); x[8 * q + 5] = bfhi(raw.z); x[8 * q + 6] = bflo(raw.w); x[8 * q + 7] = bfhi(raw.w);
            gt[8 * q + 0] = bflo(gr.x); gt[8 * q + 1] = bfhi(gr.x); gt[8 * q + 2] = bflo(gr.y); gt[8 * q + 3] = bfhi(gr.y); gt[8 * q + 4] = bflo(gr.z); gt[8 * q + 5] = bfhi(gr.z); gt[8 * q + 6] = bflo(gr.w); gt[8 * q + 7] = bfhi(gr.w);
        }
        float ss = 0.f;
#pragma unroll
        for (int i = 0; i < NC; ++i) ss += x[i] * x[i];
        ss = ODD ? red8(ss) : red16(ss);
        const float rstd = rsq_(ss * (1.f / 128.f) + EPS);
#pragma unroll
        for (int i = 0; i < NC; ++i) { const float g = ODD ? hg[(c0 + i) & 127] : hg[c0 + i]; const float s = sigmoidf_(gt[i]); x[i] = x[i] * rstd * g * (ODD ? gt[i] * s : s); }
#pragma unroll
        for (int q = 0; q < NC / 8; ++q) { v4u o; o.x = pk2(x[8 * q], x[8 * q + 1]); o.y = pk2(x[8 * q + 2], x[8 * q + 3]); o.z = pk2(x[8 * q + 4], x[8 * q + 5]); o.w = pk2(x[8 * q + 6], x[8 * q + 7]);
            *(GAS v4u*)(mix + (size_t)r * D + c0 + 8 * q) = o; }
    }
}
DI unsigned scale_pk(unsigned u, float s) { return pk2(bflo(u) * s, bfhi(u) * s); }
constexpr size_t H_NUML = 0, H_DC = 64 * MiB;
constexpr int MLS_STRIDE = 320;
struct MlaRegs { v4u q, k, v0, v1; float li, lf; };
DI void mla_load(MlaRegs& R, const bf16* proj, const float* gate, int unit, int tid) {
    const int ch = unit & 127, bh = unit >> 7, b = bh >> 2, h = bh & 3, s = tid & 63, dseg = tid >> 6;
    const size_t hb = (size_t)bh * T + ch * 64 + s;
    R.q = *(const GAS v4u*)(proj + hb * 64 + 8 * dseg); R.k = *(const GAS v4u*)(proj + (size_t)M * 256 + hb * 64 + 8 * dseg);
    const bf16* pv = proj + (size_t)M * 512 + hb * 128 + 16 * dseg; R.v0 = *(const GAS v4u*)pv; R.v1 = *(const GAS v4u*)(pv + 8);
    const float* g = gate + ((size_t)b * T + ch * 64 + s) * 16; R.li = g[h]; R.lf = g[4 + h];
}
DI void mlstm_a_unit(Frame& F, MlaRegs& R, const bf16* proj, const float* gate, bf16* numl, bf16* dc, float* scal, int unit, int unit_end) {
    constexpr int LD = 72, LN = 136;
    int tid_ = F.tid; asm volatile("" : "+v"(tid_));
    const int tid = tid_, lane = tid & 63, w = F.wave, r = lane & 15, quad = lane >> 4, dseg = tid >> 6;
    LAS bf16* qs = (LAS bf16*)F.lds; LAS bf16* ks = qs + 64 * LD; LAS bf16* ksT = ks + 64 * LD; LAS bf16* vT = ksT + 64 * LD; LAS bf16* Sd = vT + 128 * LD; LAS bf16* Cst = Sd + 64 * LD; LAS bf16* numS = Cst + 128 * LD;
    LAS float* sCm = (LAS float*)(numS + 64 * LN); LAS float* sDen = sCm + 64; LAS float* sDn = sDen + 64;
    float bb = R.lf;
#pragma unroll
    for (int o = 1; o < 64; o <<= 1) { const float t = __shfl_up(bb, o); if (lane >= o) bb += t; }
    const float a = R.li - bb; float cm = a;
#pragma unroll
    for (int o = 1; o < 64; o <<= 1) { const float t = __shfl_up(cm, o); if (lane >= o) cm = fmaxf(cm, t); }
    const float Astar = __shfl(cm, 63), b63 = __shfl(bb, 63);
    const float ksc = 0.125f * __expf(a - Astar);
    lds_barrier();
    *(LAS v4u*)(qs + lane * LD + 8 * dseg) = R.q;
    { v4u kk; kk.x = scale_pk(R.k.x, ksc); kk.y = scale_pk(R.k.y, ksc); kk.z = scale_pk(R.k.z, ksc); kk.w = scale_pk(R.k.w, ksc); *(LAS v4u*)(ks + lane * LD + 8 * dseg) = kk;
      const unsigned kw[4] = {kk.x, kk.y, kk.z, kk.w};
#pragma unroll
      for (int i = 0; i < 4; ++i) { ksT[(8 * dseg + 2 * i) * LD + lane] = (bf16)(kw[i] & 0xffffu); ksT[(8 * dseg + 2 * i + 1) * LD + lane] = (bf16)(kw[i] >> 16); }
      const unsigned vv[8] = {R.v0.x, R.v0.y, R.v0.z, R.v0.w, R.v1.x, R.v1.y, R.v1.z, R.v1.w};
#pragma unroll
      for (int i = 0; i < 8; ++i) { vT[(16 * dseg + 2 * i) * LD + lane] = (bf16)(vv[i] & 0xffffu); vT[(16 * dseg + 2 * i + 1) * LD + lane] = (bf16)(vv[i] >> 16); } }
    if (w == 0) sCm[lane] = cm;
    if (unit + 1 < unit_end) mla_load(R, proj, gate, unit + 1, tid);
    lds_barrier();
    { const int mt = w >> 1;
      const bf16x8 a0 = *(const LAS bf16x8*)(qs + (16 * mt + r) * LD + 8 * quad), a1 = *(const LAS bf16x8*)(qs + (16 * mt + r) * LD + 32 + 8 * quad);
#pragma unroll
      for (int tt = 0; tt < 2; ++tt) { const int nt = 2 * (w & 1) + tt; f32x4 acc = (f32x4){0.f, 0.f, 0.f, 0.f};
          if (nt <= mt) { acc = mfma16(a0, *(const LAS bf16x8*)(ks + (16 * nt + r) * LD + 8 * quad), acc); acc = mfma16(a1, *(const LAS bf16x8*)(ks + (16 * nt + r) * LD + 32 + 8 * quad), acc); }
          const int s = 16 * nt + r;
#pragma unroll
          for (int j = 0; j < 4; ++j) { const int t = 16 * mt + 4 * quad + j; const float v = (s <= t) ? acc[j] * __expf(Astar - sCm[t]) : 0.f; Sd[t * LD + s] = (bf16)f2bf(v); } } }
    const bf16x8 vf0 = *(const LAS bf16x8*)(vT + (16 * w + r) * LD + 8 * quad), vf1 = *(const LAS bf16x8*)(vT + (16 * w + r) * LD + 32 + 8 * quad);
#pragma unroll
    for (int nt = 0; nt < 4; ++nt) { f32x4 acc = (f32x4){0.f, 0.f, 0.f, 0.f};
        acc = mfma16(vf0, *(const LAS bf16x8*)(ksT + (16 * nt + r) * LD + 8 * quad), acc); acc = mfma16(vf1, *(const LAS bf16x8*)(ksT + (16 * nt + r) * LD + 32 + 8 * quad), acc);
#pragma unroll
        for (int j = 0; j < 4; ++j) Cst[(16 * w + 4 * quad + j) * LD + 16 * nt + r] = (bf16)f2bf(acc[j]); }
    if (w == 0) { float sum = 0.f;
#pragma unroll
        for (int q8 = 0; q8 < 8; ++q8) { const v4u t = *(const LAS v4u*)(ksT + lane * LD + 8 * q8); sum += (bflo(t.x) + bfhi(t.x)) + (bflo(t.y) + bfhi(t.y)) + (bflo(t.z) + bfhi(t.z)) + (bflo(t.w) + bfhi(t.w)); }
        sDn[lane] = sum; }
    lds_barrier();
#pragma unroll
    for (int mt = 0; mt < 4; ++mt) { f32x4 acc = (f32x4){0.f, 0.f, 0.f, 0.f};
        acc = mfma16(*(const LAS bf16x8*)(Sd + (16 * mt + r) * LD + 8 * quad), vf0, acc); acc = mfma16(*(const LAS bf16x8*)(Sd + (16 * mt + r) * LD + 32 + 8 * quad), vf1, acc);
#pragma unroll
        for (int j = 0; j < 4; ++j) numS[(16 * mt + 4 * quad + j) * LN + 16 * w + r] = (bf16)f2bf(acc[j]); }
    { const int row = tid >> 3, seg = tid & 7; const v4u sd = *(const LAS v4u*)(Sd + row * LD + 8 * seg);
      float p = (bflo(sd.x) + bfhi(sd.x)) + (bflo(sd.y) + bfhi(sd.y)) + (bflo(sd.z) + bfhi(sd.z)) + (bflo(sd.w) + bfhi(sd.w));
      p = red8(p); if (seg == 0) sDen[row] = p; }
    lds_barrier();
    { const int row = tid >> 3, c16 = (tid & 7) * 16; bf16* g = numl + (size_t)unit * 8192 + row * 128 + c16;
      *(GAS v4u*)g = *(const LAS v4u*)(numS + row * LN + c16); *(GAS v4u*)(g + 8) = *(const LAS v4u*)(numS + row * LN + c16 + 8);
      const int dv = tid >> 2, d16 = (tid & 3) * 16; bf16* gc = dc + (size_t)unit * 8192 + dv * 64 + d16;
      *(GAS v4u*)gc = *(const LAS v4u*)(Cst + dv * LD + d16); *(GAS v4u*)(gc + 8) = *(const LAS v4u*)(Cst + dv * LD + d16 + 8);
      float* sc = scal + (size_t)unit * MLS_STRIDE;
      if (w == 0) { sc[lane] = sDen[lane]; sc[64 + lane] = cm; sc[128 + lane] = bb; sc[192 + lane] = sDn[lane]; if (lane == 0) { sc[256] = Astar; sc[257] = b63; } } }
}
DI void mlstm_a_phase(Frame& F, const bf16* proj, const float* gate, bf16* numl, bf16* dc, float* scal) {
    const int per = (4096 + F.G - 1) / F.G, u0 = F.wg * per, u1 = (u0 + per < 4096) ? u0 + per : 4096;
    if (u0 >= u1) return;
    MlaRegs R; mla_load(R, proj, gate, u0, F.tid);
    for (int u = u0; u < u1; ++u) mlstm_a_unit(F, R, proj, gate, numl, dc, scal, u, u1);
}
DI void mlstm_b_phase(Frame& F, bf16* dc, float* scal) {
    for (int c = F.wg; c < 256; c += F.G) {
        const int bh = c >> 3, part = c & 7, e = part * 1024 + 2 * F.tid; const bool nth = (part == 0) && (F.tid < 64);
        float c0 = 0.f, c1 = 0.f, nn = 0.f, m = 0.f;
        for (int cb = 0; cb < 128; cb += 8) {
            unsigned dv[8]; float As[8], bs[8], dn[8];
#pragma unroll
            for (int i = 0; i < 8; ++i) { const size_t un = (size_t)bh * 128 + cb + i; dv[i] = *(const GAS unsigned*)(dc + un * 8192 + e); const float* sc = scal + un * MLS_STRIDE; As[i] = sc[256]; bs[i] = sc[257]; dn[i] = nth ? sc[192 + F.tid] : 0.f; }
#pragma unroll
            for (int i = 0; i < 8; ++i) { const size_t un = (size_t)bh * 128 + cb + i; float* sc = scal + un * MLS_STRIDE;
                const float Mx = fmaxf(m, As[i]), wo = __expf(m - Mx), wd = __expf(As[i] - Mx);
                *(GAS unsigned*)(dc + un * 8192 + e) = pk2(c0, c1);
                if (nth) sc[192 + F.tid] = nn;
                if (part == 0 && F.tid == 64) sc[258] = m;
                c0 = wo * c0 + wd * bflo(dv[i]); c1 = wo * c1 + wd * bfhi(dv[i]); nn = wo * nn + wd * dn[i]; m = bs[i] + Mx; }
        }
    }
}
struct MlcRegs { bf16x8 qa[4][2], cb[2]; v4u nl0, nl1, o0, o1, qr; f32x4 n0, n1; float denL, cm, bb, mprev; };
DI void mlc_load(MlcRegs& R, const bf16* proj, const bf16* numl, const bf16* dc, const float* scal, int unit, int tid, int w) {
    const int ch = unit & 127, bh = unit >> 7, lane = tid & 63, r = lane & 15, quad = lane >> 4, row = tid >> 3, seg = tid & 7;
    const size_t hb0 = (size_t)bh * T + ch * 64;
#pragma unroll
    for (int mt = 0; mt < 4; ++mt) { const bf16* p = proj + (hb0 + 16 * mt + r) * 64 + 8 * quad; R.qa[mt][0] = *(const GAS bf16x8*)p; R.qa[mt][1] = *(const GAS bf16x8*)(p + 32); }
    { const bf16* p = dc + (size_t)unit * 8192 + (16 * w + r) * 64 + 8 * quad; R.cb[0] = *(const GAS bf16x8*)p; R.cb[1] = *(const GAS bf16x8*)(p + 32); }
    { const bf16* p = numl + (size_t)unit * 8192 + row * 128 + 16 * seg; R.nl0 = *(const GAS v4u*)p; R.nl1 = *(const GAS v4u*)(p + 8); }
    { const bf16* p = proj + (size_t)M * 1024 + (hb0 + row) * 128 + 16 * seg; R.o0 = *(const GAS v4u*)p; R.o1 = *(const GAS v4u*)(p + 8); }
    R.qr = *(const GAS v4u*)(proj + (hb0 + row) * 64 + 8 * seg);
    const float* sc = scal + (size_t)unit * MLS_STRIDE;
    R.n0 = *(const GAS f32x4*)(sc + 192 + 8 * seg); R.n1 = *(const GAS f32x4*)(sc + 192 + 8 * seg + 4);
    R.denL = sc[row]; R.cm = sc[64 + row]; R.bb = sc[128 + row]; R.mprev = sc[258];
}
DI void mlstm_c_phase(Frame& F, const bf16* proj, const bf16* numl, const bf16* dc, const float* scal, const float* hgain, bf16* mix) {
    constexpr int HLD = 132;
    const int per = (4096 + F.G - 1) / F.G, u0 = F.wg * per, u1 = (u0 + per < 4096) ? u0 + per : 4096;
    if (u0 >= u1) return;
    LAS float* hbuf = (LAS float*)F.lds;
    MlcRegs R; mlc_load(R, proj, numl, dc, scal, u0, F.tid, F.wave);
    for (int u = u0; u < u1; ++u) {
        int tid_ = F.tid; asm volatile("" : "+v"(tid_));
        const int tid = tid_, lane = tid & 63, w = F.wave, r = lane & 15, quad = lane >> 4, row = tid >> 3, seg = tid & 7;
        const int ch = u & 127, bh = u >> 7, b = bh >> 2, h = bh & 3;
        lds_barrier();
#pragma unroll
        for (int mt = 0; mt < 4; ++mt) { f32x4 acc = (f32x4){0.f, 0.f, 0.f, 0.f}; acc = mfma16(R.qa[mt][0], R.cb[0], acc); acc = mfma16(R.qa[mt][1], R.cb[1], acc);
#pragma unroll
            for (int j = 0; j < 4; ++j) hbuf[(16 * mt + 4 * quad + j) * HLD + 16 * w + r] = acc[j]; }
        const v4u nl0 = R.nl0, nl1 = R.nl1, o0 = R.o0, o1 = R.o1, qr = R.qr; const f32x4 n0 = R.n0, n1 = R.n1; const float denL = R.denL, cm = R.cm, bb = R.bb, mprev = R.mprev;
        if (u + 1 < u1) mlc_load(R, proj, numl, dc, scal, u + 1, tid, w);
        lds_barrier();
        { const float Mx = fmaxf(mprev, cm), e1 = __expf(cm - Mx), wi = __expf(mprev - Mx);
          float qn = (bflo(qr.x) * n0[0] + bfhi(qr.x) * n0[1]) + (bflo(qr.y) * n0[2] + bfhi(qr.y) * n0[3]) + (bflo(qr.z) * n1[0] + bfhi(qr.z) * n1[1]) + (bflo(qr.w) * n1[2] + bfhi(qr.w) * n1[3]);
          qn = red8(qn);
          const float den = e1 * denL + wi * qn; const float dinv = rcp_(fmaxf(fabsf(den), __expf(-(bb + Mx))));
          const unsigned nw[8] = {nl0.x, nl0.y, nl0.z, nl0.w, nl1.x, nl1.y, nl1.z, nl1.w};
          float hv[16]; float ss = 0.f;
#pragma unroll
          for (int q4 = 0; q4 < 4; ++q4) { const f32x4 t = *(const LAS f32x4*)(hbuf + row * HLD + 16 * seg + 4 * q4);
              hv[4 * q4] = (e1 * bflo(nw[2 * q4]) + wi * t.x) * dinv; hv[4 * q4 + 1] = (e1 * bfhi(nw[2 * q4]) + wi * t.y) * dinv; hv[4 * q4 + 2] = (e1 * bflo(nw[2 * q4 + 1]) + wi * t.z) * dinv; hv[4 * q4 + 3] = (e1 * bfhi(nw[2 * q4 + 1]) + wi * t.w) * dinv; }
#pragma unroll
          for (int i = 0; i < 16; ++i) ss += hv[i] * hv[i];
          ss = red8(ss);
          const float rstd = rsq_(ss * (1.f / 128.f) + EPS);
          const unsigned og[8] = {o0.x, o0.y, o0.z, o0.w, o1.x, o1.y, o1.z, o1.w}; unsigned ow[8];
          const float* gp = hgain + h * 128 + 16 * seg;
#pragma unroll
          for (int i = 0; i < 8; ++i) ow[i] = pk2(hv[2 * i] * rstd * gp[2 * i] * sigmoidf_(bflo(og[i])), hv[2 * i + 1] * rstd * gp[2 * i + 1] * sigmoidf_(bfhi(og[i])));
          bf16* op = mix + ((size_t)b * T + ch * 64 + row) * D + h * 128 + 16 * seg;
          *(GAS v4u*)op = (v4u){ow[0], ow[1], ow[2], ow[3]}; *(GAS v4u*)(op + 8) = (v4u){ow[4], ow[5], ow[6], ow[7]}; }
    }
}
constexpr size_t MIX_AT = 0, MIX_HALO = 64 * MiB, MIX_GL = 96 * MiB;
struct G1Raw { v2u raw[3][7]; };
struct G1Cw { float w[3][4][4]; };
DI void g1_load_raw(G1Raw& R, const bf16* big, const bf16* halo, int U, int tid) {
    const int ch = U & 127, h = (U >> 7) & 7, b = U >> 10, cg = tid & 31, rs = tid >> 5;
    const size_t hb0 = (size_t)(b * 8 + h) * T + (size_t)ch * 64;
#pragma unroll
    for (int which = 0; which < 3; ++which)
#pragma unroll
        for (int i = 0; i < 7; ++i) { const int rr = 4 * rs - 3 + i; v2u t = (v2u){0u, 0u};
            if (rr >= 0) t = *(const GAS v2u*)(big + (size_t)M * 1024 * which + (hb0 + rr) * 128 + 4 * cg);
            else if (ch > 0) t = *(const GAS v2u*)(halo + ((size_t)(b * 128 + ch - 1) * 3 + (3 + rr)) * 3072 + which * 1024 + h * 128 + 4 * cg);
            R.raw[which][i] = t; }
}
DI void g1_load_cw(G1Cw& C, const float* convw, int h, int tid) {
    const int cg = tid & 31;
#pragma unroll
    for (int which = 0; which < 3; ++which)
#pragma unroll
        for (int j = 0; j < 4; ++j) { const f32x4 t = *(const GAS f32x4*)(convw + j * 3072 + which * 1024 + h * 128 + 4 * cg); C.w[which][j][0] = t.x; C.w[which][j][1] = t.y; C.w[which][j][2] = t.z; C.w[which][j][3] = t.w; }
}
DI void gdn_g1_unit(Frame& F, bf16* big, const bf16* halo, const float* gate, G1Raw& RW, const float* convw, bf16* Hb, bf16* At, float* GL, int U, int Uend, bool st) {
    constexpr int LQ = 136, LX = 72, LR = 264;
    const int ch = U & 127, h = (U >> 7) & 7, b = U >> 10;
    const size_t r0 = (size_t)b * T + (size_t)ch * 64, hb0 = (size_t)(b * 8 + h) * T + (size_t)ch * 64;
    int tid_ = F.tid; asm volatile("" : "+v"(tid_));
    const int tid = tid_, lane = tid & 63, w = F.wave, r = lane & 15, quad = lane >> 4, row = tid >> 3, seg = tid & 7;
    const size_t hb = hb0 + row;
    LAS bf16* qn = (LAS bf16*)F.lds; LAS bf16* kn = qn + 64 * LQ; LAS bf16* vn = kn + 64 * LQ; LAS bf16* knT = vn + 64 * LQ;
    LAS bf16* Lb = knT + 128 * LX; LAS float* Lf = (LAS float*)(Lb + 64 * LX);
    LAS bf16* Db = (LAS bf16*)(Lf + 4 * 16 * 17); LAS bf16* Xt = Db + 4 * 16 * 20;
    LAS bf16* Xr = qn;
    LAS bf16* Ats = Xt;
    LAS float* sG = (LAS float*)(Xt + 256 * LX); LAS float* sBeta = sG + 64; LAS float* sEg = sBeta + 64;
    f32x4 cwa[3][4];
#pragma unroll
    for (int which = 0; which < 3; ++which)
#pragma unroll
        for (int j = 0; j < 4; ++j) cwa[which][j] = *(const GAS f32x4*)(convw + j * 3072 + which * 1024 + h * 128 + 4 * (tid & 31));
    STG_T0();
    lds_barrier();
    STG(10);
    {
        const int cg = tid & 31, rs = tid >> 5;
#pragma unroll
        for (int which = 0; which < 3; ++which) {
            __builtin_amdgcn_sched_barrier(0);
            const f32x4 (&cw)[4] = cwa[which];
            float x[7][4];
#pragma unroll
            for (int i = 0; i < 7; ++i) { const v2u t = RW.raw[which][i]; x[i][0] = bflo(t.x); x[i][1] = bfhi(t.x); x[i][2] = bflo(t.y); x[i][3] = bfhi(t.y); }
            float o[4][4]; float ss[4];
#pragma unroll
            for (int rr = 0; rr < 4; ++rr) {
#pragma unroll
                for (int c = 0; c < 4; ++c) { float a = cw[0][c] * x[rr][c]; a += cw[1][c] * x[rr + 1][c]; a += cw[2][c] * x[rr + 2][c]; a += cw[3][c] * x[rr + 3][c]; o[rr][c] = a; } }
#pragma unroll
            for (int rr = 0; rr < 4; ++rr) { ss[rr] = 0.f;
#pragma unroll
                for (int c = 0; c < 4; ++c) { float a = o[rr][c]; a = a * sigmoidf_(a); o[rr][c] = a; ss[rr] += a * a; } }

            if (which < 2) {
#pragma unroll
                for (int rr = 0; rr < 4; ++rr) { float t = ss[rr]; t = red16(t); t += __shfl_xor(t, 16);
                    const float sc = rsq_(t + EPS) * (which == 0 ? 0.08838834764831845f : 1.0f);
#pragma unroll
                    for (int c = 0; c < 4; ++c) o[rr][c] *= sc; } }
            LAS bf16* dst = (which == 0 ? qn : (which == 1 ? kn : vn));
#pragma unroll
            for (int rr = 0; rr < 4; ++rr) *(LAS v2u*)(dst + (4 * rs + rr) * LQ + 4 * cg) = (v2u){pk2(o[rr][0], o[rr][1]), pk2(o[rr][2], o[rr][3])};
            if (which == 1) {
#pragma unroll
                for (int c = 0; c < 4; ++c) *(LAS v2u*)(knT + (4 * cg + c) * LX + ((4 * rs) ^ (8 * (cg & 7)))) = (v2u){pk2(o[0][c], o[1][c]), pk2(o[2][c], o[3][c])}; }
        }
    }
    if (U + 1 < Uend) g1_load_raw(RW, big, halo, U + 1, tid);
    if (w == 0) { const float* g = gate + (r0 + lane) * 16; float gg = g[8 + h]; const float be = g[h];
#pragma unroll
        for (int o = 1; o < 64; o <<= 1) { const float t = __shfl_up(gg, o); if (lane >= o) gg += t; }
        sG[lane] = gg; sBeta[lane] = be; sEg[lane] = __expf(gg); }
    STG(11);
    lds_barrier();
    STG(12);
    { const int mt = w >> 1;
#pragma unroll
      for (int tt = 0; tt < 2; ++tt) { const int nt = 2 * (w & 1) + tt; f32x4 ak = (f32x4){0.f, 0.f, 0.f, 0.f}, aq = ak;
          if (nt <= mt) {
#pragma unroll
              for (int kk = 0; kk < 4; ++kk) { const bf16x8 bk = *(const LAS bf16x8*)(kn + (16 * nt + r) * LQ + 32 * kk + 8 * quad);
                  ak = mfma16(*(const LAS bf16x8*)(kn + (16 * mt + r) * LQ + 32 * kk + 8 * quad), bk, ak); aq = mfma16(*(const LAS bf16x8*)(qn + (16 * mt + r) * LQ + 32 * kk + 8 * quad), bk, aq); } }
          const int s = 16 * nt + r; const float gs = sG[s];
#pragma unroll
          for (int j = 0; j < 4; ++j) { const int t = 16 * mt + 4 * quad + j; const float dec = (s <= t) ? __expf(sG[t] - gs) : 0.f;
              const float lv = (s < t) ? sBeta[t] * ak[j] * dec : 0.f;
              if (nt <= mt) { Lb[t * LX + s] = (bf16)f2bf(lv); if (nt == mt) Lf[(mt * 16 + 4 * quad + j) * 17 + r] = lv; }
              Ats[t * LX + s] = (bf16)f2bf(aq[j] * dec); } } }
    float R[4][2][4];
#pragma unroll
    for (int i = 0; i < 4; ++i)
#pragma unroll
        for (int ct = 0; ct < 2; ++ct)
#pragma unroll
            for (int j = 0; j < 4; ++j) { const int t = 16 * i + 4 * quad + j, cc = 32 * (w & 3) + 16 * ct + r;
                R[i][ct][j] = (w < 4) ? sBeta[t] * bf2f(vn[t * LQ + cc]) : sBeta[t] * sEg[t] * bf2f(kn[t * LQ + cc]); }
    STG(13);
    lds_barrier();
    STG(14);
    if (w == 0) { const int i = lane >> 4, cI = lane & 15; const LAS float* N = Lf + i * 16 * 17; float x[16];
#pragma unroll
        for (int rr = 0; rr < 16; ++rr) { float v = (rr == cI) ? 1.f : 0.f;
#pragma unroll
            for (int m = 0; m < rr; ++m) v -= N[rr * 17 + m] * x[m];
            x[rr] = v; Db[(i * 16 + rr) * 20 + cI] = (bf16)f2bf(v); }
    } else { const float gl = sG[63];
        if (st) for (int idx = tid - 64; idx < 2560; idx += NTHR - 64) {
            if (idx < 1024) { const int t = idx >> 4, c8 = (idx & 15) * 8; const v4u v = *(const LAS v4u*)(qn + t * LQ + c8); const float e = sEg[t];
                *(GAS v4u*)(big + (size_t)M * 2048 + (hb0 + t) * 128 + c8) = (v4u){scale_pk(v.x, e), scale_pk(v.y, e), scale_pk(v.z, e), scale_pk(v.w, e)}; }
            else if (idx >= 2048) { const int i3 = idx - 2048, t = i3 >> 3, s8 = (i3 & 7) * 8; *(GAS v4u*)(At + (size_t)U * 4096 + t * 64 + s8) = *(const LAS v4u*)(Ats + t * LX + s8); }
            else { const int i2 = idx - 1024, d = i2 >> 3, s8 = (i2 & 7) * 8; const v4u v = *(const LAS v4u*)(knT + d * LX + (s8 ^ (8 * ((d >> 2) & 7)))); float e[8];
#pragma unroll
                for (int q = 0; q < 8; ++q) e[q] = __expf(gl - sG[s8 + q]);
                *(GAS v4u*)(big + (size_t)M * 1024 + hb0 * 128 + d * 64 + s8) = (v4u){pk2(bflo(v.x) * e[0], bfhi(v.x) * e[1]), pk2(bflo(v.y) * e[2], bfhi(v.y) * e[3]), pk2(bflo(v.z) * e[4], bfhi(v.z) * e[5]), pk2(bflo(v.w) * e[6], bfhi(v.w) * e[7])}; } }
        if (st && tid == 64) GL[U] = __expf(gl); }
    STG(15);
    lds_barrier();
    STG(16);
#pragma unroll
    for (int i = 0; i < 4; ++i) {
#pragma unroll
        for (int ct = 0; ct < 2; ++ct) { const int col = 32 * w + 16 * ct + r; f32x4 acc = (f32x4){0.f, 0.f, 0.f, 0.f};
            if (i > 0) {
#pragma unroll
                for (int kk = 0; kk < 2; ++kk) if (32 * kk < 16 * i) {
                    bf16x8 af = *(const LAS bf16x8*)(Lb + (16 * i + r) * LX + 32 * kk + 8 * quad);
                    if (32 * kk + 8 * quad >= 16 * i) af = (bf16x8){0, 0, 0, 0, 0, 0, 0, 0};
                    acc = mfma16(af, *(const LAS bf16x8*)(Xt + col * LX + 32 * kk + 8 * quad), acc); } }
            const v2u bp = (v2u){pk2(R[i][ct][0] - acc[0], R[i][ct][1] - acc[1]), pk2(R[i][ct][2] - acc[2], R[i][ct][3] - acc[3])};
            const v2u ap = *(const LAS v2u*)(Db + (i * 16 + r) * 20 + 4 * quad);
            const f32x4 y = mfma16(__builtin_bit_cast(bf16x8, (v4u){ap.x, ap.y, 0u, 0u}), __builtin_bit_cast(bf16x8, (v4u){bp.x, bp.y, 0u, 0u}), (f32x4){0.f, 0.f, 0.f, 0.f});
            *(LAS v2u*)(Xt + col * LX + 16 * i + 4 * quad) = (v2u){pk2(y[0], y[1]), pk2(y[2], y[3])};
#pragma unroll
            for (int j = 0; j < 4; ++j) Xr[(16 * i + 4 * quad + j) * LR + col] = (bf16)f2bf(y[j]); }
        asm volatile("s_waitcnt lgkmcnt(0)" ::: "memory");
    }
    lds_barrier();
    STG(17);
    if (st) { const v4u u0 = *(const LAS v4u*)(Xr + row * LR + 16 * seg), u1 = *(const LAS v4u*)(Xr + row * LR + 16 * seg + 8), w0 = *(const LAS v4u*)(Xr + row * LR + 128 + 16 * seg), w1 = *(const LAS v4u*)(Xr + row * LR + 128 + 16 * seg + 8);
      bf16* up = Hb + hb * 128 + 16 * seg; *(GAS v4u*)up = u0; *(GAS v4u*)(up + 8) = u1;
      bf16* wp = big + hb * 128 + 16 * seg; *(GAS v4u*)wp = w0; *(GAS v4u*)(wp + 8) = w1; }
    STG(18);
}
DI void gdn_g1_phase(Frame& F, bf16* big, const bf16* halo, const float* gate, const float* convw, bf16* Hb, bf16* At, float* GL, bool st) {
    LAS unsigned* xt = (LAS unsigned*)(F.lds + (3 * 64 * 136 + 128 * 72 + 64 * 72) * 2 + 4 * 16 * 17 * 4 + 4 * 16 * 20 * 2);
    lds_barrier();
    for (int i = F.tid; i < 256 * 72 / 2; i += NTHR) xt[i] = 0u;
    const int per = (8192 + F.G - 1) / F.G, u0 = F.wg * per, u1 = (u0 + per < 8192) ? u0 + per : 8192;
    if (u0 >= u1) return;
    G1Raw RW;
    g1_load_raw(RW, big, halo, u0, F.tid);
    for (int U = u0; U < u1; ++U) gdn_g1_unit(F, big, halo, gate, RW, convw, Hb, At, GL, U, u1, st);
}
struct G2Regs { bf16x8 f[10]; unsigned u[8]; float gl; };
DI void g2_load(G2Regs& R, const bf16* big, const bf16* Hb, const bf16* At, const float* GL, int b, int h, int vq, int ch, int w, int r, int quad) {
    const size_t hb0 = (size_t)(b * 8 + h) * T + (size_t)ch * 64; const int U = (b * 8 + h) * 128 + ch;
    if (w < 4) { const int mt = w;
        const bf16* pw = big + (hb0 + 16 * mt + r) * 128 + 8 * quad;
#pragma unroll
        for (int kk = 0; kk < 4; ++kk) { R.f[kk] = *(const GAS bf16x8*)(pw + 32 * kk); R.f[4 + kk] = *(const GAS bf16x8*)(pw + (size_t)M * 2048 + 32 * kk); }
        const bf16* pa = At + (size_t)U * 4096 + (16 * mt + r) * 64 + 8 * quad;
        R.f[8] = *(const GAS bf16x8*)pa; R.f[9] = *(const GAS bf16x8*)(pa + 32);
        const bf16* pu = Hb + (hb0 + 16 * mt + 4 * quad) * 128 + vq * 32 + r;
#pragma unroll
        for (int nt = 0; nt < 2; ++nt)
#pragma unroll
            for (int j = 0; j < 4; ++j) R.u[nt * 4 + j] = pu[(size_t)j * 128 + 16 * nt];
    } else { const int dg = w - 4;
#pragma unroll
        for (int i = 0; i < 2; ++i) { const int d = 32 * dg + 16 * i + r; const bf16* pk = big + (size_t)M * 1024 + hb0 * 128 + d * 64 + 8 * quad;
            R.f[2 * i] = *(const GAS bf16x8*)pk; R.f[2 * i + 1] = *(const GAS bf16x8*)(pk + 32); }
        R.gl = GL[U];
    }
}
struct G2State { f32x4 accS[2][2]; unsigned opend[8]; };
DI void g2_store_o(const G2State& S, bf16* Hb, int b, int h, int vq, int ch, int w, int r, int quad) {
    if (w < 4) { const size_t hbp = (size_t)(b * 8 + h) * T + (size_t)ch * 64; bf16* po = Hb + (hbp + 16 * w + 4 * quad) * 128 + vq * 32 + r;
#pragma unroll
        for (int nt = 0; nt < 2; ++nt)
#pragma unroll
            for (int j = 0; j < 4; ++j) po[(size_t)j * 128 + 16 * nt] = (bf16)S.opend[nt * 4 + j]; }
}
DI void g2_step(Frame& F, const bf16* big, bf16* Hb, const bf16* At, const float* GL, int b, int h, int vq, int ch, const G2Regs& cur, G2Regs& ld, G2State& S, LAS bf16* St, LAS bf16* vnT, bool st) {
    constexpr int LS = 136, LV = 72;
    const int lane = F.lane, w = F.wave, r = lane & 15, quad = lane >> 4;
    if (ch > 0 && st) g2_store_o(S, Hb, b, h, vq, ch - 1, w, r, quad);
    if (ch + 1 < T / 64) g2_load(ld, big, Hb, At, GL, b, h, vq, ch + 1, w, r, quad);
    STG_T0();
    f32x4 ao[2];
    if (w < 4) { const int mt = w;
#pragma unroll
        for (int nt = 0; nt < 2; ++nt) { f32x4 av = (f32x4){0.f, 0.f, 0.f, 0.f}; ao[nt] = av;
#pragma unroll
            for (int kk = 0; kk < 4; ++kk) { const bf16x8 sf = *(const LAS bf16x8*)(St + (16 * nt + r) * LS + 32 * kk + 8 * quad); av = mfma16(cur.f[kk], sf, av); ao[nt] = mfma16(cur.f[4 + kk], sf, ao[nt]); }
            *(LAS v2u*)(vnT + (16 * nt + r) * LV + 16 * mt + 4 * quad) = (v2u){pk2(bflo(cur.u[nt * 4 + 0]) - av[0], bflo(cur.u[nt * 4 + 1]) - av[1]), pk2(bflo(cur.u[nt * 4 + 2]) - av[2], bflo(cur.u[nt * 4 + 3]) - av[3])}; }
    }
    STG(20);
    lds_barrier();
    STG(21);
    if (w < 4) {
#pragma unroll
        for (int nt = 0; nt < 2; ++nt) {
#pragma unroll
            for (int kk = 0; kk < 2; ++kk) ao[nt] = mfma16(cur.f[8 + kk], *(const LAS bf16x8*)(vnT + (16 * nt + r) * LV + 32 * kk + 8 * quad), ao[nt]);
#pragma unroll
            for (int j = 0; j < 4; ++j) S.opend[nt * 4 + j] = f2bf(ao[nt][j]); }
    } else { const int dg = w - 4;
#pragma unroll
        for (int i = 0; i < 2; ++i)
#pragma unroll
            for (int n2 = 0; n2 < 2; ++n2) { f32x4 a = S.accS[i][n2] * cur.gl;
#pragma unroll
                for (int kk = 0; kk < 2; ++kk) a = mfma16(cur.f[2 * i + kk], *(const LAS bf16x8*)(vnT + (16 * n2 + r) * LV + 32 * kk + 8 * quad), a);
                S.accS[i][n2] = a; *(LAS v2u*)(St + (16 * n2 + r) * LS + 32 * dg + 16 * i + 4 * quad) = (v2u){pk2(a[0], a[1]), pk2(a[2], a[3])}; }
    }
    STG(22);
    lds_barrier();
    STG(23);
    __builtin_amdgcn_sched_barrier(0);
}
DI void gdn_g2_chain(Frame& F, const bf16* big, bf16* Hb, const bf16* At, const float* GL, int c, bool st) {
    constexpr int LS = 136;
    const int b = c >> 5, h = (c >> 2) & 7, vq = c & 3;
    const int tid = F.tid, lane = F.lane, w = F.wave, r = lane & 15, quad = lane >> 4;
    LAS bf16* St = (LAS bf16*)F.lds;
    LAS bf16* vnT = St + 32 * LS;
    lds_barrier();
    for (int i = tid; i < 32 * LS / 2; i += NTHR) ((LAS unsigned*)St)[i] = 0u;
    G2State S;
#pragma unroll
    for (int i = 0; i < 2; ++i) { S.accS[i][0] = (f32x4){0.f, 0.f, 0.f, 0.f}; S.accS[i][1] = S.accS[i][0]; }
#pragma unroll
    for (int j = 0; j < 8; ++j) S.opend[j] = 0u;
    G2Regs R0, R1;
#pragma unroll
    for (int i = 0; i < 10; ++i) { R0.f[i] = (bf16x8){0, 0, 0, 0, 0, 0, 0, 0}; R1.f[i] = R0.f[i]; }
#pragma unroll
    for (int i = 0; i < 8; ++i) { R0.u[i] = 0u; R1.u[i] = 0u; }
    R0.gl = 0.f; R1.gl = 0.f;
    g2_load(R0, big, Hb, At, GL, b, h, vq, 0, w, r, quad);
    lds_barrier();
    for (int ch = 0; ch < T / 64; ch += 2) {
        g2_step(F, big, Hb, At, GL, b, h, vq, ch, R0, R1, S, St, vnT, st);
        g2_step(F, big, Hb, At, GL, b, h, vq, ch + 1, R1, R0, S, St, vnT, st);
    }
    if (st) g2_store_o(S, Hb, b, h, vq, T / 64 - 1, w, r, quad);
}
struct SbRegs { v4u k0, k1, v0, v1; };
DI void sb_load(SbRegs& R, const bf16* proj, int b, int h, int k0, int tid) {
    const size_t hb = (size_t)(b * 4 + h) * T + k0;
    const bf16* pk = proj + (size_t)M * 2048 + (hb + (tid >> 3)) * 128 + (tid & 7) * 16;
    R.k0 = *(const GAS v4u*)pk; R.k1 = *(const GAS v4u*)(pk + 8);
    const bf16* pv = proj + (size_t)M * 2560 + (hb + (tid & 63)) * 128 + (tid >> 6) * 16;
    R.v0 = *(const GAS v4u*)pv; R.v1 = *(const GAS v4u*)(pv + 8);
}
DI void sb_unit(Frame& F, const bf16* proj, bf16* mix, int u) {
    constexpr int LDV = 72, LDK = 136, BUF = 128 * LDV + 64 * LDK;
    const int qt = u & 63, h = (u >> 6) & 3, b = u >> 8;
    LAS bf16* lds = (LAS bf16*)F.lds;
    volatile LAS unsigned* flag = (volatile LAS unsigned*)(F.lds + MISC_OFF + 64);
    const int w = F.wave, lane = F.lane, r = lane & 15, quad = lane >> 4;
    const int t0 = qt * 128, qpos = t0 + 16 * w + r;
    const size_t rb = (size_t)b * T;
    bf16x8 qf[4];
#pragma unroll
    for (int kk = 0; kk < 4; ++kk) qf[kk] = *(const GAS bf16x8*)(proj + (size_t)M * 1536 + ((size_t)(b * 4 + h) * T + qpos) * 128 + 32 * kk + 8 * quad);
    f32x4 o[8];
#pragma unroll
    for (int i = 0; i < 8; ++i) o[i] = (f32x4){0.f, 0.f, 0.f, 0.f};
    float carry = 0.f;
    const float scale = 0.08838834764831845f;
    SbRegs R; sb_load(R, proj, b, h, (2 * qt + 1) * 64, F.tid);
    lds_barrier();
    if (F.tid < 3) flag[F.tid] = 1u;
    int it = 0;
    for (int kb = 2 * qt + 1; kb >= 0; --kb, ++it) {
        const int k0 = kb * 64;
        LAS bf16* Vt = lds + (it & 1) * BUF; LAS bf16* Ks = Vt + 128 * LDV;
        { LAS bf16* kd = Ks + (F.tid >> 3) * LDK + (F.tid & 7) * 16; *(LAS v4u*)kd = R.k0; *(LAS v4u*)(kd + 8) = R.k1;
          const unsigned ww[8] = {R.v0.x, R.v0.y, R.v0.z, R.v0.w, R.v1.x, R.v1.y, R.v1.z, R.v1.w}; const int key = F.tid & 63, ds = (F.tid >> 6) * 16;
#pragma unroll
          for (int i = 0; i < 8; ++i) { Vt[(ds + 2 * i) * LDV + key] = (bf16)(ww[i] & 0xffffu); Vt[(ds + 2 * i + 1) * LDV + key] = (bf16)(ww[i] >> 16); } }
        lds_barrier();
        if (it > 0 && flag[(it + 2) % 3] == 0u) break;
        if (F.tid == 0) flag[(it + 1) % 3] = 0u;
        if (kb > 0) sb_load(R, proj, b, h, k0 - 64, F.tid);
        const bool active = (k0 < t0 + 16 * w + 15);
        if (active) {
            const bool full = (k0 + 63 < t0 + 16 * w);
            f32x4 s[4];
#pragma unroll
            for (int mt = 0; mt < 4; ++mt) { s[mt] = (f32x4){0.f, 0.f, 0.f, 0.f};
                const LAS bf16* kp = Ks + (16 * mt + r) * LDK + 8 * quad;
#pragma unroll
                for (int kk = 0; kk < 4; ++kk) s[mt] = mfma16(*(const LAS bf16x8*)(kp + 32 * kk), qf[kk], s[mt]); }
            float l1[4][4], tot[4];
#pragma unroll
            for (int mt = 0; mt < 4; ++mt) { tot[mt] = 0.f;
#pragma unroll
                for (int j = 0; j < 4; ++j) { const float z = s[mt][j] * scale; const bool valid = full || ((k0 + 16 * mt + 4 * quad + j) < qpos);
                    const float tl = __logf(1.0f + __expf(-fabsf(z)));
                    l1[mt][j] = valid ? (fminf(-z, 0.f) - tl) : 0.f; s[mt][j] = valid ? (fminf(z, 0.f) - tl) : -1e30f; tot[mt] += l1[mt][j]; } }
            float run = carry;
#pragma unroll
            for (int mt = 3; mt >= 0; --mt) {
                const float t1 = __shfl_xor(tot[mt], 16), t2 = __shfl_xor(tot[mt], 32), t3 = __shfl_xor(t1, 32);
                float hi = 0.f;
                hi += ((quad ^ 1) > quad) ? t1 : 0.f; hi += ((quad ^ 2) > quad) ? t2 : 0.f; hi += ((quad ^ 3) > quad) ? t3 : 0.f;
                float acc = run + hi;
#pragma unroll
                for (int j = 3; j >= 0; --j) { const float e = s[mt][j] + acc; s[mt][j] = __expf(e); acc += l1[mt][j]; }
                run += (tot[mt] + t1) + (t2 + t3);
            }
            carry = run;
#pragma unroll
            for (int s2 = 0; s2 < 2; ++s2) {
                v4u pw; pw.x = pk2(s[2 * s2][0], s[2 * s2][1]); pw.y = pk2(s[2 * s2][2], s[2 * s2][3]); pw.z = pk2(s[2 * s2 + 1][0], s[2 * s2 + 1][1]); pw.w = pk2(s[2 * s2 + 1][2], s[2 * s2 + 1][3]);
                const bf16x8 pf = __builtin_bit_cast(bf16x8, pw);
#pragma unroll
                for (int dt = 0; dt < 8; ++dt) { const LAS bf16* vp = Vt + (16 * dt + r) * LDV + 32 * s2 + 4 * quad;
                    const s16x4 lo = *(const LAS s16x4*)vp, hi4 = *(const LAS s16x4*)(vp + 16);
                    o[dt] = mfma16(__builtin_shufflevector(lo, hi4, 0, 1, 2, 3, 4, 5, 6, 7), pf, o[dt]); }
            }
        }
        if (!(carry < -SB_THR)) flag[it % 3] = 1u;
    }
    bf16* op = mix + (rb + qpos) * D + 512 + h * 128 + 4 * quad;
#pragma unroll
    for (int dt = 0; dt < 8; ++dt) *(GAS v2u*)(op + 16 * dt) = (v2u){pk2(o[dt][0], o[dt][1]), pk2(o[dt][2], o[dt][3])};
}
struct XaRegs { v4u k[4], v[4]; };
DI void xa_load(XaRegs& R, const bf16* KV, int l, int b, int h, int c, int tid) {
    const bf16* pk = KV + (size_t)(b * MEMLEN + 64 * c + (tid >> 3)) * 8192 + 2048 * l + h * 256 + (tid & 7) * 32;
    const bf16* pv = KV + (size_t)(b * MEMLEN + 64 * c + (tid & 63)) * 8192 + 2048 * l + 1024 + h * 256 + (tid >> 6) * 32;
#pragma unroll
    for (int i = 0; i < 4; ++i) { R.k[i] = *(const GAS v4u*)(pk + 8 * i); R.v[i] = *(const GAS v4u*)(pv + 8 * i); }
}
DI void xattn_phase(Frame& F, const bf16* Q, const bf16* KV, int l, bf16* O) {
    constexpr int LDK = 264, LDV = 72, BUF = 64 * LDK + 256 * LDV;
    LAS bf16* lds = (LAS bf16*)F.lds;
    const int per = (2048 + F.G - 1) / F.G, u0 = F.wg * per, u1 = (u0 + per < 2048) ? u0 + per : 2048;
    if (u0 >= u1) return;
    const int w = F.wave, lane = F.lane, r = lane & 15, quad = lane >> 4, tid = F.tid;
    XaRegs R; xa_load(R, KV, l, (u0 >> 6) >> 2, (u0 >> 6) & 3, 0, tid);
    int step = 0;
    for (int u = u0; u < u1; ++u) {
        const int bh = u >> 6, qt = u & 63, b = bh >> 2, h = bh & 3;
        const size_t row = (size_t)b * T + qt * 128 + 16 * w + r;
        bf16x8 qf[8];
#pragma unroll
        for (int kk = 0; kk < 8; ++kk) qf[kk] = *(const GAS bf16x8*)(Q + row * D + h * 256 + 32 * kk + 8 * quad);
        f32x4 o[16];
#pragma unroll
        for (int i = 0; i < 16; ++i) o[i] = (f32x4){0.f, 0.f, 0.f, 0.f};
        float mrun = -1e30f, lsum = 0.f;
        for (int c = 0; c < 4; ++c, ++step) {
            LAS bf16* Kc = lds + (step & 1) * BUF; LAS bf16* Vt = Kc + 64 * LDK;
            { LAS bf16* kd = Kc + (tid >> 3) * LDK + (tid & 7) * 32;
#pragma unroll
              for (int i = 0; i < 4; ++i) *(LAS v4u*)(kd + 8 * i) = R.k[i];
              const int key = tid & 63, ds = (tid >> 6) * 32;
#pragma unroll
              for (int i = 0; i < 4; ++i) { const unsigned ww[4] = {R.v[i].x, R.v[i].y, R.v[i].z, R.v[i].w};
#pragma unroll
                  for (int e = 0; e < 4; ++e) { Vt[(ds + 8 * i + 2 * e) * LDV + key] = (bf16)(ww[e] & 0xffffu); Vt[(ds + 8 * i + 2 * e + 1) * LDV + key] = (bf16)(ww[e] >> 16); } } }
            lds_barrier();
            { const int un = (c == 3) ? u + 1 : u;
              if (un < u1) xa_load(R, KV, l, (un >> 6) >> 2, (un >> 6) & 3, (c + 1) & 3, tid); }
            f32x4 s[4];
#pragma unroll
            for (int mt = 0; mt < 4; ++mt) { s[mt] = (f32x4){0.f, 0.f, 0.f, 0.f};
                const LAS bf16* kp = Kc + (16 * mt + r) * LDK + 8 * quad;
#pragma unroll
                for (int kk = 0; kk < 8; ++kk) s[mt] = mfma16(*(const LAS bf16x8*)(kp + 32 * kk), qf[kk], s[mt]); }
            float mx = -1e30f;
#pragma unroll
            for (int mt = 0; mt < 4; ++mt) mx = fmaxf(fmaxf(fmaxf(s[mt][0], s[mt][1]), fmaxf(s[mt][2], s[mt][3])), mx);
            mx = fmaxf(mx, __shfl_xor(mx, 16)); mx = fmaxf(mx, __shfl_xor(mx, 32));
            const float mnew = fmaxf(mrun, mx), alpha = __expf((mrun - mnew) * 0.0625f); mrun = mnew;
            float ps = 0.f;
#pragma unroll
            for (int mt = 0; mt < 4; ++mt)
#pragma unroll
                for (int j = 0; j < 4; ++j) { const float p = __expf((s[mt][j] - mnew) * 0.0625f); s[mt][j] = p; ps += p; }
            lsum = lsum * alpha + ps;
#pragma unroll
            for (int i = 0; i < 16; ++i) o[i] = o[i] * alpha;
#pragma unroll
            for (int s2 = 0; s2 < 2; ++s2) {
                v4u pw; pw.x = pk2(s[2 * s2][0], s[2 * s2][1]); pw.y = pk2(s[2 * s2][2], s[2 * s2][3]); pw.z = pk2(s[2 * s2 + 1][0], s[2 * s2 + 1][1]); pw.w = pk2(s[2 * s2 + 1][2], s[2 * s2 + 1][3]);
                const bf16x8 pf = __builtin_bit_cast(bf16x8, pw);
#pragma unroll
                for (int dt = 0; dt < 16; ++dt) { const LAS bf16* vp = Vt + (16 * dt + r) * LDV + 32 * s2 + 4 * quad;
                    const s16x4 lo = *(const LAS s16x4*)vp, hi4 = *(const LAS s16x4*)(vp + 16);
                    o[dt] = mfma16(__builtin_shufflevector(lo, hi4, 0, 1, 2, 3, 4, 5, 6, 7), pf, o[dt]); }
            }
        }
        lsum += __shfl_xor(lsum, 16); lsum += __shfl_xor(lsum, 32);
        const float inv = rcp_(lsum);
        bf16* op = O + row * D + h * 256 + 4 * quad;
#pragma unroll
        for (int dt = 0; dt < 16; ++dt) *(GAS v2u*)(op + 16 * dt) = (v2u){pk2(o[dt][0] * inv, o[dt][1] * inv), pk2(o[dt][2] * inv, o[dt][3] * inv)};
    }
    lds_barrier();
}
template <class Epi> DI void run_gemm(Frame& F, const bf16* A, const bf16* Bt, int M_, int N_, int K_, const Epi& E) {
    pg8::Gemm g{A, Bt, M_, N_, K_}; pg8::StaticOrder S; S.init(M_, N_, F.G, F.wg);
    pg8::gemm_phase<Epi, pg8::StaticOrder, PG8_ALIGN, PG8_SP2>(F.lds, g, S, E, F.tid);
}
constexpr int NPHASE = 43, PH_FINAL = 42, PPL = 10;
constexpr int SB_N1 = 512, SB_N2 = 1280;
struct Args { In in; float* out; unsigned char* ws; int ph_lo, ph_hi, region, pad; };
__global__ void __launch_bounds__(NTHR, 2) fwd(Args a) {
    extern __shared__ __attribute__((aligned(16))) unsigned char lds_raw[];
    Frame F;
    F.lds = (LAS unsigned char*)lds_raw;
    F.tid = threadIdx.x; F.lane = F.tid & 63; F.wave = __builtin_amdgcn_readfirstlane(F.tid >> 6);
    F.G = gridDim.x; F.wg = blockIdx.x; F.gw = F.wg * NWAVES + F.wave; F.NGW = F.G * NWAVES;
    volatile LAS unsigned* MISC = (volatile LAS unsigned*)(F.lds + MISC_OFF);
    if (F.tid < 32) MISC[F.tid] = 0u;
    __syncthreads();
    const int lo = a.ph_lo, hi = a.ph_hi;
    unsigned char* ws = a.ws; const In& I = a.in;
    XcdBarrier bar; bar.bar = (unsigned*)(ws + WS_CTL) + CW_BAR + a.region * XCD_BAR_WORDS; bar.x = 0; bar.st = MISC + 8;
    if (hi - lo > 1) bar = xcd_barrier_post(bar.bar, MISC + 8);
#define IN(k) (lo <= (k) && (k) < hi)
#ifndef PROBE_DOUBLE
#define PROBE_DOUBLE -1
#endif
#ifndef PROBE_PAR
#define PROBE_PAR -1
#endif
#define PHASE(k) asm volatile("" : "+v"(F.tid)); F.lane = F.tid & 63; if (IN(k))
#define DUPQ(c) ((c) == PROBE_DOUBLE && (PROBE_PAR < 0 || (l & 1) == PROBE_PAR))
#ifndef PROBE_SEL
#define PROBE_SEL -1
#endif
    F.tacc = 0ull;
    unsigned long long tacc = 0ull, tlast = (PROBE_SEL >= 0) ? __builtin_amdgcn_s_memrealtime() : 0ull;
#define SELQ(k) ((PROBE_SEL >= 0 && PROBE_SEL <= 12) ? ((k) >= 2 && (k) < PH_FINAL && ((k) - 2) % PPL == PROBE_SEL && (PROBE_PAR < 0 || ((((k) - 2) / PPL) & 1) == PROBE_PAR)) : (PROBE_SEL == 101 ? (k) == 0 : (PROBE_SEL == 102 ? (k) == 1 : (PROBE_SEL == 103 ? (k) == PH_FINAL : false))))
#define SEAM(k) do { if (IN(k) && IN((k) + 1)) { \
        if (PROBE_SEL >= 0) { const unsigned long long tn_ = __builtin_amdgcn_s_memrealtime(); if (SELQ(k)) tacc += tn_ - tlast; tlast = tn_; } \
        xcd_barrier(bar); \
        if (PROBE_SEL >= 0) { const unsigned long long tn_ = __builtin_amdgcn_s_memrealtime(); if (PROBE_SEL == 100 || (PROBE_SEL >= 200 && (k) >= 2 && (k) < PH_FINAL && ((k) - 2) % PPL == PROBE_SEL - 200 && (PROBE_PAR < 0 || ((((k) - 2) / PPL) & 1) == PROBE_PAR))) tacc += tn_ - tlast; tlast = tn_; } } } while (0)
    bf16* XS = (bf16*)(ws + WS_H); unsigned char* mixb = (unsigned char*)a.out; bf16* MIX = (bf16*)mixb; unsigned char* scrb = mixb + 128 * MiB; bf16* SCR = (bf16*)scrb;
    bf16* BIG = (bf16*)(ws + WS_BIG); bf16* KVX = (bf16*)(ws + WS_KVX);
    float* GATE = (float*)(ws + WS_GATE); const bf16* WG = (const bf16*)(ws + WS_WG);

    PHASE(0) { p0_prologue(F, I, ws);
#ifdef PROBE_P0
        p0_prologue(F, I, ws);
#endif
    }
    SEAM(0);
    PHASE(1) run_gemm(F, (const bf16*)(ws + WS_MEMN), (const bf16*)(ws + WS_WKV), BATCH * MEMLEN, 8192, D, pg8::EpiBf16<0>{KVX, 8192, nullptr});
    SEAM(1);
    pg8::rs_t* RSA = (pg8::rs_t*)(ws + WS_RS);
#define RS_R(p) (RSA + (size_t)((p) & 1) * M)
#define RS_ZERO(p) do { pg8::rs_t* z_ = RSA + (size_t)(((p) + 1) & 1) * M; for (int i_ = F.wg * NTHR + F.tid; i_ < M; i_ += F.G * NTHR) __hip_atomic_store(z_ + i_, (pg8::rs_t)0, __ATOMIC_RELAXED, __HIP_MEMORY_SCOPE_AGENT); } while (0)
    for (int l = 0; l < DEPTH; ++l) {
        asm volatile("" : "+v"(F.tid)); F.lane = F.tid & 63;
        const int pb = 2 + PPL * l, j = l >> 1; const bool odd = (l & 1) != 0;
        unsigned char* wl = ws + WS_W + (size_t)l * W_LAYER;
        PHASE(pb + 0) { const int n = odd ? C_N : AB_N;
            run_gemm(F, XS, (const bf16*)(wl + WO_WIN), M, n, D, pg8::EpiBlk{BIG, odd ? (bf16*)(mixb + MIX_HALO) : nullptr, odd ? 2 : 1, RS_R(3 * l)});
            if (DUPQ(0)) { run_gemm(F, XS, (const bf16*)(wl + WO_WIN), M, n, D, pg8::EpiBlk{BIG, odd ? (bf16*)(mixb + MIX_HALO) : nullptr, odd ? 2 : 1, RS_R(3 * l)}); }
            if (!odd) gates_phase<1>(F, XS, RS_R(3 * l), WG + l * 16384, GATE, I.p[4] + j * 4, I.p[5] + j * 4);
            else gates_phase<2>(F, XS, RS_R(3 * l), WG + l * 16384, GATE, I.p[10] + j * 8, I.p[11] + j * 8);
        }
        SEAM(pb + 0);
        PHASE(pb + 1) {
            if (!odd) {
                mlstm_a_phase(F, BIG, GATE, (bf16*)(scrb + H_NUML), (bf16*)(scrb + H_DC), (float*)(ws + WS_MLS));
                for (int u = F.wg; u < SB_N1; u += F.G) sb_unit(F, BIG, MIX, u);
            } else {
                gdn_g1_phase(F, BIG, (const bf16*)(mixb + MIX_HALO), GATE, I.p[9] + (size_t)j * 4 * 3072, SCR, (bf16*)(mixb + MIX_AT), (float*)(mixb + MIX_GL), true);
            }
        }
        SEAM(pb + 1);
        PHASE(pb + 2) {
            if (odd) { for (int c = F.wg; c < 256; c += F.G) gdn_g2_chain(F, BIG, SCR, (const bf16*)(mixb + MIX_AT), (const float*)(mixb + MIX_GL), c, true); }
            else { mlstm_b_phase(F, (bf16*)(scrb + H_DC), (float*)(ws + WS_MLS)); for (int u = SB_N1 + F.wg; u < SB_N2; u += F.G) sb_unit(F, BIG, MIX, u); }
        }
        SEAM(pb + 2);
        PHASE(pb + 3) {
            if (odd) headnorm_phase<true>(F, SCR, MIX, BIG, I.p[12] + j * 128);
            else { mlstm_c_phase(F, BIG, (const bf16*)(scrb + H_NUML), (const bf16*)(scrb + H_DC), (const float*)(ws + WS_MLS), I.p[6] + j * 512, MIX); for (int u = SB_N2 + F.wg; u < 2048; u += F.G) sb_unit(F, BIG, MIX, u); }
        }
        SEAM(pb + 3);
        PHASE(pb + 4) { RS_ZERO(3 * l + 1); run_gemm(F, MIX, (const bf16*)(wl + WO_WOUT), M, D, D, pg8::EpiResidB{XS, RS_R(3 * l + 1)}); }
        SEAM(pb + 4);
        PHASE(pb + 5) { run_gemm(F, XS, (const bf16*)(wl + WO_WQ), M, D, D, pg8::EpiBf16<0>{BIG, D, RS_R(3 * l + 1)}); if (DUPQ(5)) { run_gemm(F, XS, (const bf16*)(wl + WO_WQ), M, D, D, pg8::EpiBf16<0>{BIG, D, RS_R(3 * l + 1)}); } }
        SEAM(pb + 5);
        PHASE(pb + 6) { xattn_phase(F, BIG, KVX, l, MIX); if (DUPQ(6)) { xattn_phase(F, BIG, KVX, l, MIX); } }
        SEAM(pb + 6);
        PHASE(pb + 7) { RS_ZERO(3 * l + 2); run_gemm(F, MIX, (const bf16*)(wl + WO_WO), M, D, D, pg8::EpiResidB{XS, RS_R(3 * l + 2)}); }
        SEAM(pb + 7);
        PHASE(pb + 8) { run_gemm(F, XS, (const bf16*)(wl + WO_W1), M, FF, D, pg8::EpiBf16<2>{BIG, FF, RS_R(3 * l + 2)}); if (DUPQ(8)) { run_gemm(F, XS, (const bf16*)(wl + WO_W1), M, FF, D, pg8::EpiBf16<2>{BIG, FF, RS_R(3 * l + 2)}); } }
        SEAM(pb + 8);
        PHASE(pb + 9) { RS_ZERO(3 * l + 3); run_gemm(F, BIG, (const bf16*)(wl + WO_W2), M, D, FF, pg8::EpiResidB{XS, RS_R(3 * l + 3)}); }
        SEAM(pb + 9);
    }
    PHASE(PH_FINAL) final_norm_phase(F, XS, a.out, I.p[23]);
    if (PROBE_SEL >= 0) { const unsigned long long te = __builtin_amdgcn_s_memrealtime(); if (SELQ(PH_FINAL)) tacc += te - tlast;

#ifdef PROBE_WGLO
        if (!(F.wg >= PROBE_WGLO && F.wg < PROBE_WGHI)) tacc = 0ull;
#endif
        if (PROBE_STG >= 0) tacc = F.tacc;
        while (__builtin_amdgcn_s_memrealtime() - te < tacc) __builtin_amdgcn_s_sleep(16); }
#undef IN
#undef PHASE
#undef SEAM
}

#ifndef MK_SPLIT
#define MK_SPLIT 0
#endif
extern "C" void kernel_launch(void* const* d_in, const int* in_sizes, int n_in, void* d_out, int out_size, void* d_ws, size_t ws_size, hipStream_t stream) {
    static int grid = 0;
    if (grid == 0) {
        if (n_in != 24 || in_sizes[0] != M * D || out_size != M * D || ws_size < WS_END) { fprintf(stderr, "kernel_launch: unexpected shapes (n_in %d, in0 %d, out %d, ws %zu)\n", n_in, n_in > 0 ? in_sizes[0] : -1, out_size, ws_size); grid = -1; return; }
        int dev = 0, cus = 0;
        if (hipGetDevice(&dev) != hipSuccess || hipDeviceGetAttribute(&cus, hipDeviceAttributeMultiprocessorCount, dev) != hipSuccess) { grid = -1; return; }
        if (hipFuncSetAttribute((const void*)fwd, hipFuncAttributeMaxDynamicSharedMemorySize, LDS_BYTES) != hipSuccess) { fprintf(stderr, "kernel_launch: hipFuncSetAttribute failed\n"); grid = -1; return; }
        (void)hipGetLastError();
        grid = cus;
    }
    if (grid < 0) return;
    (void)hipMemsetAsync((char*)d_ws + WS_CTL, 0, CTL_ZERO_BYTES, stream);
    Args a{};
    for (int i = 0; i < 24; ++i) a.in.p[i] = (const float*)d_in[i];
    a.out = (float*)d_out; a.ws = (unsigned char*)d_ws; a.region = 0; a.pad = 0;
#if MK_SPLIT
    for (int p = 0; p < NPHASE; ++p) { a.ph_lo = p; a.ph_hi = p + 1; hipLaunchKernelGGL(fwd, dim3(grid), dim3(NTHR), LDS_BYTES, stream, a); }
#else
    a.ph_lo = 0; a.ph_hi = NPHASE; hipLaunchKernelGGL(fwd, dim3(grid), dim3(NTHR), LDS_BYTES, stream, a);
#endif
}
```

```cpp
#include <hip/hip_runtime.h>
#include <cstdio>
#include <cstdint>
namespace pg8 {
#define PG8_LAS __attribute__((address_space(3)))
typedef unsigned short bf16_t;
typedef short bf16x8 __attribute__((ext_vector_type(8)));
typedef float f32x4 __attribute__((ext_vector_type(4)));
typedef unsigned u32x4 __attribute__((ext_vector_type(4)));
constexpr int BM = 256, BK = 64, HALF = 128, HTB = HALF * BK * 2  , STAGE_BYTES = 8 * HTB, NXCD = 8, WGM = 8;

__host__ __device__ __forceinline__ int lds_byte(int r, int c) { const int st = (r >> 4) * 2 + (c >> 5), rr = r & 15, cc = c & 31, ob = rr * 64 + cc * 2; return st * 1024 + (ob ^ (((ob >> 9) & 1) << 5)); }
__host__ __device__ __forceinline__ void stage_rc(int b, int& R, int& C) { const int st = b / 1024, sb = b % 1024, swz = sb ^ (((sb >> 9) & 1) << 5); R = (st >> 1) * 16 + swz / 64; C = (st & 1) * 32 + (swz % 64) / 2; }
__host__ __device__ __forceinline__ int perm32(int rho) { const int n = rho >> 4, i = rho & 15; return 8 * (i >> 2) + 4 * n + (i & 3); }

struct Unit { int pm, pn; };
struct Gemm { const bf16_t* A; const bf16_t* Bt; int M, N, K; };

struct StaticOrder {
    int nM, nN, nwg, G, c;
    __host__ __device__ void init(int M, int N, int G_, int c_) { nM = M / BM; nN = N / BM; nwg = nM * nN; G = G_; c = c_; }
    __host__ __device__ bool next(int i, Unit& u) const {
        const long L = (long)i * G + c; if (L >= nwg) return false;
        int wgid = (int)L; { const int q = nwg / NXCD, r = nwg % NXCD, xcd = wgid % NXCD, off = wgid / NXCD; wgid = (xcd < r ? xcd * (q + 1) : r * (q + 1) + (xcd - r) * q) + off; }
        const int nig = WGM * nN, gid = wgid / nig, fm = gid * WGM, gsz = (nM - fm) < WGM ? (nM - fm) : WGM;
        u.pm = fm + ((wgid % nig) % gsz); u.pn = (wgid % nig) / gsz; return true;
    }
    __device__ __forceinline__ void a_ready(const Unit&) const {}
    __device__ __forceinline__ void done(const Unit&) const {}
};

__device__ __forceinline__ unsigned cvt_pk_bf16(float lo, float hi) { unsigned r; asm volatile("v_cvt_pk_bf16_f32 %0, %1, %2" : "=v"(r) : "v"(lo), "v"(hi)); return r; }
typedef unsigned long long rs_t;
struct Rstd8 { float v[2][4]; };
__device__ __forceinline__ rs_t rs_fix(float ss) { return (rs_t)(ss * 16777216.0f + 0.5f); }
__device__ __forceinline__ float row_rstd(const rs_t* rs, int row) { return __builtin_amdgcn_rsqf((float)__hip_atomic_load(rs + row, __ATOMIC_RELAXED, __HIP_MEMORY_SCOPE_AGENT) * (1.0f / (16777216.0f * 1024.0f)) + 1e-6f); }
__device__ __forceinline__ Rstd8 rstd8(const rs_t* rs, int row0) { Rstd8 r; unsigned long long q[2][4];
#pragma unroll
    for (int ai = 0; ai < 2; ++ai)
#pragma unroll
        for (int m = 0; m < 4; ++m) q[ai][m] = rs[row0 + ai * HALF + m * 16];
#pragma unroll
    for (int ai = 0; ai < 2; ++ai)
#pragma unroll
        for (int m = 0; m < 4; ++m) r.v[ai][m] = __builtin_amdgcn_rsqf((float)q[ai][m] * (1.0f / (16777216.0f * 1024.0f)) + 1e-6f);
    return r; }
template <int ACT> struct EpiBf16 {
    static constexpr bool PERM = true, AFTER_DRAIN = false;
    bf16_t* O; int ldc; const rs_t* rs;
    __device__ __forceinline__ void operator()(const f32x4 (&acc)[2][2][4][2], const Unit& u, int wr, int wc, int fr, int fq) const {
        const int row0 = u.pm * BM + wr * 64 + fr; const int col0 = u.pn * BM + wc * 32 + 8 * fq;
        Rstd8 R8;
        if (rs) R8 = rstd8(rs, row0); else {
#pragma unroll
            for (int i = 0; i < 8; ++i) R8.v[i >> 2][i & 3] = 1.0f; }
#pragma unroll
        for (int ai = 0; ai < 2; ++ai)
#pragma unroll
            for (int m = 0; m < 4; ++m) { bf16_t* rowp = O + (size_t)(row0 + ai * HALF + m * 16) * ldc + col0;
                const float sc = R8.v[ai][m];
#pragma unroll
                for (int bj = 0; bj < 2; ++bj) { f32x4 v0 = acc[ai][bj][m][0] * sc, v1 = acc[ai][bj][m][1] * sc;
                    if (ACT == 2) {
#pragma unroll
                        for (int j = 0; j < 4; ++j) { v0[j] = fmaxf(v0[j], 0.f); v1[j] = fmaxf(v1[j], 0.f); }
                        v0 = v0 * v0; v1 = v1 * v1; }
                    u32x4 w; w.x = cvt_pk_bf16(v0[0], v0[1]); w.y = cvt_pk_bf16(v0[2], v0[3]); w.z = cvt_pk_bf16(v1[0], v1[1]); w.w = cvt_pk_bf16(v1[2], v1[3]);
                    *(u32x4*)(rowp + bj * HALF) = w; }
                if (m & 1) asm volatile("" ::: "memory"); }
    }
};


struct EpiTile {
    static constexpr bool PERM = true, AFTER_DRAIN = false;
    bf16_t* O; int MODE; int mtiles; const rs_t* rs;
    __device__ __forceinline__ void operator()(const f32x4 (&acc)[2][2][4][2], const Unit& u, int wr, int wc, int fr, int fq) const {
        const size_t blk = (MODE == 0) ? (size_t)(((u.pn >> 2) * 8 + u.pm) * 4 + (u.pn & 3)) : (MODE == 1) ? (size_t)(((u.pm >> 2) * 8 + u.pn) * 4 + (u.pm & 3)) : (size_t)u.pn * mtiles + u.pm;
        bf16_t* base = O + blk * 65536 + (size_t)(wr * 64 + fr) * 256 + wc * 32 + 8 * fq;
        Rstd8 R8;
        if (MODE == 2) R8 = rstd8(rs, u.pm * BM + wr * 64 + fr); else {
#pragma unroll
            for (int i = 0; i < 8; ++i) R8.v[i >> 2][i & 3] = 1.0f; }
#pragma unroll
        for (int ai = 0; ai < 2; ++ai)
#pragma unroll
            for (int m = 0; m < 4; ++m) { const float sc = R8.v[ai][m];
#pragma unroll
                for (int bj = 0; bj < 2; ++bj) { const f32x4 v0 = acc[ai][bj][m][0] * sc, v1 = acc[ai][bj][m][1] * sc;
                    u32x4 w; w.x = cvt_pk_bf16(v0[0], v0[1]); w.y = cvt_pk_bf16(v0[2], v0[3]); w.z = cvt_pk_bf16(v1[0], v1[1]); w.w = cvt_pk_bf16(v1[2], v1[3]);
                    *(u32x4*)(base + (size_t)(ai * HALF + m * 16) * 256 + bj * HALF) = w; }
                if (m & 1) asm volatile("" ::: "memory"); }
    }
};
struct EpiSoftmaxP {
    static constexpr bool PERM = true, AFTER_DRAIN = false;
    bf16_t* P; PG8_LAS float* xch; const rs_t* rs;
    __device__ __forceinline__ void operator()(const f32x4 (&acc)[2][2][4][2], const Unit& u, int wr, int wc, int fr, int fq) const {
        float mw[2][4];
        f32x4 e[2][2][4][2];
        Rstd8 R8 = rstd8(rs, u.pm * BM + wr * 64 + fr);
#pragma unroll
        for (int ai = 0; ai < 2; ++ai)
#pragma unroll
            for (int m = 0; m < 4; ++m) R8.v[ai][m] *= 0.0625f;
#pragma unroll
        for (int ai = 0; ai < 2; ++ai)
#pragma unroll
            for (int m = 0; m < 4; ++m) { float mx = -1e30f; const float sc = R8.v[ai][m];
#pragma unroll
                for (int bj = 0; bj < 2; ++bj)
#pragma unroll
                    for (int n = 0; n < 2; ++n) { const f32x4 v = acc[ai][bj][m][n]; mx = fmaxf(mx, fmaxf(fmaxf(v[0], v[1]), fmaxf(v[2], v[3]))); }
                mx = fmaxf(mx, __shfl_xor(mx, 16)); mx = fmaxf(mx, __shfl_xor(mx, 32)); float l = 0.f;
#pragma unroll
                for (int bj = 0; bj < 2; ++bj)
#pragma unroll
                    for (int n = 0; n < 2; ++n) { const f32x4 v = acc[ai][bj][m][n]; f32x4 t; t[0] = __expf((v[0] - mx) * sc); t[1] = __expf((v[1] - mx) * sc); t[2] = __expf((v[2] - mx) * sc); t[3] = __expf((v[3] - mx) * sc);
                        e[ai][bj][m][n] = t; l += (t[0] + t[1]) + (t[2] + t[3]); }
                l += __shfl_xor(l, 16); l += __shfl_xor(l, 32);
                mw[ai][m] = mx;
                if (fq == 0) { typedef float f2_ __attribute__((ext_vector_type(2))); *(PG8_LAS f2_*)(xch + ((wr * 64 + fr + ai * HALF + m * 16) * 4 + wc) * 2) = (f2_){mx, l}; } }
        asm volatile("s_waitcnt lgkmcnt(0)" ::: "memory"); __builtin_amdgcn_s_barrier(); asm volatile("" ::: "memory");
        bf16_t* base = P + (size_t)(u.pm * BM + wr * 64 + fr) * 1024 + (u.pn & 3) * 256 + wc * 32 + 8 * fq;
#pragma unroll
        for (int ai = 0; ai < 2; ++ai)
#pragma unroll
            for (int m = 0; m < 4; ++m) { const float sc = R8.v[ai][m]; const PG8_LAS f32x4* xp = (const PG8_LAS f32x4*)(xch + (wr * 64 + fr + ai * HALF + m * 16) * 8); const f32x4 a = xp[0], b = xp[1];
                const float mx = fmaxf(fmaxf(a[0], a[2]), fmaxf(b[0], b[2]));
                const float l = (a[1] * __expf((a[0] - mx) * sc) + a[3] * __expf((a[2] - mx) * sc)) + (b[1] * __expf((b[0] - mx) * sc) + b[3] * __expf((b[2] - mx) * sc));
                const float f = __expf((mw[ai][m] - mx) * sc) * __builtin_amdgcn_rcpf(l);
#pragma unroll
                for (int bj = 0; bj < 2; ++bj) { const f32x4 v0 = e[ai][bj][m][0] * f, v1 = e[ai][bj][m][1] * f;
                    u32x4 w; w.x = cvt_pk_bf16(v0[0], v0[1]); w.y = cvt_pk_bf16(v0[2], v0[3]); w.z = cvt_pk_bf16(v1[0], v1[1]); w.w = cvt_pk_bf16(v1[2], v1[3]);
                    *(u32x4*)(base + (size_t)(ai * HALF + m * 16) * 1024 + bj * HALF) = w; }
                if (m & 1) asm volatile("" ::: "memory"); }
    }
};
struct EpiOtile {
    static constexpr bool PERM = true, AFTER_DRAIN = false;
    bf16_t* O; int mtiles;
    __device__ __forceinline__ void operator()(const f32x4 (&acc)[2][2][4][2], const Unit& u, int wr, int wc, int fr, int fq) const {
        const int h = u.pm / mtiles, panel = u.pm - h * mtiles;
        bf16_t* base = O + (size_t)(panel * BM + wr * 64 + fr) * 1024 + h * 256 + wc * 32 + 8 * fq;
#pragma unroll
        for (int ai = 0; ai < 2; ++ai)
#pragma unroll
            for (int m = 0; m < 4; ++m) {
#pragma unroll
                for (int bj = 0; bj < 2; ++bj) { const f32x4 v0 = acc[ai][bj][m][0], v1 = acc[ai][bj][m][1];
                    u32x4 w; w.x = cvt_pk_bf16(v0[0], v0[1]); w.y = cvt_pk_bf16(v0[2], v0[3]); w.z = cvt_pk_bf16(v1[0], v1[1]); w.w = cvt_pk_bf16(v1[2], v1[3]);
                    *(u32x4*)(base + (size_t)(ai * HALF + m * 16) * 1024 + bj * HALF) = w; } }
    }
};
struct XbOrder {
    int G, c, nunits, ppb, layer;
    __device__ bool next(int i, Unit& u) const { const long L = (long)i * G + c; if (L >= nunits) return false;
        const int w = ((int)L & 7) * (nunits >> 3) + ((int)L >> 3), k = w & 31, panel = (w >> 5) * 8 + (k & 7), ct = k >> 3;
        u.pm = panel; u.pn = (layer * 8 + panel / ppb) * 4 + ct; return true; }
    __device__ __forceinline__ void a_ready(const Unit&) const {}
    __device__ __forceinline__ void done(const Unit&) const {}
};
struct FoldOrder {
    int G, c, MODE, wlt;
    __device__ bool next(int i, Unit& u) const { const int L = i * G + c; if (L >= 512) return false; const int kb = L >> 2, wt = (kb >> 5) * wlt + (kb & 3) * 4 + (L & 3);
        u.pm = MODE == 0 ? kb : wt; u.pn = MODE == 0 ? wt : kb; return true; }
    __device__ __forceinline__ void a_ready(const Unit&) const {}
    __device__ __forceinline__ void done(const Unit&) const {}
};

struct EpiBlk {
    static constexpr bool PERM = true, AFTER_DRAIN = false;
    bf16_t* O; bf16_t* halo; int LAYOUT; const rs_t* rs;
    __device__ __forceinline__ void operator()(const f32x4 (&acc)[2][2][4][2], const Unit& u, int wr, int wc, int fr, int fq) const {
        constexpr int TT = 8192; constexpr size_t MTOT = 65536;
        const int row0 = u.pm * BM + wr * 64 + fr; const int b = row0 >> 13, t0 = row0 & (TT - 1);
        const int col0 = u.pn * BM + wc * 32 + 8 * fq;
        const bool dohalo = (LAYOUT == 2) && (halo != nullptr) && (fr >= 13) && (u.pn < 12);
        const Rstd8 R8 = rstd8(rs, row0);
        size_t base[2]; int wv[2];
#pragma unroll
        for (int bj = 0; bj < 2; ++bj) {
            const int cb = u.pn * BM + bj * HALF + wc * 32;
            if (LAYOUT == 2) { const int c0 = cb & ~1023, h = (cb >> 7) & 7; wv[bj] = 128; base[bj] = MTOT * c0 + (size_t)((b * 8 + h) * TT) * 128 + (cb & 127) + 8 * fq; }
            else if (cb < 512) { const int c0 = cb & ~255, h = (cb >> 6) & 3; wv[bj] = 64; base[bj] = MTOT * c0 + (size_t)((b * 4 + h) * TT) * 64 + (cb & 63) + 8 * fq; }
            else { const int c0 = 512 + ((cb - 512) & ~511), h = ((cb - 512) >> 7) & 3; wv[bj] = 128; base[bj] = MTOT * c0 + (size_t)((b * 4 + h) * TT) * 128 + (cb & 127) + 8 * fq; }
        }
#pragma unroll
        for (int ai = 0; ai < 2; ++ai)
#pragma unroll
            for (int m = 0; m < 4; ++m) { const int t = t0 + ai * HALF + m * 16; const float sc = R8.v[ai][m];
#pragma unroll
                for (int bj = 0; bj < 2; ++bj) {
                    const f32x4 v0 = acc[ai][bj][m][0] * sc, v1 = acc[ai][bj][m][1] * sc;
                    u32x4 ww; ww.x = cvt_pk_bf16(v0[0], v0[1]); ww.y = cvt_pk_bf16(v0[2], v0[3]); ww.z = cvt_pk_bf16(v1[0], v1[1]); ww.w = cvt_pk_bf16(v1[2], v1[3]);
                    *(u32x4*)(O + base[bj] + (size_t)t * wv[bj]) = ww;
                    if (m == 3 && dohalo) *(u32x4*)(halo + ((size_t)((row0 + ai * HALF + 48) >> 6) * 3 + (fr - 13)) * 3072 + col0 + bj * HALF) = ww; }
                if (m & 1) asm volatile("" ::: "memory"); }
    }
};
struct EpiResidB {
    static constexpr bool PERM = true, AFTER_DRAIN = false;
    bf16_t* xs; rs_t* rs;
    __device__ __forceinline__ void operator()(const f32x4 (&acc)[2][2][4][2], const Unit& u, int wr, int wc, int fr, int fq) const {
        const int row0 = u.pm * BM + wr * 64 + fr, col0 = u.pn * BM + wc * 32 + 8 * fq;
#pragma unroll
        for (int ai = 0; ai < 2; ++ai) {
            u32x4 old[4][2];
#pragma unroll
            for (int m = 0; m < 4; ++m) { const bf16_t* p = xs + (size_t)(row0 + ai * HALF + m * 16) * 1024 + col0;
#pragma unroll
                for (int bj = 0; bj < 2; ++bj) old[m][bj] = *(const u32x4*)(p + bj * HALF); }
#pragma unroll
            for (int m = 0; m < 4; ++m) { const int row = row0 + ai * HALF + m * 16; bf16_t* p = xs + (size_t)row * 1024 + col0; float ss = 0.f;
#pragma unroll
                for (int bj = 0; bj < 2; ++bj) { const u32x4 b = old[m][bj]; const f32x4 a0 = acc[ai][bj][m][0], a1 = acc[ai][bj][m][1];
                    u32x4 w; w.x = cvt_pk_bf16(__uint_as_float(b.x << 16) + a0[0], __uint_as_float(b.x & 0xffff0000u) + a0[1]); w.y = cvt_pk_bf16(__uint_as_float(b.y << 16) + a0[2], __uint_as_float(b.y & 0xffff0000u) + a0[3]);
                    w.z = cvt_pk_bf16(__uint_as_float(b.z << 16) + a1[0], __uint_as_float(b.z & 0xffff0000u) + a1[1]); w.w = cvt_pk_bf16(__uint_as_float(b.w << 16) + a1[2], __uint_as_float(b.w & 0xffff0000u) + a1[3]);
                    *(u32x4*)(p + bj * HALF) = w;
#pragma unroll
                    for (int q = 0; q < 4; ++q) { const unsigned wq = q == 0 ? w.x : q == 1 ? w.y : q == 2 ? w.z : w.w; const float r0 = __uint_as_float(wq << 16), r1 = __uint_as_float(wq & 0xffff0000u); ss += r0 * r0 + r1 * r1; } }
                ss += __shfl_xor(ss, 16); ss += __shfl_xor(ss, 32);
                if (fq == 0) __hip_atomic_fetch_add(rs + row, rs_fix(ss), __ATOMIC_RELAXED, __HIP_MEMORY_SCOPE_AGENT); }
            asm volatile("" ::: "memory");
        }
    }
};
struct EpiResidBx {
    static constexpr bool PERM = true, AFTER_DRAIN = false;
    bf16_t* xs; rs_t* rs;
    __device__ __forceinline__ void operator()(const f32x4 (&acc)[2][2][4][2], const Unit& u, int wr, int wc, int fr, int fq) const {
        const Unit v{u.pm, u.pn & 3}; EpiResidB{xs, rs}(acc, v, wr, wc, fr, fq); }
};
struct EpiFold {
    static constexpr bool PERM = true, AFTER_DRAIN = false;
    bf16_t* O; int MODE;
    __device__ __forceinline__ void operator()(const f32x4 (&acc)[2][2][4][2], const Unit& u, int wr, int wc, int fr, int fq) const {
        const Unit v{MODE == 0 ? u.pm : (u.pn >> 2) * 4 + (u.pm & 3), MODE == 0 ? (u.pn & 3) : (u.pn & 3)}; EpiBf16<0>{O, 1024, nullptr}(acc, v, wr, wc, fr, fq); }
};

template <class Epi, class Sched, bool ALIGN_EPI = false, bool SP2 = false>
__device__ __forceinline__ void gemm_phase(PG8_LAS unsigned char* lds, const Gemm g, const Sched& S, const Epi& E, int tid_in) {
    int tid_ = tid_in; asm volatile("" : "+v"(tid_)); const int tid = tid_, wid = __builtin_amdgcn_readfirstlane(tid >> 6), lane = tid & 63, wr = wid >> 2, wc = wid & 3, fr = lane & 15, fq = lane >> 4;
    const int K = g.K, nt = K / BK;
    unsigned voffA[2], voffB[2];
#pragma unroll
    for (int i = 0; i < 2; ++i) { int R, C; stage_rc(tid * 16 + i * 8192, R, C); const int Rb = Epi::PERM ? ((R & ~31) + perm32(R & 31)) : R;
        voffA[i] = (unsigned)(R * K + C) * 2u; voffB[i] = (unsigned)(Rb * K + C) * 2u; }
    const size_t kstep = (size_t)(BK * 2);
    const size_t hstep = (size_t)HALF * K * 2;
    const size_t tstep = 2 * hstep;
    const unsigned ldsw = (unsigned)wid * 1024u;
    const int aoff = lds_byte(wr * 64 + fr, fq * 8), boff = lds_byte(wc * 32 + fr, fq * 8);
#define PG8_SA(b, h) (((b) * 2 + (h)) * HTB)
#define PG8_SB(b, h) ((4 + (b) * 2 + (h)) * HTB)
#define PG8_STAGE(bufoff, gbase, voff) do { _Pragma("unroll") for (int _i = 0; _i < 2; ++_i) \
        __builtin_amdgcn_global_load_lds((const unsigned*)((const char*)(gbase) + (voff)[_i]), (PG8_LAS unsigned*)(lds + (bufoff) + ldsw + _i * 8192), 16, 0, 0); } while (0)
#define PG8_LDA(dst, b, h) do { _Pragma("unroll") for (int m = 0; m < 4; ++m) _Pragma("unroll") for (int k = 0; k < 2; ++k) dst[m][k] = *(const PG8_LAS bf16x8*)(lds + PG8_SA(b, h) + aoff + m * 2048 + k * 1024); } while (0)
#define PG8_LDB(dst, b, h) do { _Pragma("unroll") for (int n = 0; n < 2; ++n) _Pragma("unroll") for (int k = 0; k < 2; ++k) dst[n][k] = *(const PG8_LAS bf16x8*)(lds + PG8_SB(b, h) + boff + n * 2048 + k * 1024); } while (0)
#define PG8_MMA(ai, bj, At, Bt) do { __builtin_amdgcn_s_setprio(1); _Pragma("unroll") for (int m = 0; m < 4; ++m) _Pragma("unroll") for (int n = 0; n < 2; ++n) _Pragma("unroll") for (int k = 0; k < 2; ++k) \
        acc[ai][bj][m][n] = __builtin_amdgcn_mfma_f32_16x16x32_bf16(Bt[n][k], At[m][k], acc[ai][bj][m][n], 0, 0, 0); __builtin_amdgcn_s_setprio(0); } while (0)
#define PG8_WAIT_V(n) asm volatile("s_waitcnt vmcnt(" #n ")" ::: "memory")
#define PG8_WAIT_L(n) asm volatile("s_waitcnt lgkmcnt(" #n ")" ::: "memory")
#define PG8_BAR __builtin_amdgcn_s_barrier()
#define PG8_SCHED __builtin_amdgcn_sched_barrier(0)
    Unit cur, nxt; int ui = 0;
    if (!S.next(0, cur)) return;
    f32x4 acc[2][2][4][2];
#pragma unroll
    for (int a = 0; a < 2; ++a)
#pragma unroll
        for (int b = 0; b < 2; ++b)
#pragma unroll
            for (int m = 0; m < 4; ++m)
#pragma unroll
                for (int n = 0; n < 2; ++n) acc[a][b][m][n] = (f32x4){0.f, 0.f, 0.f, 0.f};
    bf16x8 At[4][2], B0[2][2], B1[2][2];
    const char* cA = (const char*)g.A + (size_t)cur.pm * tstep; const char* cB = (const char*)g.Bt + (size_t)cur.pn * tstep;
    S.a_ready(cur);
    if constexpr (SP2) {
        PG8_STAGE(PG8_SB(0, 0), cB, voffB); PG8_STAGE(PG8_SB(0, 1), cB + hstep, voffB); PG8_STAGE(PG8_SA(0, 0), cA, voffA); PG8_STAGE(PG8_SA(0, 1), cA + hstep, voffA);
        if (wr == 1) PG8_BAR;
        PG8_WAIT_V(2); PG8_BAR;
        PG8_STAGE(PG8_SB(1, 0), cB + kstep, voffB); PG8_STAGE(PG8_SA(1, 0), cA + kstep, voffA); PG8_STAGE(PG8_SB(1, 1), cB + hstep + kstep, voffB);
        PG8_WAIT_V(6); PG8_BAR;
    } else {
        PG8_STAGE(PG8_SB(0, 0), cB, voffB); PG8_STAGE(PG8_SA(0, 0), cA, voffA); PG8_STAGE(PG8_SB(0, 1), cB + hstep, voffB); PG8_STAGE(PG8_SA(0, 1), cA + hstep, voffA);
        if (wr == 1) PG8_BAR;
        PG8_WAIT_V(4); PG8_BAR;
        PG8_STAGE(PG8_SB(1, 0), cB + kstep, voffB); PG8_STAGE(PG8_SA(1, 0), cA + kstep, voffA); PG8_STAGE(PG8_SB(1, 1), cB + hstep + kstep, voffB);
        PG8_WAIT_V(6); PG8_BAR;
    }
    for (;;) {
        const bool has_next = S.next(ui + 1, nxt);
        const char* nA = has_next ? (const char*)g.A + (size_t)nxt.pm * tstep : cA; const char* nB = has_next ? (const char*)g.Bt + (size_t)nxt.pn * tstep : cB;
#pragma unroll 1
        for (int t = 0; t < nt; t += 2) {
            const bool last = (t == nt - 2);
            const char* a1 = cA + (size_t)(t + 1) * kstep;
            const char* a2 = last ? nA : cA + (size_t)(t + 2) * kstep; const char* b2 = last ? nB : cB + (size_t)(t + 2) * kstep;
            const char* a3 = a2 + kstep; const char* b3 = b2 + kstep;
            if (last && has_next) S.a_ready(nxt);
            if constexpr (SP2) {
            PG8_LDB(B0, 0, 0); PG8_LDB(B1, 0, 1); PG8_SCHED; PG8_LDA(At, 0, 0); PG8_STAGE(PG8_SA(1, 1), a1 + hstep, voffA);
            PG8_WAIT_V(8); PG8_WAIT_L(0); PG8_BAR; PG8_MMA(0, 0, At, B0); PG8_MMA(0, 1, At, B1); PG8_BAR; PG8_SCHED;
            PG8_LDA(At, 0, 1); PG8_STAGE(PG8_SB(0, 0), b2, voffB); PG8_STAGE(PG8_SB(0, 1), b2 + hstep, voffB); PG8_STAGE(PG8_SA(0, 0), a2, voffA);
            PG8_WAIT_V(8); PG8_WAIT_L(0); PG8_BAR; PG8_MMA(1, 0, At, B0); PG8_MMA(1, 1, At, B1); PG8_BAR; PG8_SCHED;
            PG8_LDB(B0, 1, 0); PG8_LDB(B1, 1, 1); PG8_SCHED; PG8_LDA(At, 1, 0); PG8_STAGE(PG8_SA(0, 1), a2 + hstep, voffA);
            PG8_WAIT_V(8); PG8_WAIT_L(0); PG8_BAR; PG8_MMA(0, 0, At, B0); PG8_MMA(0, 1, At, B1); PG8_BAR; PG8_SCHED;
            PG8_LDA(At, 1, 1); PG8_STAGE(PG8_SB(1, 0), b3, voffB); PG8_STAGE(PG8_SB(1, 1), b3 + hstep, voffB); PG8_STAGE(PG8_SA(1, 0), a3, voffA);
            PG8_WAIT_V(8); PG8_WAIT_L(0); PG8_BAR; PG8_MMA(1, 0, At, B0); PG8_MMA(1, 1, At, B1); PG8_BAR; PG8_SCHED;
            } else {
            PG8_LDB(B0, 0, 0); PG8_SCHED; PG8_LDA(At, 0, 0); PG8_STAGE(PG8_SA(1, 1), a1 + hstep, voffA);
            PG8_WAIT_L(8); PG8_BAR; PG8_WAIT_L(0); PG8_MMA(0, 0, At, B0); PG8_BAR; PG8_SCHED;
            PG8_LDB(B1, 0, 1); PG8_STAGE(PG8_SB(0, 0), b2, voffB);
            PG8_BAR; PG8_WAIT_L(0); PG8_MMA(0, 1, At, B1); PG8_BAR;
            PG8_LDA(At, 0, 1); PG8_STAGE(PG8_SA(0, 0), a2, voffA);
            PG8_BAR; PG8_WAIT_L(0); PG8_MMA(1, 0, At, B0); PG8_BAR; PG8_SCHED;
            PG8_STAGE(PG8_SB(0, 1), b2 + hstep, voffB);
            PG8_WAIT_V(6); PG8_BAR; PG8_MMA(1, 1, At, B1); PG8_BAR;
            PG8_LDB(B0, 1, 0); PG8_SCHED; PG8_LDA(At, 1, 0); PG8_STAGE(PG8_SA(0, 1), a2 + hstep, voffA);
            PG8_WAIT_L(8); PG8_BAR; PG8_WAIT_L(0); PG8_MMA(0, 0, At, B0); PG8_BAR; PG8_SCHED;
            PG8_LDB(B1, 1, 1); PG8_STAGE(PG8_SB(1, 0), b3, voffB);
            PG8_BAR; PG8_WAIT_L(0); PG8_MMA(0, 1, At, B1); PG8_BAR;
            PG8_LDA(At, 1, 1); PG8_STAGE(PG8_SA(1, 0), a3, voffA);
            PG8_BAR; PG8_WAIT_L(0); PG8_MMA(1, 0, At, B0); PG8_BAR; PG8_SCHED;
            PG8_STAGE(PG8_SB(1, 1), b3 + hstep, voffB);
            PG8_WAIT_V(6); PG8_BAR; PG8_MMA(1, 1, At, B1); PG8_BAR;
            }
        }
        if constexpr (ALIGN_EPI) { if (wr == 0) PG8_BAR; }
        if constexpr (!Epi::AFTER_DRAIN) { E(acc, cur, wr, wc, fr, fq); S.done(cur); }
        if (!has_next) break;
#pragma unroll
        for (int a = 0; a < 2; ++a)
#pragma unroll
            for (int b = 0; b < 2; ++b)
#pragma unroll
                for (int m = 0; m < 4; ++m)
#pragma unroll
                    for (int n = 0; n < 2; ++n) acc[a][b][m][n] = (f32x4){0.f, 0.f, 0.f, 0.f};
        cur = nxt; cA = nA; cB = nB; ++ui;
        if constexpr (ALIGN_EPI) { if (wr == 1) PG8_BAR; }
    }
    PG8_WAIT_V(0);
    if constexpr (!ALIGN_EPI) { if (wr == 0) PG8_BAR; }
    PG8_BAR;
    if constexpr (Epi::AFTER_DRAIN) { E.fused(acc, cur, wr, wc, fr, fq, lds, wid, lane); S.done(cur); }
#undef PG8_SA
#undef PG8_SB
#undef PG8_STAGE
#undef PG8_LDA
#undef PG8_LDB
#undef PG8_MMA
#undef PG8_WAIT_V
#undef PG8_WAIT_L
#undef PG8_BAR
#undef PG8_SCHED
}
}
#ifndef PG8_SP2
#define PG8_SP2 true
#endif
#ifndef PG8_ALIGN
#define PG8_ALIGN true
#endif
constexpr int NWAVES = 8, NTHR = 512;
constexpr int BATCH = 8, T = 8192, D = 1024, DEPTH = 4, MEMLEN = 256, FF = 4096;
constexpr int M = BATCH * T;
constexpr int AB_IN = 3080, AB_N = 3072, C_IN = 4112, C_N = 4096;
constexpr float EPS = 1e-6f;
constexpr float SB_EPS = 4.2e-18f;

constexpr size_t MiB = 1u << 20;
constexpr size_t WS_CTL = 0, CTL_ZERO_BYTES = 1 * MiB;
constexpr size_t WS_WG = 1 * MiB;
constexpr size_t WS_MEMN = 2 * MiB;
constexpr size_t WS_WKV = 6 * MiB;
constexpr size_t WS_W = 22 * MiB, W_LAYER = 30 * MiB;
constexpr size_t WO_WIN = 0, WO_WOUT = 8 * MiB, WO_WQ = 10 * MiB, WO_WO = 12 * MiB, WO_W1 = 14 * MiB, WO_W2 = 22 * MiB;
constexpr size_t WS_KVX = 142 * MiB;
constexpr size_t WS_GATE = 174 * MiB;
constexpr size_t WS_H = 178 * MiB;
constexpr size_t WS_MIX = 306 * MiB;
constexpr size_t WS_BIG = 434 * MiB;
constexpr size_t WS_RS = 946 * MiB;
constexpr size_t WS_MLS = 950 * MiB;
constexpr size_t WS_END = 956 * MiB;
constexpr int CW_TMO = 0, CW_BAR = 4096;

constexpr int LDS_BYTES = 147456;
constexpr int MISC_OFF = 140 * 1024;

#define GAS __attribute__((address_space(1)))
#define LAS __attribute__((address_space(3)))
#define DI __device__ __forceinline__
typedef unsigned short bf16;
typedef unsigned v4u __attribute__((ext_vector_type(4)));
typedef unsigned v2u __attribute__((ext_vector_type(2)));
typedef float f32x4 __attribute__((ext_vector_type(4)));
typedef short bf16x8 __attribute__((ext_vector_type(8)));
typedef short s16x4 __attribute__((ext_vector_type(4)));
#define LDS_WAIT() asm volatile("s_waitcnt lgkmcnt(0)" ::: "memory")
typedef float f32x2_ __attribute__((ext_vector_type(2)));
typedef __bf16 bf16x2_ __attribute__((ext_vector_type(2)));
DI unsigned pk2(float lo, float hi) { const f32x2_ v = {lo, hi}; return __builtin_bit_cast(unsigned, __builtin_convertvector(v, bf16x2_)); }
DI unsigned f2bf(float f) { return pk2(f, f) & 0xffffu; }
DI float bf2f(unsigned short b) { return __builtin_bit_cast(float, ((unsigned)b) << 16); }
DI float bflo(unsigned u) { return __builtin_bit_cast(float, u << 16); }
DI float bfhi(unsigned u) { return __builtin_bit_cast(float, u & 0xffff0000u); }
template <int CTRL> DI float dppf(float v) { return __builtin_bit_cast(float, __builtin_amdgcn_update_dpp(0, __builtin_bit_cast(int, v), CTRL, 0xF, 0xF, true)); }
DI float red4(float v) { v += dppf<0xB1>(v); v += dppf<0x4E>(v); return v; }
DI float red8(float v) { v = red4(v); v += dppf<0x141>(v); return v; }
DI float red16(float v) { v = red8(v); v += dppf<0x140>(v); return v; }
template <int CTRL, int RMASK> DI float dpps(float old, float v) { return __builtin_bit_cast(float, __builtin_amdgcn_update_dpp(__builtin_bit_cast(int, old), __builtin_bit_cast(int, v), CTRL, RMASK, 0xF, false)); }
DI float scan64_add(float v) { v += dpps<0x111, 0xF>(0.f, v); v += dpps<0x112, 0xF>(0.f, v); v += dpps<0x114, 0xF>(0.f, v); v += dpps<0x118, 0xF>(0.f, v); v += dpps<0x142, 0xA>(0.f, v); v += dpps<0x143, 0xC>(0.f, v); return v; }
DI float scan64_max(float v) { constexpr float NI = -3.0e38f; v = fmaxf(v, dpps<0x111, 0xF>(NI, v)); v = fmaxf(v, dpps<0x112, 0xF>(NI, v)); v = fmaxf(v, dpps<0x114, 0xF>(NI, v)); v = fmaxf(v, dpps<0x118, 0xF>(NI, v));
    v = fmaxf(v, dpps<0x142, 0xA>(NI, v)); v = fmaxf(v, dpps<0x143, 0xC>(NI, v)); return v; }
DI float lane63(float v) { return __builtin_bit_cast(float, __builtin_amdgcn_readlane(__builtin_bit_cast(int, v), 63)); }
DI float wave_sum(float v) { v = red16(v); v += __shfl_xor(v, 16); v += __shfl_xor(v, 32); return v; }
DI float rcp_(float x) { return __builtin_amdgcn_rcpf(x); }
DI float rsq_(float x) { return __builtin_amdgcn_rsqf(x); }
DI float sigmoidf_(float x) { return rcp_(1.0f + __expf(-x)); }
DI void lds_barrier() { asm volatile("s_waitcnt lgkmcnt(0)" ::: "memory"); __builtin_amdgcn_s_barrier(); asm volatile("" ::: "memory"); }
#ifndef PROBE_STG
#define PROBE_STG -1
#endif
#define STG_T0() unsigned long long stg_t_ = (PROBE_STG >= 0) ? __builtin_amdgcn_s_memrealtime() : 0ull
#define STG(n) do { if (PROBE_STG >= 0) { const unsigned long long t_ = __builtin_amdgcn_s_memrealtime(); if (PROBE_STG == (n)) F.tacc += t_ - stg_t_; stg_t_ = t_; } } while (0)
DI f32x4 mfma16(bf16x8 a, bf16x8 b, f32x4 c) { return __builtin_amdgcn_mfma_f32_16x16x32_bf16(a, b, c, 0, 0, 0); }
#define XB_TMO      128
#define XB_XCNT(j)  (256  + 64 * (j))
#define XB_XSUB(j)  (1280 + 64 * (j))
#define XB_XGEN(j)  (2304 + 64 * (j))
#define XB_TOP      3328
#define XB_TOPGEN   3392
#define XCD_BAR_WORDS 3456
#define XB_SPIN_CAP (1u << 22)

__device__ __forceinline__ unsigned xb_ld(unsigned* p)              { return __hip_atomic_load(p, __ATOMIC_RELAXED, __HIP_MEMORY_SCOPE_AGENT); }
__device__ __forceinline__ unsigned xb_add(unsigned* p, unsigned v) { return __hip_atomic_fetch_add(p, v, __ATOMIC_RELAXED, __HIP_MEMORY_SCOPE_AGENT); }
__device__ __forceinline__ unsigned xb_xcc_id() { return (unsigned)__builtin_amdgcn_s_getreg((3 << 11) | 20) & 0xFu; }
#define XB_SPIN(cond, bar) do { unsigned _sp = 0; while (cond) { __builtin_amdgcn_s_sleep(1); \
    if ((++_sp & 255u) == 0u) { if (xb_ld(&(bar)[XB_TMO])) break; if (_sp > XB_SPIN_CAP) { atomicAdd(&(bar)[XB_TMO], 1u); break; } } } } while (0)

struct XcdBarrier {
    unsigned* bar; unsigned x;
    volatile LAS unsigned* st;
};

__device__ __forceinline__ XcdBarrier xcd_barrier_post(unsigned* bar, volatile LAS unsigned* st) {
    XcdBarrier b; b.bar = bar; b.x = xb_xcc_id(); b.st = st;
    if (threadIdx.x == 0) (void)xb_add(&bar[XB_XCNT(b.x)], 1u);
    return b;
}
__device__ __forceinline__ void xcd_barrier_complete(unsigned* bar, unsigned x, unsigned& nloc, unsigned& nx) {
    const unsigned G = gridDim.x * gridDim.y * gridDim.z;
    unsigned sum, cnt, mine, sp = 0u;
    for (;;) {
        sum = 0u; cnt = 0u; mine = 0u;
#pragma unroll
        for (unsigned j = 0; j < 16; ++j) { const unsigned c = xb_ld(&bar[XB_XCNT(j)]); sum += c; cnt += (c > 0u) ? 1u : 0u; mine = (j == x) ? c : mine; }
        if (sum == G) break;
        __builtin_amdgcn_s_sleep(1);
        if ((++sp & 255u) == 0u) { if (xb_ld(&bar[XB_TMO])) break; if (sp > XB_SPIN_CAP) { atomicAdd(&bar[XB_TMO], 1u); break; } }
    }
    nloc = mine > 0u ? mine : 1u; nx = cnt > 0u ? cnt : 1u;
}

__device__ __forceinline__ void xcd_barrier(const XcdBarrier& b) {
    asm volatile("s_waitcnt vmcnt(0)" ::: "memory");
    __syncthreads();
    if (threadIdx.x == 0) {
        unsigned* bar = b.bar;
        __builtin_amdgcn_s_waitcnt(0);
        unsigned nloc = b.st[0], nx = b.st[1];
        if (nloc == 0u) { xcd_barrier_complete(bar, b.x, nloc, nx); b.st[0] = nloc; b.st[1] = nx; }
        const unsigned old = xb_add(&bar[XB_XSUB(b.x)], 1u);
        const unsigned gen = old / nloc;
        if (old + 1u == (gen + 1u) * nloc) {
            __builtin_amdgcn_fence(__ATOMIC_RELEASE, "agent");
            asm volatile("s_waitcnt vmcnt(0)" ::: "memory");
            const unsigned og = xb_add(&bar[XB_TOP], 1u);
            const unsigned tg = og / nx;
            if (og + 1u == (tg + 1u) * nx) xb_add(&bar[XB_TOPGEN], 1u);
            else XB_SPIN(xb_ld(&bar[XB_TOPGEN]) == tg, bar);
            __builtin_amdgcn_fence(__ATOMIC_ACQUIRE, "agent");
            xb_add(&bar[XB_XGEN(b.x)], 1u);
            asm volatile("s_waitcnt vmcnt(0)" ::: "memory");
        } else {
            XB_SPIN(xb_ld(&bar[XB_XGEN(b.x)]) == gen, bar);
            __builtin_amdgcn_fence(__ATOMIC_ACQUIRE, "agent");
            asm volatile("s_waitcnt vmcnt(0)" ::: "memory");
        }
    }
    __syncthreads();
}
struct Frame {
    LAS unsigned char* lds;
    int tid, lane, wave;
    int G, wg, gw, NGW;
    unsigned long long tacc;
};

DI void transpose_item(const float* W, int ldsrc, int coloff, bf16* WT, int K, int row_off, int nblk, LAS float* scr, int item, int lane, const float* gain) {
    const int kb = item / nblk, nb = item % nblk, k0 = 64 * kb, n0 = 32 * nb;
    const bool al16 = (((ldsrc | (coloff + n0)) & 3) == 0);
    if (al16) { const int kr = lane >> 3, c4 = (lane & 7) * 4;
#pragma unroll
        for (int i = 0; i < 8; ++i) { const int kk = 8 * i + kr; const f32x4 v = *(const GAS f32x4*)(W + (size_t)(k0 + kk) * ldsrc + coloff + n0 + c4); const float g = gain ? gain[k0 + kk] : 1.0f;
            scr[kk * 33 + c4] = v.x * g; scr[kk * 33 + c4 + 1] = v.y * g; scr[kk * 33 + c4 + 2] = v.z * g; scr[kk * 33 + c4 + 3] = v.w * g; }
    } else {
#pragma unroll 8
        for (int i = 0; i < 32; ++i) { const int kk = 2 * i + (lane >> 5); scr[kk * 33 + (lane & 31)] = W[(size_t)(k0 + kk) * ldsrc + coloff + n0 + (lane & 31)] * (gain ? gain[k0 + kk] : 1.0f); }
    }
    LDS_WAIT(); asm volatile("" ::: "memory");
    const int c = lane & 7;
#pragma unroll
    for (int j = 0; j < 4; ++j) { const int n = (lane >> 3) + 8 * j; const LAS float* s = scr + (8 * c) * 33 + n;
        v4u o; o.x = pk2(s[0 * 33], s[1 * 33]); o.y = pk2(s[2 * 33], s[3 * 33]); o.z = pk2(s[4 * 33], s[5 * 33]); o.w = pk2(s[6 * 33], s[7 * 33]);
        *(GAS v4u*)(WT + (size_t)(row_off + n0 + n) * K + k0 + 8 * c) = o; }
    LDS_WAIT(); asm volatile("" ::: "memory");
}
DI void transpose_matrix(Frame& F, const float* W, int ldsrc, int coloff, int ncols, int K, bf16* WT, int row_off, unsigned& base, const float* gain = nullptr) {
    LAS float* scr = (LAS float*)(F.lds + F.wave * 16384);
    const int nblk = ncols / 32, nitems = (K / 64) * nblk;
    int it = (int)(((unsigned)F.gw + (unsigned)F.NGW - (base % (unsigned)F.NGW)) % (unsigned)F.NGW);
    for (; it < nitems; it += F.NGW) transpose_item(W, ldsrc, coloff, WT, K, row_off, nblk, scr, it, F.lane, gain);
    base += (unsigned)nitems;
}
DI void rms_row(const float* xrow, const f32x4 (&g4)[4], f32x4 (&v)[4], int lane) {
    const GAS f32x4* xr = (const GAS f32x4*)xrow + lane; float s = 0.f;
#pragma unroll
    for (int j = 0; j < 4; ++j) { v[j] = xr[64 * j]; s += (v[j].x * v[j].x + v[j].y * v[j].y) + (v[j].z * v[j].z + v[j].w * v[j].w); }
    const float rstd = rsq_(wave_sum(s) * (1.f / 1024.f) + EPS);
#pragma unroll
    for (int j = 0; j < 4; ++j) v[j] = v[j] * rstd * g4[j];
}
DI void store_row_bf16(bf16* orow, const f32x4 (&v)[4], int lane) {
    GAS unsigned long long* o8 = (GAS unsigned long long*)orow + lane;
#pragma unroll
    for (int j = 0; j < 4; ++j) o8[64 * j] = (unsigned long long)pk2(v[j].x, v[j].y) | ((unsigned long long)pk2(v[j].z, v[j].w) << 32);
}
struct In { const float* p[24]; };
DI void p0_prologue(Frame& F, const In& I, unsigned char* ws) {
    unsigned base = 0;
    for (int l = 0; l < DEPTH; ++l) {
        const int j = l >> 1; unsigned char* wl = ws + WS_W + (size_t)l * W_LAYER;
        if ((l & 1) == 0) {
            transpose_matrix(F, I.p[3] + (size_t)j * D * AB_IN, AB_IN, 0, 1536, D, (bf16*)(wl + WO_WIN), 0, base, I.p[2] + l * D);
            transpose_matrix(F, I.p[3] + (size_t)j * D * AB_IN, AB_IN, 1544, 1536, D, (bf16*)(wl + WO_WIN), 1536, base, I.p[2] + l * D);
            transpose_matrix(F, I.p[7] + (size_t)j * D * D, D, 0, D, D, (bf16*)(wl + WO_WOUT), 0, base);
        } else {
            transpose_matrix(F, I.p[8] + (size_t)j * D * C_IN, C_IN, 0, 4096, D, (bf16*)(wl + WO_WIN), 0, base, I.p[2] + l * D);
            transpose_matrix(F, I.p[13] + (size_t)j * D * D, D, 0, D, D, (bf16*)(wl + WO_WOUT), 0, base);
        }
        for (int idx = F.wg * NTHR + F.tid; idx < 4 * D * 32; idx += F.G * NTHR) { const int h = idx >> 15, d = (idx >> 5) & 1023, e8 = (idx & 31) * 8;
            const GAS f32x4* src = (const GAS f32x4*)(I.p[16] + (size_t)l * D * D + (size_t)d * D + h * 256 + e8); const f32x4 v0 = src[0], v1 = src[1]; const float g = I.p[14][l * D + d];
            v4u o; o.x = pk2(v0.x * g, v0.y * g); o.y = pk2(v0.z * g, v0.w * g); o.z = pk2(v1.x * g, v1.y * g); o.w = pk2(v1.z * g, v1.w * g);
            *(GAS v4u*)((bf16*)(wl + WO_WQ) + ((size_t)h * D + d) * 256 + e8) = o; }
        for (int h = 0; h < 4; ++h) transpose_matrix(F, I.p[19] + (size_t)l * D * D + (size_t)h * 256 * D, D, 0, D, 256, (bf16*)(wl + WO_WO) + (size_t)h * D * 256, 0, base);
        transpose_matrix(F, I.p[17] + (size_t)l * D * D, D, 0, D, D, (bf16*)(ws + WS_WKV), 1024 * l, base);
        transpose_matrix(F, I.p[18] + (size_t)l * D * D, D, 0, D, D, (bf16*)(ws + WS_WKV), 4096 + 1024 * l, base);
        transpose_matrix(F, I.p[21] + (size_t)l * D * FF, FF, 0, FF, D, (bf16*)(wl + WO_W1), 0, base, I.p[20] + l * D);
        transpose_matrix(F, I.p[22] + (size_t)l * FF * D, D, 0, D, FF, (bf16*)(wl + WO_W2), 0, base);
    }
    for (int idx = F.wg * NTHR + F.tid; idx < DEPTH * 16 * 1024; idx += F.G * NTHR) {
        const int l = idx >> 14, g = (idx >> 10) & 15, k = idx & 1023, j = l >> 1; float v = 0.f;
        if ((l & 1) == 0) { if (g < 8) v = I.p[3][(size_t)j * D * AB_IN + (size_t)k * AB_IN + 1536 + g]; }
        else v = I.p[8][(size_t)j * D * C_IN + (size_t)k * C_IN + 4096 + g];
        ((bf16*)(ws + WS_WG))[idx] = (bf16)f2bf(v * I.p[2][l * D + k]);
    }
    { f32x4 g4[4];
#pragma unroll
      for (int j = 0; j < 4; ++j) g4[j] = ((const GAS f32x4*)I.p[15])[F.lane + 64 * j];
      for (int r = F.gw; r < BATCH * MEMLEN; r += F.NGW) { f32x4 v[4]; rms_row(I.p[1] + (size_t)r * D, g4, v, F.lane); store_row_bf16((bf16*)(ws + WS_MEMN) + (size_t)r * D, v, F.lane); } }
    for (int r0 = 4 * F.gw; r0 < M; r0 += 4 * F.NGW) { f32x4 vv[4][4];
#pragma unroll
        for (int q = 0; q < 4; ++q) { const GAS f32x4* xr = (const GAS f32x4*)(I.p[0] + (size_t)(r0 + q) * D) + F.lane;
#pragma unroll
            for (int j = 0; j < 4; ++j) vv[q][j] = xr[64 * j]; }
#pragma unroll
        for (int q = 0; q < 4; ++q) { const int r = r0 + q; float s = 0.f;
#pragma unroll
            for (int j = 0; j < 4; ++j) { const unsigned a = pk2(vv[q][j].x, vv[q][j].y), b = pk2(vv[q][j].z, vv[q][j].w); const float e0 = bflo(a), e1 = bfhi(a), e2 = bflo(b), e3 = bfhi(b); s += (e0 * e0 + e1 * e1) + (e2 * e2 + e3 * e3); }
            s = wave_sum(s); store_row_bf16((bf16*)(ws + WS_H) + (size_t)r * D, vv[q], F.lane);
            if (F.lane == 0) { __hip_atomic_store((pg8::rs_t*)(ws + WS_RS) + r, pg8::rs_fix(s), __ATOMIC_RELAXED, __HIP_MEMORY_SCOPE_AGENT); __hip_atomic_store((pg8::rs_t*)(ws + WS_RS) + M + r, (pg8::rs_t)0, __ATOMIC_RELAXED, __HIP_MEMORY_SCOPE_AGENT); } }
    }
}
template <int MODE> DI void gates_phase(Frame& F, const bf16* xb, const pg8::rs_t* rs, const bf16* WgB, float* gate, const float* p0, const float* p1) {
    constexpr int LW = 1032, NT = M / 16;
    LAS bf16* wl = (LAS bf16*)F.lds;
    const int r = F.lane & 15, quad = F.lane >> 4;
    bf16x8 alo[16], ahi[16];
    int g = F.gw;
    if (g < NT) { const bf16* xa = xb + (size_t)(16 * g + r) * D + 8 * quad;
#pragma unroll
        for (int kk = 0; kk < 16; ++kk) alo[kk] = *(const GAS bf16x8*)(xa + 32 * kk);
#pragma unroll
        for (int kk = 0; kk < 16; ++kk) ahi[kk] = *(const GAS bf16x8*)(xa + 512 + 32 * kk); }
    lds_barrier();
    for (int i = F.tid; i < 2048; i += NTHR) { const int gg = i >> 7, c8 = (i & 127) * 8; *(LAS v4u*)(wl + gg * LW + c8) = *(const GAS v4u*)(WgB + gg * 1024 + c8); }
    float par = 0.f, par2 = 0.f;
    if (MODE == 1) { if (r < 4) par = p0[r]; else if (r < 8) par = p1[r - 4]; }
    if (MODE == 2) { if (r >= 8) { par = p0[r - 8]; par2 = p1[r - 8]; } }
    lds_barrier();
    while (g < NT) {
        float rq[4];
#pragma unroll
        for (int j = 0; j < 4; ++j) rq[j] = pg8::row_rstd(rs, 16 * g + 4 * quad + j);
        const int gn = g + F.NGW; const bf16* xn = xb + (size_t)(16 * (gn < NT ? gn : g) + r) * D + 8 * quad;
        f32x4 acc = (f32x4){0.f, 0.f, 0.f, 0.f};
#pragma unroll
        for (int kk = 0; kk < 16; ++kk) acc = mfma16(alo[kk], *(const LAS bf16x8*)(wl + r * LW + 32 * kk + 8 * quad), acc);
        if (gn < NT) {
#pragma unroll
            for (int kk = 0; kk < 16; ++kk) alo[kk] = *(const GAS bf16x8*)(xn + 32 * kk); }
#pragma unroll
        for (int kk = 0; kk < 16; ++kk) acc = mfma16(ahi[kk], *(const LAS bf16x8*)(wl + r * LW + 512 + 32 * kk + 8 * quad), acc);
        __builtin_amdgcn_sched_barrier(0);
#pragma unroll
        for (int j = 0; j < 4; ++j) { const int row = 16 * g + 4 * quad + j; const float keep = acc[j] * rq[j]; float o = 0.f;
            if (MODE == 1) { const float v = keep + par; o = (r < 4) ? 15.0f * tanhf(v * (1.0f / 15.0f)) : (fminf(v, 0.f) - log1pf(expf(-fabsf(v)))); }
            if (MODE == 2) { if (r < 8) o = 1.0f / (1.0f + expf(-keep)); else { const float z = keep + par2; o = -expf(par) * (fmaxf(z, 0.f) + log1pf(expf(-fabsf(z)))); } }
            if (MODE == 2 || r < 8) gate[(size_t)row * 16 + r] = o; }
        __builtin_amdgcn_sched_barrier(0);
        if (gn < NT) {
#pragma unroll
            for (int kk = 0; kk < 16; ++kk) ahi[kk] = *(const GAS bf16x8*)(xn + 512 + 32 * kk); }
        g = gn;
    }
    lds_barrier();
}
DI void final_norm_phase(Frame& F, const bf16* xs, float* out, const float* gain) {
    f32x4 g4[4];
#pragma unroll
    for (int j = 0; j < 4; ++j) g4[j] = ((const GAS f32x4*)gain)[F.lane + 64 * j];
    for (int r0 = 4 * F.gw; r0 < M; r0 += 4 * F.NGW) {
        v2u t[4][4];
#pragma unroll
        for (int q = 0; q < 4; ++q) { const GAS v2u* xr = (const GAS v2u*)(xs + (size_t)(r0 + q) * D) + F.lane;
#pragma unroll
            for (int j = 0; j < 4; ++j) t[q][j] = xr[64 * j]; }
#pragma unroll
        for (int q = 0; q < 4; ++q) { f32x4 v[4]; float s = 0.f;
#pragma unroll
            for (int j = 0; j < 4; ++j) { v[j] = (f32x4){bflo(t[q][j].x), bfhi(t[q][j].x), bflo(t[q][j].y), bfhi(t[q][j].y)}; s += (v[j].x * v[j].x + v[j].y * v[j].y) + (v[j].z * v[j].z + v[j].w * v[j].w); }
            const float rstd = rsq_(wave_sum(s) * (1.f / 1024.f) + EPS); GAS f32x4* o = (GAS f32x4*)(out + (size_t)(r0 + q) * D) + F.lane;
#pragma unroll
            for (int j = 0; j < 4; ++j) o[64 * j] = v[j] * rstd * g4[j]; }
    }
}
template <bool ODD> DI void headnorm_phase(Frame& F, const bf16* src, bf16* mix, const bf16* proj, const float* hg) {
    constexpr int NC = ODD ? 16 : 8;
#pragma unroll 2
    for (int r = F.gw; r < M; r += F.NGW) {
        const int c0 = NC * F.lane;
        float x[NC], gt[NC];
#pragma unroll
        for (int q = 0; q < NC / 8; ++q) {
            const size_t hoff = ((size_t)((r >> 13) * 8 + ((c0 + 8 * q) >> 7)) * T + (r & (T - 1))) * 128 + ((c0 + 8 * q) & 127);
            const v4u raw = ODD ? *(const GAS v4u*)(src + hoff) : *(const GAS v4u*)(src + (size_t)r * D + c0 + 8 * q);
            const v4u gr = ODD ? *(const GAS v4u*)(proj + (size_t)M * 3072 + hoff) : *(const GAS v4u*)(proj + (size_t)r * AB_N + 1024 + c0 + 8 * q);
            x[8 * q + 0] = bflo(raw.x); x[8 * q + 1] = bfhi(raw.x); x[8 * q + 2] = bflo(raw.y); x[8 * q + 3] = bfhi(raw.y); x[8 * q + 4] = bflo(raw.z); x[8 * q + 5] = bfhi(raw.z); x[8 * q + 6] = bflo(raw.w); x[8 * q + 7] = bfhi(raw.w);
            gt[8 * q + 0] = bflo(gr.x); gt[8 * q + 1] = bfhi(gr.x); gt[8 * q + 2] = bflo(gr.y); gt[8 * q + 3] = bfhi(gr.y); gt[8 * q + 4] = bflo(gr.z); gt[8 * q + 5] = bfhi(gr.z); gt[8 * q + 6] = bflo(gr.w); gt[8 * q + 7] = bfhi(gr.w);
        }
        float ss = 0.f;
#pragma unroll
        for (int i = 0; i < NC; ++i) ss += x[i] * x[i];
        ss = ODD ? red8(ss) : red16(ss);
        const float rstd = rsq_(ss * (1.f / 128.f) + EPS);
#pragma unroll
        for (int i = 0; i < NC; ++i) { const float g = ODD ? hg[(c0 + i) & 127] : hg[c0 + i]; const float s = sigmoidf_(gt[i]); x[i] = x[i] * rstd * g * (ODD ? gt[i] * s : s); }
#pragma unroll
        for (int q = 0; q < NC / 8; ++q) { v4u o; o.x = pk2(x[8 * q], x[8 * q + 1]); o.y = pk2(x[8 * q + 2], x[8 * q + 3]); o.z = pk2(x[8 * q + 4], x[8 * q + 5]); o.w = pk2(x[8 * q + 6], x[8 * q + 7]);
            *(GAS v4u*)(mix + (size_t)r * D + c0 + 8 * q) = o; }
    }
}
DI unsigned scale_pk(unsigned u, float s) { return pk2(bflo(u) * s, bfhi(u) * s); }
constexpr size_t H_NUML = 0, H_DC = 64 * MiB;
constexpr int MLS_STRIDE = 320;
struct MlaRegs { v4u q, k, v0, v1; float li, lf; };
DI void mla_load(MlaRegs& R, const bf16* proj, const float* gate, int unit, int tid) {
    const int ch = unit & 127, bh = unit >> 7, b = bh >> 2, h = bh & 3, s = tid & 63, dseg = tid >> 6;
    const size_t hb = (size_t)bh * T + ch * 64 + s;
    R.q = *(const GAS v4u*)(proj + hb * 64 + 8 * dseg); R.k = *(const GAS v4u*)(proj + (size_t)M * 256 + hb * 64 + 8 * dseg);
    const bf16* pv = proj + (size_t)M * 512 + hb * 128 + 16 * dseg; R.v0 = *(const GAS v4u*)pv; R.v1 = *(const GAS v4u*)(pv + 8);
    const float* g = gate + ((size_t)b * T + ch * 64 + s) * 16; R.li = g[h]; R.lf = g[4 + h];
}
DI void mlstm_a_unit(Frame& F, MlaRegs& R, const bf16* proj, const float* gate, bf16* numl, bf16* dc, float* scal, int unit, int unit_end) {
    constexpr int LD = 72, LN = 136;
    int tid_ = F.tid; asm volatile("" : "+v"(tid_));
    const int tid = tid_, lane = tid & 63, w = F.wave, r = lane & 15, quad = lane >> 4, dseg = tid >> 6;
    LAS bf16* qs = (LAS bf16*)F.lds; LAS bf16* ks = qs + 64 * LD; LAS bf16* ksT = ks + 64 * LD; LAS bf16* vT = ksT + 64 * LD; LAS bf16* Sd = vT + 128 * LD; LAS bf16* Cst = Sd + 64 * LD; LAS bf16* numS = Cst + 128 * LD;
    LAS float* sCm = (LAS float*)(numS + 64 * LN); LAS float* sDen = sCm + 64; LAS float* sDn = sDen + 64;
    const float bb = scan64_add(R.lf);
    const float a = R.li - bb; const float cm = scan64_max(a);
    const float Astar = lane63(cm), b63 = lane63(bb);
    const float ksc = 0.125f * __expf(a - Astar);
    lds_barrier();
    *(LAS v4u*)(qs + lane * LD + 8 * dseg) = R.q;
    { v4u kk; kk.x = scale_pk(R.k.x, ksc); kk.y = scale_pk(R.k.y, ksc); kk.z = scale_pk(R.k.z, ksc); kk.w = scale_pk(R.k.w, ksc); *(LAS v4u*)(ks + lane * LD + 8 * dseg) = kk;
      const unsigned kw[4] = {kk.x, kk.y, kk.z, kk.w};
#pragma unroll
      for (int i = 0; i < 4; ++i) { ksT[(8 * dseg + 2 * i) * LD + lane] = (bf16)(kw[i] & 0xffffu); ksT[(8 * dseg + 2 * i + 1) * LD + lane] = (bf16)(kw[i] >> 16); }
      const unsigned vv[8] = {R.v0.x, R.v0.y, R.v0.z, R.v0.w, R.v1.x, R.v1.y, R.v1.z, R.v1.w};
#pragma unroll
      for (int i = 0; i < 8; ++i) { vT[(16 * dseg + 2 * i) * LD + lane] = (bf16)(vv[i] & 0xffffu); vT[(16 * dseg + 2 * i + 1) * LD + lane] = (bf16)(vv[i] >> 16); } }
    if (w == 0) sCm[lane] = cm;
    if (unit + 1 < unit_end) mla_load(R, proj, gate, unit + 1, tid);
    lds_barrier();
    { const int mt = w >> 1;
      const bf16x8 a0 = *(const LAS bf16x8*)(qs + (16 * mt + r) * LD + 8 * quad), a1 = *(const LAS bf16x8*)(qs + (16 * mt + r) * LD + 32 + 8 * quad);
      const int t = 16 * mt + r; const float et = __expf(Astar - sCm[t]);
#pragma unroll
      for (int tt = 0; tt < 2; ++tt) { const int nt = 2 * (w & 1) + tt; f32x4 acc = (f32x4){0.f, 0.f, 0.f, 0.f};
          if (nt <= mt) { acc = mfma16(*(const LAS bf16x8*)(ks + (16 * nt + r) * LD + 8 * quad), a0, acc); acc = mfma16(*(const LAS bf16x8*)(ks + (16 * nt + r) * LD + 32 + 8 * quad), a1, acc); }
#pragma unroll
          for (int j = 0; j < 4; ++j) { const int s = 16 * nt + 4 * quad + j; const float v = (s <= t) ? acc[j] * et : 0.f; Sd[t * LD + s] = (bf16)f2bf(v); } } }
    const bf16x8 vf0 = *(const LAS bf16x8*)(vT + (16 * w + r) * LD + 8 * quad), vf1 = *(const LAS bf16x8*)(vT + (16 * w + r) * LD + 32 + 8 * quad);
#pragma unroll
    for (int nt = 0; nt < 4; ++nt) { f32x4 acc = (f32x4){0.f, 0.f, 0.f, 0.f};
        acc = mfma16(*(const LAS bf16x8*)(ksT + (16 * nt + r) * LD + 8 * quad), vf0, acc); acc = mfma16(*(const LAS bf16x8*)(ksT + (16 * nt + r) * LD + 32 + 8 * quad), vf1, acc);
#pragma unroll
        for (int j = 0; j < 4; ++j) Cst[(16 * w + r) * LD + 16 * nt + 4 * quad + j] = (bf16)f2bf(acc[j]); }
    if (w == 0) { float sum = 0.f;
#pragma unroll
        for (int q8 = 0; q8 < 8; ++q8) { const v4u t = *(const LAS v4u*)(ksT + lane * LD + 8 * q8); sum += (bflo(t.x) + bfhi(t.x)) + (bflo(t.y) + bfhi(t.y)) + (bflo(t.z) + bfhi(t.z)) + (bflo(t.w) + bfhi(t.w)); }
        sDn[lane] = sum; }
    lds_barrier();
#pragma unroll
    for (int mt = 0; mt < 4; ++mt) { f32x4 acc = (f32x4){0.f, 0.f, 0.f, 0.f};
        acc = mfma16(vf0, *(const LAS bf16x8*)(Sd + (16 * mt + r) * LD + 8 * quad), acc); acc = mfma16(vf1, *(const LAS bf16x8*)(Sd + (16 * mt + r) * LD + 32 + 8 * quad), acc);
#pragma unroll
        for (int j = 0; j < 4; ++j) numS[(16 * mt + r) * LN + 16 * w + 4 * quad + j] = (bf16)f2bf(acc[j]); }
    { const int row = tid >> 3, seg = tid & 7; const v4u sd = *(const LAS v4u*)(Sd + row * LD + 8 * seg);
      float p = (bflo(sd.x) + bfhi(sd.x)) + (bflo(sd.y) + bfhi(sd.y)) + (bflo(sd.z) + bfhi(sd.z)) + (bflo(sd.w) + bfhi(sd.w));
      p = red8(p); if (seg == 0) sDen[row] = p; }
    lds_barrier();
    { const int row = tid >> 3, c16 = (tid & 7) * 16; bf16* g = numl + (size_t)unit * 8192 + row * 128 + c16;
      *(GAS v4u*)g = *(const LAS v4u*)(numS + row * LN + c16); *(GAS v4u*)(g + 8) = *(const LAS v4u*)(numS + row * LN + c16 + 8);
      const int dv = tid >> 2, d16 = (tid & 3) * 16; bf16* gc = dc + (size_t)unit * 8192 + dv * 64 + d16;
      *(GAS v4u*)gc = *(const LAS v4u*)(Cst + dv * LD + d16); *(GAS v4u*)(gc + 8) = *(const LAS v4u*)(Cst + dv * LD + d16 + 8);
      float* sc = scal + (size_t)unit * MLS_STRIDE;
      if (w == 0) { sc[lane] = sDen[lane]; sc[64 + lane] = cm; sc[128 + lane] = bb; sc[192 + lane] = sDn[lane]; if (lane == 0) { sc[256] = Astar; sc[257] = b63; } } }
}
DI void mlstm_a_phase(Frame& F, const bf16* proj, const float* gate, bf16* numl, bf16* dc, float* scal) {
    const int per = (4096 + F.G - 1) / F.G, u0 = F.wg * per, u1 = (u0 + per < 4096) ? u0 + per : 4096;
    if (u0 >= u1) return;
    MlaRegs R; mla_load(R, proj, gate, u0, F.tid);
    for (int u = u0; u < u1; ++u) mlstm_a_unit(F, R, proj, gate, numl, dc, scal, u, u1);
}
DI void mlstm_b_phase(Frame& F, bf16* dc, float* scal) {
    for (int c = F.wg; c < 256; c += F.G) {
        const int bh = c >> 3, part = c & 7, e = part * 1024 + 2 * F.tid; const bool nth = (part == 0) && (F.tid < 64);
        float c0 = 0.f, c1 = 0.f, nn = 0.f, m = 0.f;
        for (int cb = 0; cb < 128; cb += 8) {
            unsigned dv[8]; float As[8], bs[8], dn[8];
#pragma unroll
            for (int i = 0; i < 8; ++i) { const size_t un = (size_t)bh * 128 + cb + i; dv[i] = *(const GAS unsigned*)(dc + un * 8192 + e); const float* sc = scal + un * MLS_STRIDE; As[i] = sc[256]; bs[i] = sc[257]; dn[i] = nth ? sc[192 + F.tid] : 0.f; }
#pragma unroll
            for (int i = 0; i < 8; ++i) { const size_t un = (size_t)bh * 128 + cb + i; float* sc = scal + un * MLS_STRIDE;
                const float Mx = fmaxf(m, As[i]), wo = __expf(m - Mx), wd = __expf(As[i] - Mx);
                *(GAS unsigned*)(dc + un * 8192 + e) = pk2(c0, c1);
                if (nth) sc[192 + F.tid] = nn;
                if (part == 0 && F.tid == 64) sc[258] = m;
                c0 = wo * c0 + wd * bflo(dv[i]); c1 = wo * c1 + wd * bfhi(dv[i]); nn = wo * nn + wd * dn[i]; m = bs[i] + Mx; }
        }
    }
}
struct MlcRegs { bf16x8 qa[4][2], cb[2]; v4u nl0, nl1, o0, o1, qr; f32x4 n0, n1; float denL, cm, bb, mprev; };
DI void mlc_load(MlcRegs& R, const bf16* proj, const bf16* numl, const bf16* dc, const float* scal, int unit, int tid, int w) {
    const int ch = unit & 127, bh = unit >> 7, lane = tid & 63, r = lane & 15, quad = lane >> 4, row = tid >> 3, seg = tid & 7;
    const size_t hb0 = (size_t)bh * T + ch * 64;
#pragma unroll
    for (int mt = 0; mt < 4; ++mt) { const bf16* p = proj + (hb0 + 16 * mt + r) * 64 + 8 * quad; R.qa[mt][0] = *(const GAS bf16x8*)p; R.qa[mt][1] = *(const GAS bf16x8*)(p + 32); }
    { const bf16* p = dc + (size_t)unit * 8192 + (16 * w + r) * 64 + 8 * quad; R.cb[0] = *(const GAS bf16x8*)p; R.cb[1] = *(const GAS bf16x8*)(p + 32); }
    { const bf16* p = numl + (size_t)unit * 8192 + row * 128 + 16 * seg; R.nl0 = *(const GAS v4u*)p; R.nl1 = *(const GAS v4u*)(p + 8); }
    { const bf16* p = proj + (size_t)M * 1024 + (hb0 + row) * 128 + 16 * seg; R.o0 = *(const GAS v4u*)p; R.o1 = *(const GAS v4u*)(p + 8); }
    R.qr = *(const GAS v4u*)(proj + (hb0 + row) * 64 + 8 * seg);
    const float* sc = scal + (size_t)unit * MLS_STRIDE;
    R.n0 = *(const GAS f32x4*)(sc + 192 + 8 * seg); R.n1 = *(const GAS f32x4*)(sc + 192 + 8 * seg + 4);
    R.denL = sc[row]; R.cm = sc[64 + row]; R.bb = sc[128 + row]; R.mprev = sc[258];
}
DI void mlstm_c_phase(Frame& F, const bf16* proj, const bf16* numl, const bf16* dc, const float* scal, const float* hgain, bf16* mix) {
    constexpr int HLD = 132;
    const int per = (4096 + F.G - 1) / F.G, u0 = F.wg * per, u1 = (u0 + per < 4096) ? u0 + per : 4096;
    if (u0 >= u1) return;
    LAS float* hbuf = (LAS float*)F.lds;
    MlcRegs R; mlc_load(R, proj, numl, dc, scal, u0, F.tid, F.wave);
    for (int u = u0; u < u1; ++u) {
        int tid_ = F.tid; asm volatile("" : "+v"(tid_));
        const int tid = tid_, lane = tid & 63, w = F.wave, r = lane & 15, quad = lane >> 4, row = tid >> 3, seg = tid & 7;
        const int ch = u & 127, bh = u >> 7, b = bh >> 2, h = bh & 3;
        lds_barrier();
#pragma unroll
        for (int mt = 0; mt < 4; ++mt) { f32x4 acc = (f32x4){0.f, 0.f, 0.f, 0.f}; acc = mfma16(R.cb[0], R.qa[mt][0], acc); acc = mfma16(R.cb[1], R.qa[mt][1], acc);
#pragma unroll
            for (int j = 0; j < 4; ++j) hbuf[(16 * mt + r) * HLD + 16 * w + 4 * quad + j] = acc[j]; }
        const v4u nl0 = R.nl0, nl1 = R.nl1, o0 = R.o0, o1 = R.o1, qr = R.qr; const f32x4 n0 = R.n0, n1 = R.n1; const float denL = R.denL, cm = R.cm, bb = R.bb, mprev = R.mprev;
        if (u + 1 < u1) mlc_load(R, proj, numl, dc, scal, u + 1, tid, w);
        lds_barrier();
        { const float Mx = fmaxf(mprev, cm), e1 = __expf(cm - Mx), wi = __expf(mprev - Mx);
          float qn = (bflo(qr.x) * n0[0] + bfhi(qr.x) * n0[1]) + (bflo(qr.y) * n0[2] + bfhi(qr.y) * n0[3]) + (bflo(qr.z) * n1[0] + bfhi(qr.z) * n1[1]) + (bflo(qr.w) * n1[2] + bfhi(qr.w) * n1[3]);
          qn = red8(qn);
          const float den = e1 * denL + wi * qn; const float dinv = rcp_(fmaxf(fabsf(den), __expf(-(bb + Mx))));
          const unsigned nw[8] = {nl0.x, nl0.y, nl0.z, nl0.w, nl1.x, nl1.y, nl1.z, nl1.w};
          float hv[16]; float ss = 0.f;
#pragma unroll
          for (int q4 = 0; q4 < 4; ++q4) { const f32x4 t = *(const LAS f32x4*)(hbuf + row * HLD + 16 * seg + 4 * q4);
              hv[4 * q4] = (e1 * bflo(nw[2 * q4]) + wi * t.x) * dinv; hv[4 * q4 + 1] = (e1 * bfhi(nw[2 * q4]) + wi * t.y) * dinv; hv[4 * q4 + 2] = (e1 * bflo(nw[2 * q4 + 1]) + wi * t.z) * dinv; hv[4 * q4 + 3] = (e1 * bfhi(nw[2 * q4 + 1]) + wi * t.w) * dinv; }
#pragma unroll
          for (int i = 0; i < 16; ++i) ss += hv[i] * hv[i];
          ss = red8(ss);
          const float rstd = rsq_(ss * (1.f / 128.f) + EPS);
          const unsigned og[8] = {o0.x, o0.y, o0.z, o0.w, o1.x, o1.y, o1.z, o1.w}; unsigned ow[8];
          const float* gp = hgain + h * 128 + 16 * seg;
#pragma unroll
          for (int i = 0; i < 8; ++i) ow[i] = pk2(hv[2 * i] * rstd * gp[2 * i] * sigmoidf_(bflo(og[i])), hv[2 * i + 1] * rstd * gp[2 * i + 1] * sigmoidf_(bfhi(og[i])));
          bf16* op = mix + ((size_t)b * T + ch * 64 + row) * D + h * 128 + 16 * seg;
          *(GAS v4u*)op = (v4u){ow[0], ow[1], ow[2], ow[3]}; *(GAS v4u*)(op + 8) = (v4u){ow[4], ow[5], ow[6], ow[7]}; }
    }
}
constexpr size_t MIX_AT = 0, MIX_HALO = 64 * MiB, MIX_GL = 96 * MiB;
struct G1Raw { v2u raw[3][7]; float gg, be; };
struct G1Cw { float w[3][4][4]; };
DI void g1_load_raw(G1Raw& R, const bf16* big, const bf16* halo, const float* gate, int U, int tid) {
    const int ch = U & 127, h = (U >> 7) & 7, b = U >> 10, cg = tid & 31, rs = tid >> 5;
    const size_t hb0 = (size_t)(b * 8 + h) * T + (size_t)ch * 64;
    R.gg = 0.f; R.be = 0.f;
    if (tid < 64) { const float* g = gate + ((size_t)b * T + (size_t)ch * 64 + tid) * 16; R.gg = g[8 + h]; R.be = g[h]; }
    const bf16* own = big + ((ptrdiff_t)hb0 + 4 * rs - 3) * 128 + 4 * cg;
#pragma unroll
    for (int which = 0; which < 3; ++which)
#pragma unroll
        for (int i = 0; i < 7; ++i) R.raw[which][i] = *(const GAS v2u*)(own + (size_t)M * 1024 * which + i * 128);
    if (rs == 0) {
#pragma unroll
        for (int which = 0; which < 3; ++which)
#pragma unroll
            for (int i = 0; i < 3; ++i) { v2u t = (v2u){0u, 0u};
                if (ch > 0) t = *(const GAS v2u*)(halo + ((size_t)(b * 128 + ch - 1) * 3 + i) * 3072 + which * 1024 + h * 128 + 4 * cg);
                R.raw[which][i] = t; }
    }
}
DI void g1_load_cw(G1Cw& C, const float* convw, int h, int tid) {
    const int cg = tid & 31;
#pragma unroll
    for (int which = 0; which < 3; ++which)
#pragma unroll
        for (int j = 0; j < 4; ++j) { const f32x4 t = *(const GAS f32x4*)(convw + j * 3072 + which * 1024 + h * 128 + 4 * cg); C.w[which][j][0] = t.x; C.w[which][j][1] = t.y; C.w[which][j][2] = t.z; C.w[which][j][3] = t.w; }
}
DI void gdn_g1_unit(Frame& F, bf16* big, const bf16* halo, const float* gate, G1Raw& RW, const float* convw, bf16* Hb, bf16* At, float* GL, int U, int Uend, bool st) {
    constexpr int LQ = 136, LX = 72, LR = 264;
    const int ch = U & 127, h = (U >> 7) & 7, b = U >> 10;
    const size_t r0 = (size_t)b * T + (size_t)ch * 64, hb0 = (size_t)(b * 8 + h) * T + (size_t)ch * 64;
    int tid_ = F.tid; asm volatile("" : "+v"(tid_));
    const int tid = tid_, lane = tid & 63, w = F.wave, r = lane & 15, quad = lane >> 4, row = tid >> 3, seg = tid & 7;
    const size_t hb = hb0 + row;
    LAS bf16* qn = (LAS bf16*)F.lds; LAS bf16* kn = qn + 64 * LQ; LAS bf16* vn = kn + 64 * LQ; LAS bf16* knT = vn + 64 * LQ;
    LAS bf16* Lb = knT + 128 * LX; LAS float* Lf = (LAS float*)(Lb + 64 * LX);
    LAS bf16* Db = (LAS bf16*)(Lf + 4 * 16 * 17); LAS bf16* Xt = Db + 4 * 16 * 20;
    LAS bf16* Xr = qn;
    LAS bf16* Ats = Xt;
    LAS float* sG = (LAS float*)(Xt + 256 * LX); LAS float* sBeta = sG + 64; LAS float* sEg = sBeta + 64; LAS float* sEk = sEg + 64;
    LAS bf16* vnT = (LAS bf16*)(sEk + 64);
    static_assert((3 * 64 * 136 + 128 * 72 + 64 * 72 + 4 * 16 * 20 + 256 * 72 + 128 * 72) * 2 + 4 * 16 * 17 * 4 + 4 * 64 * 4 <= MISC_OFF, "G1 LDS layout");
    f32x4 cwa[3][4];
#pragma unroll
    for (int which = 0; which < 3; ++which)
#pragma unroll
        for (int j = 0; j < 4; ++j) cwa[which][j] = *(const GAS f32x4*)(convw + j * 3072 + which * 1024 + h * 128 + 4 * (tid & 31));
    STG_T0();
    lds_barrier();
    STG(10);
    const float gate_gg = RW.gg, gate_be = RW.be;
    {
        const int cg = tid & 31, rs = tid >> 5;
#pragma unroll
        for (int which = 0; which < 3; ++which) {
            __builtin_amdgcn_sched_barrier(0);
            const f32x4 (&cw)[4] = cwa[which];
            float x[7][4];
#pragma unroll
            for (int i = 0; i < 7; ++i) { const v2u t = RW.raw[which][i]; x[i][0] = bflo(t.x); x[i][1] = bfhi(t.x); x[i][2] = bflo(t.y); x[i][3] = bfhi(t.y); }
            float o[4][4]; float ss[4];
#pragma unroll
            for (int rr = 0; rr < 4; ++rr) {
#pragma unroll
                for (int c = 0; c < 4; ++c) { float a = cw[0][c] * x[rr][c]; a += cw[1][c] * x[rr + 1][c]; a += cw[2][c] * x[rr + 2][c]; a += cw[3][c] * x[rr + 3][c]; o[rr][c] = a; } }
#pragma unroll
            for (int rr = 0; rr < 4; ++rr) { ss[rr] = 0.f;
#pragma unroll
                for (int c = 0; c < 4; ++c) { float a = o[rr][c]; a = a * sigmoidf_(a); o[rr][c] = a; ss[rr] += a * a; } }

            if (which < 2) {
#pragma unroll
                for (int rr = 0; rr < 4; ++rr) { float t = ss[rr]; t = red16(t); t += __shfl_xor(t, 16);
                    const float sc = rsq_(t + EPS) * (which == 0 ? 0.08838834764831845f : 1.0f);
#pragma unroll
                    for (int c = 0; c < 4; ++c) o[rr][c] *= sc; } }
            if (which < 2) { LAS bf16* dst = (which == 0 ? qn : kn);
#pragma unroll
                for (int rr = 0; rr < 4; ++rr) *(LAS v2u*)(dst + (4 * rs + rr) * LQ + 4 * cg) = (v2u){pk2(o[rr][0], o[rr][1]), pk2(o[rr][2], o[rr][3])}; }
            if (which >= 1) { LAS bf16* dT = (which == 1 ? knT : vnT);
#pragma unroll
                for (int c = 0; c < 4; ++c) *(LAS v2u*)(dT + (4 * cg + c) * LX + ((4 * rs) ^ (8 * (cg & 7)))) = (v2u){pk2(o[0][c], o[1][c]), pk2(o[2][c], o[3][c])}; }
        }
    }
    if (U + 1 < Uend) g1_load_raw(RW, big, halo, gate, U + 1, tid);
    if (w == 0) { float gg = gate_gg; const float be = gate_be;
        gg = scan64_add(gg);
        sG[lane] = gg; sBeta[lane] = be; sEg[lane] = __expf(gg); sEk[lane] = __expf(lane63(gg) - gg); }
    STG(11);
    lds_barrier();
    STG(12);
    { const int mt = w >> 1;
#pragma unroll
      for (int tt = 0; tt < 2; ++tt) { const int nt = 2 * (w & 1) + tt; f32x4 ak = (f32x4){0.f, 0.f, 0.f, 0.f}, aq = ak;
          if (nt <= mt) {
#pragma unroll
              for (int kk = 0; kk < 4; ++kk) { const bf16x8 bk = *(const LAS bf16x8*)(kn + (16 * nt + r) * LQ + 32 * kk + 8 * quad);
                  ak = mfma16(*(const LAS bf16x8*)(kn + (16 * mt + r) * LQ + 32 * kk + 8 * quad), bk, ak); aq = mfma16(*(const LAS bf16x8*)(qn + (16 * mt + r) * LQ + 32 * kk + 8 * quad), bk, aq); } }
          const int s = 16 * nt + r; const float gs = sG[s];
          const f32x4 g4 = *(const LAS f32x4*)(sG + 16 * mt + 4 * quad), b4 = *(const LAS f32x4*)(sBeta + 16 * mt + 4 * quad);
#pragma unroll
          for (int j = 0; j < 4; ++j) { const int t = 16 * mt + 4 * quad + j; const float dec = (s <= t) ? __expf(g4[j] - gs) : 0.f;
              const float lv = (s < t) ? b4[j] * ak[j] * dec : 0.f;
              if (nt <= mt) { Lb[t * LX + s] = (bf16)f2bf(lv); if (nt == mt) Lf[(mt * 16 + 4 * quad + j) * 17 + r] = lv; }
              Ats[t * LX + s] = (bf16)f2bf(aq[j] * dec); } } }
    float R[4][2][4];
#pragma unroll
    for (int i = 0; i < 4; ++i)
#pragma unroll
        for (int ct = 0; ct < 2; ++ct)
            { const int t0 = 16 * i + 4 * quad, cc = 32 * (w & 3) + 16 * ct + r;
                f32x4 sc4 = *(const LAS f32x4*)(sBeta + t0); if (w >= 4) sc4 = sc4 * *(const LAS f32x4*)(sEg + t0);
                const v2u pv = *(const LAS v2u*)((w < 4 ? vnT : knT) + cc * LX + (t0 ^ (8 * ((cc >> 2) & 7))));
                R[i][ct][0] = sc4[0] * bflo(pv.x); R[i][ct][1] = sc4[1] * bfhi(pv.x); R[i][ct][2] = sc4[2] * bflo(pv.y); R[i][ct][3] = sc4[3] * bfhi(pv.y); }
    STG(13);
    lds_barrier();
    STG(14);
    if (w == 0) { const int i = lane >> 4, cI = lane & 15; const LAS float* N = Lf + i * 16 * 17; float x[16];
#pragma unroll
        for (int rr = 0; rr < 16; ++rr) { float v = (rr == cI) ? 1.f : 0.f;
#pragma unroll
            for (int m = 0; m < rr; ++m) v -= N[rr * 17 + m] * x[m];
            x[rr] = v; Db[(i * 16 + rr) * 20 + cI] = (bf16)f2bf(v); }
    } else { const float gl = sG[63];
        if (st) for (int idx = tid - 64; idx < 2560; idx += NTHR - 64) {
            if (idx < 1024) { const int t = idx >> 4, c8 = (idx & 15) * 8; const v4u v = *(const LAS v4u*)(qn + t * LQ + c8); const float e = sEg[t];
                *(GAS v4u*)(big + (size_t)M * 2048 + (hb0 + t) * 128 + c8) = (v4u){scale_pk(v.x, e), scale_pk(v.y, e), scale_pk(v.z, e), scale_pk(v.w, e)}; }
            else if (idx >= 2048) { const int i3 = idx - 2048, t = i3 >> 3, s8 = (i3 & 7) * 8; *(GAS v4u*)(At + (size_t)U * 4096 + t * 64 + s8) = *(const LAS v4u*)(Ats + t * LX + s8); }
            else { const int i2 = idx - 1024, d = i2 >> 3, s8 = (i2 & 7) * 8; const v4u v = *(const LAS v4u*)(knT + d * LX + (s8 ^ (8 * ((d >> 2) & 7)))); const f32x4 ea = *(const LAS f32x4*)(sEk + s8), eb = *(const LAS f32x4*)(sEk + s8 + 4); const float e[8] = {ea.x, ea.y, ea.z, ea.w, eb.x, eb.y, eb.z, eb.w};
                *(GAS v4u*)(big + (size_t)M * 1024 + hb0 * 128 + d * 64 + s8) = (v4u){pk2(bflo(v.x) * e[0], bfhi(v.x) * e[1]), pk2(bflo(v.y) * e[2], bfhi(v.y) * e[3]), pk2(bflo(v.z) * e[4], bfhi(v.z) * e[5]), pk2(bflo(v.w) * e[6], bfhi(v.w) * e[7])}; } }
        if (st && tid == 64) GL[U] = __expf(gl); }
    STG(15);
    lds_barrier();
    STG(16);
#pragma unroll
    for (int i = 0; i < 4; ++i) {
#pragma unroll
        for (int ct = 0; ct < 2; ++ct) { const int col = 32 * w + 16 * ct + r; f32x4 acc = (f32x4){0.f, 0.f, 0.f, 0.f};
            if (i > 0) {
#pragma unroll
                for (int kk = 0; kk < 2; ++kk) if (32 * kk < 16 * i) {
                    bf16x8 af = *(const LAS bf16x8*)(Lb + (16 * i + r) * LX + 32 * kk + 8 * quad);
                    if (32 * kk + 8 * quad >= 16 * i) af = (bf16x8){0, 0, 0, 0, 0, 0, 0, 0};
                    acc = mfma16(af, *(const LAS bf16x8*)(Xt + col * LX + 32 * kk + 8 * quad), acc); } }
            const v2u bp = (v2u){pk2(R[i][ct][0] - acc[0], R[i][ct][1] - acc[1]), pk2(R[i][ct][2] - acc[2], R[i][ct][3] - acc[3])};
            const v2u ap = *(const LAS v2u*)(Db + (i * 16 + r) * 20 + 4 * quad);
            const bf16x8 apf = __builtin_bit_cast(bf16x8, (v4u){ap.x, ap.y, 0u, 0u}), bpf = __builtin_bit_cast(bf16x8, (v4u){bp.x, bp.y, 0u, 0u});
            const f32x4 y = mfma16(apf, bpf, (f32x4){0.f, 0.f, 0.f, 0.f});
            *(LAS v2u*)(Xt + col * LX + 16 * i + 4 * quad) = (v2u){pk2(y[0], y[1]), pk2(y[2], y[3])};
            const f32x4 yt = mfma16(bpf, apf, (f32x4){0.f, 0.f, 0.f, 0.f});
#pragma unroll
            for (int j = 0; j < 4; ++j) Xr[(16 * i + r) * LR + 32 * w + 16 * ct + 4 * quad + j] = (bf16)f2bf(yt[j]); }
        asm volatile("s_waitcnt lgkmcnt(0)" ::: "memory");
    }
    lds_barrier();
    STG(17);
    if (st) { const v4u u0 = *(const LAS v4u*)(Xr + row * LR + 16 * seg), u1 = *(const LAS v4u*)(Xr + row * LR + 16 * seg + 8), w0 = *(const LAS v4u*)(Xr + row * LR + 128 + 16 * seg), w1 = *(const LAS v4u*)(Xr + row * LR + 128 + 16 * seg + 8);
      bf16* up = Hb + hb * 128 + 16 * seg; *(GAS v4u*)up = u0; *(GAS v4u*)(up + 8) = u1;
      bf16* wp = big + hb * 128 + 16 * seg; *(GAS v4u*)wp = w0; *(GAS v4u*)(wp + 8) = w1; }
    STG(18);
}
DI void gdn_g1_phase(Frame& F, bf16* big, const bf16* halo, const float* gate, const float* convw, bf16* Hb, bf16* At, float* GL, bool st) {
    LAS unsigned* xt = (LAS unsigned*)(F.lds + (3 * 64 * 136 + 128 * 72 + 64 * 72) * 2 + 4 * 16 * 17 * 4 + 4 * 16 * 20 * 2);
    lds_barrier();
    for (int i = F.tid; i < 256 * 72 / 2; i += NTHR) xt[i] = 0u;
    const int per = (8192 + F.G - 1) / F.G, u0 = F.wg * per, u1 = (u0 + per < 8192) ? u0 + per : 8192;
    if (u0 >= u1) return;
    G1Raw RW;
    g1_load_raw(RW, big, halo, gate, u0, F.tid);
    for (int U = u0; U < u1; ++U) gdn_g1_unit(F, big, halo, gate, RW, convw, Hb, At, GL, U, u1, st);
}
constexpr int G2_SLOT = 61440, G2_W = 0, G2_QD = 16384, G2_KDT = 32768, G2_AT = 49152, G2_U = 57344;
#define G2_DMA(gptr, ldsptr) __builtin_amdgcn_global_load_lds((const unsigned*)(gptr), (LAS unsigned*)(ldsptr), 16, 0, 0)
DI void g2_issue(Frame& F, const bf16* big, const bf16* Hb, const bf16* At, int bh, int vq, int ch) {
    const int w = F.wave, lane = F.lane; const size_t hb0 = (size_t)bh * T + (size_t)ch * 64; const int U = bh * 128 + ch;
    LAS unsigned char* slot = F.lds + (ch & 1) * G2_SLOT;
#pragma unroll
    for (int j = 0; j < 7; ++j) { const int I = w * 7 + j;
        if (I < 32) { const int ten = I >> 4, k = I & 15, row = 4 * k + (lane >> 4), g = (lane & 15) ^ (row & 15);
            G2_DMA(big + (ten ? (size_t)M * 2048 : (size_t)0) + (hb0 + row) * 128 + g * 8, slot + ten * 16384 + k * 1024); }
        else if (I < 48) { const int k = I & 15, row = 8 * k + (lane >> 3), g = (lane & 7) ^ (row & 7);
            G2_DMA(big + (size_t)M * 1024 + hb0 * 128 + row * 64 + g * 8, slot + G2_KDT + k * 1024); }
        else { const int k = I - 48, row = 8 * k + (lane >> 3), g = (lane & 7) ^ (row & 7);
            G2_DMA(At + (size_t)U * 4096 + row * 64 + g * 8, slot + G2_AT + k * 1024); } }
    if (w < 4) { const int row = 16 * w + (lane >> 2), g = lane & 3;
        G2_DMA(Hb + (hb0 + row) * 128 + vq * 32 + g * 8, slot + G2_U + w * 1024); }
}
DI void gdn_g2_chain(Frame& F, const bf16* big, bf16* Hb, const bf16* At, const float* GL, int c, bool st) {
    constexpr int LS = 136, LV = 72;
    const int b = c >> 5, h = (c >> 2) & 7, vq = c & 3, bh = b * 8 + h;
    const int tid = F.tid, lane = F.lane, w = F.wave, r = lane & 15, quad = lane >> 4;
    LAS bf16* St = (LAS bf16*)(F.lds + 2 * G2_SLOT);
    LAS bf16* vnT = St + 32 * LS;
    lds_barrier();
    for (int i = tid; i < 32 * LS / 2; i += NTHR) ((LAS unsigned*)St)[i] = 0u;
    f32x4 accS[2][2];
#pragma unroll
    for (int i = 0; i < 2; ++i) { accS[i][0] = (f32x4){0.f, 0.f, 0.f, 0.f}; accS[i][1] = accS[i][0]; }
    const float glv0 = GL[bh * 128 + lane], glv1 = GL[bh * 128 + 64 + lane];
    asm volatile("s_waitcnt vmcnt(0)" ::: "memory");
    g2_issue(F, big, Hb, At, bh, vq, 0); g2_issue(F, big, Hb, At, bh, vq, 1);
    if (w < 4) asm volatile("s_waitcnt vmcnt(8)" ::: "memory"); else asm volatile("s_waitcnt vmcnt(7)" ::: "memory");
    lds_barrier();
    for (int ch = 0; ch < T / 64; ++ch) {
        const LAS unsigned char* slot = F.lds + (ch & 1) * G2_SLOT;
        STG_T0();
        f32x4 ao[2];
        if (w < 4) { const int mt = w; const int rw = 16 * mt + r;
            bf16x8 wf[4], qf[4];
#pragma unroll
            for (int kk = 0; kk < 4; ++kk) { const int off = rw * 256 + (((4 * kk + quad) ^ r) << 4); wf[kk] = *(const LAS bf16x8*)(slot + G2_W + off); qf[kk] = *(const LAS bf16x8*)(slot + G2_QD + off); }
#pragma unroll
            for (int nt = 0; nt < 2; ++nt) { f32x4 av = (f32x4){0.f, 0.f, 0.f, 0.f}; ao[nt] = av;
#pragma unroll
                for (int kk = 0; kk < 4; ++kk) { const bf16x8 sf = *(const LAS bf16x8*)(St + (16 * nt + r) * LS + 32 * kk + 8 * quad); av = mfma16(wf[kk], sf, av); ao[nt] = mfma16(qf[kk], sf, ao[nt]); }
                const LAS bf16* pu = (const LAS bf16*)(slot + G2_U) + (16 * mt + 4 * quad) * 32 + 16 * nt + r;
                *(LAS v2u*)(vnT + (16 * nt + r) * LV + 16 * mt + 4 * quad) = (v2u){pk2(bf2f(pu[0]) - av[0], bf2f(pu[32]) - av[1]), pk2(bf2f(pu[64]) - av[2], bf2f(pu[96]) - av[3])}; }
        }
        STG(20);
        lds_barrier();
        STG(21);
        if (w < 4) { const int mt = w; const int rw = 16 * mt + r;
#pragma unroll
            for (int nt = 0; nt < 2; ++nt) {
#pragma unroll
                for (int kk = 0; kk < 2; ++kk) ao[nt] = mfma16(*(const LAS bf16x8*)(slot + G2_AT + rw * 128 + (((4 * kk + quad) ^ (r & 7)) << 4)), *(const LAS bf16x8*)(vnT + (16 * nt + r) * LV + 32 * kk + 8 * quad), ao[nt]); }
            if (st) { bf16* po = Hb + ((size_t)bh * T + (size_t)ch * 64 + 16 * mt + 4 * quad) * 128 + vq * 32 + r;
#pragma unroll
                for (int nt = 0; nt < 2; ++nt)
#pragma unroll
                    for (int j = 0; j < 4; ++j) po[(size_t)j * 128 + 16 * nt] = (bf16)f2bf(ao[nt][j]); }
        } else { const int dg = w - 4; const float gl = __builtin_bit_cast(float, __builtin_amdgcn_readlane(__builtin_bit_cast(int, ch < 64 ? glv0 : glv1), ch & 63));
#pragma unroll
            for (int i = 0; i < 2; ++i) { const int d = 32 * dg + 16 * i + r;
                const bf16x8 k0 = *(const LAS bf16x8*)(slot + G2_KDT + d * 128 + ((quad ^ (d & 7)) << 4)), k1 = *(const LAS bf16x8*)(slot + G2_KDT + d * 128 + (((4 + quad) ^ (d & 7)) << 4));
#pragma unroll
                for (int n2 = 0; n2 < 2; ++n2) { f32x4 a = accS[i][n2] * gl;
                    a = mfma16(k0, *(const LAS bf16x8*)(vnT + (16 * n2 + r) * LV + 8 * quad), a); a = mfma16(k1, *(const LAS bf16x8*)(vnT + (16 * n2 + r) * LV + 32 + 8 * quad), a);
                    accS[i][n2] = a; *(LAS v2u*)(St + (16 * n2 + r) * LS + 32 * dg + 16 * i + 4 * quad) = (v2u){pk2(a[0], a[1]), pk2(a[2], a[3])}; } }
        }
        STG(22);
        if (w < 4 && st) asm volatile("s_waitcnt vmcnt(8)" ::: "memory"); else asm volatile("s_waitcnt vmcnt(0)" ::: "memory");
        lds_barrier();
        STG(23);
        if (ch + 2 < T / 64) g2_issue(F, big, Hb, At, bh, vq, ch + 2);
    }
    asm volatile("s_waitcnt vmcnt(0)" ::: "memory");
}
struct SbRegs { v4u k0, k1, v0, v1; };
DI void sb_load(SbRegs& R, const bf16* proj, int b, int h, int k0, int tid) {
    const size_t hb = (size_t)(b * 4 + h) * T + k0;
    const bf16* pk = proj + (size_t)M * 2048 + (hb + (tid >> 3)) * 128 + (tid & 7) * 16;
    R.k0 = *(const GAS v4u*)pk; R.k1 = *(const GAS v4u*)(pk + 8);
    const bf16* pv = proj + (size_t)M * 2560 + (hb + (tid & 63)) * 128 + (tid >> 6) * 16;
    R.v0 = *(const GAS v4u*)pv; R.v1 = *(const GAS v4u*)(pv + 8);
}
DI void sb_unit(Frame& F, const bf16* proj, bf16* mix, int u) {
    constexpr int LDV = 72, LDK = 136, BUF = 128 * LDV + 64 * LDK;
    const int qt = u & 63, h = (u >> 6) & 3, b = u >> 8;
    LAS bf16* lds = (LAS bf16*)F.lds;
    volatile LAS unsigned* flag = (volatile LAS unsigned*)(F.lds + MISC_OFF + 64);
    const int w = F.wave, lane = F.lane, r = lane & 15, quad = lane >> 4;
    const int t0 = qt * 128, qpos = t0 + 16 * w + r;
    const size_t rb = (size_t)b * T;
    bf16x8 qf[4];
#pragma unroll
    for (int kk = 0; kk < 4; ++kk) qf[kk] = *(const GAS bf16x8*)(proj + (size_t)M * 1536 + ((size_t)(b * 4 + h) * T + qpos) * 128 + 32 * kk + 8 * quad);
    f32x4 o[8];
#pragma unroll
    for (int i = 0; i < 8; ++i) o[i] = (f32x4){0.f, 0.f, 0.f, 0.f};
    float carry = 1.f;
    const float scale = 0.08838834764831845f;
    SbRegs R; sb_load(R, proj, b, h, (2 * qt + 1) * 64, F.tid);
    lds_barrier();
    if (F.tid < 3) flag[F.tid] = 1u;
    int it = 0;
    for (int kb = 2 * qt + 1; kb >= 0; --kb, ++it) {
        const int k0 = kb * 64;
        LAS bf16* Vt = lds + (it & 1) * BUF; LAS bf16* Ks = Vt + 128 * LDV;
        { LAS bf16* kd = Ks + (F.tid >> 3) * LDK + (F.tid & 7) * 16; *(LAS v4u*)kd = R.k0; *(LAS v4u*)(kd + 8) = R.k1;
          const unsigned ww[8] = {R.v0.x, R.v0.y, R.v0.z, R.v0.w, R.v1.x, R.v1.y, R.v1.z, R.v1.w}; const int key = F.tid & 63, ds = (F.tid >> 6) * 16;
          const int kp = (key & 32) + 8 * ((key >> 2) & 3) + 4 * ((key >> 4) & 1) + (key & 3);
#pragma unroll
          for (int i = 0; i < 8; ++i) { Vt[(ds + 2 * i) * LDV + kp] = (bf16)(ww[i] & 0xffffu); Vt[(ds + 2 * i + 1) * LDV + kp] = (bf16)(ww[i] >> 16); } }
        lds_barrier();
        if (it > 0 && flag[(it + 2) % 3] == 0u) break;
        if (F.tid == 0) flag[(it + 1) % 3] = 0u;
        if (kb > 0) sb_load(R, proj, b, h, k0 - 64, F.tid);
        const bool active = (k0 < t0 + 16 * w + 15);
        if (active) {
            const bool full = (k0 + 63 < t0 + 16 * w);
            f32x4 s[4];
#pragma unroll
            for (int mt = 0; mt < 4; ++mt) { s[mt] = (f32x4){0.f, 0.f, 0.f, 0.f};
                const LAS bf16* kp = Ks + (16 * mt + r) * LDK + 8 * quad;
#pragma unroll
                for (int kk = 0; kk < 4; ++kk) s[mt] = mfma16(*(const LAS bf16x8*)(kp + 32 * kk), qf[kk], s[mt]); }
            float om[4][4], tot[4];
#pragma unroll
            for (int mt = 0; mt < 4; ++mt) { tot[mt] = 1.f;
#pragma unroll
                for (int j = 0; j < 4; ++j) { const float z = s[mt][j] * scale; const bool valid = full || ((k0 + 16 * mt + 4 * quad + j) < qpos);
                    const float e = __expf(-fabsf(z)), rr = rcp_(1.0f + e), er = e * rr; const bool pos = z >= 0.f;
                    om[mt][j] = valid ? (pos ? er : rr) : 1.f; s[mt][j] = valid ? (pos ? rr : er) : 0.f; tot[mt] *= om[mt][j]; } }
            float run = carry;
#pragma unroll
            for (int mt = 3; mt >= 0; --mt) {
                const float t1 = __shfl_xor(tot[mt], 16), t2 = __shfl_xor(tot[mt], 32), t3 = __shfl_xor(t1, 32);
                float acc = run;
                acc *= ((quad ^ 1) > quad) ? t1 : 1.f; acc *= ((quad ^ 2) > quad) ? t2 : 1.f; acc *= ((quad ^ 3) > quad) ? t3 : 1.f;
#pragma unroll
                for (int j = 3; j >= 0; --j) { s[mt][j] *= acc; acc *= om[mt][j]; }
                run *= (tot[mt] * t1) * (t2 * t3);
            }
            carry = run;
#pragma unroll
            for (int s2 = 0; s2 < 2; ++s2) {
                v4u pw; pw.x = pk2(s[2 * s2][0], s[2 * s2][1]); pw.y = pk2(s[2 * s2][2], s[2 * s2][3]); pw.z = pk2(s[2 * s2 + 1][0], s[2 * s2 + 1][1]); pw.w = pk2(s[2 * s2 + 1][2], s[2 * s2 + 1][3]);
                const bf16x8 pf = __builtin_bit_cast(bf16x8, pw);
#pragma unroll
                for (int dt = 0; dt < 8; ++dt) o[dt] = mfma16(*(const LAS bf16x8*)(Vt + (16 * dt + r) * LDV + 32 * s2 + 8 * quad), pf, o[dt]);
            }
        }
        if (!(carry < SB_EPS)) flag[it % 3] = 1u;
    }
    bf16* op = mix + (rb + qpos) * D + 512 + h * 128 + 4 * quad;
#pragma unroll
    for (int dt = 0; dt < 8; ++dt) *(GAS v2u*)(op + 16 * dt) = (v2u){pk2(o[dt][0], o[dt][1]), pk2(o[dt][2], o[dt][3])};
}
struct XaRegs { v4u k[4], v[4]; };
DI void xa_load(XaRegs& R, const bf16* KV, int l, int b, int h, int c, int tid) {
    const bf16* pk = KV + (size_t)(b * MEMLEN + 64 * c + (tid >> 3)) * 8192 + 2048 * l + h * 256 + (tid & 7) * 32;
    const bf16* pv = KV + (size_t)(b * MEMLEN + 64 * c + (tid & 63)) * 8192 + 2048 * l + 1024 + h * 256 + (tid >> 6) * 32;
#pragma unroll
    for (int i = 0; i < 4; ++i) { R.k[i] = *(const GAS v4u*)(pk + 8 * i); R.v[i] = *(const GAS v4u*)(pv + 8 * i); }
}
DI void xattn_phase(Frame& F, const bf16* Q, const bf16* KV, int l, bf16* O) {
    constexpr int LDK = 264, LDV = 72, BUF = 64 * LDK + 256 * LDV;
    LAS bf16* lds = (LAS bf16*)F.lds;
    const int per = (2048 + F.G - 1) / F.G, u0 = F.wg * per, u1 = (u0 + per < 2048) ? u0 + per : 2048;
    if (u0 >= u1) return;
    const int w = F.wave, lane = F.lane, r = lane & 15, quad = lane >> 4, tid = F.tid;
    XaRegs R; xa_load(R, KV, l, (u0 >> 6) >> 2, (u0 >> 6) & 3, 0, tid);
    int step = 0;
    for (int u = u0; u < u1; ++u) {
        const int bh = u >> 6, qt = u & 63, b = bh >> 2, h = bh & 3;
        const size_t row = (size_t)b * T + qt * 128 + 16 * w + r;
        bf16x8 qf[8];
#pragma unroll
        for (int kk = 0; kk < 8; ++kk) qf[kk] = *(const GAS bf16x8*)(Q + row * D + h * 256 + 32 * kk + 8 * quad);
        f32x4 o[16];
#pragma unroll
        for (int i = 0; i < 16; ++i) o[i] = (f32x4){0.f, 0.f, 0.f, 0.f};
        float mrun = -1e30f, lsum = 0.f;
        for (int c = 0; c < 4; ++c, ++step) {
            LAS bf16* Kc = lds + (step & 1) * BUF; LAS bf16* Vt = Kc + 64 * LDK;
            { LAS bf16* kd = Kc + (tid >> 3) * LDK + (tid & 7) * 32;
#pragma unroll
              for (int i = 0; i < 4; ++i) *(LAS v4u*)(kd + 8 * i) = R.k[i];
              const int key = tid & 63, ds = (tid >> 6) * 32;
#pragma unroll
              for (int i = 0; i < 4; ++i) { const unsigned ww[4] = {R.v[i].x, R.v[i].y, R.v[i].z, R.v[i].w};
#pragma unroll
                  for (int e = 0; e < 4; ++e) { Vt[(ds + 8 * i + 2 * e) * LDV + key] = (bf16)(ww[e] & 0xffffu); Vt[(ds + 8 * i + 2 * e + 1) * LDV + key] = (bf16)(ww[e] >> 16); } } }
            lds_barrier();
            { const int un = (c == 3) ? u + 1 : u;
              if (un < u1) xa_load(R, KV, l, (un >> 6) >> 2, (un >> 6) & 3, (c + 1) & 3, tid); }
            f32x4 s[4];
#pragma unroll
            for (int mt = 0; mt < 4; ++mt) { s[mt] = (f32x4){0.f, 0.f, 0.f, 0.f};
                const LAS bf16* kp = Kc + (16 * mt + r) * LDK + 8 * quad;
#pragma unroll
                for (int kk = 0; kk < 8; ++kk) s[mt] = mfma16(*(const LAS bf16x8*)(kp + 32 * kk), qf[kk], s[mt]); }
            float mx = -1e30f;
#pragma unroll
            for (int mt = 0; mt < 4; ++mt) mx = fmaxf(fmaxf(fmaxf(s[mt][0], s[mt][1]), fmaxf(s[mt][2], s[mt][3])), mx);
            mx = fmaxf(mx, __shfl_xor(mx, 16)); mx = fmaxf(mx, __shfl_xor(mx, 32));
            const float mnew = fmaxf(mrun, mx), alpha = __expf((mrun - mnew) * 0.0625f); mrun = mnew;
            float ps = 0.f;
#pragma unroll
            for (int mt = 0; mt < 4; ++mt)
#pragma unroll
                for (int j = 0; j < 4; ++j) { const float p = __expf((s[mt][j] - mnew) * 0.0625f); s[mt][j] = p; ps += p; }
            lsum = lsum * alpha + ps;
#pragma unroll
            for (int i = 0; i < 16; ++i) o[i] = o[i] * alpha;
#pragma unroll
            for (int s2 = 0; s2 < 2; ++s2) {
                v4u pw; pw.x = pk2(s[2 * s2][0], s[2 * s2][1]); pw.y = pk2(s[2 * s2][2], s[2 * s2][3]); pw.z = pk2(s[2 * s2 + 1][0], s[2 * s2 + 1][1]); pw.w = pk2(s[2 * s2 + 1][2], s[2 * s2 + 1][3]);
                const bf16x8 pf = __builtin_bit_cast(bf16x8, pw);
#pragma unroll
                for (int dt = 0; dt < 16; ++dt) { const LAS bf16* vp = Vt + (16 * dt + r) * LDV + 32 * s2 + 4 * quad;
                    const s16x4 lo = *(const LAS s16x4*)vp, hi4 = *(const LAS s16x4*)(vp + 16);
                    o[dt] = mfma16(__builtin_shufflevector(lo, hi4, 0, 1, 2, 3, 4, 5, 6, 7), pf, o[dt]); }
            }
        }
        lsum += __shfl_xor(lsum, 16); lsum += __shfl_xor(lsum, 32);
        const float inv = rcp_(lsum);
        bf16* op = O + row * D + h * 256 + 4 * quad;
#pragma unroll
        for (int dt = 0; dt < 16; ++dt) *(GAS v2u*)(op + 16 * dt) = (v2u){pk2(o[dt][0] * inv, o[dt][1] * inv), pk2(o[dt][2] * inv, o[dt][3] * inv)};
    }
    lds_barrier();
}
template <class Epi> DI void run_gemm(Frame& F, const bf16* A, const bf16* Bt, int M_, int N_, int K_, const Epi& E) {
    pg8::Gemm g{A, Bt, M_, N_, K_}; pg8::StaticOrder S; S.init(M_, N_, F.G, F.wg);
    pg8::gemm_phase<Epi, pg8::StaticOrder, PG8_ALIGN, PG8_SP2>(F.lds, g, S, E, F.tid);
}
template <class Epi, class Sched> DI void run_gemm_s(Frame& F, const bf16* A, const bf16* Bt, int M_, int N_, int K_, const Sched& S, const Epi& E) {
    pg8::Gemm g{A, Bt, M_, N_, K_};
    pg8::gemm_phase<Epi, Sched, PG8_ALIGN, PG8_SP2>(F.lds, g, S, E, F.tid);
}
constexpr int MLPQ = 4, MQ = M / MLPQ;
constexpr int NPHASE = 3 + 4 * (7 + 2 * MLPQ) + 1, PH_FINAL = NPHASE - 1, PPL = 7 + 2 * MLPQ, PB0 = 3;
constexpr int SB_N1 = 512, SB_N2 = 1280;
struct Args { In in; float* out; unsigned char* ws; int ph_lo, ph_hi, region, pad; };
__global__ void __launch_bounds__(NTHR, 2) fwd(Args a) {
    extern __shared__ __attribute__((aligned(16))) unsigned char lds_raw[];
    Frame F;
    F.lds = (LAS unsigned char*)lds_raw;
    F.tid = threadIdx.x; F.lane = F.tid & 63; F.wave = __builtin_amdgcn_readfirstlane(F.tid >> 6);
    F.G = gridDim.x; F.wg = blockIdx.x; F.gw = F.wg * NWAVES + F.wave; F.NGW = F.G * NWAVES;
    volatile LAS unsigned* MISC = (volatile LAS unsigned*)(F.lds + MISC_OFF);
    if (F.tid < 32) MISC[F.tid] = 0u;
    __syncthreads();
    const int lo = a.ph_lo, hi = a.ph_hi;
    unsigned char* ws = a.ws; const In& I = a.in;
    XcdBarrier bar; bar.bar = (unsigned*)(ws + WS_CTL) + CW_BAR + a.region * XCD_BAR_WORDS; bar.x = 0; bar.st = MISC + 8;
    if (hi - lo > 1) bar = xcd_barrier_post(bar.bar, MISC + 8);
#define IN(k) (lo <= (k) && (k) < hi)
#ifndef PROBE_DOUBLE
#define PROBE_DOUBLE -1
#endif
#ifndef PROBE_PAR
#define PROBE_PAR -1
#endif
#define PHASE(k) asm volatile("" : "+v"(F.tid)); F.lane = F.tid & 63; if (IN(k))
#define DUPQ(c) ((c) == PROBE_DOUBLE && (PROBE_PAR < 0 || (l & 1) == PROBE_PAR))
#ifndef PROBE_SEL
#define PROBE_SEL -1
#endif
    F.tacc = 0ull;
    unsigned long long tacc = 0ull, tlast = (PROBE_SEL >= 0) ? __builtin_amdgcn_s_memrealtime() : 0ull;
#define SELQ(k) ((PROBE_SEL >= 0 && PROBE_SEL <= 12) ? ((k) >= PB0 && (k) < PH_FINAL && ((k) - PB0) % PPL == PROBE_SEL && (PROBE_PAR < 0 || ((((k) - PB0) / PPL) & 1) == PROBE_PAR)) : (PROBE_SEL == 101 ? (k) == 0 : (PROBE_SEL == 102 ? (k) == 1 : (PROBE_SEL == 103 ? (k) == PH_FINAL : false))))
#define SEAM(k) do { if (IN(k) && IN((k) + 1)) { \
        if (PROBE_SEL >= 0) { const unsigned long long tn_ = __builtin_amdgcn_s_memrealtime(); if (SELQ(k)) tacc += tn_ - tlast; tlast = tn_; } \
        xcd_barrier(bar); \
        if (PROBE_SEL >= 0) { const unsigned long long tn_ = __builtin_amdgcn_s_memrealtime(); if (PROBE_SEL == 100 || (PROBE_SEL >= 200 && (k) >= PB0 && (k) < PH_FINAL && ((k) - PB0) % PPL == PROBE_SEL - 200 && (PROBE_PAR < 0 || ((((k) - PB0) / PPL) & 1) == PROBE_PAR))) tacc += tn_ - tlast; tlast = tn_; } } } while (0)
    bf16* XS = (bf16*)(ws + WS_H); unsigned char* mixb = (unsigned char*)a.out; bf16* MIX = (bf16*)mixb; unsigned char* scrb = mixb + 128 * MiB; bf16* SCR = (bf16*)scrb;
    bf16* BIG = (bf16*)(ws + WS_BIG); bf16* KVX = (bf16*)(ws + WS_KVX); bf16* WQK = (bf16*)(ws + WS_MIX); bf16* VWO = WQK + (size_t)32768 * 1024;
    float* GATE = (float*)(ws + WS_GATE); const bf16* WG = (const bf16*)(ws + WS_WG);

    PHASE(0) { p0_prologue(F, I, ws);
#ifdef PROBE_P0
        p0_prologue(F, I, ws);
#endif
    }
    SEAM(0);
    PHASE(1) {
        pg8::StaticOrder S; S.init(BATCH * MEMLEN, 8192, F.G, F.wg);
        run_gemm_s(F, (const bf16*)(ws + WS_MEMN), (const bf16*)(ws + WS_WKV), BATCH * MEMLEN, 8192, D, S, pg8::EpiTile{KVX, 0, 0, nullptr});
    }
    SEAM(1);
    PHASE(2) {
        constexpr int WLT = (int)(W_LAYER / 131072); static_assert(W_LAYER % 131072 == 0, "layer stride in 256 x 256 bf16 blocks");
        { pg8::FoldOrder S{F.G, F.wg, 0, WLT}; run_gemm_s(F, KVX, (const bf16*)(ws + WS_W + WO_WQ), 32768, 1024, 256, S, pg8::EpiFold{WQK, 0}); }
        { pg8::FoldOrder S{F.G, F.wg, 1, WLT}; run_gemm_s(F, (const bf16*)(ws + WS_W + WO_WO), KVX + (size_t)128 * 65536, 32768, 1024, 256, S, pg8::EpiFold{VWO, 1}); }
    }
    SEAM(2);
    pg8::rs_t* RSA = (pg8::rs_t*)(ws + WS_RS);
#define RS_R(p) (RSA + (size_t)((p) & 1) * M)
#define RS_ZERO(p) do { pg8::rs_t* z_ = RSA + (size_t)(((p) + 1) & 1) * M; for (int i_ = F.wg * NTHR + F.tid; i_ < M; i_ += F.G * NTHR) __hip_atomic_store(z_ + i_, (pg8::rs_t)0, __ATOMIC_RELAXED, __HIP_MEMORY_SCOPE_AGENT); } while (0)
    for (int l = 0; l < DEPTH; ++l) {
        asm volatile("" : "+v"(F.tid)); F.lane = F.tid & 63;
        const int pb = PB0 + PPL * l, j = l >> 1; const bool odd = (l & 1) != 0;
        const int SBW = (F.G == 256) ? ((F.wg & 7) * 32 + (F.wg >> 3)) : F.wg;
        unsigned char* wl = ws + WS_W + (size_t)l * W_LAYER;
        PHASE(pb + 0) { const int n = odd ? C_N : AB_N;
            run_gemm(F, XS, (const bf16*)(wl + WO_WIN), M, n, D, pg8::EpiBlk{BIG, odd ? (bf16*)(mixb + MIX_HALO) : nullptr, odd ? 2 : 1, RS_R(3 * l)});
            if (DUPQ(0)) { run_gemm(F, XS, (const bf16*)(wl + WO_WIN), M, n, D, pg8::EpiBlk{BIG, odd ? (bf16*)(mixb + MIX_HALO) : nullptr, odd ? 2 : 1, RS_R(3 * l)}); }
            if (!odd) gates_phase<1>(F, XS, RS_R(3 * l), WG + l * 16384, GATE, I.p[4] + j * 4, I.p[5] + j * 4);
            else gates_phase<2>(F, XS, RS_R(3 * l), WG + l * 16384, GATE, I.p[10] + j * 8, I.p[11] + j * 8);
        }
        SEAM(pb + 0);
        PHASE(pb + 1) {
            if (!odd) {
                mlstm_a_phase(F, BIG, GATE, (bf16*)(scrb + H_NUML), (bf16*)(scrb + H_DC), (float*)(ws + WS_MLS));
                for (int u = SBW; u < SB_N1; u += F.G) sb_unit(F, BIG, MIX, u);
            } else {
                gdn_g1_phase(F, BIG, (const bf16*)(mixb + MIX_HALO), GATE, I.p[9] + (size_t)j * 4 * 3072, SCR, (bf16*)(mixb + MIX_AT), (float*)(mixb + MIX_GL), true);
            }
        }
        SEAM(pb + 1);
        PHASE(pb + 2) {
            if (odd) { for (int c0 = F.wg; c0 < 256; c0 += F.G) {
                    const int x = c0 & 7, k = c0 >> 3, c = ((x * 8 + (k >> 2)) << 2) | (k & 3);
                    gdn_g2_chain(F, BIG, SCR, (const bf16*)(mixb + MIX_AT), (const float*)(mixb + MIX_GL), c, true); } }
            else { mlstm_b_phase(F, (bf16*)(scrb + H_DC), (float*)(ws + WS_MLS)); for (int u = SB_N1 + SBW; u < SB_N2; u += F.G) sb_unit(F, BIG, MIX, u); }
        }
        SEAM(pb + 2);
        PHASE(pb + 3) {
            if (odd) headnorm_phase<true>(F, SCR, MIX, BIG, I.p[12] + j * 128);
            else { mlstm_c_phase(F, BIG, (const bf16*)(scrb + H_NUML), (const bf16*)(scrb + H_DC), (const float*)(ws + WS_MLS), I.p[6] + j * 512, MIX); for (int u = SB_N2 + SBW; u < 2048; u += F.G) sb_unit(F, BIG, MIX, u); }
        }
        SEAM(pb + 3);
        PHASE(pb + 4) { RS_ZERO(3 * l + 1); run_gemm(F, MIX, (const bf16*)(wl + WO_WOUT), M, D, D, pg8::EpiResidB{XS, RS_R(3 * l + 1)}); }
        SEAM(pb + 4);
        static_assert(PG8_ALIGN, "EpiSoftmaxP has a workgroup barrier inside the epilogue: both half-workgroups must run their epilogues together (ALIGN_EPI)");
        PHASE(pb + 5) { pg8::XbOrder S{F.G, F.wg, 4 * (M / 256), T / 256, l};
            run_gemm_s(F, XS, WQK, M, D, D, S, pg8::EpiSoftmaxP{BIG, (LAS float*)(F.lds + 131072), RS_R(3 * l + 1)}); }
        SEAM(pb + 5);
        PHASE(pb + 6) { RS_ZERO(3 * l + 2); pg8::XbOrder S{F.G, F.wg, 4 * (M / 256), T / 256, l};
            run_gemm_s(F, BIG, VWO, M, D, D, S, pg8::EpiResidBx{XS, RS_R(3 * l + 2)}); }
        SEAM(pb + 6);
#pragma unroll 1
        for (int q = 0; q < MLPQ; ++q) {
            PHASE(pb + 7 + 2 * q) { run_gemm(F, XS + (size_t)q * MQ * D, (const bf16*)(wl + WO_W1), MQ, FF, D, pg8::EpiBf16<2>{BIG, FF, RS_R(3 * l + 2) + (size_t)q * MQ}); }
            SEAM(pb + 7 + 2 * q);
            PHASE(pb + 8 + 2 * q) { if (q == MLPQ - 1) RS_ZERO(3 * l + 3);     run_gemm(F, BIG, (const bf16*)(wl + WO_W2), MQ, D, FF, pg8::EpiResidB{XS + (size_t)q * MQ * D, RS_R(3 * l + 3) + (size_t)q * MQ}); }
            SEAM(pb + 8 + 2 * q);
        }
    }
    PHASE(PH_FINAL) final_norm_phase(F, XS, a.out, I.p[23]);
    if (PROBE_SEL >= 0) { const unsigned long long te = __builtin_amdgcn_s_memrealtime(); if (SELQ(PH_FINAL)) tacc += te - tlast;

#ifdef PROBE_WGLO
        if (!(F.wg >= PROBE_WGLO && F.wg < PROBE_WGHI)) tacc = 0ull;
#endif
        if (PROBE_STG >= 0) tacc = F.tacc;
        while (__builtin_amdgcn_s_memrealtime() - te < tacc) __builtin_amdgcn_s_sleep(16); }
#undef IN
#undef PHASE
#undef SEAM
}

#ifndef MK_SPLIT
#define MK_SPLIT 0
#endif
extern "C" void kernel_launch(void* const* d_in, const int* in_sizes, int n_in, void* d_out, int out_size, void* d_ws, size_t ws_size, hipStream_t stream) {
    static int grid = 0;
    if (grid == 0) {
        if (n_in != 24 || in_sizes[0] != M * D || out_size != M * D || ws_size < WS_END) { fprintf(stderr, "kernel_launch: unexpected shapes (n_in %d, in0 %d, out %d, ws %zu)\n", n_in, n_in > 0 ? in_sizes[0] : -1, out_size, ws_size); grid = -1; return; }
        int dev = 0, cus = 0;
        if (hipGetDevice(&dev) != hipSuccess || hipDeviceGetAttribute(&cus, hipDeviceAttributeMultiprocessorCount, dev) != hipSuccess) { grid = -1; return; }
        if (hipFuncSetAttribute((const void*)fwd, hipFuncAttributeMaxDynamicSharedMemorySize, LDS_BYTES) != hipSuccess) { fprintf(stderr, "kernel_launch: hipFuncSetAttribute failed\n"); grid = -1; return; }
        (void)hipGetLastError();
        grid = cus;
    }
    if (grid < 0) return;
    (void)hipMemsetAsync((char*)d_ws + WS_CTL, 0, CTL_ZERO_BYTES, stream);
    Args a{};
    for (int i = 0; i < 24; ++i) a.in.p[i] = (const float*)d_in[i];
    a.out = (float*)d_out; a.ws = (unsigned char*)d_ws; a.region = 0; a.pad = 0;
#if MK_SPLIT
    for (int p = 0; p < NPHASE; ++p) { a.ph_lo = p; a.ph_hi = p + 1; hipLaunchKernelGGL(fwd, dim3(grid), dim3(NTHR), LDS_BYTES, stream, a); }
#else
    a.ph_lo = 0; a.ph_hi = NPHASE; hipLaunchKernelGGL(fwd, dim3(grid), dim3(NTHR), LDS_BYTES, stream, a);
#endif
}
```
